# Optimizing an MI355X kernel written in HIP

```python
import math
import jax
import jax.numpy as jnp
from jax import lax
import numpy as np

D_MODEL = 1024
BATCH = 4
SEQ = 4096
DEPTH = 4

CHUNK = 64
N_MIXERS = 2
CONV_WIDTH = 4
EPS = 1e-6

D_RNN = D_MODEL
LRU_BLOCKS = 8
LRU_BLOCK_W = D_RNN // LRU_BLOCKS
RG_C = 8.0

GDN_HEAD_DIM = 128
GDN_HEADS = max(4, D_MODEL // GDN_HEAD_DIM)
GDN_DK = GDN_HEAD_DIM
GDN_DV = GDN_HEAD_DIM
GDN_HK = GDN_HEADS * GDN_DK
GDN_HV = GDN_HEADS * GDN_DV
GDN_PROJ = 2 * GDN_HK + 2 * GDN_HV + 2 * GDN_HEADS

kernel_name = "hybrid_rglru_gdn_adaln_trunk"


def rmsnorm(x, g):
    xf = x.astype(jnp.float32)
    y = xf * lax.rsqrt(jnp.mean(xf * xf, axis=-1, keepdims=True) + EPS)
    return (y * g.astype(jnp.float32)).astype(x.dtype)


def l2norm(x):
    return x * lax.rsqrt(jnp.sum(x * x, axis=-1, keepdims=True) + EPS)


def causal_dwconv(x, w):
    k = w.shape[0]
    s = x.shape[1]
    xp = jnp.pad(x, ((0, 0), (k - 1, 0), (0, 0)))
    out = xp[:, 0:s] * w[0]
    for j in range(1, k):
        out = out + xp[:, j:j + s] * w[j]
    return out


def _lin_combine(e1, e2):
    a1, b1 = e1
    a2, b2 = e2
    return a1 * a2, a2 * b1 + b2


def rglru_block(h, in_w, conv_w, conv_b, gate_w, gate_b, lam, out_w):
    bsz, s, _ = h.shape
    proj = h @ in_w
    xb, zg = proj[..., :D_RNN], proj[..., D_RNN:]
    xb = causal_dwconv(xb, conv_w) + conv_b
    xf = xb.astype(jnp.float32)
    xg = xf.reshape(bsz, s, LRU_BLOCKS, LRU_BLOCK_W)
    pre = jnp.einsum('bsni,knij->kbsnj', xg, gate_w.astype(jnp.float32))
    pre = pre.reshape(2, bsz, s, D_RNN) + gate_b.astype(jnp.float32)[:, None, None, :]
    gates = jax.nn.sigmoid(pre)
    r_t, i_t = gates[0], gates[1]
    log_a = -RG_C * r_t * jax.nn.softplus(-lam.astype(jnp.float32))
    a_t = jnp.exp(log_a)
    mult = jnp.sqrt(-jnp.expm1(2.0 * log_a))
    b_t = mult * (i_t * xf)
    _, hseq = lax.associative_scan(_lin_combine, (a_t, b_t), axis=1)
    y = hseq.astype(h.dtype) * jax.nn.silu(zg)
    return y @ out_w


def chunk_gated_delta_rule(q, k, v, g, beta):
    bsz, s, nh, dk = q.shape
    dv = v.shape[-1]
    n = s // CHUNK

    def to_chunks(t):
        return t.reshape(bsz, n, CHUNK, nh, -1).transpose(0, 3, 1, 2, 4)

    q, k, v = to_chunks(q), to_chunks(k), to_chunks(v)
    g = g.reshape(bsz, n, CHUNK, nh).transpose(0, 3, 1, 2)
    beta = beta.reshape(bsz, n, CHUNK, nh).transpose(0, 3, 1, 2)
    g = jnp.cumsum(g, axis=-1)
    idx = jnp.arange(CHUNK)
    causal = idx[:, None] >= idx[None, :]
    strict = idx[:, None] > idx[None, :]
    diff = g[..., :, None] - g[..., None, :]
    decay_mask = jnp.exp(jnp.where(causal, diff, -jnp.inf))
    k_beta = k * beta[..., None]
    v_beta = v * beta[..., None]
    a_mat = jnp.where(strict, jnp.einsum('bhncd,bhnmd->bhncm', k_beta, k) * decay_mask, 0.0)
    eye = jnp.eye(CHUNK, dtype=jnp.float32)
    t_mat = lax.linalg.triangular_solve(a_mat + eye, jnp.broadcast_to(eye, a_mat.shape),
                                        left_side=True, lower=True)
    w = jnp.einsum('bhncm,bhnmd->bhncd', t_mat, k_beta * jnp.exp(g)[..., None])
    u = jnp.einsum('bhncm,bhnmd->bhncd', t_mat, v_beta)
    attn = jnp.where(causal, jnp.einsum('bhncd,bhnmd->bhncm', q, k) * decay_mask, 0.0)
    g_last = g[..., -1]
    q_dec = q * jnp.exp(g)[..., None]
    k_dec = k * jnp.exp(g_last[..., None] - g)[..., None]
    e_last = jnp.exp(g_last)

    def step(state, inp):
        w_c, u_c, attn_c, q_c, k_c, e_c = inp
        v_new = u_c - jnp.einsum('bhcd,bhde->bhce', w_c, state)
        o_c = jnp.einsum('bhcd,bhde->bhce', q_c, state) + jnp.einsum('bhcm,bhme->bhce', attn_c, v_new)
        state = state * e_c[..., None, None] + jnp.einsum('bhcd,bhce->bhde', k_c, v_new)
        return state, o_c

    def lead(t):
        return jnp.moveaxis(t, 2, 0)

    s0 = jnp.zeros((bsz, nh, dk, dv), jnp.float32)
    _, o = lax.scan(step, s0, (lead(w), lead(u), lead(attn), lead(q_dec), lead(k_dec), lead(e_last)))
    return o.transpose(1, 0, 3, 2, 4).reshape(bsz, s, nh, dv)


def gated_deltanet_block(h, in_w, conv_w, a_log, dt_bias, onorm_g, out_w):
    bsz, s, _ = h.shape
    proj = h @ in_w
    o1 = 2 * GDN_HK + GDN_HV
    o2 = o1 + GDN_HV
    qkv = jax.nn.silu(causal_dwconv(proj[..., :o1], conv_w))
    z = proj[..., o1:o2]
    a_in = proj[..., o2:o2 + GDN_HEADS]
    b_in = proj[..., o2 + GDN_HEADS:]
    qkv = qkv.astype(jnp.float32)
    q = qkv[..., :GDN_HK].reshape(bsz, s, GDN_HEADS, GDN_DK)
    k = qkv[..., GDN_HK:2 * GDN_HK].reshape(bsz, s, GDN_HEADS, GDN_DK)
    v = qkv[..., 2 * GDN_HK:].reshape(bsz, s, GDN_HEADS, GDN_DV)
    q = l2norm(q) * (GDN_DK ** -0.5)
    k = l2norm(k)
    beta = jax.nn.sigmoid(b_in.astype(jnp.float32))
    g = -jnp.exp(a_log.astype(jnp.float32)) * jax.nn.softplus(
        a_in.astype(jnp.float32) + dt_bias.astype(jnp.float32))
    o = chunk_gated_delta_rule(q, k, v, g, beta)
    o = o * lax.rsqrt(jnp.mean(o * o, axis=-1, keepdims=True) + EPS) * onorm_g.astype(jnp.float32)
    o = o.astype(h.dtype) * jax.nn.silu(z.reshape(bsz, s, GDN_HEADS, GDN_DV))
    return o.reshape(bsz, s, GDN_HV) @ out_w


def setup_inputs(seed: int = 0) -> dict:
    key = jax.random.key(seed)
    ks = jax.random.split(key, 24)
    n_a = (DEPTH + 1) // 2
    n_b = DEPTH // 2
    f32 = jnp.float32
    nrm = lambda k, shp, sc: jax.random.normal(k, shp, f32) * sc
    x = jax.random.normal(ks[0], (BATCH, SEQ, D_MODEL), f32)
    c = jax.random.normal(ks[1], (BATCH, D_MODEL), f32)
    ada_w = nrm(ks[2], (DEPTH, D_MODEL, 3 * D_MODEL), 0.5 * D_MODEL ** -0.5)
    ada_b = nrm(ks[3], (DEPTH, 3 * D_MODEL), 0.02)
    norm_g = 1.0 + nrm(ks[4], (DEPTH, D_MODEL), 0.02)
    final_g = 1.0 + nrm(ks[5], (D_MODEL,), 0.02)
    lru_in_w = nrm(ks[6], (n_a, D_MODEL, 2 * D_RNN), D_MODEL ** -0.5)
    lru_conv_w = nrm(ks[7], (n_a, CONV_WIDTH, D_RNN), CONV_WIDTH ** -0.5)
    lru_conv_b = nrm(ks[8], (n_a, D_RNN), 0.01)
    lru_gate_w = nrm(ks[9], (n_a, 2, LRU_BLOCKS, LRU_BLOCK_W, LRU_BLOCK_W), LRU_BLOCK_W ** -0.5)
    lru_gate_b = nrm(ks[10], (n_a, 2, D_RNN), 0.01)
    a_target = jax.random.uniform(ks[11], (n_a, D_RNN), f32, 0.9, 0.999)
    s_lam = a_target ** (1.0 / RG_C)
    lru_lambda = jnp.log(s_lam) - jnp.log1p(-s_lam)
    lru_out_w = nrm(ks[12], (n_a, D_RNN, D_MODEL), D_RNN ** -0.5)
    gdn_in_w = nrm(ks[13], (n_b, D_MODEL, GDN_PROJ), D_MODEL ** -0.5)
    gdn_conv_w = nrm(ks[14], (n_b, CONV_WIDTH, 2 * GDN_HK + GDN_HV), CONV_WIDTH ** -0.5)
    gdn_a_log = jnp.log(jax.random.uniform(ks[15], (n_b, GDN_HEADS), f32, 1.0, 16.0))
    dt = jnp.exp(jax.random.uniform(ks[16], (n_b, GDN_HEADS), f32, math.log(1e-3), math.log(1e-1)))
    gdn_dt_bias = dt + jnp.log(-jnp.expm1(-dt))
    gdn_onorm_g = 1.0 + nrm(ks[17], (n_b, GDN_DV), 0.02)
    gdn_out_w = nrm(ks[18], (n_b, GDN_HV, D_MODEL), GDN_HV ** -0.5)
    return {"x": x, "c": c, "ada_w": ada_w, "ada_b": ada_b, "norm_g": norm_g, "final_g": final_g,
            "lru_in_w": lru_in_w, "lru_conv_w": lru_conv_w, "lru_conv_b": lru_conv_b,
            "lru_gate_w": lru_gate_w, "lru_gate_b": lru_gate_b, "lru_lambda": lru_lambda,
            "lru_out_w": lru_out_w,
            "gdn_in_w": gdn_in_w, "gdn_conv_w": gdn_conv_w, "gdn_a_log": gdn_a_log,
            "gdn_dt_bias": gdn_dt_bias, "gdn_onorm_g": gdn_onorm_g, "gdn_out_w": gdn_out_w}


def reference(x, c, ada_w, ada_b, norm_g, final_g,
              lru_in_w, lru_conv_w, lru_conv_b, lru_gate_w, lru_gate_b, lru_lambda, lru_out_w,
              gdn_in_w, gdn_conv_w, gdn_a_log, gdn_dt_bias, gdn_onorm_g, gdn_out_w):
    c_act = jax.nn.silu(c)
    for i in range(DEPTH):
        cond = c_act @ ada_w[i] + ada_b[i]
        shift = cond[:, None, :D_MODEL]
        scale = cond[:, None, D_MODEL:2 * D_MODEL]
        gate = cond[:, None, 2 * D_MODEL:]
        h = rmsnorm(x, norm_g[i]) * (1.0 + scale) + shift
        j = i // N_MIXERS
        if i % N_MIXERS == 0:
            out = rglru_block(h, lru_in_w[j], lru_conv_w[j], lru_conv_b[j], lru_gate_w[j],
                              lru_gate_b[j], lru_lambda[j], lru_out_w[j])
        else:
            out = gated_deltanet_block(h, gdn_in_w[j], gdn_conv_w[j], gdn_a_log[j],
                                       gdn_dt_bias[j], gdn_onorm_g[j], gdn_out_w[j])
        x = x + gate * out
    return rmsnorm(x, final_g)
```

```cpp
#include <hip/hip_runtime.h>
#include <hip/hip_cooperative_groups.h>
#include <cstdio>
namespace cg = cooperative_groups;

#ifndef MK_MODE
#define MK_MODE 1
#endif

typedef unsigned short bfr;
typedef __attribute__((ext_vector_type(8))) short bf16x8;
typedef __attribute__((ext_vector_type(4))) short bf16x4;
typedef __attribute__((ext_vector_type(4))) float f32x4;
typedef __attribute__((ext_vector_type(4))) unsigned u32x4;
typedef __attribute__((ext_vector_type(2))) unsigned u32x2;

#define DI __device__ __forceinline__
#define MFMA16(a, b, c) __builtin_amdgcn_mfma_f32_16x16x32_bf16((a), (b), (c), 0, 0, 0)

constexpr int PLD = 4112;
constexpr float EPS = 1e-6f;
constexpr int NPHASE = 22;
constexpr int LDS_BYTES = 163840;

constexpr size_t O_WLI = 0;
constexpr size_t O_WLO = 8388608;
constexpr size_t O_WGI = 12582912;
constexpr size_t O_WGO = 29884416;
constexpr size_t O_WG = 34078720;
constexpr size_t O_CONDP = 35127296;
constexpr size_t O_H = 36700160;
constexpr size_t O_PROJ = 70254592;
constexpr size_t O_ATTN = 204996608;
constexpr size_t O_HALO = 221773824;
constexpr size_t O_SCR = 226492416;
constexpr size_t O_AB = 260046848;
constexpr size_t O_ELAST = 261095424;
constexpr size_t O_AGG = 261103616;
constexpr size_t WS_END = 263200768;

struct Params {
  const float *x, *c, *ada_w, *ada_b, *norm_g, *final_g;
  const float *lru_in_w, *lru_conv_w, *lru_conv_b, *lru_gate_w, *lru_gate_b, *lru_lambda, *lru_out_w;
  const float *gdn_in_w, *gdn_conv_w, *gdn_a_log, *gdn_dt_bias, *gdn_onorm_g, *gdn_out_w;
  float* out;
  char* ws;
  int ph_lo, ph_hi;
};

DI int otid() { int t = threadIdx.x; asm volatile("" : "+v"(t)); return t; }
DI int obid() { int b = blockIdx.x; asm volatile("" : "+s"(b)); return b; }
DI bfr f2bf(float x) { unsigned u = __float_as_uint(x); u += 0x7fffu + ((u >> 16) & 1u); return (bfr)(u >> 16); }
DI float bf2f(bfr b) { return __uint_as_float(((unsigned)b) << 16); }
DI unsigned pack2(float a, float b) { return (unsigned)f2bf(a) | ((unsigned)f2bf(b) << 16); }
DI float sigmoidf_(float x) { return 1.f / (1.f + __expf(-x)); }
DI float siluf_(float x) { return x / (1.f + __expf(-x)); }
DI float softplusf_(float x) { return x > 20.f ? x : log1pf(expf(x)); }
DI float bfe(const bf16x8& v, int e) { return bf2f((bfr)v[e]); }

DI char* ows(const Params& p) { char* w = p.ws; asm volatile("" : "+s"(w)); return w; }
DI float cond_get(const Params& p, int layer, int b, int n) {
  const float* cp = (const float*)(ows(p) + O_CONDP);
  float s = p.ada_b[layer * 3072 + n];
#pragma unroll
  for (int sg = 0; sg < 8; ++sg) s += cp[((sg * 4 + layer) * 4 + b) * 3072 + n];
  return s;
}

DI void transpose_tile(const float* __restrict__ src, int ldsrc, int nvalid, bfr* __restrict__ dst, int ldd, int k0, int n0, float* sm) {
  const int tid = otid();
  for (int e = tid; e < 4096; e += 512) {
    int kk = e >> 6, nn = e & 63;
    float v = 0.f;
    if (n0 + nn < nvalid) v = src[(size_t)(k0 + kk) * ldsrc + n0 + nn];
    sm[kk * 65 + nn] = v;
  }
  __syncthreads();
  for (int e = tid; e < 4096; e += 512) {
    int nn = e >> 6, kk = e & 63;
    dst[(size_t)(n0 + nn) * ldd + k0 + kk] = f2bf(sm[kk * 65 + nn]);
  }
  __syncthreads();
}

DI void phase0(const Params& p, char* lds) {
  float* sm = (float*)lds;
  const int tid = otid();
  for (int it = obid(); it < 4480; it += gridDim.x) {
    if (it < 1024) {
      int l = it >> 9, r = it & 511, kt = r >> 5, nt = r & 31;
      transpose_tile(p.lru_in_w + (size_t)l * 1024 * 2048, 2048, 2048, (bfr*)(ows(p) + O_WLI) + (size_t)l * 2048 * 1024, 1024, kt * 64, nt * 64, sm);
    } else if (it < 1536) {
      int r0 = it - 1024, l = r0 >> 8, r = r0 & 255, kt = r >> 4, nt = r & 15;
      transpose_tile(p.lru_out_w + (size_t)l * 1024 * 1024, 1024, 1024, (bfr*)(ows(p) + O_WLO) + (size_t)l * 1024 * 1024, 1024, kt * 64, nt * 64, sm);
    } else if (it < 3648) {
      int r0 = it - 1536, l = r0 / 1056, r = r0 % 1056, kt = r / 66, nt = r % 66;
      transpose_tile(p.gdn_in_w + (size_t)l * 1024 * 4112, 4112, 4112, (bfr*)(ows(p) + O_WGI) + (size_t)l * 4224 * 1024, 1024, kt * 64, nt * 64, sm);
    } else if (it < 4160) {
      int r0 = it - 3648, l = r0 >> 8, r = r0 & 255, kt = r >> 4, nt = r & 15;
      transpose_tile(p.gdn_out_w + (size_t)l * 1024 * 1024, 1024, 1024, (bfr*)(ows(p) + O_WGO) + (size_t)l * 1024 * 1024, 1024, kt * 64, nt * 64, sm);
    } else if (it < 4288) {
      int r0 = it - 4160, mat = r0 >> 2, r = r0 & 3, kt = r >> 1, nt = r & 1;
      transpose_tile(p.lru_gate_w + (size_t)mat * 16384, 128, 128, (bfr*)(ows(p) + O_WG) + (size_t)mat * 16384, 128, kt * 64, nt * 64, sm);
    } else {
      int r0 = it - 4288, i = r0 / 48, r = r0 % 48, s = r / 6, cb = r % 6;
      sm[tid] = siluf_(p.c[(tid >> 7) * 1024 + s * 128 + (tid & 127)]);
      __syncthreads();
      int n = cb * 512 + tid;
      float a0 = 0.f, a1 = 0.f, a2 = 0.f, a3 = 0.f;
      const float* w = p.ada_w + ((size_t)i * 1024 + s * 128) * 3072 + n;
#pragma unroll 8
      for (int k = 0; k < 128; ++k) {
        float wv = w[(size_t)k * 3072];
        a0 += sm[k] * wv; a1 += sm[128 + k] * wv; a2 += sm[256 + k] * wv; a3 += sm[384 + k] * wv;
      }
      float* cp = (float*)(ows(p) + O_CONDP);
      cp[((s * 4 + i) * 4 + 0) * 3072 + n] = a0;
      cp[((s * 4 + i) * 4 + 1) * 3072 + n] = a1;
      cp[((s * 4 + i) * 4 + 2) * 3072 + n] = a2;
      cp[((s * 4 + i) * 4 + 3) * 3072 + n] = a3;
      __syncthreads();
    }
  }
}

DI void norm_phase(const Params& p, int layer, const float* __restrict__ xs, char* lds) {
  float* gm = (float*)lds;
  float* sh = gm + 1024;
  const int tid = otid(), lane = tid & 63, wv = tid >> 6;
  bfr* H = (bfr*)(ows(p) + O_H);
  for (int rt = obid(); rt < 256; rt += gridDim.x) {
    int b = rt >> 6;
    for (int c = tid; c < 1024; c += 512) {
      if (layer < 4) {
        float scale = cond_get(p, layer, b, 1024 + c), shift = cond_get(p, layer, b, c);
        gm[c] = p.norm_g[layer * 1024 + c] * (1.f + scale);
        sh[c] = shift;
      } else {
        gm[c] = p.final_g[c];
        sh[c] = 0.f;
      }
    }
    __syncthreads();
    for (int r = 0; r < 8; ++r) {
      size_t row = (size_t)rt * 64 + wv * 8 + r;
      f32x4 v[4];
      float ss = 0.f;
#pragma unroll
      for (int jx = 0; jx < 4; ++jx) {
        v[jx] = *(const f32x4*)&xs[row * 1024 + jx * 256 + lane * 4];
        ss += v[jx][0] * v[jx][0] + v[jx][1] * v[jx][1] + v[jx][2] * v[jx][2] + v[jx][3] * v[jx][3];
      }
#pragma unroll
      for (int o = 1; o < 64; o <<= 1) ss += __shfl_xor(ss, o);
      float rstd = rsqrtf(ss * (1.f / 1024.f) + EPS);
#pragma unroll
      for (int jx = 0; jx < 4; ++jx) {
        int c = jx * 256 + lane * 4;
        f32x4 g4 = *(const f32x4*)&gm[c], s4 = *(const f32x4*)&sh[c];
        f32x4 y;
#pragma unroll
        for (int e = 0; e < 4; ++e) y[e] = v[jx][e] * rstd * g4[e] + s4[e];
        if (layer < 4) {
          u32x2 o2; o2[0] = pack2(y[0], y[1]); o2[1] = pack2(y[2], y[3]);
          *(u32x2*)&H[row * 1024 + c] = o2;
        } else {
          *(f32x4*)&p.out[row * 1024 + c] = y;
        }
      }
    }
    __syncthreads();
  }
}

template <int EPI>
DI void gemm_phase(const Params& p, const bfr* __restrict__ A, int lda, const bfr* __restrict__ Bt, int nN, int layer, const float* __restrict__ xin, char* lds) {
  bfr* As = (bfr*)lds;
  bfr* Bs = As + 2 * 256 * 72;
  const int tid = otid(), lane = tid & 63, wv = tid >> 6, wm = wv >> 1, wn = wv & 1, l15 = lane & 15, q = lane >> 4;
  const int total = 64 * nN;
  bfr* PROJ = (bfr*)(ows(p) + O_PROJ);
  for (int tile = obid(); tile < total; tile += gridDim.x) {
    const int mt = tile / nN, nt = tile - mt * nN;
    const int m0 = mt * 256, n0 = nt * 128;
    f32x4 acc[4][4];
#pragma unroll
    for (int a = 0; a < 4; ++a)
#pragma unroll
      for (int b = 0; b < 4; ++b) acc[a][b] = (f32x4){0.f, 0.f, 0.f, 0.f};
    const bfr* Ag = A + (size_t)m0 * lda;
    const bfr* Bg = Bt + (size_t)n0 * 1024;
    u32x4 ra[4], rb[2];
#define GLOAD(kt)                                                                                   \
  {                                                                                                 \
    _Pragma("unroll") for (int i = 0; i < 4; ++i) {                                                 \
      int id = tid + 512 * i, r = id >> 3, kc = id & 7;                                             \
      ra[i] = *(const u32x4*)(Ag + (size_t)r * lda + (kt) * 64 + kc * 8);                           \
    }                                                                                               \
    _Pragma("unroll") for (int i = 0; i < 2; ++i) {                                                 \
      int id = tid + 512 * i, r = id >> 3, kc = id & 7;                                             \
      rb[i] = *(const u32x4*)(Bg + (size_t)r * 1024 + (kt) * 64 + kc * 8);                          \
    }                                                                                               \
  }
#define LSTORE(buf)                                                                                 \
  {                                                                                                 \
    _Pragma("unroll") for (int i = 0; i < 4; ++i) {                                                 \
      int id = tid + 512 * i, r = id >> 3, kc = id & 7;                                             \
      *(u32x4*)(As + (buf) * 256 * 72 + r * 72 + kc * 8) = ra[i];                                   \
    }                                                                                               \
    _Pragma("unroll") for (int i = 0; i < 2; ++i) {                                                 \
      int id = tid + 512 * i, r = id >> 3, kc = id & 7;                                             \
      *(u32x4*)(Bs + (buf) * 128 * 72 + r * 72 + kc * 8) = rb[i];                                   \
    }                                                                                               \
  }
    GLOAD(0);
    LSTORE(0);
    __syncthreads();
    for (int kt = 0; kt < 16; ++kt) {
      if (kt < 15) GLOAD(kt + 1);
      const bfr* Ab = As + (kt & 1) * 256 * 72 + (wm * 64 + l15) * 72 + q * 8;
      const bfr* Bb = Bs + (kt & 1) * 128 * 72 + (wn * 64 + l15) * 72 + q * 8;
#pragma unroll
      for (int ks = 0; ks < 2; ++ks) {
        bf16x8 af[4], bfg[4];
#pragma unroll
        for (int mi = 0; mi < 4; ++mi) af[mi] = *(const bf16x8*)(Ab + mi * 16 * 72 + ks * 32);
#pragma unroll
        for (int ni = 0; ni < 4; ++ni) bfg[ni] = *(const bf16x8*)(Bb + ni * 16 * 72 + ks * 32);
#pragma unroll
        for (int mi = 0; mi < 4; ++mi)
#pragma unroll
          for (int ni = 0; ni < 4; ++ni) acc[mi][ni] = MFMA16(af[mi], bfg[ni], acc[mi][ni]);
      }
      if (kt < 15) LSTORE((kt + 1) & 1);
      __syncthreads();
    }
#undef GLOAD
#undef LSTORE
#pragma unroll
    for (int ni = 0; ni < 4; ++ni) {
      const int col = n0 + wn * 64 + ni * 16 + l15;
      float gate = 0.f;
      if (EPI == 2) gate = cond_get(p, layer, m0 >> 12, 2048 + col);
#pragma unroll
      for (int mi = 0; mi < 4; ++mi) {
#pragma unroll
        for (int jx = 0; jx < 4; ++jx) {
          const int row = m0 + wm * 64 + mi * 16 + q * 4 + jx;
          const float v = acc[mi][ni][jx];
          if (EPI == 0) {
            PROJ[(size_t)row * 2048 + col] = f2bf(v);
          } else if (EPI == 1) {
            if (col < 4096) {
              bfr bv = f2bf(v);
              PROJ[(size_t)row * PLD + col] = bv;
              if (col < 3072 && (row & 63) >= 61) ((bfr*)(ows(p) + O_HALO))[((size_t)(row >> 6) * 3 + ((row & 63) - 61)) * 3072 + col] = bv;
            } else if (col < 4112) {
              ((float*)(ows(p) + O_AB))[(size_t)row * 16 + (col - 4096)] = v;
            }
          } else {
            p.out[(size_t)row * 1024 + col] = xin[(size_t)row * 1024 + col] + gate * v;
          }
        }
      }
    }
  }
}

DI void lru_phase(const Params& p, int j, int mode, char* lds) {
  float* Xf = (float*)lds;
  float* Pre = (float*)(lds + 32768);
  bfr* Xb = (bfr*)(lds + 98304);
  float* Seg = (float*)(lds + 115712);
  float* Car = (float*)(lds + 119808);
  const int tid = otid(), lane = tid & 63, wv = tid >> 6, l15 = lane & 15, q = lane >> 4;
  bfr* proj = (bfr*)(ows(p) + O_PROJ);
  float* AGGA = (float*)(ows(p) + O_AGG);
  float* AGGB = AGGA + 4 * 64 * 1024;
  const bfr* WG = (const bfr*)(ows(p) + O_WG);
  for (int grp = obid(); grp < 256; grp += gridDim.x) {
    const int b = grp >> 6, n = grp & 63, t0 = b * 4096 + n * 64;
    if (mode == 1) {
      for (int c = tid; c < 1024; c += 512) {
        float cr = 0.f;
        for (int n2 = 0; n2 < n; ++n2) {
          float a = AGGA[(size_t)(b * 64 + n2) * 1024 + c], bb = AGGB[(size_t)(b * 64 + n2) * 1024 + c];
          cr = a * cr + bb;
        }
        Car[c] = cr;
      }
    }
    for (int gb = 0; gb < 8; ++gb) {
      {
        const int rg = tid >> 4, cgi = tid & 15, r0 = rg * 2, col = gb * 128 + cgi * 8;
        bf16x8 raw[5];
#pragma unroll
        for (int i = 0; i < 5; ++i) {
          int tt = n * 64 + r0 - 3 + i;
          if (tt >= 0) raw[i] = *(const bf16x8*)&proj[(size_t)(b * 4096 + tt) * 2048 + col];
          else raw[i] = (bf16x8){0, 0, 0, 0, 0, 0, 0, 0};
        }
        float cwv[4][8], cb[8];
#pragma unroll
        for (int tp = 0; tp < 4; ++tp)
#pragma unroll
          for (int e = 0; e < 8; ++e) cwv[tp][e] = p.lru_conv_w[(size_t)(j * 4 + tp) * 1024 + col + e];
#pragma unroll
        for (int e = 0; e < 8; ++e) cb[e] = p.lru_conv_b[j * 1024 + col + e];
#pragma unroll
        for (int rr = 0; rr < 2; ++rr) {
          float o[8];
#pragma unroll
          for (int e = 0; e < 8; ++e) {
            float s = cb[e];
#pragma unroll
            for (int tp = 0; tp < 4; ++tp) s += cwv[tp][e] * bfe(raw[rr + tp], e);
            o[e] = s;
          }
          *(f32x4*)&Xf[(r0 + rr) * 128 + cgi * 8] = (f32x4){o[0], o[1], o[2], o[3]};
          *(f32x4*)&Xf[(r0 + rr) * 128 + cgi * 8 + 4] = (f32x4){o[4], o[5], o[6], o[7]};
          u32x4 pk; pk[0] = pack2(o[0], o[1]); pk[1] = pack2(o[2], o[3]); pk[2] = pack2(o[4], o[5]); pk[3] = pack2(o[6], o[7]);
          *(u32x4*)&Xb[(r0 + rr) * 136 + cgi * 8] = pk;
        }
      }
      __syncthreads();
      {
        const int mt = wv & 3, kq = wv >> 2;
        f32x4 acc[8];
#pragma unroll
        for (int i = 0; i < 8; ++i) acc[i] = (f32x4){0.f, 0.f, 0.f, 0.f};
        const bfr* gw = WG + (size_t)((j * 2 + kq) * 8 + gb) * 16384;
#pragma unroll
        for (int ks = 0; ks < 4; ++ks) {
          bf16x8 a = *(const bf16x8*)&Xb[(mt * 16 + l15) * 136 + ks * 32 + q * 8];
#pragma unroll
          for (int nt = 0; nt < 8; ++nt) {
            bf16x8 bb = *(const bf16x8*)&gw[(nt * 16 + l15) * 128 + ks * 32 + q * 8];
            acc[nt] = MFMA16(a, bb, acc[nt]);
          }
        }
#pragma unroll
        for (int nt = 0; nt < 8; ++nt) {
          int cc = nt * 16 + l15;
          float gbias = p.lru_gate_b[(j * 2 + kq) * 1024 + gb * 128 + cc];
#pragma unroll
          for (int jx = 0; jx < 4; ++jx) Pre[(kq * 64 + mt * 16 + q * 4 + jx) * 128 + cc] = acc[nt][jx] + gbias;
        }
      }
      __syncthreads();
      const int c = tid & 127, sg = tid >> 7;
      {
        float sp = softplusf_(-p.lru_lambda[j * 1024 + gb * 128 + c]);
        float hl = 0.f, ap = 1.f;
        for (int tt = 0; tt < 16; ++tt) {
          int t = sg * 16 + tt;
          float r = sigmoidf_(Pre[t * 128 + c]), ii = sigmoidf_(Pre[(64 + t) * 128 + c]);
          float la = -8.f * r * sp;
          float a = expf(la);
          float mult = sqrtf(fmaxf(-expm1f(2.f * la), 0.f));
          float bt = mult * ii * Xf[t * 128 + c];
          hl = a * hl + bt;
          ap *= a;
          if (mode == 1) { Pre[t * 128 + c] = hl; Pre[(64 + t) * 128 + c] = ap; }
        }
        Seg[(sg * 128 + c) * 2] = ap;
        Seg[(sg * 128 + c) * 2 + 1] = hl;
      }
      __syncthreads();
      if (mode == 0) {
        if (tid < 128) {
          float Aa = 1.f, Bb = 0.f;
#pragma unroll
          for (int s = 0; s < 4; ++s) {
            float a = Seg[(s * 128 + tid) * 2], bb = Seg[(s * 128 + tid) * 2 + 1];
            Bb = a * Bb + bb;
            Aa *= a;
          }
          AGGA[(size_t)grp * 1024 + gb * 128 + tid] = Aa;
          AGGB[(size_t)grp * 1024 + gb * 128 + tid] = Bb;
        }
      } else {
        float cr = Car[gb * 128 + c];
        for (int s = 0; s < sg; ++s) cr = Seg[(s * 128 + c) * 2] * cr + Seg[(s * 128 + c) * 2 + 1];
        for (int tt = 0; tt < 16; ++tt) {
          int t = sg * 16 + tt;
          float h = Pre[t * 128 + c] + Pre[(64 + t) * 128 + c] * cr;
          size_t zi = (size_t)(t0 + t) * 2048 + 1024 + gb * 128 + c;
          float z = bf2f(proj[zi]);
          proj[zi] = f2bf(h * siluf_(z));
        }
      }
      __syncthreads();
    }
  }
}

DI bf16x8 ld_perm(const bfr* base) {
  u32x2 lo = *(const u32x2*)base, hi = *(const u32x2*)(base + 16);
  u32x4 r; r[0] = lo[0]; r[1] = lo[1]; r[2] = hi[0]; r[3] = hi[1];
  return __builtin_bit_cast(bf16x8, r);
}
DI bf16x8 pack_cc(const f32x4& a, const f32x4& b) {
  u32x4 r; r[0] = pack2(a[0], a[1]); r[1] = pack2(a[2], a[3]); r[2] = pack2(b[0], b[1]); r[3] = pack2(b[2], b[3]);
  return __builtin_bit_cast(bf16x8, r);
}


template <int NL> DI void row_load(f32x4 (&a)[8], unsigned addr, float& dep) {
  if constexpr (NL == 1) asm volatile("ds_read_b128 %0, %2\n\ts_waitcnt lgkmcnt(0)" : "=&v"(a[0]), "+v"(dep) : "v"(addr) : "memory");
  if constexpr (NL == 2) asm volatile("ds_read_b128 %0, %3\n\tds_read_b128 %1, %3 offset:16\n\ts_waitcnt lgkmcnt(0)" : "=&v"(a[0]), "=&v"(a[1]), "+v"(dep) : "v"(addr) : "memory");
  if constexpr (NL == 3) asm volatile("ds_read_b128 %0, %4\n\tds_read_b128 %1, %4 offset:16\n\tds_read_b128 %2, %4 offset:32\n\ts_waitcnt lgkmcnt(0)" : "=&v"(a[0]), "=&v"(a[1]), "=&v"(a[2]), "+v"(dep) : "v"(addr) : "memory");
  if constexpr (NL == 4) asm volatile("ds_read_b128 %0, %5\n\tds_read_b128 %1, %5 offset:16\n\tds_read_b128 %2, %5 offset:32\n\tds_read_b128 %3, %5 offset:48\n\ts_waitcnt lgkmcnt(0)" : "=&v"(a[0]), "=&v"(a[1]), "=&v"(a[2]), "=&v"(a[3]), "+v"(dep) : "v"(addr) : "memory");
  if constexpr (NL == 5) asm volatile("ds_read_b128 %0, %6\n\tds_read_b128 %1, %6 offset:16\n\tds_read_b128 %2, %6 offset:32\n\tds_read_b128 %3, %6 offset:48\n\tds_read_b128 %4, %6 offset:64\n\ts_waitcnt lgkmcnt(0)" : "=&v"(a[0]), "=&v"(a[1]), "=&v"(a[2]), "=&v"(a[3]), "=&v"(a[4]), "+v"(dep) : "v"(addr) : "memory");
  if constexpr (NL == 6) asm volatile("ds_read_b128 %0, %7\n\tds_read_b128 %1, %7 offset:16\n\tds_read_b128 %2, %7 offset:32\n\tds_read_b128 %3, %7 offset:48\n\tds_read_b128 %4, %7 offset:64\n\tds_read_b128 %5, %7 offset:80\n\ts_waitcnt lgkmcnt(0)" : "=&v"(a[0]), "=&v"(a[1]), "=&v"(a[2]), "=&v"(a[3]), "=&v"(a[4]), "=&v"(a[5]), "+v"(dep) : "v"(addr) : "memory");
  if constexpr (NL == 7) asm volatile("ds_read_b128 %0, %8\n\tds_read_b128 %1, %8 offset:16\n\tds_read_b128 %2, %8 offset:32\n\tds_read_b128 %3, %8 offset:48\n\tds_read_b128 %4, %8 offset:64\n\tds_read_b128 %5, %8 offset:80\n\tds_read_b128 %6, %8 offset:96\n\ts_waitcnt lgkmcnt(0)" : "=&v"(a[0]), "=&v"(a[1]), "=&v"(a[2]), "=&v"(a[3]), "=&v"(a[4]), "=&v"(a[5]), "=&v"(a[6]), "+v"(dep) : "v"(addr) : "memory");
  if constexpr (NL == 8) asm volatile("ds_read_b128 %0, %9\n\tds_read_b128 %1, %9 offset:16\n\tds_read_b128 %2, %9 offset:32\n\tds_read_b128 %3, %9 offset:48\n\tds_read_b128 %4, %9 offset:64\n\tds_read_b128 %5, %9 offset:80\n\tds_read_b128 %6, %9 offset:96\n\tds_read_b128 %7, %9 offset:112\n\ts_waitcnt lgkmcnt(0)" : "=&v"(a[0]), "=&v"(a[1]), "=&v"(a[2]), "=&v"(a[3]), "=&v"(a[4]), "=&v"(a[5]), "=&v"(a[6]), "=&v"(a[7]), "+v"(dep) : "v"(addr) : "memory");
}
template <int I> DI void inv_rows(float (&t)[32], unsigned abase, int j) {
  if constexpr (I < 32) {
    float s = (I == j) ? 1.f : 0.f;
    if constexpr (I > 0) {
      f32x4 a[8];
      row_load<(I + 3) / 4>(a, abase + I * 256, t[I - 1]);
#pragma unroll
      for (int m4 = 0; m4 < I; m4 += 4) {
        s -= a[m4 >> 2][0] * t[m4];
        if (m4 + 1 < I) s -= a[m4 >> 2][1] * t[m4 + 1];
        if (m4 + 2 < I) s -= a[m4 >> 2][2] * t[m4 + 2];
        if (m4 + 3 < I) s -= a[m4 >> 2][3] * t[m4 + 3];
      }
    }
    t[I] = s;
    inv_rows<I + 1>(t, abase, j);
  }
}
DI void tri_invert32(const float* __restrict__ Au, bfr* __restrict__ Ttu, bfr* __restrict__ Tcu, int hf, int lane) {
  const int j = lane & 31;
  const float* Ab = Au + (32 * hf) * 64 + 32 * hf;
  float t[32];
  const unsigned abase = (unsigned)(size_t)Ab;
  inv_rows<0>(t, abase, j);
  if (lane < 32) {
#pragma unroll
    for (int i = 0; i < 32; ++i) Ttu[(32 * hf + i) * 72 + 32 * hf + j] = f2bf(t[i]);
    if (hf == 0) {
#pragma unroll
      for (int i = 0; i < 32; ++i) Ttu[i * 72 + 32 + j] = 0;
#pragma unroll
      for (int i4 = 0; i4 < 4; ++i4) {
        u32x4 pk;
        pk[0] = pack2(t[8 * i4], t[8 * i4 + 1]); pk[1] = pack2(t[8 * i4 + 2], t[8 * i4 + 3]);
        pk[2] = pack2(t[8 * i4 + 4], t[8 * i4 + 5]); pk[3] = pack2(t[8 * i4 + 6], t[8 * i4 + 7]);
        *(u32x4*)&Tcu[j * 40 + 8 * i4] = pk;
      }
    }
  }
}
DI void tri_merge(const float* __restrict__ Au, bfr* __restrict__ Ttu, const bfr* __restrict__ Tcu, int nt2, int lane) {
  const int l15 = lane & 15, q = lane >> 4;
  const f32x4 zero = (f32x4){0.f, 0.f, 0.f, 0.f};
  bf16x8 bfrag = *(const bf16x8*)&Tcu[(nt2 * 16 + l15) * 40 + q * 8];
  f32x4 X[2];
#pragma unroll
  for (int mt = 0; mt < 2; ++mt) {
    const float* ar = Au + (32 + mt * 16 + l15) * 64 + q * 8;
    f32x4 a0 = *(const f32x4*)ar, a1 = *(const f32x4*)(ar + 4);
    X[mt] = MFMA16(pack_cc(a0, a1), bfrag, zero);
  }
  bf16x8 xb = pack_cc(X[0], X[1]);
#pragma unroll
  for (int mt2 = 0; mt2 < 2; ++mt2) {
    bf16x8 a = ld_perm(Ttu + (32 + mt2 * 16 + l15) * 72 + 32 + q * 4);
    f32x4 r = MFMA16(a, xb, zero);
#pragma unroll
    for (int jx = 0; jx < 4; ++jx) Ttu[(32 + mt2 * 16 + q * 4 + jx) * 72 + nt2 * 16 + l15] = f2bf(-r[jx]);
  }
}

DI void gdn_g1(const Params& p, int j, char* lds) {
  float* Asl = (float*)lds;
  bfr* Tt = (bfr*)(lds + 65536);
  bfr* Kt = (bfr*)(lds + 102400);
  bfr* Qt = (bfr*)(lds + 119808);
  bfr* Vt = (bfr*)(lds + 137216);
  float* gc = (float*)(lds + 154624);
  float* be = (float*)(lds + 155648);
  float* cw = (float*)(lds + 156672);
  const int tid0 = otid();
  bfr* proj = (bfr*)(ows(p) + O_PROJ);
  bfr* KDT = (bfr*)(ows(p) + O_H);
  bfr* ATT = (bfr*)(ows(p) + O_ATTN);
  const bfr* HALO = (const bfr*)(ows(p) + O_HALO);
  bfr* SCR = (bfr*)(ows(p) + O_SCR) + (size_t)obid() * (4 * 2 * 8192);
  const float* AB = (const float*)(ows(p) + O_AB);
  float* EL = (float*)(ows(p) + O_ELAST);
  for (int grp = obid(); grp < 256; grp += gridDim.x) {
    const int bh = grp >> 3, b = bh >> 3, h = bh & 7;
    for (int e = tid0; e < 1536; e += 512) {
      int X = e >> 9, rem = e & 511, tap = rem >> 7, c = rem & 127;
      cw[(X * 4 + tap) * 128 + c] = p.gdn_conv_w[(size_t)(j * 4 + tap) * 3072 + X * 1024 + h * 128 + c];
    }
#pragma unroll 1
    for (int half = 0; half < 2; ++half) {
#pragma unroll 1
      for (int u = 0; u < 4; ++u) {
        const int un = grp * 8 + half * 4 + u, n = un & 63, t0 = b * 4096 + n * 64;
        int tid = tid0; asm volatile("" : "+v"(tid));
        const int lane = tid & 63, wv = tid >> 6, l15 = lane & 15, q = lane >> 4;
        if (wv == 0) {
          float a_in = AB[(size_t)(t0 + lane) * 16 + h], b_in = AB[(size_t)(t0 + lane) * 16 + 8 + h];
          float g = -expf(p.gdn_a_log[j * 8 + h]) * softplusf_(a_in + p.gdn_dt_bias[j * 8 + h]);
#pragma unroll
          for (int off = 1; off < 64; off <<= 1) {
            float v = __shfl_up(g, off);
            if (lane >= off) g += v;
          }
          gc[u * 64 + lane] = g;
          be[u * 64 + lane] = sigmoidf_(b_in);
          if (lane == 63) EL[un] = expf(g);
        }
        const int rg = tid >> 4, cgi = tid & 15, r0 = rg * 2;
#pragma unroll
        for (int X = 0; X < 3; ++X) {
          const int col = X * 1024 + h * 128 + cgi * 8;
          bf16x8 raw[5];
#pragma unroll
          for (int i = 0; i < 5; ++i) {
            int rr = r0 - 3 + i;
            if (rr >= 0) raw[i] = *(const bf16x8*)&proj[(size_t)(t0 + rr) * PLD + col];
            else if (n > 0) raw[i] = *(const bf16x8*)&HALO[((size_t)(b * 64 + n - 1) * 3 + 3 + rr) * 3072 + col];
            else raw[i] = (bf16x8){0, 0, 0, 0, 0, 0, 0, 0};
          }
          if (X == 0) __syncthreads();
          float val[2][8];
#pragma unroll
          for (int rr = 0; rr < 2; ++rr)
#pragma unroll
            for (int e = 0; e < 8; ++e) {
              float sacc = 0.f;
#pragma unroll
              for (int tp = 0; tp < 4; ++tp) sacc += cw[(X * 4 + tp) * 128 + cgi * 8 + e] * bfe(raw[rr + tp], e);
              val[rr][e] = siluf_(sacc);
            }
          if (X < 2) {
#pragma unroll
            for (int rr = 0; rr < 2; ++rr) {
              float ss = 0.f;
#pragma unroll
              for (int e = 0; e < 8; ++e) ss += val[rr][e] * val[rr][e];
              ss += __shfl_xor(ss, 1); ss += __shfl_xor(ss, 2); ss += __shfl_xor(ss, 4); ss += __shfl_xor(ss, 8);
              float rn = rsqrtf(ss + EPS);
              if (X == 0) rn *= 0.08838834764831845f;
#pragma unroll
              for (int e = 0; e < 8; ++e) val[rr][e] *= rn;
            }
          }
          bfr* Tile = (X == 0) ? Qt : (X == 1 ? Kt : Vt);
#pragma unroll
          for (int rr = 0; rr < 2; ++rr) {
            const int r = r0 + rr;
            u32x4 pk;
            pk[0] = pack2(val[rr][0], val[rr][1]); pk[1] = pack2(val[rr][2], val[rr][3]);
            pk[2] = pack2(val[rr][4], val[rr][5]); pk[3] = pack2(val[rr][6], val[rr][7]);
            *(u32x4*)&Tile[r * 136 + cgi * 8] = pk;
            if (X == 0) {
              const float eg = expf(gc[u * 64 + r]);
              pk[0] = pack2(val[rr][0] * eg, val[rr][1] * eg); pk[1] = pack2(val[rr][2] * eg, val[rr][3] * eg);
              pk[2] = pack2(val[rr][4] * eg, val[rr][5] * eg); pk[3] = pack2(val[rr][6] * eg, val[rr][7] * eg);
              *(u32x4*)&proj[(size_t)(t0 + r) * PLD + h * 128 + cgi * 8] = pk;
            }
          }
        }
        __syncthreads();
        {
          const int mt = wv >> 1;
          f32x4 kk[2], qk[2];
          kk[0] = kk[1] = qk[0] = qk[1] = (f32x4){0.f, 0.f, 0.f, 0.f};
#pragma unroll
          for (int ks = 0; ks < 4; ++ks) {
            bf16x8 ak = *(const bf16x8*)&Kt[(mt * 16 + l15) * 136 + ks * 32 + q * 8];
            bf16x8 aq = *(const bf16x8*)&Qt[(mt * 16 + l15) * 136 + ks * 32 + q * 8];
#pragma unroll
            for (int t2 = 0; t2 < 2; ++t2) {
              int nt = (wv & 1) * 2 + t2;
              bf16x8 bk = *(const bf16x8*)&Kt[(nt * 16 + l15) * 136 + ks * 32 + q * 8];
              kk[t2] = MFMA16(ak, bk, kk[t2]);
              qk[t2] = MFMA16(aq, bk, qk[t2]);
            }
          }
#pragma unroll
          for (int t2 = 0; t2 < 2; ++t2) {
            const int m = ((wv & 1) * 2 + t2) * 16 + l15;
            const float gmv = gc[u * 64 + m];
#pragma unroll
            for (int jx = 0; jx < 4; ++jx) {
              const int i = mt * 16 + q * 4 + jx;
              const float d = (i >= m) ? expf(gc[u * 64 + i] - gmv) : 0.f;
              const float av = (i > m) ? be[u * 64 + i] * kk[t2][jx] * d : 0.f;
              Asl[u * 4096 + i * 64 + m] = av;
              ATT[(size_t)un * 4096 + i * 64 + m] = f2bf(qk[t2][jx] * d);
            }
          }
        }
        {
          const int dd = tid >> 2, tq = tid & 3;
          const float glast = gc[u * 64 + 63];
#pragma unroll
          for (int g8 = 0; g8 < 2; ++g8) {
            const int tok0 = tq * 16 + g8 * 8;
            float okd[8], okb[8], ovb[8];
#pragma unroll
            for (int e = 0; e < 8; ++e) {
              const int tok = tok0 + e;
              const float kv = bf2f(Kt[tok * 136 + dd]), vv = bf2f(Vt[tok * 136 + dd]);
              const float gg = gc[u * 64 + tok], bb = be[u * 64 + tok];
              okd[e] = kv * expf(glast - gg);
              okb[e] = kv * bb * expf(gg);
              ovb[e] = vv * bb;
            }
            u32x4 pk;
            pk[0] = pack2(okd[0], okd[1]); pk[1] = pack2(okd[2], okd[3]); pk[2] = pack2(okd[4], okd[5]); pk[3] = pack2(okd[6], okd[7]);
            *(u32x4*)&KDT[(size_t)un * 8192 + dd * 64 + tok0] = pk;
            pk[0] = pack2(okb[0], okb[1]); pk[1] = pack2(okb[2], okb[3]); pk[2] = pack2(okb[4], okb[5]); pk[3] = pack2(okb[6], okb[7]);
            *(u32x4*)&SCR[(u * 2 + 0) * 8192 + dd * 64 + tok0] = pk;
            pk[0] = pack2(ovb[0], ovb[1]); pk[1] = pack2(ovb[2], ovb[3]); pk[2] = pack2(ovb[4], ovb[5]); pk[3] = pack2(ovb[6], ovb[7]);
            *(u32x4*)&SCR[(u * 2 + 1) * 8192 + dd * 64 + tok0] = pk;
          }
        }
      }
      __syncthreads();
      {
      int tid = tid0; asm volatile("" : "+v"(tid));
      const int lane = tid & 63, wv = tid >> 6;
      tri_invert32(Asl + (wv >> 1) * 4096, Tt + (wv >> 1) * 4608, Kt + (wv >> 1) * 1280, wv & 1, lane);
      __syncthreads();
      tri_merge(Asl + (wv >> 1) * 4096, Tt + (wv >> 1) * 4608, Kt + (wv >> 1) * 1280, wv & 1, lane);
      __syncthreads();
      }
#pragma unroll 1
      for (int u = 0; u < 4; ++u) {
        const int un = grp * 8 + half * 4 + u, n = un & 63, t0 = b * 4096 + n * 64;
        int tid = tid0; asm volatile("" : "+v"(tid));
        const int lane = tid & 63, wv = tid >> 6, l15 = lane & 15, q = lane >> 4;
        f32x4 aw[4], au[4];
#pragma unroll
        for (int i = 0; i < 4; ++i) aw[i] = au[i] = (f32x4){0.f, 0.f, 0.f, 0.f};
        const bfr* kb = SCR + (u * 2) * 8192;
        const bfr* vb = SCR + (u * 2 + 1) * 8192;
#pragma unroll
        for (int ks = 0; ks < 2; ++ks) {
          bf16x8 bk = *(const bf16x8*)&kb[(wv * 16 + l15) * 64 + ks * 32 + q * 8];
          bf16x8 bv = *(const bf16x8*)&vb[(wv * 16 + l15) * 64 + ks * 32 + q * 8];
#pragma unroll
          for (int mt = 0; mt < 4; ++mt) {
            bf16x8 a = *(const bf16x8*)&Tt[u * 4608 + (mt * 16 + l15) * 72 + ks * 32 + q * 8];
            aw[mt] = MFMA16(a, bk, aw[mt]);
            au[mt] = MFMA16(a, bv, au[mt]);
          }
        }
#pragma unroll
        for (int mt = 0; mt < 4; ++mt)
#pragma unroll
          for (int jx = 0; jx < 4; ++jx) {
            const int i = mt * 16 + q * 4 + jx, dc = wv * 16 + l15;
            proj[(size_t)(t0 + i) * PLD + 1024 + h * 128 + dc] = f2bf(aw[mt][jx]);
            proj[(size_t)(t0 + i) * PLD + 2048 + h * 128 + dc] = f2bf(au[mt][jx]);
          }
      }
      __syncthreads();
    }
  }
}

DI void gdn_g2(const Params& p, int j, char* lds) {
  constexpr int STG = 62464;
  float* ssq = (float*)(lds + 2 * STG);
  const int tid = otid(), lane = tid & 63, wv = tid >> 6, l15 = lane & 15, q = lane >> 4;
  bfr* proj = (bfr*)(ows(p) + O_PROJ);
  const bfr* KDT = (const bfr*)(ows(p) + O_H);
  const bfr* ATT = (const bfr*)(ows(p) + O_ATTN);
  const float* EL = (const float*)(ows(p) + O_ELAST);
  for (int bh = obid(); bh < 32; bh += gridDim.x) {
    const int b = bh >> 3, h = bh & 7;
    const int dv = wv * 16 + l15;
    const float og = p.gdn_onorm_g[j * 128 + dv];
    const int lofs = q * 4 * PLD + dv;
    f32x4 S[8];
#pragma unroll
    for (int i = 0; i < 8; ++i) S[i] = (f32x4){0.f, 0.f, 0.f, 0.f};
    u32x4 st[7];
    bfr un_[16];
#define G2_GLOAD(n)                                                                                          \
  {                                                                                                          \
    const int unl = bh * 64 + (n);                                                                           \
    const size_t tb = (size_t)(b * 4096 + (n) * 64);                                                         \
    _Pragma("unroll") for (int i = 0; i < 2; ++i) {                                                          \
      int id = tid + 512 * i, r = id >> 4, c16 = id & 15;                                                    \
      st[i] = *(const u32x4*)&proj[(tb + r) * PLD + 1024 + h * 128 + c16 * 8];                               \
      st[2 + i] = *(const u32x4*)&proj[(tb + r) * PLD + h * 128 + c16 * 8];                                  \
      int r2 = id >> 3, c8 = id & 7;                                                                         \
      st[4 + i] = *(const u32x4*)&KDT[(size_t)unl * 8192 + r2 * 64 + c8 * 8];                                \
    }                                                                                                        \
    st[6] = *(const u32x4*)&ATT[(size_t)unl * 4096 + (tid >> 3) * 64 + (tid & 7) * 8];                       \
    const bfr* pu_ = proj + tb * PLD + h * 128 + 2048;                                                       \
    _Pragma("unroll") for (int mt = 0; mt < 4; ++mt) _Pragma("unroll") for (int jx = 0; jx < 4; ++jx)        \
      un_[mt * 4 + jx] = pu_[lofs + (mt * 16 + jx) * PLD];                                                   \
  }
#define G2_LSTORE(sb)                                                                                        \
  {                                                                                                          \
    char* sbase = lds + (sb) * STG;                                                                          \
    _Pragma("unroll") for (int i = 0; i < 2; ++i) {                                                          \
      int id = tid + 512 * i, r = id >> 4, c16 = id & 15;                                                    \
      *(u32x4*)(sbase + (r * 136 + c16 * 8) * 2) = st[i];                                                    \
      *(u32x4*)(sbase + 17408 + (r * 136 + c16 * 8) * 2) = st[2 + i];                                        \
      int r2 = id >> 3, c8 = id & 7;                                                                         \
      *(u32x4*)(sbase + 34816 + (r2 * 72 + c8 * 8) * 2) = st[4 + i];                                         \
    }                                                                                                        \
    *(u32x4*)(sbase + 53248 + ((tid >> 3) * 72 + (tid & 7) * 8) * 2) = st[6];                                \
  }
    G2_GLOAD(0);
    G2_LSTORE(0);
    __syncthreads();
    for (int n = 0; n < 64; ++n) {
      float uc[16];
      bfr zc[16];
#pragma unroll
      for (int i = 0; i < 16; ++i) uc[i] = bf2f(un_[i]);
#pragma unroll
      for (int mt = 0; mt < 4; ++mt)
#pragma unroll
        for (int jx = 0; jx < 4; ++jx) zc[mt * 4 + jx] = (proj + (size_t)(b * 4096 + n * 64) * PLD + h * 128 + 3072)[lofs + (mt * 16 + jx) * PLD];
      if (n < 63) G2_GLOAD(n + 1);
      const char* sbase = lds + (n & 1) * STG;
      const bfr* Ws = (const bfr*)sbase;
      const bfr* Qs = (const bfr*)(sbase + 17408);
      const bfr* Ks = (const bfr*)(sbase + 34816);
      const bfr* As = (const bfr*)(sbase + 53248);
      bf16x8 sb[4];
#pragma unroll
      for (int ks = 0; ks < 4; ++ks) sb[ks] = pack_cc(S[2 * ks], S[2 * ks + 1]);
      f32x4 P[4], O[4];
#pragma unroll
      for (int mt = 0; mt < 4; ++mt) {
        P[mt] = O[mt] = (f32x4){0.f, 0.f, 0.f, 0.f};
#pragma unroll
        for (int ks = 0; ks < 4; ++ks) {
          bf16x8 aw = ld_perm(Ws + (mt * 16 + l15) * 136 + ks * 32 + q * 4);
          bf16x8 aq = ld_perm(Qs + (mt * 16 + l15) * 136 + ks * 32 + q * 4);
          P[mt] = MFMA16(aw, sb[ks], P[mt]);
          O[mt] = MFMA16(aq, sb[ks], O[mt]);
        }
      }
      f32x4 vn[4];
#pragma unroll
      for (int mt = 0; mt < 4; ++mt)
#pragma unroll
        for (int jx = 0; jx < 4; ++jx) vn[mt][jx] = uc[mt * 4 + jx] - P[mt][jx];
      bf16x8 vb[2];
      vb[0] = pack_cc(vn[0], vn[1]);
      vb[1] = pack_cc(vn[2], vn[3]);
#pragma unroll
      for (int mt = 0; mt < 4; ++mt)
#pragma unroll
        for (int k2 = 0; k2 < 2; ++k2) {
          bf16x8 aa = ld_perm(As + (mt * 16 + l15) * 72 + k2 * 32 + q * 4);
          O[mt] = MFMA16(aa, vb[k2], O[mt]);
        }
      const float el = EL[bh * 64 + n];
#pragma unroll
      for (int m8 = 0; m8 < 8; ++m8) {
        S[m8] = S[m8] * el;
#pragma unroll
        for (int k2 = 0; k2 < 2; ++k2) {
          bf16x8 ak = ld_perm(Ks + (m8 * 16 + l15) * 72 + k2 * 32 + q * 4);
          S[m8] = MFMA16(ak, vb[k2], S[m8]);
        }
      }
#pragma unroll
      for (int mt = 0; mt < 4; ++mt)
#pragma unroll
        for (int jx = 0; jx < 4; ++jx) {
          float s = O[mt][jx] * O[mt][jx];
          s += __shfl_xor(s, 1); s += __shfl_xor(s, 2); s += __shfl_xor(s, 4); s += __shfl_xor(s, 8);
          if (l15 == 0) ssq[wv * 64 + mt * 16 + q * 4 + jx] = s;
        }
      __syncthreads();
      {
        const size_t tb = (size_t)(b * 4096 + n * 64);
#pragma unroll
        for (int mt = 0; mt < 4; ++mt)
#pragma unroll
          for (int jx = 0; jx < 4; ++jx) {
            const int tok = mt * 16 + q * 4 + jx;
            float tot = 0.f;
#pragma unroll
            for (int w8 = 0; w8 < 8; ++w8) tot += ssq[w8 * 64 + tok];
            const float rstd = rsqrtf(tot * (1.f / 128.f) + EPS);
            const float y = O[mt][jx] * rstd * og * siluf_(bf2f(zc[mt * 4 + jx]));
            (proj + tb * PLD + h * 128 + 3072)[lofs + (mt * 16 + jx) * PLD] = f2bf(y);
          }
      }
      if (n < 63) G2_LSTORE((n + 1) & 1);
      __syncthreads();
    }
#undef G2_GLOAD
#undef G2_LSTORE
  }
}

DI void run_phase(const Params& p, int ph, char* lds) {
  if (ph == 0) { phase0(p, lds); return; }
  if (ph == NPHASE - 1) { norm_phase(p, 4, p.out, lds); return; }
  const int layer = (ph - 1) / 5, sub = (ph - 1) % 5, j = layer >> 1;
  const bool is_lru = (layer & 1) == 0;
  const bfr* H = (const bfr*)(ows(p) + O_H);
  const bfr* PROJ = (const bfr*)(ows(p) + O_PROJ);
  const float* xcur = (layer == 0) ? p.x : p.out;
  switch (sub) {
    case 0: norm_phase(p, layer, xcur, lds); break;
    case 1:
      if (is_lru) gemm_phase<0>(p, H, 1024, (const bfr*)(ows(p) + O_WLI) + (size_t)j * 2048 * 1024, 16, layer, nullptr, lds);
      else gemm_phase<1>(p, H, 1024, (const bfr*)(ows(p) + O_WGI) + (size_t)j * 4224 * 1024, 33, layer, nullptr, lds);
      break;
    case 2:
      if (is_lru) lru_phase(p, j, 0, lds); else gdn_g1(p, j, lds);
      break;
    case 3:
      if (is_lru) lru_phase(p, j, 1, lds); else gdn_g2(p, j, lds);
      break;
    case 4:
      if (is_lru) gemm_phase<2>(p, PROJ + 1024, 2048, (const bfr*)(ows(p) + O_WLO) + (size_t)j * 1024 * 1024, 8, layer, xcur, lds);
      else gemm_phase<2>(p, PROJ + 3072, PLD, (const bfr*)(ows(p) + O_WGO) + (size_t)j * 1024 * 1024, 8, layer, xcur, lds);
      break;
  }
}

__global__ void __launch_bounds__(512) mega_fwd(Params p) {
  extern __shared__ __attribute__((aligned(16))) char lds[];
#if MK_MODE == 1
  cg::grid_group grid = cg::this_grid();
  for (int ph = p.ph_lo; ph < p.ph_hi; ++ph) {
    if (ph > p.ph_lo) grid.sync();
    run_phase(p, ph, lds);
  }
#else
  for (int ph = p.ph_lo; ph < p.ph_hi; ++ph) run_phase(p, ph, lds);
#endif
}

extern "C" void kernel_launch(void* const* d_in, const int* in_sizes, int n_in, void* d_out, int out_size, void* d_ws, size_t ws_size, hipStream_t stream) {
  static int grid = 0;
  if (grid == 0) {
    if (n_in != 19 || ws_size < WS_END) { fprintf(stderr, "kernel_launch: unexpected inputs (n_in %d, ws %zu)\n", n_in, ws_size); grid = -1; return; }
    int dev = 0, cus = 0, per_cu = 0;
    hipGetDevice(&dev);
    hipDeviceGetAttribute(&cus, hipDeviceAttributeMultiprocessorCount, dev);
    if (hipFuncSetAttribute((const void*)mega_fwd, hipFuncAttributeMaxDynamicSharedMemorySize, LDS_BYTES) != hipSuccess) { fprintf(stderr, "kernel_launch: hipFuncSetAttribute failed\n"); grid = -1; return; }
    hipOccupancyMaxActiveBlocksPerMultiprocessor(&per_cu, (const void*)mega_fwd, 512, LDS_BYTES);
    if (per_cu < 1) { fprintf(stderr, "kernel_launch: occupancy query returned %d\n", per_cu); per_cu = 1; }
    (void)hipGetLastError();
    grid = cus * per_cu;
    if (grid > 256) grid = 256;
  }
  if (grid < 0) return;
  Params p{};
  const float** pp = (const float**)&p;
  for (int i = 0; i < 19; ++i) pp[i] = (const float*)d_in[i];
  p.out = (float*)d_out;
  p.ws = (char*)d_ws;
#if MK_MODE == 1
  p.ph_lo = 0; p.ph_hi = NPHASE;
  void* args[] = {&p};
  hipError_t e = hipLaunchCooperativeKernel((const void*)mega_fwd, dim3(grid), dim3(512), args, LDS_BYTES, stream);
  if (e != hipSuccess) fprintf(stderr, "cooperative launch failed: %s (grid %d)\n", hipGetErrorString(e), grid);
#else
  for (int ph = 0; ph < NPHASE; ++ph) {
    p.ph_lo = ph; p.ph_hi = ph + 1;
    hipLaunchKernelGGL(mega_fwd, dim3(grid), dim3(512), LDS_BYTES, stream, p);
  }
#endif
}
```

```cpp
#include <hip/hip_runtime.h>
#include <hip/hip_cooperative_groups.h>
#include <cstdio>
namespace cg = cooperative_groups;

#ifndef G2_LOADER
#define G2_LOADER 1
#endif
#ifndef MK_MODE
#define MK_MODE 1
#endif

typedef unsigned short bfr;
typedef __attribute__((ext_vector_type(8))) short bf16x8;
typedef __attribute__((ext_vector_type(4))) short bf16x4;
typedef __attribute__((ext_vector_type(4))) float f32x4;
typedef __attribute__((ext_vector_type(4))) unsigned u32x4;
typedef __attribute__((ext_vector_type(2))) unsigned u32x2;

#define DI __device__ __forceinline__
#define MFMA16(a, b, c) __builtin_amdgcn_mfma_f32_16x16x32_bf16((a), (b), (c), 0, 0, 0)

constexpr int PLANE = 16384 * 1024;
constexpr float EPS = 1e-6f;
constexpr int NPHASE = 22;
constexpr int LDS_BYTES = 163840;

constexpr size_t O_WLI = 0;
constexpr size_t O_WLO = 8388608;
constexpr size_t O_WGI = 12582912;
constexpr size_t O_WGO = 29884416;
constexpr size_t O_WG = 34078720;
constexpr size_t O_CONDP = 35127296;
constexpr size_t O_H = 36700160;
constexpr size_t O_PROJ = 70254592;
constexpr size_t O_ATTN = 204996608;
constexpr size_t O_HALO = 221773824;
constexpr size_t O_SCR = 226492416;
constexpr size_t O_AB = 260046848;
constexpr size_t O_ELAST = 261095424;
constexpr size_t O_AGG = 261103616;
constexpr size_t O_COND = 263200768;
constexpr size_t O_BAR = 263397376;
constexpr size_t WS_END = 263397376 + 16384;

struct Params {
  const float *x, *c, *ada_w, *ada_b, *norm_g, *final_g;
  const float *lru_in_w, *lru_conv_w, *lru_conv_b, *lru_gate_w, *lru_gate_b, *lru_lambda, *lru_out_w;
  const float *gdn_in_w, *gdn_conv_w, *gdn_a_log, *gdn_dt_bias, *gdn_onorm_g, *gdn_out_w;
  float* out;
  char* ws;
  int ph_lo, ph_hi;
};

DI int otid() { int t = threadIdx.x; asm volatile("" : "+v"(t)); return t; }
DI int obid() { int b = blockIdx.x; asm volatile("" : "+s"(b)); return b; }
DI void lds_barrier() { asm volatile("s_waitcnt lgkmcnt(0)" ::: "memory"); __builtin_amdgcn_s_barrier(); asm volatile("" ::: "memory"); }
typedef float f32x2_t __attribute__((ext_vector_type(2)));
typedef __bf16 bf16x2_t __attribute__((ext_vector_type(2)));
DI unsigned pack2(float a, float b) { f32x2_t v = {a, b}; bf16x2_t r = __builtin_convertvector(v, bf16x2_t); return __builtin_bit_cast(unsigned, r); }
DI bfr f2bf(float x) { return (bfr)(pack2(x, x) & 0xffffu); }
DI float bf2f(bfr b) { return __uint_as_float(((unsigned)b) << 16); }
DI float sum16(float x) {
  x += __uint_as_float(__builtin_amdgcn_update_dpp(0, __float_as_uint(x), 0xB1, 0xF, 0xF, true));
  x += __uint_as_float(__builtin_amdgcn_update_dpp(0, __float_as_uint(x), 0x4E, 0xF, 0xF, true));
  x += __uint_as_float(__builtin_amdgcn_update_dpp(0, __float_as_uint(x), 0x141, 0xF, 0xF, true));
  x += __uint_as_float(__builtin_amdgcn_update_dpp(0, __float_as_uint(x), 0x140, 0xF, 0xF, true));
  return x;
}
DI float sigmoidf_(float x) { return __builtin_amdgcn_rcpf(1.f + __expf(-x)); }
DI float siluf_(float x) { return x * __builtin_amdgcn_rcpf(1.f + __expf(-x)); }
DI float softplusf_(float x) { return x > 20.f ? x : log1pf(expf(x)); }
DI float bfe(const bf16x8& v, int e) { return bf2f((bfr)v[e]); }

DI char* ows(const Params& p) { size_t z = 0; asm volatile("" : "+s"(z)); return p.ws + z; }
DI float cond_get(const Params& p, int layer, int b, int n) {
  const float* cp = (const float*)(ows(p) + O_CONDP);
  float s = p.ada_b[layer * 3072 + n];
#pragma unroll
  for (int sg = 0; sg < 8; ++sg) s += cp[((sg * 4 + layer) * 4 + b) * 3072 + n];
  return s;
}

DI void transpose_tile(const float* __restrict__ src, int ldsrc, int nvalid, bfr* __restrict__ dst, int ldd, int k0, int n0, float* sm) {
  const int tid = otid();
  for (int e = tid; e < 4096; e += 512) {
    int kk = e >> 6, nn = e & 63;
    float v = 0.f;
    if (n0 + nn < nvalid) v = src[(size_t)(k0 + kk) * ldsrc + n0 + nn];
    sm[kk * 65 + nn] = v;
  }
  __syncthreads();
  for (int e = tid; e < 4096; e += 512) {
    int nn = e >> 6, kk = e & 63;
    dst[(size_t)(n0 + nn) * ldd + k0 + kk] = f2bf(sm[kk * 65 + nn]);
  }
  __syncthreads();
}

struct P0Item { const float* src; bfr* dst; int ldsrc, nvalid, ldd, k0, n0; };
DI P0Item p0_decode(const Params& p, int it) {
  P0Item r;
  if (it < 1024) {
    int l = it >> 9, q = it & 511, kt = q >> 5, nt = q & 31;
    r.src = p.lru_in_w + (size_t)l * 1024 * 2048; r.ldsrc = 2048; r.nvalid = 2048; r.dst = (bfr*)(ows(p) + O_WLI) + (size_t)l * 2048 * 1024; r.ldd = 1024; r.k0 = kt * 64; r.n0 = nt * 64;
  } else if (it < 1536) {
    int r0 = it - 1024, l = r0 >> 8, q = r0 & 255, kt = q >> 4, nt = q & 15;
    r.src = p.lru_out_w + (size_t)l * 1024 * 1024; r.ldsrc = 1024; r.nvalid = 1024; r.dst = (bfr*)(ows(p) + O_WLO) + (size_t)l * 1024 * 1024; r.ldd = 1024; r.k0 = kt * 64; r.n0 = nt * 64;
  } else if (it < 3648) {
    int r0 = it - 1536, l = r0 / 1056, q = r0 % 1056, kt = q / 66, nt = q % 66;
    r.src = p.gdn_in_w + (size_t)l * 1024 * 4112; r.ldsrc = 4112; r.nvalid = 4112; r.dst = (bfr*)(ows(p) + O_WGI) + (size_t)l * 4224 * 1024; r.ldd = 1024; r.k0 = kt * 64; r.n0 = nt * 64;
  } else if (it < 4160) {
    int r0 = it - 3648, l = r0 >> 8, q = r0 & 255, kt = q >> 4, nt = q & 15;
    r.src = p.gdn_out_w + (size_t)l * 1024 * 1024; r.ldsrc = 1024; r.nvalid = 1024; r.dst = (bfr*)(ows(p) + O_WGO) + (size_t)l * 1024 * 1024; r.ldd = 1024; r.k0 = kt * 64; r.n0 = nt * 64;
  } else {
    int r0 = it - 4160, mat = r0 >> 2, q = r0 & 3, kt = q >> 1, nt = q & 1;
    r.src = p.lru_gate_w + (size_t)mat * 16384; r.ldsrc = 128; r.nvalid = 128; r.dst = (bfr*)(ows(p) + O_WG) + (size_t)mat * 16384; r.ldd = 128; r.k0 = kt * 64; r.n0 = nt * 64;
  }
  return r;
}

DI void phase0(const Params& p, char* lds) {
  float* sm = (float*)lds;
  const int tid = otid();
  float v[8];
#define P0_LOAD(it_)                                                                                 \
  {                                                                                                  \
    const P0Item t_ = p0_decode(p, (it_));                                                           \
    _Pragma("unroll") for (int i = 0; i < 8; ++i) {                                                  \
      const int e = tid + 512 * i, kk = e >> 6, nn = e & 63;                                         \
      v[i] = (t_.n0 + nn < t_.nvalid) ? t_.src[(size_t)(t_.k0 + kk) * t_.ldsrc + t_.n0 + nn] : 0.f; \
    }                                                                                                \
  }
  if (obid() < 4288) P0_LOAD(obid());
#pragma unroll 1
  for (int it = obid(); it < 4288; it += gridDim.x) {
    const P0Item t = p0_decode(p, it);
#pragma unroll
    for (int i = 0; i < 8; ++i) { const int e = tid + 512 * i; sm[(e >> 6) * 65 + (e & 63)] = v[i]; }
    lds_barrier();
    if (it + (int)gridDim.x < 4288) P0_LOAD(it + gridDim.x);
#pragma unroll
    for (int i = 0; i < 4; ++i) {
      const int e = tid + 512 * i, nn = e >> 5, kp = e & 31;
      *(unsigned*)&t.dst[(size_t)(t.n0 + nn) * t.ldd + t.k0 + 2 * kp] = pack2(sm[(2 * kp) * 65 + nn], sm[(2 * kp + 1) * 65 + nn]);
    }
    lds_barrier();
  }
#undef P0_LOAD
  __syncthreads();
  for (int r0 = obid(); r0 < 192; r0 += gridDim.x) {
    int i = r0 / 48, r = r0 % 48, sg = r / 6, cb = r % 6;
    sm[tid] = siluf_(p.c[(tid >> 7) * 1024 + sg * 128 + (tid & 127)]);
    __syncthreads();
    int n = cb * 512 + tid;
    float a0 = 0.f, a1 = 0.f, a2 = 0.f, a3 = 0.f;
    const float* w = p.ada_w + ((size_t)i * 1024 + sg * 128) * 3072 + n;
#pragma unroll 32
    for (int k = 0; k < 128; ++k) {
      float wv = w[(size_t)k * 3072];
      a0 += sm[k] * wv; a1 += sm[128 + k] * wv; a2 += sm[256 + k] * wv; a3 += sm[384 + k] * wv;
    }
    float* cp = (float*)(ows(p) + O_CONDP);
    cp[((sg * 4 + i) * 4 + 0) * 3072 + n] = a0;
    cp[((sg * 4 + i) * 4 + 1) * 3072 + n] = a1;
    cp[((sg * 4 + i) * 4 + 2) * 3072 + n] = a2;
    cp[((sg * 4 + i) * 4 + 3) * 3072 + n] = a3;
    __syncthreads();
  }
}

DI void norm_phase(const Params& p, int layer, const void* __restrict__ xsrc, char* lds) {
  const float* xs = (const float*)xsrc; const bfr* xsb = (const bfr*)xsrc;
  float* gm = (float*)lds;
  float* sh = gm + 1024;
  const int tid = otid(), lane = tid & 63, wv = tid >> 6;
  bfr* H = (bfr*)(ows(p) + O_H);
  if (layer == 0) {
    float* cd = (float*)(ows(p) + O_COND);
    for (int e = obid() * 512 + tid; e < 4 * 4 * 3072; e += gridDim.x * 512) {
      int n = e % 3072, ib = e / 3072;
      cd[e] = cond_get(p, ib >> 2, ib & 3, n);
    }
  }
  const float* cd = (const float*)(ows(p) + O_COND);
  for (int rt = obid(); rt < 256; rt += gridDim.x) {
    int b = rt >> 6;
    for (int c = tid; c < 1024; c += 512) {
      if (layer == 0) {
        float scale = cond_get(p, layer, b, 1024 + c), shift = cond_get(p, layer, b, c);
        gm[c] = p.norm_g[layer * 1024 + c] * (1.f + scale);
        sh[c] = shift;
      } else if (layer < 4) {
        gm[c] = p.norm_g[layer * 1024 + c] * (1.f + cd[(size_t)(layer * 4 + b) * 3072 + 1024 + c]);
        sh[c] = cd[(size_t)(layer * 4 + b) * 3072 + c];
      } else {
        gm[c] = p.final_g[c];
        sh[c] = 0.f;
      }
    }
    __syncthreads();
    u32x2 rb[2][4][4];
    if (layer != 0) {
#pragma unroll
      for (int g = 0; g < 2; ++g)
#pragma unroll
        for (int r = 0; r < 4; ++r)
#pragma unroll
          for (int jx = 0; jx < 4; ++jx) rb[g][r][jx] = *(const u32x2*)&xsb[((size_t)rt * 64 + wv * 8 + g * 4 + r) * 1024 + jx * 256 + lane * 4];
    }
#pragma unroll
    for (int r4 = 0; r4 < 8; r4 += 4) {
      f32x4 v[4][4];
#pragma unroll
      for (int r = 0; r < 4; ++r)
#pragma unroll
        for (int jx = 0; jx < 4; ++jx) {
          const size_t xi = ((size_t)rt * 64 + wv * 8 + r4 + r) * 1024 + jx * 256 + lane * 4;
          if (layer == 0) v[r][jx] = *(const f32x4*)&xs[xi];
          else {
            const u32x2 xb = rb[r4 >> 2][r][jx];
            v[r][jx] = (f32x4){__uint_as_float(xb[0] << 16), __uint_as_float(xb[0] & 0xffff0000u), __uint_as_float(xb[1] << 16), __uint_as_float(xb[1] & 0xffff0000u)};
          }
        }
#pragma unroll
      for (int r = 0; r < 4; ++r) {
        const size_t row = (size_t)rt * 64 + wv * 8 + r4 + r;
        float ss = 0.f;
#pragma unroll
        for (int jx = 0; jx < 4; ++jx) ss += v[r][jx][0] * v[r][jx][0] + v[r][jx][1] * v[r][jx][1] + v[r][jx][2] * v[r][jx][2] + v[r][jx][3] * v[r][jx][3];
        ss = sum16(ss);
        ss += __shfl_xor(ss, 16);
        ss += __shfl_xor(ss, 32);
        const float rstd = rsqrtf(ss * (1.f / 1024.f) + EPS);
#pragma unroll
        for (int jx = 0; jx < 4; ++jx) {
          const int c = jx * 256 + lane * 4;
          f32x4 g4 = *(const f32x4*)&gm[c], s4 = *(const f32x4*)&sh[c];
          f32x4 y;
#pragma unroll
          for (int e = 0; e < 4; ++e) y[e] = v[r][jx][e] * rstd * g4[e] + s4[e];
          if (layer < 4) {
            u32x2 o2; o2[0] = pack2(y[0], y[1]); o2[1] = pack2(y[2], y[3]);
            *(u32x2*)&H[row * 1024 + c] = o2;
          } else {
            *(f32x4*)&p.out[row * 1024 + c] = y;
          }
        }
      }
    }
    __syncthreads();
  }
}

namespace pg8 {
#define PG8_LAS __attribute__((address_space(3)))
typedef unsigned short bf16_t;
typedef short bf16x8 __attribute__((ext_vector_type(8)));
typedef float f32x4 __attribute__((ext_vector_type(4)));
typedef unsigned u32x4 __attribute__((ext_vector_type(4)));
constexpr int BM = 256, BK = 64, HALF = 128, HTB = HALF * BK * 2  , STAGE_BYTES = 8 * HTB, NXCD = 8, WGM = 8;

__host__ __device__ __forceinline__ int lds_byte(int r, int c) { const int st = (r >> 4) * 2 + (c >> 5), rr = r & 15, cc = c & 31, ob = rr * 64 + cc * 2; return st * 1024 + (ob ^ (((ob >> 9) & 1) << 5)); }
__host__ __device__ __forceinline__ void stage_rc(int b, int& R, int& C) { const int st = b / 1024, sb = b % 1024, swz = sb ^ (((sb >> 9) & 1) << 5); R = (st >> 1) * 16 + swz / 64; C = (st & 1) * 32 + (swz % 64) / 2; }
__host__ __device__ __forceinline__ int perm32(int rho) { const int n = rho >> 4, i = rho & 15; return 8 * (i >> 2) + 4 * n + (i & 3); }

struct Unit { int pm, pn; };
struct Gemm { const bf16_t* A; const bf16_t* Bt; int M, N, K; };

struct StaticOrder {
    int nM, nN, nwg, G, c;
    __host__ __device__ void init(int M, int N, int G_, int c_) { nM = M / BM; nN = N / BM; nwg = nM * nN; G = G_; c = c_; }
    __host__ __device__ bool next(int i, Unit& u) const {
        const long L = (long)i * G + c; if (L >= nwg) return false;
        int wgid = (int)L; { const int q = nwg / NXCD, r = nwg % NXCD, xcd = wgid % NXCD, off = wgid / NXCD; wgid = (xcd < r ? xcd * (q + 1) : r * (q + 1) + (xcd - r) * q) + off; }
        const int nig = WGM * nN, gid = wgid / nig, fm = gid * WGM, gsz = (nM - fm) < WGM ? (nM - fm) : WGM;
        u.pm = fm + ((wgid % nig) % gsz); u.pn = (wgid % nig) / gsz; return true;
    }
    __device__ __forceinline__ void a_ready(const Unit&) const {}
    __device__ __forceinline__ void done(const Unit&) const {}
};
__device__ __forceinline__ unsigned cvt_pk_bf16(float lo, float hi) { unsigned r; asm volatile("v_cvt_pk_bf16_f32 %0, %1, %2" : "=v"(r) : "v"(lo), "v"(hi)); return r; }

template <class Epi, class Sched, bool STAMP = false>
__device__ __forceinline__ void gemm_phase(PG8_LAS unsigned char* lds, const Gemm g, const Sched& S, const Epi& E, unsigned long long* stamps) {
    const int tid = otid(), wid = __builtin_amdgcn_readfirstlane(tid >> 6), lane = tid & 63, wr = wid >> 2, wc = wid & 3, fr = lane & 15, fq = lane >> 4;
    const int K = g.K, nt = K / BK;
    int ts_lo = 0, ts_hi = 0, nts = 0; const unsigned long long rt_entry = STAMP ? (unsigned long long)wall_clock64() : 0ull;
#define PG8_STAMP() do { if (STAMP && wid == 0 && nts < 64) { const unsigned long long _c = (unsigned long long)clock64(); \
        ts_lo = (lane == nts) ? (int)(unsigned)_c : ts_lo; ts_hi = (lane == nts) ? (int)(unsigned)(_c >> 32) : ts_hi; ++nts; } } while (0)
    PG8_STAMP();
    unsigned voffA[2], voffB[2];
#pragma unroll
    for (int i = 0; i < 2; ++i) { int R, C; stage_rc(tid * 16 + i * 8192, R, C); const int Rb = Epi::PERM ? ((R & ~31) + perm32(R & 31)) : R;
        voffA[i] = (unsigned)(R * K + C) * 2u; voffB[i] = (unsigned)(Rb * K + C) * 2u; }
    const size_t kstep = (size_t)(BK * 2);
    const size_t hstep = (size_t)HALF * K * 2;
    const size_t tstep = 2 * hstep;
    const unsigned ldsw = (unsigned)wid * 1024u;
    const int aoff = lds_byte(wr * 64 + fr, fq * 8), boff = lds_byte(wc * 32 + fr, fq * 8);
#define PG8_SA(b, h) (((b) * 2 + (h)) * HTB)
#define PG8_SB(b, h) ((4 + (b) * 2 + (h)) * HTB)
#define PG8_STAGE(bufoff, gbase, voff) do { _Pragma("unroll") for (int _i = 0; _i < 2; ++_i) \
        __builtin_amdgcn_global_load_lds((const unsigned*)((const char*)(gbase) + (voff)[_i]), (PG8_LAS unsigned*)(lds + (bufoff) + ldsw + _i * 8192), 16, 0, 0); } while (0)
#define PG8_LDA(dst, b, h) do { _Pragma("unroll") for (int m = 0; m < 4; ++m) _Pragma("unroll") for (int k = 0; k < 2; ++k) dst[m][k] = *(const PG8_LAS bf16x8*)(lds + PG8_SA(b, h) + aoff + m * 2048 + k * 1024); } while (0)
#define PG8_LDB(dst, b, h) do { _Pragma("unroll") for (int n = 0; n < 2; ++n) _Pragma("unroll") for (int k = 0; k < 2; ++k) dst[n][k] = *(const PG8_LAS bf16x8*)(lds + PG8_SB(b, h) + boff + n * 2048 + k * 1024); } while (0)
#define PG8_MMA(ai, bj, At, Bt) do { __builtin_amdgcn_s_setprio(1); _Pragma("unroll") for (int m = 0; m < 4; ++m) _Pragma("unroll") for (int n = 0; n < 2; ++n) _Pragma("unroll") for (int k = 0; k < 2; ++k) \
        acc[ai][bj][m][n] = __builtin_amdgcn_mfma_f32_16x16x32_bf16(Bt[n][k], At[m][k], acc[ai][bj][m][n], 0, 0, 0); __builtin_amdgcn_s_setprio(0); } while (0)
#define PG8_WAIT_V(n) asm volatile("s_waitcnt vmcnt(" #n ")" ::: "memory")
#define PG8_WAIT_L(n) asm volatile("s_waitcnt lgkmcnt(" #n ")" ::: "memory")
#define PG8_BAR __builtin_amdgcn_s_barrier()
#define PG8_SCHED __builtin_amdgcn_sched_barrier(0)
    Unit cur, nxt; int ui = 0;
    if (!S.next(0, cur)) return;
    f32x4 acc[2][2][4][2];
#pragma unroll
    for (int a = 0; a < 2; ++a)
#pragma unroll
        for (int b = 0; b < 2; ++b)
#pragma unroll
            for (int m = 0; m < 4; ++m)
#pragma unroll
                for (int n = 0; n < 2; ++n) acc[a][b][m][n] = (f32x4){0.f, 0.f, 0.f, 0.f};
    bf16x8 At[4][2], B0[2][2], B1[2][2];
    const char* cA = (const char*)g.A + (size_t)cur.pm * tstep; const char* cB = (const char*)g.Bt + (size_t)cur.pn * tstep;
    S.a_ready(cur);
    PG8_STAGE(PG8_SB(0, 0), cB, voffB); PG8_STAGE(PG8_SA(0, 0), cA, voffA); PG8_STAGE(PG8_SB(0, 1), cB + hstep, voffB); PG8_STAGE(PG8_SA(0, 1), cA + hstep, voffA);
    if (wr == 1) PG8_BAR;
    PG8_WAIT_V(4); PG8_BAR;
    PG8_STAGE(PG8_SB(1, 0), cB + kstep, voffB); PG8_STAGE(PG8_SA(1, 0), cA + kstep, voffA); PG8_STAGE(PG8_SB(1, 1), cB + hstep + kstep, voffB);
    PG8_WAIT_V(6); PG8_BAR;
    PG8_STAMP();
    for (;;) {
        const bool has_next = S.next(ui + 1, nxt);
        const char* nA = has_next ? (const char*)g.A + (size_t)nxt.pm * tstep : cA; const char* nB = has_next ? (const char*)g.Bt + (size_t)nxt.pn * tstep : cB;
        for (int t = 0; t < nt; t += 2) {
            const bool last = (t == nt - 2);
            const char* a1 = cA + (size_t)(t + 1) * kstep;
            const char* a2 = last ? nA : cA + (size_t)(t + 2) * kstep; const char* b2 = last ? nB : cB + (size_t)(t + 2) * kstep;
            const char* a3 = a2 + kstep; const char* b3 = b2 + kstep;
            if (last && has_next) S.a_ready(nxt);
            PG8_LDB(B0, 0, 0); PG8_SCHED; PG8_LDA(At, 0, 0); PG8_STAGE(PG8_SA(1, 1), a1 + hstep, voffA);
            PG8_WAIT_L(8); PG8_BAR; PG8_WAIT_L(0); PG8_MMA(0, 0, At, B0); PG8_BAR; PG8_SCHED;
            PG8_LDB(B1, 0, 1); PG8_STAGE(PG8_SB(0, 0), b2, voffB);
            PG8_BAR; PG8_WAIT_L(0); PG8_MMA(0, 1, At, B1); PG8_BAR;
            PG8_LDA(At, 0, 1); PG8_STAGE(PG8_SA(0, 0), a2, voffA);
            PG8_BAR; PG8_WAIT_L(0); PG8_MMA(1, 0, At, B0); PG8_BAR; PG8_SCHED;
            PG8_STAGE(PG8_SB(0, 1), b2 + hstep, voffB);
            PG8_WAIT_V(6); PG8_BAR; PG8_MMA(1, 1, At, B1); PG8_BAR;
            PG8_LDB(B0, 1, 0); PG8_SCHED; PG8_LDA(At, 1, 0); PG8_STAGE(PG8_SA(0, 1), a2 + hstep, voffA);
            PG8_WAIT_L(8); PG8_BAR; PG8_WAIT_L(0); PG8_MMA(0, 0, At, B0); PG8_BAR; PG8_SCHED;
            PG8_LDB(B1, 1, 1); PG8_STAGE(PG8_SB(1, 0), b3, voffB);
            PG8_BAR; PG8_WAIT_L(0); PG8_MMA(0, 1, At, B1); PG8_BAR;
            PG8_LDA(At, 1, 1); PG8_STAGE(PG8_SA(1, 0), a3, voffA);
            PG8_BAR; PG8_WAIT_L(0); PG8_MMA(1, 0, At, B0); PG8_BAR; PG8_SCHED;
            PG8_STAGE(PG8_SB(1, 1), b3 + hstep, voffB);
            PG8_WAIT_V(6); PG8_BAR; PG8_MMA(1, 1, At, B1); PG8_BAR;
        }
        PG8_STAMP();
        if constexpr (!Epi::AFTER_DRAIN) { E(acc, cur, wr, wc, fr, fq); S.done(cur); }
        PG8_STAMP();
        if (!has_next) break;
#pragma unroll
        for (int a = 0; a < 2; ++a)
#pragma unroll
            for (int b = 0; b < 2; ++b)
#pragma unroll
                for (int m = 0; m < 4; ++m)
#pragma unroll
                    for (int n = 0; n < 2; ++n) acc[a][b][m][n] = (f32x4){0.f, 0.f, 0.f, 0.f};
        cur = nxt; cA = nA; cB = nB; ++ui;
    }
    PG8_WAIT_V(0);
    if (wr == 0) PG8_BAR;
    PG8_BAR;
    if constexpr (Epi::AFTER_DRAIN) { E.fused(acc, cur, wr, wc, fr, fq, lds, wid, lane); S.done(cur); }
    PG8_STAMP();
    if (STAMP && wid == 0) { stamps[lane] = lane < nts ? (((unsigned long long)(unsigned)ts_hi << 32) | (unsigned)ts_lo) : 0ull;
        if (lane == 62) stamps[62] = rt_entry; if (lane == 63) stamps[63] = (unsigned long long)wall_clock64(); }
#undef PG8_STAMP
#undef PG8_SA
#undef PG8_SB
#undef PG8_STAGE
#undef PG8_LDA
#undef PG8_LDB
#undef PG8_MMA
#undef PG8_WAIT_V
#undef PG8_WAIT_L
#undef PG8_BAR
#undef PG8_SCHED
}
}

struct EpiProjBf16 {
  static constexpr bool PERM = true, AFTER_DRAIN = false;
  bfr* O; bfr* halo;
  __device__ __forceinline__ void operator()(const f32x4 (&acc)[2][2][4][2], const pg8::Unit& u, int wr, int wc, int fr, int fq) const {
    const int row0 = u.pm * 256 + wr * 64 + fr, col0 = u.pn * 256 + wc * 32 + 8 * fq;
#pragma unroll
    for (int ai = 0; ai < 2; ++ai)
#pragma unroll
      for (int m = 0; m < 4; ++m) {
        const int row = row0 + ai * 128 + m * 16;
        const int bb = row >> 12, ts = row & 4095;
#pragma unroll
        for (int bj = 0; bj < 2; ++bj) {
          const int col = col0 + bj * 128;
          const f32x4 v0 = acc[ai][bj][m][0], v1 = acc[ai][bj][m][1];
          u32x4 w; w.x = pack2(v0[0], v0[1]); w.y = pack2(v0[2], v0[3]); w.z = pack2(v1[0], v1[1]); w.w = pack2(v1[2], v1[3]);
          *(u32x4*)(O + (size_t)(col >> 10) * PLANE + ((size_t)((bb * 8 + ((col >> 7) & 7)) * 4096 + ts)) * 128 + (col & 127)) = w;
          if (halo && (row & 63) >= 61 && col < 3072)
            *(u32x4*)(halo + ((size_t)(row >> 6) * 3 + ((row & 63) - 61)) * 3072 + col) = w;
        }
      }
  }
};
struct EpiResid {
  static constexpr bool PERM = true, AFTER_DRAIN = false;
  bfr* out; const void* xin; int xin_f32; const float* gate;
  __device__ __forceinline__ void operator()(const f32x4 (&acc)[2][2][4][2], const pg8::Unit& u, int wr, int wc, int fr, int fq) const {
    const int row0 = u.pm * 256 + wr * 64 + fr, col0 = u.pn * 256 + wc * 32 + 8 * fq;
    const float* gp = gate + (size_t)((u.pm * 256) >> 12) * 3072 + col0;
    f32x4 gv[2][2];
#pragma unroll
    for (int bj = 0; bj < 2; ++bj)
#pragma unroll
      for (int n = 0; n < 2; ++n) gv[bj][n] = *(const f32x4*)(gp + bj * 128 + n * 4);
#pragma unroll
    for (int ai = 0; ai < 2; ++ai)
#pragma unroll
      for (int m = 0; m < 4; ++m) {
        const size_t ro = (size_t)(row0 + ai * 128 + m * 16) * 1024 + col0;
#pragma unroll
        for (int bj = 0; bj < 2; ++bj) {
          f32x4 x0, x1;
          if (xin_f32) {
            x0 = *(const f32x4*)((const float*)xin + ro + bj * 128);
            x1 = *(const f32x4*)((const float*)xin + ro + bj * 128 + 4);
          } else {
            const u32x4 xb = *(const u32x4*)((const bfr*)xin + ro + bj * 128);
            x0 = (f32x4){__uint_as_float(xb[0] << 16), __uint_as_float(xb[0] & 0xffff0000u), __uint_as_float(xb[1] << 16), __uint_as_float(xb[1] & 0xffff0000u)};
            x1 = (f32x4){__uint_as_float(xb[2] << 16), __uint_as_float(xb[2] & 0xffff0000u), __uint_as_float(xb[3] << 16), __uint_as_float(xb[3] & 0xffff0000u)};
          }
          const f32x4 v0 = x0 + gv[bj][0] * acc[ai][bj][m][0], v1 = x1 + gv[bj][1] * acc[ai][bj][m][1];
          u32x4 w; w.x = pack2(v0[0], v0[1]); w.y = pack2(v0[2], v0[3]); w.z = pack2(v1[0], v1[1]); w.w = pack2(v1[2], v1[3]);
          *(u32x4*)(out + ro + bj * 128) = w;
        }
      }
  }
};

template <int EPI>
DI void gemm_phase(const Params& p, const bfr* __restrict__ A, int lda, const bfr* __restrict__ Bt, int nN, int layer, const void* __restrict__ xin, bfr* __restrict__ xout, char* lds) {
  pg8::Gemm g; g.A = A; g.Bt = Bt; g.M = 16384; g.N = nN * 256; g.K = 1024;
  pg8::StaticOrder S; S.init(g.M, g.N, gridDim.x, obid());
  if (EPI == 2) {
    EpiResid E; E.out = xout; E.xin = xin; E.xin_f32 = (layer == 0) ? 1 : 0; E.gate = (const float*)(ows(p) + O_COND) + (size_t)layer * 4 * 3072 + 2048;
    pg8::gemm_phase<EpiResid, pg8::StaticOrder, false>((PG8_LAS unsigned char*)lds, g, S, E, nullptr);
  } else {
    EpiProjBf16 E; E.O = (bfr*)(ows(p) + O_PROJ); E.halo = (EPI == 1) ? (bfr*)(ows(p) + O_HALO) : nullptr;
    pg8::gemm_phase<EpiProjBf16, pg8::StaticOrder, false>((PG8_LAS unsigned char*)lds, g, S, E, nullptr);
  }
  if (EPI == 1) {
    __syncthreads();
    float* red = (float*)lds;
    const int tid = otid(), lane = tid & 63, wv = tid >> 6, l15 = lane & 15, q = lane >> 4;
    const int mt4 = wv & 3, kh = wv >> 2;
    for (int rt = obid(); rt < 256; rt += gridDim.x) {
      const bfr* Ar = A + (size_t)(rt * 64 + mt4 * 16 + l15) * lda + kh * 512 + q * 8;
      const bfr* Br = Bt + (size_t)(4096 + l15) * 1024 + kh * 512 + q * 8;
      f32x4 acc = (f32x4){0.f, 0.f, 0.f, 0.f};
#pragma unroll 4
      for (int ks = 0; ks < 16; ++ks) acc = MFMA16(*(const bf16x8*)(Ar + ks * 32), *(const bf16x8*)(Br + ks * 32), acc);
      if (kh == 1) *(f32x4*)&red[(mt4 * 64 + lane) * 4] = acc;
      __syncthreads();
      if (kh == 0) {
        f32x4 o = *(const f32x4*)&red[(mt4 * 64 + lane) * 4];
#pragma unroll
        for (int jx = 0; jx < 4; ++jx) ((float*)(ows(p) + O_AB))[(size_t)(rt * 64 + mt4 * 16 + q * 4 + jx) * 16 + l15] = acc[jx] + o[jx];
      }
      __syncthreads();
    }
  }
}

DI void lru_phase(const Params& p, int j, char* lds) {
  const int tid = otid(), lane = tid & 63, wv = tid >> 6, l15 = lane & 15, q = lane >> 4;
  bfr* Xw = (bfr*)lds + wv * (32 * 136);
  float* WAgg = (float*)(lds + 8 * 32 * 136 * 2);
  const bfr* proj = (const bfr*)(ows(p) + O_PROJ);
  bfr* Yb = (bfr*)(ows(p) + O_H);
  const bfr* WG = (const bfr*)(ows(p) + O_WG);
  for (int unit = obid(); unit < 256; unit += gridDim.x) {
    const int xcd = unit & 7, li = unit >> 3, idx = xcd * 4 + (li >> 3), sl = li & 7, b = idx >> 3, gb = idx & 7;
    const int ch = gb * 128 + sl * 16 + l15;
    bf16x8 Bf[2][4];
#pragma unroll
    for (int kq = 0; kq < 2; ++kq)
#pragma unroll
      for (int ks = 0; ks < 4; ++ks) Bf[kq][ks] = *(const bf16x8*)&WG[(size_t)((j * 2 + kq) * 8 + gb) * 16384 + (sl * 16 + l15) * 128 + ks * 32 + q * 8];
    const float gbr = p.lru_gate_b[(j * 2) * 1024 + ch], gbi = p.lru_gate_b[(j * 2 + 1) * 1024 + ch];
    const float sp = softplusf_(-p.lru_lambda[j * 1024 + ch]);
    const int cg = lane & 15, rs = lane >> 4, ccol = gb * 128 + cg * 8;
    float cwv[4][8], cb[8];
#pragma unroll
    for (int tp = 0; tp < 4; ++tp)
#pragma unroll
      for (int e = 0; e < 8; ++e) cwv[tp][e] = p.lru_conv_w[(size_t)(j * 4 + tp) * 1024 + ccol + e];
#pragma unroll
    for (int e = 0; e < 8; ++e) cb[e] = p.lru_conv_b[j * 1024 + ccol + e];
    const bfr* xb_u = proj + (size_t)(b * 8 + gb) * 4096 * 128;
    bfr* yb_u = Yb + (size_t)b * 4096 * 1024;
    const int xo = (wv * 32 + rs * 8 - 3) * 128 + cg * 8;
    const int zo = PLANE + (wv * 32 + q * 4) * 128 + sl * 16 + (l15 & ~1);
    const int zsh = (l15 & 1) * 16;
    const int yo = (wv * 32 + q * 4) * 1024 + ch;
    float carry = 0.f;
    bf16x8 raw[11];
    unsigned zr[8];
#define LRU_LOAD(it)                                                                                   \
  {                                                                                                    \
    const bfr* xit = xb_u + (it) * (256 * 128);                                                        \
    _Pragma("unroll") for (int i = 0; i < 11; ++i) {                                                   \
      const int t = (it) * 256 + wv * 32 + rs * 8 - 3 + i;                                             \
      if (t >= 0) raw[i] = *(const bf16x8*)&xit[xo + i * 128];                                         \
      else raw[i] = (bf16x8){0, 0, 0, 0, 0, 0, 0, 0};                                                  \
    }                                                                                                  \
    _Pragma("unroll") for (int mt = 0; mt < 2; ++mt) _Pragma("unroll") for (int jx = 0; jx < 4; ++jx)  \
      zr[mt * 4 + jx] = *(const unsigned*)&xit[zo + (mt * 16 + jx) * 128];                                               \
  }
    LRU_LOAD(0);
#pragma unroll 1
    for (int it = 0; it < 16; ++it) {
#pragma unroll
      for (int r = 0; r < 8; ++r) {
        float o[8];
#pragma unroll
        for (int e = 0; e < 8; ++e) {
          float s = cb[e];
#pragma unroll
          for (int tp = 0; tp < 4; ++tp) s += cwv[tp][e] * bfe(raw[r + tp], e);
          o[e] = s;
        }
        u32x4 pk; pk[0] = pack2(o[0], o[1]); pk[1] = pack2(o[2], o[3]); pk[2] = pack2(o[4], o[5]); pk[3] = pack2(o[6], o[7]);
        *(u32x4*)&Xw[(rs * 8 + r) * 136 + cg * 8] = pk;
      }
      float zc[8];
#pragma unroll
      for (int i = 0; i < 8; ++i) zc[i] = bf2f((bfr)(zr[i] >> zsh));
      if (it < 15) LRU_LOAD(it + 1);
      f32x4 accr[2], acci[2];
#pragma unroll
      for (int mt = 0; mt < 2; ++mt) {
        accr[mt] = acci[mt] = (f32x4){0.f, 0.f, 0.f, 0.f};
#pragma unroll
        for (int ks = 0; ks < 4; ++ks) {
          bf16x8 af = *(const bf16x8*)&Xw[(mt * 16 + l15) * 136 + ks * 32 + q * 8];
          accr[mt] = MFMA16(af, Bf[0][ks], accr[mt]);
          acci[mt] = MFMA16(af, Bf[1][ks], acci[mt]);
        }
      }
      float av[2][4], bv[2][4];
      float Aex[2], Bex[2], At[2], Bt_[2];
#pragma unroll
      for (int mt = 0; mt < 2; ++mt) {
        float Al = 1.f, Bl = 0.f;
#pragma unroll
        for (int jx = 0; jx < 4; ++jx) {
          const float r = sigmoidf_(accr[mt][jx] + gbr), ig = sigmoidf_(acci[mt][jx] + gbi);
          const float a = __expf(-8.f * r * sp);
          const float mult = __builtin_amdgcn_sqrtf(fmaxf(1.f - a * a, 0.f));
          const float xf = bf2f(Xw[(mt * 16 + q * 4 + jx) * 136 + sl * 16 + l15]);
          const float bt = mult * ig * xf;
          av[mt][jx] = a; bv[mt][jx] = bt;
          Bl = a * Bl + bt; Al *= a;
        }
        float Ai = Al, Bi = Bl;
#pragma unroll
        for (int off = 16; off < 64; off <<= 1) {
          const float Ap = __shfl_up(Ai, off), Bp = __shfl_up(Bi, off);
          if (lane >= off) { Bi = Ai * Bp + Bi; Ai = Ai * Ap; }
        }
        float Ae = __shfl_up(Ai, 16), Be = __shfl_up(Bi, 16);
        if (q == 0) { Ae = 1.f; Be = 0.f; }
        Aex[mt] = Ae; Bex[mt] = Be;
        At[mt] = __shfl(Ai, 48 + l15); Bt_[mt] = __shfl(Bi, 48 + l15);
      }
      float* wa = WAgg + (it & 1) * 256;
      if (q == 0) { wa[(wv * 16 + l15) * 2] = At[0] * At[1]; wa[(wv * 16 + l15) * 2 + 1] = At[1] * Bt_[0] + Bt_[1]; }
      lds_barrier();
      float cin = carry, cnew = carry;
#pragma unroll
      for (int w = 0; w < 8; ++w) {
        const float Aw = wa[(w * 16 + l15) * 2], Bw = wa[(w * 16 + l15) * 2 + 1];
        cnew = Aw * cnew + Bw;
        if (w < wv) cin = Aw * cin + Bw;
      }
      carry = cnew;
      bfr* yit = yb_u + it * (256 * 1024);
#pragma unroll
      for (int mt = 0; mt < 2; ++mt) {
        float h = Aex[mt] * cin + Bex[mt];
#pragma unroll
        for (int jx = 0; jx < 4; ++jx) {
          h = av[mt][jx] * h + bv[mt][jx];
          yit[yo + (mt * 16 + jx) * 1024] = f2bf(h * siluf_(zc[mt * 4 + jx]));
        }
        cin = At[mt] * cin + Bt_[mt];
      }
    }
#undef LRU_LOAD
  }
}

DI bf16x8 ld_perm(const bfr* base) {
  u32x2 lo = *(const u32x2*)base, hi = *(const u32x2*)(base + 16);
  u32x4 r; r[0] = lo[0]; r[1] = lo[1]; r[2] = hi[0]; r[3] = hi[1];
  return __builtin_bit_cast(bf16x8, r);
}
DI bf16x8 pack_cc(const f32x4& a, const f32x4& b) {
  u32x4 r; r[0] = pack2(a[0], a[1]); r[1] = pack2(a[2], a[3]); r[2] = pack2(b[0], b[1]); r[3] = pack2(b[2], b[3]);
  return __builtin_bit_cast(bf16x8, r);
}


template <int NL> DI void row_load(f32x4 (&a)[8], unsigned addr, float& dep) {
  if constexpr (NL == 1) asm volatile("ds_read_b128 %0, %2\n\ts_waitcnt lgkmcnt(0)" : "=&v"(a[0]), "+v"(dep) : "v"(addr) : "memory");
  if constexpr (NL == 2) asm volatile("ds_read_b128 %0, %3\n\tds_read_b128 %1, %3 offset:16\n\ts_waitcnt lgkmcnt(0)" : "=&v"(a[0]), "=&v"(a[1]), "+v"(dep) : "v"(addr) : "memory");
  if constexpr (NL == 3) asm volatile("ds_read_b128 %0, %4\n\tds_read_b128 %1, %4 offset:16\n\tds_read_b128 %2, %4 offset:32\n\ts_waitcnt lgkmcnt(0)" : "=&v"(a[0]), "=&v"(a[1]), "=&v"(a[2]), "+v"(dep) : "v"(addr) : "memory");
  if constexpr (NL == 4) asm volatile("ds_read_b128 %0, %5\n\tds_read_b128 %1, %5 offset:16\n\tds_read_b128 %2, %5 offset:32\n\tds_read_b128 %3, %5 offset:48\n\ts_waitcnt lgkmcnt(0)" : "=&v"(a[0]), "=&v"(a[1]), "=&v"(a[2]), "=&v"(a[3]), "+v"(dep) : "v"(addr) : "memory");
  if constexpr (NL == 5) asm volatile("ds_read_b128 %0, %6\n\tds_read_b128 %1, %6 offset:16\n\tds_read_b128 %2, %6 offset:32\n\tds_read_b128 %3, %6 offset:48\n\tds_read_b128 %4, %6 offset:64\n\ts_waitcnt lgkmcnt(0)" : "=&v"(a[0]), "=&v"(a[1]), "=&v"(a[2]), "=&v"(a[3]), "=&v"(a[4]), "+v"(dep) : "v"(addr) : "memory");
  if constexpr (NL == 6) asm volatile("ds_read_b128 %0, %7\n\tds_read_b128 %1, %7 offset:16\n\tds_read_b128 %2, %7 offset:32\n\tds_read_b128 %3, %7 offset:48\n\tds_read_b128 %4, %7 offset:64\n\tds_read_b128 %5, %7 offset:80\n\ts_waitcnt lgkmcnt(0)" : "=&v"(a[0]), "=&v"(a[1]), "=&v"(a[2]), "=&v"(a[3]), "=&v"(a[4]), "=&v"(a[5]), "+v"(dep) : "v"(addr) : "memory");
  if constexpr (NL == 7) asm volatile("ds_read_b128 %0, %8\n\tds_read_b128 %1, %8 offset:16\n\tds_read_b128 %2, %8 offset:32\n\tds_read_b128 %3, %8 offset:48\n\tds_read_b128 %4, %8 offset:64\n\tds_read_b128 %5, %8 offset:80\n\tds_read_b128 %6, %8 offset:96\n\ts_waitcnt lgkmcnt(0)" : "=&v"(a[0]), "=&v"(a[1]), "=&v"(a[2]), "=&v"(a[3]), "=&v"(a[4]), "=&v"(a[5]), "=&v"(a[6]), "+v"(dep) : "v"(addr) : "memory");
  if constexpr (NL == 8) asm volatile("ds_read_b128 %0, %9\n\tds_read_b128 %1, %9 offset:16\n\tds_read_b128 %2, %9 offset:32\n\tds_read_b128 %3, %9 offset:48\n\tds_read_b128 %4, %9 offset:64\n\tds_read_b128 %5, %9 offset:80\n\tds_read_b128 %6, %9 offset:96\n\tds_read_b128 %7, %9 offset:112\n\ts_waitcnt lgkmcnt(0)" : "=&v"(a[0]), "=&v"(a[1]), "=&v"(a[2]), "=&v"(a[3]), "=&v"(a[4]), "=&v"(a[5]), "=&v"(a[6]), "=&v"(a[7]), "+v"(dep) : "v"(addr) : "memory");
}
template <int I> DI void inv_rows(float (&t)[32], unsigned abase, int j) {
  if constexpr (I < 32) {
    float s = (I == j) ? 1.f : 0.f;
    if constexpr (I > 0) {
      f32x4 a[8];
      row_load<(I + 3) / 4>(a, abase + I * 256, t[I - 1]);
#pragma unroll
      for (int m4 = 0; m4 < I; m4 += 4) {
        s -= a[m4 >> 2][0] * t[m4];
        if (m4 + 1 < I) s -= a[m4 >> 2][1] * t[m4 + 1];
        if (m4 + 2 < I) s -= a[m4 >> 2][2] * t[m4 + 2];
        if (m4 + 3 < I) s -= a[m4 >> 2][3] * t[m4 + 3];
      }
    }
    t[I] = s;
    inv_rows<I + 1>(t, abase, j);
  }
}
DI void tri_invert32(const float* __restrict__ Au, bfr* __restrict__ Ttu, bfr* __restrict__ Tcu, int hf, int lane) {
  const int j = lane & 31;
  const float* Ab = Au + (32 * hf) * 64 + 32 * hf;
  float t[32];
  const unsigned abase = (unsigned)(size_t)Ab;
  inv_rows<0>(t, abase, j);
  if (lane < 32) {
#pragma unroll
    for (int i = 0; i < 32; ++i) Ttu[(32 * hf + i) * 72 + 32 * hf + j] = f2bf(t[i]);
    if (hf == 0) {
#pragma unroll
      for (int i = 0; i < 32; ++i) Ttu[i * 72 + 32 + j] = 0;
#pragma unroll
      for (int i4 = 0; i4 < 4; ++i4) {
        u32x4 pk;
        pk[0] = pack2(t[8 * i4], t[8 * i4 + 1]); pk[1] = pack2(t[8 * i4 + 2], t[8 * i4 + 3]);
        pk[2] = pack2(t[8 * i4 + 4], t[8 * i4 + 5]); pk[3] = pack2(t[8 * i4 + 6], t[8 * i4 + 7]);
        *(u32x4*)&Tcu[j * 40 + 8 * i4] = pk;
      }
    }
  }
}
DI void tri_merge(const float* __restrict__ Au, bfr* __restrict__ Ttu, const bfr* __restrict__ Tcu, int nt2, int lane) {
  const int l15 = lane & 15, q = lane >> 4;
  const f32x4 zero = (f32x4){0.f, 0.f, 0.f, 0.f};
  bf16x8 bfrag = *(const bf16x8*)&Tcu[(nt2 * 16 + l15) * 40 + q * 8];
  f32x4 X[2];
#pragma unroll
  for (int mt = 0; mt < 2; ++mt) {
    const float* ar = Au + (32 + mt * 16 + l15) * 64 + q * 8;
    f32x4 a0 = *(const f32x4*)ar, a1 = *(const f32x4*)(ar + 4);
    X[mt] = MFMA16(pack_cc(a0, a1), bfrag, zero);
  }
  bf16x8 xb = pack_cc(X[0], X[1]);
#pragma unroll
  for (int mt2 = 0; mt2 < 2; ++mt2) {
    bf16x8 a = ld_perm(Ttu + (32 + mt2 * 16 + l15) * 72 + 32 + q * 4);
    f32x4 r = MFMA16(a, xb, zero);
#pragma unroll
    for (int jx = 0; jx < 4; ++jx) Ttu[(32 + mt2 * 16 + q * 4 + jx) * 72 + nt2 * 16 + l15] = f2bf(-r[jx]);
  }
}

DI void gdn_g1(const Params& p, int j, char* lds) {
  float* Asl = (float*)lds;
  bfr* Tt = (bfr*)(lds + 65536);
  bfr* Kt = (bfr*)(lds + 102400);
  bfr* Qt = (bfr*)(lds + 119808);
  bfr* Vt = (bfr*)(lds + 137216);
  float* gc = (float*)(lds + 154624);
  float* be = (float*)(lds + 155648);
  float* cw = (float*)(lds + 156672);
  const int tid0 = otid();
  bfr* proj = (bfr*)(ows(p) + O_PROJ);
  bfr* KDT = (bfr*)(ows(p) + O_H);
  bfr* ATT = (bfr*)(ows(p) + O_ATTN);
  const bfr* HALO = (const bfr*)(ows(p) + O_HALO);
  bfr* SCR = (bfr*)(ows(p) + O_SCR) + (size_t)obid() * (4 * 2 * 8192);
  const float* AB = (const float*)(ows(p) + O_AB);
  float* EL = (float*)(ows(p) + O_ELAST);
  for (int grp = obid(); grp < 256; grp += gridDim.x) {
    const int bh = grp >> 3, b = bh >> 3, h = bh & 7;
    for (int e = tid0; e < 1536; e += 512) {
      int X = e >> 9, rem = e & 511, tap = rem >> 7, c = rem & 127;
      cw[(X * 4 + tap) * 128 + c] = p.gdn_conv_w[(size_t)(j * 4 + tap) * 3072 + X * 1024 + h * 128 + c];
    }
    bf16x8 nxt[3][5];
    float pfx_g = 0.f, pfx_b = 0.f;
#define G1_RAWLOAD(nn)                                                                                         \
  {                                                                                                            \
    const int rg_ = tid0 >> 4, cgi_ = tid0 & 15, r0_ = rg_ * 2;                                                \
    _Pragma("unroll") for (int X = 0; X < 3; ++X) {                                                            \
      _Pragma("unroll") for (int i = 0; i < 5; ++i) {                                                          \
        const int rr = r0_ - 3 + i;                                                                            \
        if (rr >= 0) nxt[X][i] = *(const bf16x8*)&proj[(size_t)X * PLANE + (size_t)(bh * 4096 + (nn) * 64 + rr) * 128 + cgi_ * 8];   \
        else if ((nn) > 0) nxt[X][i] = *(const bf16x8*)&HALO[((size_t)(b * 64 + (nn) - 1) * 3 + 3 + rr) * 3072 + X * 1024 + h * 128 + cgi_ * 8];   \
        else nxt[X][i] = (bf16x8){0, 0, 0, 0, 0, 0, 0, 0};                                                     \
      }                                                                                                        \
    }                                                                                                          \
  }
    G1_RAWLOAD((grp * 8) & 63);
#pragma unroll 1
    for (int half = 0; half < 2; ++half) {
      {
        int tid = tid0; asm volatile("" : "+v"(tid));
        const int lane = tid & 63, wv = tid >> 6;
        if (half == 0) {
          const int un = grp * 8 + wv, n = un & 63, t0 = b * 4096 + n * 64;
          float a_in = AB[(size_t)(t0 + lane) * 16 + h], b_in = AB[(size_t)(t0 + lane) * 16 + 8 + h];
          float g = -__expf(p.gdn_a_log[j * 8 + h]) * softplusf_(a_in + p.gdn_dt_bias[j * 8 + h]);
#pragma unroll
          for (int off = 1; off < 64; off <<= 1) {
            float v = __shfl_up(g, off);
            if (lane >= off) g += v;
          }
          pfx_g = g; pfx_b = sigmoidf_(b_in);
          if (lane == 63) EL[un] = __expf(g);
          if (wv < 4) { gc[wv * 64 + lane] = pfx_g; be[wv * 64 + lane] = pfx_b; }
        } else if (wv >= 4) {
          gc[(wv - 4) * 64 + lane] = pfx_g; be[(wv - 4) * 64 + lane] = pfx_b;
        }
      }
#pragma unroll 1
      for (int u = 0; u < 4; ++u) {
        const int un = grp * 8 + half * 4 + u, n = un & 63, t0 = b * 4096 + n * 64;
        int tid = tid0; asm volatile("" : "+v"(tid));
        const int lane = tid & 63, wv = tid >> 6, l15 = lane & 15, q = lane >> 4;
        const int rg = tid >> 4, cgi = tid & 15, r0 = rg * 2;
        __syncthreads();
        bf16x8 cur[3][5];
#pragma unroll
        for (int X = 0; X < 3; ++X)
#pragma unroll
          for (int i = 0; i < 5; ++i) cur[X][i] = nxt[X][i];
        if (half * 4 + u < 7) G1_RAWLOAD(n + 1);
#pragma unroll
        for (int X = 0; X < 3; ++X) {
          float val[2][8];
#pragma unroll
          for (int rr = 0; rr < 2; ++rr)
#pragma unroll
            for (int e = 0; e < 8; ++e) {
              float sacc = 0.f;
#pragma unroll
              for (int tp = 0; tp < 4; ++tp) sacc += cw[(X * 4 + tp) * 128 + cgi * 8 + e] * bfe(cur[X][rr + tp], e);
              val[rr][e] = siluf_(sacc);
            }
          if (X < 2) {
#pragma unroll
            for (int rr = 0; rr < 2; ++rr) {
              float ss = 0.f;
#pragma unroll
              for (int e = 0; e < 8; ++e) ss += val[rr][e] * val[rr][e];
              ss = sum16(ss);
              float rn = rsqrtf(ss + EPS);
              if (X == 0) rn *= 0.08838834764831845f;
#pragma unroll
              for (int e = 0; e < 8; ++e) val[rr][e] *= rn;
            }
          }
          bfr* Tile = (X == 0) ? Qt : (X == 1 ? Kt : Vt);
#pragma unroll
          for (int rr = 0; rr < 2; ++rr) {
            const int r = r0 + rr;
            u32x4 pk;
            pk[0] = pack2(val[rr][0], val[rr][1]); pk[1] = pack2(val[rr][2], val[rr][3]);
            pk[2] = pack2(val[rr][4], val[rr][5]); pk[3] = pack2(val[rr][6], val[rr][7]);
            *(u32x4*)&Tile[r * 136 + cgi * 8] = pk;
            if (X == 0) {
              const float eg = __expf(gc[u * 64 + r]);
              pk[0] = pack2(val[rr][0] * eg, val[rr][1] * eg); pk[1] = pack2(val[rr][2] * eg, val[rr][3] * eg);
              pk[2] = pack2(val[rr][4] * eg, val[rr][5] * eg); pk[3] = pack2(val[rr][6] * eg, val[rr][7] * eg);
              *(u32x4*)&proj[(size_t)(bh * 4096 + n * 64 + r) * 128 + cgi * 8] = pk;
            }
          }
        }
        lds_barrier();
        {
          const int mt = wv >> 1;
          f32x4 kk[2], qk[2];
          kk[0] = kk[1] = qk[0] = qk[1] = (f32x4){0.f, 0.f, 0.f, 0.f};
#pragma unroll
          for (int ks = 0; ks < 4; ++ks) {
            bf16x8 ak = *(const bf16x8*)&Kt[(mt * 16 + l15) * 136 + ks * 32 + q * 8];
            bf16x8 aq = *(const bf16x8*)&Qt[(mt * 16 + l15) * 136 + ks * 32 + q * 8];
#pragma unroll
            for (int t2 = 0; t2 < 2; ++t2) {
              int nt = (wv & 1) * 2 + t2;
              bf16x8 bk = *(const bf16x8*)&Kt[(nt * 16 + l15) * 136 + ks * 32 + q * 8];
              kk[t2] = MFMA16(bk, ak, kk[t2]);
              qk[t2] = MFMA16(bk, aq, qk[t2]);
            }
          }
          const int i = mt * 16 + l15;
          const float giv = gc[u * 64 + i], bei = be[u * 64 + i];
#pragma unroll
          for (int t2 = 0; t2 < 2; ++t2) {
            const int m0 = ((wv & 1) * 2 + t2) * 16 + q * 4;
            f32x4 av, tv;
#pragma unroll
            for (int jx = 0; jx < 4; ++jx) {
              const int m = m0 + jx;
              const float d = (i >= m) ? __expf(giv - gc[u * 64 + m]) : 0.f;
              av[jx] = (i > m) ? bei * kk[t2][jx] * d : 0.f;
              tv[jx] = qk[t2][jx] * d;
            }
            *(f32x4*)&Asl[u * 4096 + i * 64 + m0] = av;
            u32x2 pk; pk[0] = pack2(tv[0], tv[1]); pk[1] = pack2(tv[2], tv[3]);
            *(u32x2*)&ATT[(size_t)un * 4096 + i * 64 + m0] = pk;
          }
        }
        {
          const int dd = tid >> 2, tq = tid & 3;
          const float glast = gc[u * 64 + 63];
#pragma unroll
          for (int g8 = 0; g8 < 2; ++g8) {
            const int tok0 = tq * 16 + g8 * 8;
            float okd[8], okb[8], ovb[8];
#pragma unroll
            for (int e = 0; e < 8; ++e) {
              const int tok = tok0 + e;
              const float kv = bf2f(Kt[tok * 136 + dd]), vv = bf2f(Vt[tok * 136 + dd]);
              const float gg = gc[u * 64 + tok], bb = be[u * 64 + tok];
              okd[e] = kv * __expf(glast - gg);
              okb[e] = kv * bb * __expf(gg);
              ovb[e] = vv * bb;
            }
            u32x4 pk;
            pk[0] = pack2(okd[0], okd[1]); pk[1] = pack2(okd[2], okd[3]); pk[2] = pack2(okd[4], okd[5]); pk[3] = pack2(okd[6], okd[7]);
            *(u32x4*)&KDT[(size_t)un * 8192 + dd * 64 + tok0] = pk;
            pk[0] = pack2(okb[0], okb[1]); pk[1] = pack2(okb[2], okb[3]); pk[2] = pack2(okb[4], okb[5]); pk[3] = pack2(okb[6], okb[7]);
            *(u32x4*)&SCR[(u * 2 + 0) * 8192 + dd * 64 + tok0] = pk;
            pk[0] = pack2(ovb[0], ovb[1]); pk[1] = pack2(ovb[2], ovb[3]); pk[2] = pack2(ovb[4], ovb[5]); pk[3] = pack2(ovb[6], ovb[7]);
            *(u32x4*)&SCR[(u * 2 + 1) * 8192 + dd * 64 + tok0] = pk;
          }
        }
      }
      __syncthreads();
      {
      int tid = tid0; asm volatile("" : "+v"(tid));
      const int lane = tid & 63, wv = tid >> 6;
      tri_invert32(Asl + (wv >> 1) * 4096, Tt + (wv >> 1) * 4608, Kt + (wv >> 1) * 1280, wv & 1, lane);
      __syncthreads();
      tri_merge(Asl + (wv >> 1) * 4096, Tt + (wv >> 1) * 4608, Kt + (wv >> 1) * 1280, wv & 1, lane);
      __syncthreads();
      }
      {
        int tid = tid0; asm volatile("" : "+v"(tid));
        const int lane = tid & 63, wv = tid >> 6, l15 = lane & 15, q = lane >> 4;
        bf16x8 bkf[4][2], bvf[4][2];
#pragma unroll
        for (int u = 0; u < 4; ++u)
#pragma unroll
          for (int ks = 0; ks < 2; ++ks) {
            bkf[u][ks] = *(const bf16x8*)&SCR[(u * 2) * 8192 + (wv * 16 + l15) * 64 + ks * 32 + q * 8];
            bvf[u][ks] = *(const bf16x8*)&SCR[(u * 2 + 1) * 8192 + (wv * 16 + l15) * 64 + ks * 32 + q * 8];
          }
#pragma unroll
        for (int u = 0; u < 4; ++u) {
          const int n = (grp * 8 + half * 4 + u) & 63;
          f32x4 aw[4], au[4];
#pragma unroll
          for (int i = 0; i < 4; ++i) aw[i] = au[i] = (f32x4){0.f, 0.f, 0.f, 0.f};
#pragma unroll
          for (int ks = 0; ks < 2; ++ks) {
#pragma unroll
            for (int mt = 0; mt < 4; ++mt) {
              bf16x8 a = *(const bf16x8*)&Tt[u * 4608 + (mt * 16 + l15) * 72 + ks * 32 + q * 8];
              aw[mt] = MFMA16(bkf[u][ks], a, aw[mt]);
              au[mt] = MFMA16(bvf[u][ks], a, au[mt]);
            }
          }
          bfr* Wst = (u & 1) ? Kt : (bfr*)Asl;
          bfr* Ust = Wst + 64 * 136;
#pragma unroll
          for (int mt = 0; mt < 4; ++mt) {
            const int i = mt * 16 + l15, dc = wv * 16 + q * 4;
            u32x2 pk; pk[0] = pack2(aw[mt][0], aw[mt][1]); pk[1] = pack2(aw[mt][2], aw[mt][3]);
            *(u32x2*)&Wst[i * 136 + dc] = pk;
            pk[0] = pack2(au[mt][0], au[mt][1]); pk[1] = pack2(au[mt][2], au[mt][3]);
            *(u32x2*)&Ust[i * 136 + dc] = pk;
          }
          lds_barrier();
#pragma unroll
          for (int k = 0; k < 2; ++k) {
            const int id = tid + 512 * k, row = id >> 4, c16 = id & 15;
            const size_t go = (size_t)(bh * 4096 + n * 64 + row) * 128 + c16 * 8;
            *(u32x4*)&proj[(size_t)PLANE + go] = *(const u32x4*)&Wst[row * 136 + c16 * 8];
            *(u32x4*)&proj[(size_t)2 * PLANE + go] = *(const u32x4*)&Ust[row * 136 + c16 * 8];
          }
        }
      }
      __syncthreads();
    }
  }
#undef G1_RAWLOAD
}

DI void gdn_g2(const Params& p, int j, char* lds) {
  bfr* SbT = (bfr*)lds;
  bfr* VbT = (bfr*)(lds + 4352);
  const int tid = otid(), lane = tid & 63, wv = tid >> 6, l15 = lane & 15, q = lane >> 4;
  const bfr* proj = (const bfr*)(ows(p) + O_PROJ);
  const bfr* KDT = (const bfr*)(ows(p) + O_H);
  const bfr* ATT = (const bfr*)(ows(p) + O_ATTN);
  const float* EL = (const float*)(ows(p) + O_ELAST);
  bfr* OB = (bfr*)(ows(p) + O_SCR);
  for (int unit = obid(); unit < 256; unit += gridDim.x) {
    const int xcd = unit & 7, li = unit >> 3, bh = xcd * 4 + (li >> 3), slice = li & 7;
    const int b = bh >> 3, h = bh & 7;
    const int mt = wv & 3;
    const bool lo = wv < 4;
    const float elv = EL[bh * 64 + lane];
    f32x4 S = (f32x4){0.f, 0.f, 0.f, 0.f};
    for (int e = tid; e < 16 * 136; e += 512) SbT[e] = 0;
    bf16x8 A1s[4][4], K2s[4][2], A2s[4][2];
    unsigned urs[4][4];
    const bfr* pa_u = proj + (lo ? (size_t)PLANE : (size_t)0) + (size_t)bh * 4096 * 128;
    const int pa_o = (mt * 16 + l15) * 128 + q * 8;
    const bfr* pu_u = proj + (size_t)2 * PLANE + (size_t)bh * 4096 * 128 + slice * 16;
    const int pu_o = (mt * 16 + q * 4) * 128 + (l15 & ~1);
    const int ush = (l15 & 1) * 16;
    const bfr* kd_u = KDT + (size_t)bh * 64 * 8192;
    const int kd_o = (wv * 16 + l15) * 64 + q * 8;
    const bfr* at_u = ATT + (size_t)bh * 64 * 4096;
    const int at_o = (mt * 16 + l15) * 64 + q * 8;
#define G2_GLOAD(set, n)                                                                                     \
  {                                                                                                          \
    const bfr* pa_n = pa_u + (size_t)(n) * 64 * 128;                                                         \
    _Pragma("unroll") for (int ks = 0; ks < 4; ++ks) A1s[set][ks] = *(const bf16x8*)&pa_n[pa_o + ks * 32];   \
    const bfr* kd_n = kd_u + (n) * 8192;                                                                     \
    K2s[set][0] = *(const bf16x8*)&kd_n[kd_o];                                                               \
    K2s[set][1] = *(const bf16x8*)&kd_n[kd_o + 32];                                                          \
    if (lo) {                                                                                                \
      const bfr* pu_n = pu_u + (size_t)(n) * 64 * 128;                                                       \
      _Pragma("unroll") for (int jx = 0; jx < 4; ++jx) urs[set][jx] = *(const unsigned*)&pu_n[pu_o + jx * 128];               \
    } else {                                                                                                 \
      const bfr* at_n = at_u + (n) * 4096;                                                                   \
      A2s[set][0] = *(const bf16x8*)&at_n[at_o];                                                             \
      A2s[set][1] = *(const bf16x8*)&at_n[at_o + 32];                                                        \
    }                                                                                                        \
  }
#define G2_STEP(n, rs)                                                                                       \
  {                                                                                                          \
    f32x4 acc = (f32x4){0.f, 0.f, 0.f, 0.f};                                                                 \
    _Pragma("unroll") for (int ks = 0; ks < 4; ++ks) {                                                       \
      bf16x8 sb = *(const bf16x8*)&SbT[l15 * 136 + ks * 32 + q * 8];                                         \
      acc = lo ? MFMA16(A1s[rs][ks], sb, acc) : MFMA16(sb, A1s[rs][ks], acc);     \
    }                                                                                                        \
    if (lo) {                                                                                                \
      u32x2 pk;                                                                                              \
      pk[0] = pack2(bf2f((bfr)(urs[rs][0] >> ush)) - acc[0], bf2f((bfr)(urs[rs][1] >> ush)) - acc[1]);       \
      pk[1] = pack2(bf2f((bfr)(urs[rs][2] >> ush)) - acc[2], bf2f((bfr)(urs[rs][3] >> ush)) - acc[3]);       \
      *(u32x2*)&VbT[l15 * 72 + mt * 16 + q * 4] = pk;                                                        \
    }                                                                                                        \
    lds_barrier();                                                                                           \
    bf16x8 vb0 = *(const bf16x8*)&VbT[l15 * 72 + q * 8];                                                     \
    bf16x8 vb1 = *(const bf16x8*)&VbT[l15 * 72 + 32 + q * 8];                                                \
    if (!lo) {                                                                                               \
      acc = MFMA16(vb0, A2s[rs][0], acc);                                                                    \
      acc = MFMA16(vb1, A2s[rs][1], acc);                                                                    \
      u32x2 ok; ok[0] = pack2(acc[0], acc[1]); ok[1] = pack2(acc[2], acc[3]);                                \
      *(u32x2*)&OB[((size_t)(b * 4096 + (n) * 64) + mt * 16 + l15) * 1024 + h * 128 + slice * 16 + q * 4] = ok;  \
    }                                                                                                        \
    const float el = __shfl(elv, (n));                                                                       \
    S = S * el;                                                                                              \
    S = MFMA16(K2s[rs][0], vb0, S);                                                                          \
    S = MFMA16(K2s[rs][1], vb1, S);                                                                          \
    {                                                                                                        \
      u32x2 pk;                                                                                              \
      pk[0] = pack2(S[0], S[1]);                                                                             \
      pk[1] = pack2(S[2], S[3]);                                                                             \
      *(u32x2*)&SbT[l15 * 136 + wv * 16 + q * 4] = pk;                                                       \
    }                                                                                                        \
    if ((n) + 4 < 64) G2_GLOAD(rs, (n) + 4);                                                                 \
    lds_barrier();                                                                                           \
  }
    G2_GLOAD(0, 0);
    G2_GLOAD(1, 1);
    G2_GLOAD(2, 2);
    G2_GLOAD(3, 3);
    __syncthreads();
#pragma unroll 1
    for (int n = 0; n < 64; n += 4) {
      G2_STEP(n, 0);
      G2_STEP(n + 1, 1);
      G2_STEP(n + 2, 2);
      G2_STEP(n + 3, 3);
    }
#undef G2_GLOAD
#undef G2_STEP
  }
}

DI void gdn_g2l(const Params& p, int j, char* lds) {
  constexpr int STG = 51200;
  bfr* SbT = (bfr*)(lds + 3 * STG);
  bfr* VbT = (bfr*)(lds + 3 * STG + 4352);
  const int tid = otid(), lane = tid & 63, wv = tid >> 6, l15 = lane & 15, q = lane >> 4;
  const bfr* proj = (const bfr*)(ows(p) + O_PROJ);
  const bfr* KDT = (const bfr*)(ows(p) + O_H);
  const bfr* ATT = (const bfr*)(ows(p) + O_ATTN);
  const float* EL = (const float*)(ows(p) + O_ELAST);
  bfr* OB = (bfr*)(ows(p) + O_SCR);
  for (int unit = obid(); unit < 256; unit += gridDim.x) {
    const int xcd = unit & 7, li = unit >> 3, bh = xcd * 4 + (li >> 3), slice = li & 7;
    const int b = bh >> 3, h = bh & 7;
    const bool loader = wv >= 4;
    for (int e = tid; e < 16 * 136; e += 512) SbT[e] = 0;
    if (loader) {
      const int lw = __builtin_amdgcn_readfirstlane(wv - 4);
      const bfr* wq_u = proj + (size_t)bh * 4096 * 128;
      const bfr* kd_u = KDT + (size_t)bh * 64 * 8192;
      const int lo_wq = (lane >> 2) * 128 + (lane & 3) * 8, lo_kd = (lane >> 2) * 64 + (lane & 3) * 8;
      const bfr* u_u = proj + (size_t)2 * PLANE + (size_t)bh * 4096 * 128 + slice * 16 + (lw * 32 + (lane >> 1)) * 128 + (lane & 1) * 8;
#define G2L_DMA(c, stg)                                                                                      \
  {                                                                                                          \
    const int cc = (c) < 64 ? (c) : 63;                                                                      \
    const bfr* wq_c = wq_u + (size_t)cc * 64 * 128;                                                          \
    const bfr* kd_c = kd_u + (size_t)cc * 8192;                                                              \
    _Pragma("unroll") for (int i = 0; i < 12; ++i) {                                                         \
      const int blk = lw * 12 + i, X = blk >> 4, idx = blk & 15;                                             \
      const bfr* g = (X == 2) ? (kd_c + ((idx >> 1) * 16 * 64 + (idx & 1) * 32) + lo_kd)                     \
                              : (wq_c + (X == 0 ? (size_t)PLANE : (size_t)0) + ((idx >> 2) * 16 * 128 + (idx & 3) * 32) + lo_wq);  \
      __builtin_amdgcn_global_load_lds((const unsigned*)g, (PG8_LAS unsigned*)(lds + (stg) * STG + blk * 1024), 16, 0, 0);  \
    }                                                                                                        \
    if (lw < 2) __builtin_amdgcn_global_load_lds((const unsigned*)(u_u + (size_t)cc * 64 * 128), (PG8_LAS unsigned*)(lds + (stg) * STG + (48 + lw) * 1024), 16, 0, 0);  \
  }
#define G2L_WAITPREV() { if (lw < 2) asm volatile("s_waitcnt vmcnt(13)" ::: "memory"); else asm volatile("s_waitcnt vmcnt(12)" ::: "memory"); }
      G2L_DMA(0, 0);
      G2L_DMA(1, 1);
      G2L_WAITPREV();
      lds_barrier();
#pragma unroll 1
      for (int n = 0; n < 64; n += 3) {
#pragma unroll
        for (int s3 = 0; s3 < 3; ++s3) {
          if (n + s3 < 64) {
            G2L_DMA(n + s3 + 2, (s3 + 2) % 3);
            lds_barrier();
            G2L_WAITPREV();
            lds_barrier();
          }
        }
      }
      asm volatile("s_waitcnt vmcnt(0)" ::: "memory");
#undef G2L_DMA
#undef G2L_WAITPREV
    } else {
      const int mt = wv;
      const float elv = EL[bh * 64 + lane];
      f32x4 S0 = (f32x4){0.f, 0.f, 0.f, 0.f}, S1 = S0;
      bf16x8 At[4][2];
      const bfr* at_u = ATT + (size_t)bh * 64 * 4096 + (mt * 16 + l15) * 64 + q * 8;
#define G2L_GLOAD(set, c)                                                                                    \
  {                                                                                                          \
    const int cc = (c) < 64 ? (c) : 63;                                                                      \
    At[set][0] = *(const bf16x8*)&at_u[cc * 4096];                                                           \
    At[set][1] = *(const bf16x8*)&at_u[cc * 4096 + 32];                                                      \
  }
#define G2L_STEP(n, stg, rs)                                                                                 \
  {                                                                                                          \
    const char* sb_ = lds + (stg) * STG + l15 * 64 + q * 16;                                                 \
    f32x4 accp = (f32x4){0.f, 0.f, 0.f, 0.f}, acco = accp;                                                   \
    if ((n) > 0) {     \
      accd = MFMA16(vbd0, Atd0, accd);                                                                       \
      accd = MFMA16(vbd1, Atd1, accd);                                                                       \
      u32x2 ok; ok[0] = pack2(accd[0], accd[1]); ok[1] = pack2(accd[2], accd[3]);                            \
      *(u32x2*)&OB[((size_t)(b * 4096 + ((n) - 1) * 64) + mt * 16 + l15) * 1024 + h * 128 + slice * 16 + q * 4] = ok;  \
    }                                                                                                        \
    bf16x8 sbv[4], wfv[4], qfv[4];     \
    _Pragma("unroll") for (int ks = 0; ks < 4; ++ks) {                                                       \
      sbv[ks] = *(const bf16x8*)&SbT[l15 * 136 + ks * 32 + q * 8];                                           \
      wfv[ks] = *(const bf16x8*)(sb_ + (mt * 4 + ks) * 1024);                                                \
    }                                                                                                        \
    _Pragma("unroll") for (int ks = 0; ks < 4; ++ks) qfv[ks] = *(const bf16x8*)(sb_ + (16 + mt * 4 + ks) * 1024);  \
    __builtin_amdgcn_sched_barrier(0);                                                                       \
    _Pragma("unroll") for (int ks = 0; ks < 4; ++ks) {                                                       \
      accp = MFMA16(wfv[ks], sbv[ks], accp);                                                                 \
      acco = MFMA16(sbv[ks], qfv[ks], acco);                 \
    }                                                                                                        \
    {                                                                                                        \
      u32x2 pk;                                                                                              \
      const bfr* up_ = (const bfr*)(lds + (stg) * STG + 48 * 1024) + (mt * 16 + q * 4) * 16 + l15;           \
      pk[0] = pack2(bf2f(up_[0]) - accp[0], bf2f(up_[16]) - accp[1]);                                        \
      pk[1] = pack2(bf2f(up_[32]) - accp[2], bf2f(up_[48]) - accp[3]);                                       \
      *(u32x2*)&VbT[l15 * 72 + mt * 16 + q * 4] = pk;                                                        \
    }                                                                                                        \
    lds_barrier();                                                                                           \
    const bf16x8 vb0 = *(const bf16x8*)&VbT[l15 * 72 + q * 8];                                               \
    const bf16x8 vb1 = *(const bf16x8*)&VbT[l15 * 72 + 32 + q * 8];                                          \
    accd = acco; vbd0 = vb0; vbd1 = vb1; Atd0 = At[rs][0]; Atd1 = At[rs][1];                                 \
    const float el = __uint_as_float(__builtin_amdgcn_readlane(__float_as_uint(elv), (n)));       \
    S0 = S0 * el; S1 = S1 * el;                                                                              \
    {                                                                                                        \
      const bf16x8 k00 = *(const bf16x8*)(sb_ + (32 + (2 * mt) * 2 + 0) * 1024), k01 = *(const bf16x8*)(sb_ + (32 + (2 * mt) * 2 + 1) * 1024);          \
      const bf16x8 k10 = *(const bf16x8*)(sb_ + (32 + (2 * mt + 1) * 2 + 0) * 1024), k11 = *(const bf16x8*)(sb_ + (32 + (2 * mt + 1) * 2 + 1) * 1024);  \
      S0 = MFMA16(k00, vb0, S0);                                                                             \
      S1 = MFMA16(k10, vb0, S1);                                                                             \
      S0 = MFMA16(k01, vb1, S0);                                                                             \
      S1 = MFMA16(k11, vb1, S1);                                                                             \
    }                                                                                                        \
    {                                                                                                        \
      u32x2 pk;                                                                                              \
      pk[0] = pack2(S0[0], S0[1]); pk[1] = pack2(S0[2], S0[3]);                                              \
      *(u32x2*)&SbT[l15 * 136 + (2 * mt) * 16 + q * 4] = pk;                                                 \
      pk[0] = pack2(S1[0], S1[1]); pk[1] = pack2(S1[2], S1[3]);                                              \
      *(u32x2*)&SbT[l15 * 136 + (2 * mt + 1) * 16 + q * 4] = pk;                                             \
    }                                                                                                        \
    G2L_GLOAD(rs, (n) + 4);                                                                                  \
    lds_barrier();                                                                                           \
  }
      G2L_GLOAD(0, 0);
      G2L_GLOAD(1, 1);
      G2L_GLOAD(2, 2);
      G2L_GLOAD(3, 3);
      f32x4 accd = (f32x4){0.f, 0.f, 0.f, 0.f};
      bf16x8 vbd0 = (bf16x8){0, 0, 0, 0, 0, 0, 0, 0}, vbd1 = vbd0, Atd0 = vbd0, Atd1 = vbd0;
      lds_barrier();
#pragma unroll 1
      for (int n = 0; n < 60; n += 12) {
        G2L_STEP(n, 0, 0); G2L_STEP(n + 1, 1, 1); G2L_STEP(n + 2, 2, 2); G2L_STEP(n + 3, 0, 3);
        G2L_STEP(n + 4, 1, 0); G2L_STEP(n + 5, 2, 1); G2L_STEP(n + 6, 0, 2); G2L_STEP(n + 7, 1, 3);
        G2L_STEP(n + 8, 2, 0); G2L_STEP(n + 9, 0, 1); G2L_STEP(n + 10, 1, 2); G2L_STEP(n + 11, 2, 3);
      }
      G2L_STEP(60, 0, 0); G2L_STEP(61, 1, 1); G2L_STEP(62, 2, 2); G2L_STEP(63, 0, 3);
      {
        accd = MFMA16(vbd0, Atd0, accd);
        accd = MFMA16(vbd1, Atd1, accd);
        u32x2 ok; ok[0] = pack2(accd[0], accd[1]); ok[1] = pack2(accd[2], accd[3]);
        *(u32x2*)&OB[((size_t)(b * 4096 + 63 * 64) + mt * 16 + l15) * 1024 + h * 128 + slice * 16 + q * 4] = ok;
      }
#undef G2L_GLOAD
#undef G2L_STEP
    }
    __syncthreads();
  }
}

DI void gdn_g3(const Params& p, int j, char* lds) {
  const int tid = otid(), lane = tid & 63, wv = tid >> 6, l15 = lane & 15, q = lane >> 4;
  const bfr* proj = (const bfr*)(ows(p) + O_PROJ);
  bfr* OB = (bfr*)(ows(p) + O_SCR);
  f32x4 g0 = *(const f32x4*)&p.gdn_onorm_g[j * 128 + l15 * 8], g1 = *(const f32x4*)&p.gdn_onorm_g[j * 128 + l15 * 8 + 4];
  const int stride = gridDim.x * 32;
  int pi = (obid() * 8 + wv) * 4 + q;
  bf16x8 ov, zv;
#define G3_LOAD(pp)                                                                                                  \
  {                                                                                                                  \
    const int t_ = (pp) >> 3, h_ = (pp) & 7;                                                                         \
    ov = *(const bf16x8*)&OB[(size_t)t_ * 1024 + h_ * 128 + l15 * 8];                                                \
    zv = *(const bf16x8*)&proj[(size_t)3 * PLANE + (size_t)(((t_ >> 12) * 8 + h_) * 4096 + (t_ & 4095)) * 128 + l15 * 8];  \
  }
  if (pi < 131072) G3_LOAD(pi);
  for (; pi < 131072; pi += stride) {
    const int t = pi >> 3, h = pi & 7;
    const bf16x8 oc = ov, zc = zv;
    if (pi + stride < 131072) G3_LOAD(pi + stride);
    float o[8], ss = 0.f;
#pragma unroll
    for (int e = 0; e < 8; ++e) { o[e] = bfe(oc, e); ss += o[e] * o[e]; }
    ss = sum16(ss);
    const float rstd = rsqrtf(ss * (1.f / 128.f) + EPS);
    float y[8];
#pragma unroll
    for (int e = 0; e < 8; ++e) y[e] = o[e] * rstd * (e < 4 ? g0[e] : g1[e - 4]) * siluf_(bfe(zc, e));
    u32x4 pk;
    pk[0] = pack2(y[0], y[1]); pk[1] = pack2(y[2], y[3]); pk[2] = pack2(y[4], y[5]); pk[3] = pack2(y[6], y[7]);
    *(u32x4*)&OB[(size_t)t * 1024 + h * 128 + l15 * 8] = pk;
  }
#undef G3_LOAD
}


#define XB_TMO      128
#define XB_XCNT(j)  (256  + 64 * (j))
#define XB_XSUB(j)  (1280 + 64 * (j))
#define XB_XGEN(j)  (2304 + 64 * (j))
#define XB_TOP      3328
#define XB_TOPGEN   3392
#define XCD_BAR_WORDS 3456
#define XB_SPIN_CAP (1u << 18)
#define LAS __attribute__((address_space(3)))

__device__ __forceinline__ unsigned xb_ld(unsigned* p)              { return __hip_atomic_load(p, __ATOMIC_RELAXED, __HIP_MEMORY_SCOPE_AGENT); }
__device__ __forceinline__ unsigned xb_add(unsigned* p, unsigned v) { return __hip_atomic_fetch_add(p, v, __ATOMIC_RELAXED, __HIP_MEMORY_SCOPE_AGENT); }
__device__ __forceinline__ unsigned xb_xcc_id() { return (unsigned)__builtin_amdgcn_s_getreg((3 << 11) | 20) & 0xFu; }
#define XB_SPIN(cond, bar) do { unsigned _sp = 0; while (cond) { __builtin_amdgcn_s_sleep(1); \
    if ((++_sp & 255u) == 0u) { if (xb_ld(&(bar)[XB_TMO])) break; if (_sp > XB_SPIN_CAP) { atomicAdd(&(bar)[XB_TMO], 1u); break; } } } } while (0)

struct XcdBarrier {
    unsigned* bar; unsigned x;
    volatile LAS unsigned* st;
};

__device__ __forceinline__ XcdBarrier xcd_barrier_post(unsigned* bar, volatile LAS unsigned* st) {
    XcdBarrier b; b.bar = bar; b.x = xb_xcc_id(); b.st = st;
    if (threadIdx.x == 0) (void)xb_add(&bar[XB_XCNT(b.x)], 1u);
    return b;
}
__device__ __forceinline__ void xcd_barrier_complete(unsigned* bar, unsigned x, unsigned& nloc, unsigned& nx) {
    const unsigned G = gridDim.x * gridDim.y * gridDim.z;
    unsigned sum, cnt, mine, sp = 0u;
    for (;;) {
        sum = 0u; cnt = 0u; mine = 0u;
#pragma unroll
        for (unsigned j = 0; j < 16; ++j) { const unsigned c = xb_ld(&bar[XB_XCNT(j)]); sum += c; cnt += (c > 0u) ? 1u : 0u; mine = (j == x) ? c : mine; }
        if (sum == G) break;
        __builtin_amdgcn_s_sleep(1);
        if ((++sp & 255u) == 0u) { if (xb_ld(&bar[XB_TMO])) break; if (sp > XB_SPIN_CAP) { atomicAdd(&bar[XB_TMO], 1u); break; } }
    }
    nloc = mine > 0u ? mine : 1u; nx = cnt > 0u ? cnt : 1u;
}

__device__ __forceinline__ void xcd_barrier(const XcdBarrier& b) {
    asm volatile("s_waitcnt vmcnt(0)" ::: "memory");
    __syncthreads();
    if (threadIdx.x == 0) {
        unsigned* bar = b.bar;
        __builtin_amdgcn_s_waitcnt(0);
        unsigned nloc = b.st[0], nx = b.st[1];
        if (nloc == 0u) { xcd_barrier_complete(bar, b.x, nloc, nx); b.st[0] = nloc; b.st[1] = nx; }
        const unsigned old = xb_add(&bar[XB_XSUB(b.x)], 1u);
        const unsigned gen = old / nloc;
        if (old + 1u == (gen + 1u) * nloc) {
            __builtin_amdgcn_fence(__ATOMIC_RELEASE, "agent");
            asm volatile("s_waitcnt vmcnt(0)" ::: "memory");
            const unsigned og = xb_add(&bar[XB_TOP], 1u);
            const unsigned tg = og / nx;
            if (og + 1u == (tg + 1u) * nx) xb_add(&bar[XB_TOPGEN], 1u);
            else XB_SPIN(xb_ld(&bar[XB_TOPGEN]) == tg, bar);
            __builtin_amdgcn_fence(__ATOMIC_ACQUIRE, "agent");
            xb_add(&bar[XB_XGEN(b.x)], 1u);
            asm volatile("s_waitcnt vmcnt(0)" ::: "memory");
        } else {
            XB_SPIN(xb_ld(&bar[XB_XGEN(b.x)]) == gen, bar);
            __builtin_amdgcn_fence(__ATOMIC_ACQUIRE, "agent");
            asm volatile("s_waitcnt vmcnt(0)" ::: "memory");
        }
    }
    __syncthreads();
}


DI void run_phase(const Params& p, int ph, char* lds) {
  if (ph == 0) { phase0(p, lds); return; }
  if (ph == NPHASE - 1) { norm_phase(p, 4, ows(p) + O_H, lds); return; }
  int layer, sub;
  if (ph < 5) { layer = 0; sub = ph - 1; }
  else if (ph < 11) { layer = 1; sub = ph - 5; }
  else if (ph < 15) { layer = 2; sub = ph - 11; }
  else { layer = 3; sub = ph - 15; }
  const int j = layer >> 1;
  const bool is_lru = (layer & 1) == 0;
  const bfr* H = (const bfr*)(ows(p) + O_H);
  const void* xcur = (layer == 0) ? (const void*)p.x : (const void*)p.out;
  bfr* xnext = (layer == 3) ? (bfr*)(ows(p) + O_H) : (bfr*)p.out;
  if (is_lru) {
    switch (sub) {
      case 0: norm_phase(p, layer, xcur, lds); break;
      case 1: gemm_phase<0>(p, H, 1024, (const bfr*)(ows(p) + O_WLI) + (size_t)j * 2048 * 1024, 8, layer, nullptr, nullptr, lds); break;
      case 2: lru_phase(p, j, lds); break;
      case 3: gemm_phase<2>(p, H, 1024, (const bfr*)(ows(p) + O_WLO) + (size_t)j * 1024 * 1024, 4, layer, xcur, xnext, lds); break;
    }
  } else {
    switch (sub) {
      case 0: norm_phase(p, layer, xcur, lds); break;
      case 1: gemm_phase<1>(p, H, 1024, (const bfr*)(ows(p) + O_WGI) + (size_t)j * 4224 * 1024, 16, layer, nullptr, nullptr, lds); break;
      case 2: gdn_g1(p, j, lds); break;
#if G2_LOADER
      case 3: gdn_g2l(p, j, lds); break;
#else
      case 3: gdn_g2(p, j, lds); break;
#endif
      case 4: gdn_g3(p, j, lds); break;
      case 5: gemm_phase<2>(p, (const bfr*)(ows(p) + O_SCR), 1024, (const bfr*)(ows(p) + O_WGO) + (size_t)j * 1024 * 1024, 4, layer, xcur, xnext, lds); break;
    }
  }
}

__global__ void __launch_bounds__(512) mega_fwd(Params p) {
  extern __shared__ __attribute__((aligned(16))) char lds[];
#if MK_MODE == 1
  cg::grid_group grid = cg::this_grid();
  if (p.ph_lo < 0) grid.sync();
  volatile LAS unsigned* bst = (volatile LAS unsigned*)(lds + LDS_BYTES - 16);
  if (threadIdx.x == 0) { bst[0] = 0u; bst[1] = 0u; }
  __syncthreads();
  const XcdBarrier xb = xcd_barrier_post((unsigned*)(p.ws + O_BAR), bst);
  for (int ph = p.ph_lo; ph < p.ph_hi; ++ph) {
    if (ph > p.ph_lo) xcd_barrier(xb);
#ifdef PROBE_MASK
    const bool probe = (PROBE_MASK >> ph) & 1;
    long long ts = 0;
    if (probe) ts = wall_clock64();
#endif
    run_phase(p, ph, lds);
#ifdef PROBE_MASK
    if (probe) {
      xcd_barrier(xb);
      if (blockIdx.x == 0 && threadIdx.x == 0) {
        long long dt = wall_clock64() - ts, t1 = wall_clock64();
        while (wall_clock64() - t1 < dt) __builtin_amdgcn_s_sleep(8);
      }
    }
#endif
  }
#else
  for (int ph = p.ph_lo; ph < p.ph_hi; ++ph) run_phase(p, ph, lds);
#endif
}

extern "C" void kernel_launch(void* const* d_in, const int* in_sizes, int n_in, void* d_out, int out_size, void* d_ws, size_t ws_size, hipStream_t stream) {
  static int grid = 0;
  if (grid == 0) {
    if (n_in != 19 || ws_size < WS_END) { fprintf(stderr, "kernel_launch: unexpected inputs (n_in %d, ws %zu)\n", n_in, ws_size); grid = -1; return; }
    int dev = 0, cus = 0, per_cu = 0;
    hipGetDevice(&dev);
    hipDeviceGetAttribute(&cus, hipDeviceAttributeMultiprocessorCount, dev);
    if (hipFuncSetAttribute((const void*)mega_fwd, hipFuncAttributeMaxDynamicSharedMemorySize, LDS_BYTES) != hipSuccess) { fprintf(stderr, "kernel_launch: hipFuncSetAttribute failed\n"); grid = -1; return; }
    hipOccupancyMaxActiveBlocksPerMultiprocessor(&per_cu, (const void*)mega_fwd, 512, LDS_BYTES);
    if (per_cu < 1) { fprintf(stderr, "kernel_launch: occupancy query returned %d\n", per_cu); per_cu = 1; }
    (void)hipGetLastError();
    grid = cus * per_cu;
    if (grid > 256) grid = 256;
  }
  if (grid < 0) return;
  Params p{};
  const float** pp = (const float**)&p;
  for (int i = 0; i < 19; ++i) pp[i] = (const float*)d_in[i];
  p.out = (float*)d_out;
  p.ws = (char*)d_ws;
#if MK_MODE == 1
  p.ph_lo = 0; p.ph_hi = NPHASE;
  if (hipMemsetAsync((char*)d_ws + O_BAR, 0, 16384, stream) != hipSuccess) { fprintf(stderr, "kernel_launch: memset of barrier words failed\n"); return; }
  void* args[] = {&p};
  hipError_t e = hipLaunchCooperativeKernel((const void*)mega_fwd, dim3(grid), dim3(512), args, LDS_BYTES, stream);
  if (e != hipSuccess) fprintf(stderr, "cooperative launch failed: %s (grid %d)\n", hipGetErrorString(e), grid);
#else
  for (int ph = 0; ph < NPHASE; ++ph) {
    p.ph_lo = ph; p.ph_hi = ph + 1;
    hipLaunchKernelGGL(mega_fwd, dim3(grid), dim3(512), LDS_BYTES, stream, p);
  }
#endif
}
```

```cpp
#include <hip/hip_runtime.h>
#include <hip/hip_cooperative_groups.h>
#include <cstdio>
namespace cg = cooperative_groups;

#ifndef G2_LOADER
#define G2_LOADER 1
#endif
#ifndef MK_MODE
#define MK_MODE 1
#endif

typedef unsigned short bfr;
typedef __attribute__((ext_vector_type(8))) short bf16x8;
typedef __attribute__((ext_vector_type(4))) short bf16x4;
typedef __attribute__((ext_vector_type(4))) float f32x4;
typedef __attribute__((ext_vector_type(4))) unsigned u32x4;
typedef __attribute__((ext_vector_type(2))) unsigned u32x2;

#define DI __device__ __forceinline__
#define MFMA16(a, b, c) __builtin_amdgcn_mfma_f32_16x16x32_bf16((a), (b), (c), 0, 0, 0)

constexpr int PLANE = 16384 * 1024;
constexpr float EPS = 1e-6f;
constexpr int NPHASE = 22;
constexpr int LDS_BYTES = 163840;

constexpr size_t O_WLI = 0;
constexpr size_t O_WLO = 8388608;
constexpr size_t O_WGI = 12582912;
constexpr size_t O_WGO = 29884416;
constexpr size_t O_WG = 34078720;
constexpr size_t O_CONDP = 35127296;
constexpr size_t O_H = 36700160;
constexpr size_t O_PROJ = 70254592;
constexpr size_t O_ATTN = 204996608;
constexpr size_t O_HALO = 221773824;
constexpr size_t O_SCR = 226492416;
constexpr size_t O_AB = 260046848;
constexpr size_t O_ELAST = 261095424;
constexpr size_t O_AGG = 261103616;
constexpr size_t O_COND = 263200768;
constexpr size_t O_BAR = 263397376;
constexpr size_t WS_END = 263397376 + 16384;

struct Params {
  const float *x, *c, *ada_w, *ada_b, *norm_g, *final_g;
  const float *lru_in_w, *lru_conv_w, *lru_conv_b, *lru_gate_w, *lru_gate_b, *lru_lambda, *lru_out_w;
  const float *gdn_in_w, *gdn_conv_w, *gdn_a_log, *gdn_dt_bias, *gdn_onorm_g, *gdn_out_w;
  float* out;
  char* ws;
  int ph_lo, ph_hi;
};

DI int otid() { int t = threadIdx.x; asm volatile("" : "+v"(t)); return t; }
DI int obid() { int b = blockIdx.x; asm volatile("" : "+s"(b)); return b; }
DI void lds_barrier() { asm volatile("s_waitcnt lgkmcnt(0)" ::: "memory"); __builtin_amdgcn_s_barrier(); asm volatile("" ::: "memory"); }
typedef float f32x2_t __attribute__((ext_vector_type(2)));
typedef __bf16 bf16x2_t __attribute__((ext_vector_type(2)));
DI unsigned pack2(float a, float b) { f32x2_t v = {a, b}; bf16x2_t r = __builtin_convertvector(v, bf16x2_t); return __builtin_bit_cast(unsigned, r); }
DI bfr f2bf(float x) { return (bfr)(pack2(x, x) & 0xffffu); }
DI float bf2f(bfr b) { return __uint_as_float(((unsigned)b) << 16); }
DI float sum16(float x) {
  x += __uint_as_float(__builtin_amdgcn_update_dpp(0, __float_as_uint(x), 0xB1, 0xF, 0xF, true));
  x += __uint_as_float(__builtin_amdgcn_update_dpp(0, __float_as_uint(x), 0x4E, 0xF, 0xF, true));
  x += __uint_as_float(__builtin_amdgcn_update_dpp(0, __float_as_uint(x), 0x141, 0xF, 0xF, true));
  x += __uint_as_float(__builtin_amdgcn_update_dpp(0, __float_as_uint(x), 0x140, 0xF, 0xF, true));
  return x;
}
DI float sigmoidf_(float x) { return __builtin_amdgcn_rcpf(1.f + __expf(-x)); }
DI float siluf_(float x) { return x * __builtin_amdgcn_rcpf(1.f + __expf(-x)); }
DI float softplusf_(float x) { return x > 20.f ? x : log1pf(expf(x)); }
DI float bfe(const bf16x8& v, int e) { return bf2f((bfr)v[e]); }

DI char* ows(const Params& p) { size_t z = 0; asm volatile("" : "+s"(z)); return p.ws + z; }
DI float cond_get(const Params& p, int layer, int b, int n) {
  const float* cp = (const float*)(ows(p) + O_CONDP);
  float s = p.ada_b[layer * 3072 + n];
#pragma unroll
  for (int sg = 0; sg < 8; ++sg) s += cp[((sg * 4 + layer) * 4 + b) * 3072 + n];
  return s;
}

DI void transpose_tile(const float* __restrict__ src, int ldsrc, int nvalid, bfr* __restrict__ dst, int ldd, int k0, int n0, float* sm) {
  const int tid = otid();
  for (int e = tid; e < 4096; e += 512) {
    int kk = e >> 6, nn = e & 63;
    float v = 0.f;
    if (n0 + nn < nvalid) v = src[(size_t)(k0 + kk) * ldsrc + n0 + nn];
    sm[kk * 65 + nn] = v;
  }
  __syncthreads();
  for (int e = tid; e < 4096; e += 512) {
    int nn = e >> 6, kk = e & 63;
    dst[(size_t)(n0 + nn) * ldd + k0 + kk] = f2bf(sm[kk * 65 + nn]);
  }
  __syncthreads();
}

struct P0Item { const float* src; bfr* dst; int ldsrc, nvalid, ldd, k0, n0; };
DI P0Item p0_decode(const Params& p, int it) {
  P0Item r;
  if (it < 1024) {
    int l = it >> 9, q = it & 511, kt = q >> 5, nt = q & 31;
    r.src = p.lru_in_w + (size_t)l * 1024 * 2048; r.ldsrc = 2048; r.nvalid = 2048; r.dst = (bfr*)(ows(p) + O_WLI) + (size_t)l * 2048 * 1024; r.ldd = 1024; r.k0 = kt * 64; r.n0 = nt * 64;
  } else if (it < 1536) {
    int r0 = it - 1024, l = r0 >> 8, q = r0 & 255, kt = q >> 4, nt = q & 15;
    r.src = p.lru_out_w + (size_t)l * 1024 * 1024; r.ldsrc = 1024; r.nvalid = 1024; r.dst = (bfr*)(ows(p) + O_WLO) + (size_t)l * 1024 * 1024; r.ldd = 1024; r.k0 = kt * 64; r.n0 = nt * 64;
  } else if (it < 3648) {
    int r0 = it - 1536, l = r0 / 1056, q = r0 % 1056, kt = q / 66, nt = q % 66;
    r.src = p.gdn_in_w + (size_t)l * 1024 * 4112; r.ldsrc = 4112; r.nvalid = 4112; r.dst = (bfr*)(ows(p) + O_WGI) + (size_t)l * 4224 * 1024; r.ldd = 1024; r.k0 = kt * 64; r.n0 = nt * 64;
  } else if (it < 4160) {
    int r0 = it - 3648, l = r0 >> 8, q = r0 & 255, kt = q >> 4, nt = q & 15;
    r.src = p.gdn_out_w + (size_t)l * 1024 * 1024; r.ldsrc = 1024; r.nvalid = 1024; r.dst = (bfr*)(ows(p) + O_WGO) + (size_t)l * 1024 * 1024; r.ldd = 1024; r.k0 = kt * 64; r.n0 = nt * 64;
  } else {
    int r0 = it - 4160, mat = r0 >> 2, q = r0 & 3, kt = q >> 1, nt = q & 1;
    r.src = p.lru_gate_w + (size_t)mat * 16384; r.ldsrc = 128; r.nvalid = 128; r.dst = (bfr*)(ows(p) + O_WG) + (size_t)mat * 16384; r.ldd = 128; r.k0 = kt * 64; r.n0 = nt * 64;
  }
  return r;
}

DI void phase0(const Params& p, char* lds) {
  float* sm = (float*)lds;
  const int tid = otid();
  float v[8];
#define P0_LOAD(it_)                                                                                 \
  {                                                                                                  \
    const P0Item t_ = p0_decode(p, (it_));                                                           \
    _Pragma("unroll") for (int i = 0; i < 8; ++i) {                                                  \
      const int e = tid + 512 * i, kk = e >> 6, nn = e & 63;                                         \
      v[i] = (t_.n0 + nn < t_.nvalid) ? __builtin_nontemporal_load(&t_.src[(size_t)(t_.k0 + kk) * t_.ldsrc + t_.n0 + nn]) : 0.f; \
    }                                                                                                \
  }
  if (obid() < 4288) P0_LOAD(obid());
#pragma unroll 1
  for (int it = obid(); it < 4288; it += gridDim.x) {
    const P0Item t = p0_decode(p, it);
#pragma unroll
    for (int i = 0; i < 8; ++i) { const int e = tid + 512 * i; sm[(e >> 6) * 65 + (e & 63)] = v[i]; }
    lds_barrier();
    if (it + (int)gridDim.x < 4288) P0_LOAD(it + gridDim.x);
#pragma unroll
    for (int i = 0; i < 4; ++i) {
      const int e = tid + 512 * i, nn = e >> 5, kp = e & 31;
      *(unsigned*)&t.dst[(size_t)(t.n0 + nn) * t.ldd + t.k0 + 2 * kp] = pack2(sm[(2 * kp) * 65 + nn], sm[(2 * kp + 1) * 65 + nn]);
    }
    lds_barrier();
  }
#undef P0_LOAD
  __syncthreads();
  for (int r0 = obid(); r0 < 192; r0 += gridDim.x) {
    int i = r0 / 48, r = r0 % 48, sg = r / 6, cb = r % 6;
    sm[tid] = siluf_(p.c[(tid >> 7) * 1024 + sg * 128 + (tid & 127)]);
    __syncthreads();
    int n = cb * 512 + tid;
    float a0 = 0.f, a1 = 0.f, a2 = 0.f, a3 = 0.f;
    const float* w = p.ada_w + ((size_t)i * 1024 + sg * 128) * 3072 + n;
#pragma unroll 32
    for (int k = 0; k < 128; ++k) {
      float wv = __builtin_nontemporal_load(&w[(size_t)k * 3072]);
      a0 += sm[k] * wv; a1 += sm[128 + k] * wv; a2 += sm[256 + k] * wv; a3 += sm[384 + k] * wv;
    }
    float* cp = (float*)(ows(p) + O_CONDP);
    cp[((sg * 4 + i) * 4 + 0) * 3072 + n] = a0;
    cp[((sg * 4 + i) * 4 + 1) * 3072 + n] = a1;
    cp[((sg * 4 + i) * 4 + 2) * 3072 + n] = a2;
    cp[((sg * 4 + i) * 4 + 3) * 3072 + n] = a3;
    __syncthreads();
  }
}

DI void norm_phase(const Params& p, int layer, const void* __restrict__ xsrc, char* lds) {
  const float* xs = (const float*)xsrc; const bfr* xsb = (const bfr*)xsrc;
  float* gm = (float*)lds;
  float* sh = gm + 1024;
  const int tid = otid(), lane = tid & 63, wv = tid >> 6;
  bfr* H = (bfr*)(ows(p) + O_H);
  if (layer == 0) {
    float* cd = (float*)(ows(p) + O_COND);
    for (int e = obid() * 512 + tid; e < 4 * 4 * 3072; e += gridDim.x * 512) {
      int n = e % 3072, ib = e / 3072;
      cd[e] = cond_get(p, ib >> 2, ib & 3, n);
    }
  }
  const float* cd = (const float*)(ows(p) + O_COND);
  for (int rt = obid(); rt < 256; rt += gridDim.x) {
    int b = rt >> 6;
    for (int c = tid; c < 1024; c += 512) {
      if (layer == 0) {
        float scale = cond_get(p, layer, b, 1024 + c), shift = cond_get(p, layer, b, c);
        gm[c] = p.norm_g[layer * 1024 + c] * (1.f + scale);
        sh[c] = shift;
      } else if (layer < 4) {
        gm[c] = p.norm_g[layer * 1024 + c] * (1.f + cd[(size_t)(layer * 4 + b) * 3072 + 1024 + c]);
        sh[c] = cd[(size_t)(layer * 4 + b) * 3072 + c];
      } else {
        gm[c] = p.final_g[c];
        sh[c] = 0.f;
      }
    }
    __syncthreads();
    u32x2 rb[2][4][4];
    if (layer != 0) {
#pragma unroll
      for (int g = 0; g < 2; ++g)
#pragma unroll
        for (int r = 0; r < 4; ++r)
#pragma unroll
          for (int jx = 0; jx < 4; ++jx) rb[g][r][jx] = *(const u32x2*)&xsb[((size_t)rt * 64 + wv * 8 + g * 4 + r) * 1024 + jx * 256 + lane * 4];
    }
#pragma unroll
    for (int r4 = 0; r4 < 8; r4 += 4) {
      f32x4 v[4][4];
#pragma unroll
      for (int r = 0; r < 4; ++r)
#pragma unroll
        for (int jx = 0; jx < 4; ++jx) {
          const size_t xi = ((size_t)rt * 64 + wv * 8 + r4 + r) * 1024 + jx * 256 + lane * 4;
          if (layer == 0) v[r][jx] = *(const f32x4*)&xs[xi];
          else {
            const u32x2 xb = rb[r4 >> 2][r][jx];
            v[r][jx] = (f32x4){__uint_as_float(xb[0] << 16), __uint_as_float(xb[0] & 0xffff0000u), __uint_as_float(xb[1] << 16), __uint_as_float(xb[1] & 0xffff0000u)};
          }
        }
#pragma unroll
      for (int r = 0; r < 4; ++r) {
        const size_t row = (size_t)rt * 64 + wv * 8 + r4 + r;
        float ss = 0.f;
#pragma unroll
        for (int jx = 0; jx < 4; ++jx) ss += v[r][jx][0] * v[r][jx][0] + v[r][jx][1] * v[r][jx][1] + v[r][jx][2] * v[r][jx][2] + v[r][jx][3] * v[r][jx][3];
        ss = sum16(ss);
        ss += __shfl_xor(ss, 16);
        ss += __shfl_xor(ss, 32);
        const float rstd = rsqrtf(ss * (1.f / 1024.f) + EPS);
#pragma unroll
        for (int jx = 0; jx < 4; ++jx) {
          const int c = jx * 256 + lane * 4;
          f32x4 g4 = *(const f32x4*)&gm[c], s4 = *(const f32x4*)&sh[c];
          f32x4 y;
#pragma unroll
          for (int e = 0; e < 4; ++e) y[e] = v[r][jx][e] * rstd * g4[e] + s4[e];
          if (layer < 4) {
            u32x2 o2; o2[0] = pack2(y[0], y[1]); o2[1] = pack2(y[2], y[3]);
            *(u32x2*)&H[row * 1024 + c] = o2;
          } else {
            __builtin_nontemporal_store(y, (f32x4*)&p.out[row * 1024 + c]);
          }
        }
      }
    }
    __syncthreads();
  }
}

namespace pg8 {
#define PG8_LAS __attribute__((address_space(3)))
typedef unsigned short bf16_t;
typedef short bf16x8 __attribute__((ext_vector_type(8)));
typedef float f32x4 __attribute__((ext_vector_type(4)));
typedef unsigned u32x4 __attribute__((ext_vector_type(4)));
constexpr int BM = 256, BK = 64, HALF = 128, HTB = HALF * BK * 2  , STAGE_BYTES = 8 * HTB, NXCD = 8, WGM = 8;

__host__ __device__ __forceinline__ int lds_byte(int r, int c) { const int st = (r >> 4) * 2 + (c >> 5), rr = r & 15, cc = c & 31, ob = rr * 64 + cc * 2; return st * 1024 + (ob ^ (((ob >> 9) & 1) << 5)); }
__host__ __device__ __forceinline__ void stage_rc(int b, int& R, int& C) { const int st = b / 1024, sb = b % 1024, swz = sb ^ (((sb >> 9) & 1) << 5); R = (st >> 1) * 16 + swz / 64; C = (st & 1) * 32 + (swz % 64) / 2; }
__host__ __device__ __forceinline__ int perm32(int rho) { const int n = rho >> 4, i = rho & 15; return 8 * (i >> 2) + 4 * n + (i & 3); }

struct Unit { int pm, pn; };
struct Gemm { const bf16_t* A; const bf16_t* Bt; int M, N, K; };

struct StaticOrder {
    int nM, nN, nwg, G, c;
    __host__ __device__ void init(int M, int N, int G_, int c_) { nM = M / BM; nN = N / BM; nwg = nM * nN; G = G_; c = c_; }
    __host__ __device__ bool next(int i, Unit& u) const {
        const long L = (long)i * G + c; if (L >= nwg) return false;
        int wgid = (int)L; { const int q = nwg / NXCD, r = nwg % NXCD, xcd = wgid % NXCD, off = wgid / NXCD; wgid = (xcd < r ? xcd * (q + 1) : r * (q + 1) + (xcd - r) * q) + off; }
        const int nig = WGM * nN, gid = wgid / nig, fm = gid * WGM, gsz = (nM - fm) < WGM ? (nM - fm) : WGM;
        u.pm = fm + ((wgid % nig) % gsz); u.pn = (wgid % nig) / gsz; return true;
    }
    __device__ __forceinline__ void a_ready(const Unit&) const {}
    __device__ __forceinline__ void done(const Unit&) const {}
};
__device__ __forceinline__ unsigned cvt_pk_bf16(float lo, float hi) { unsigned r; asm volatile("v_cvt_pk_bf16_f32 %0, %1, %2" : "=v"(r) : "v"(lo), "v"(hi)); return r; }

template <class Epi, class Sched, bool STAMP = false>
__device__ __forceinline__ void gemm_phase(PG8_LAS unsigned char* lds, const Gemm g, const Sched& S, const Epi& E, unsigned long long* stamps) {
    const int tid = otid(), wid = __builtin_amdgcn_readfirstlane(tid >> 6), lane = tid & 63, wr = wid >> 2, wc = wid & 3, fr = lane & 15, fq = lane >> 4;
    const int K = g.K, nt = K / BK;
    int ts_lo = 0, ts_hi = 0, nts = 0; const unsigned long long rt_entry = STAMP ? (unsigned long long)wall_clock64() : 0ull;
#define PG8_STAMP() do { if (STAMP && wid == 0 && nts < 64) { const unsigned long long _c = (unsigned long long)clock64(); \
        ts_lo = (lane == nts) ? (int)(unsigned)_c : ts_lo; ts_hi = (lane == nts) ? (int)(unsigned)(_c >> 32) : ts_hi; ++nts; } } while (0)
    PG8_STAMP();
    unsigned voffA[2], voffB[2];
#pragma unroll
    for (int i = 0; i < 2; ++i) { int R, C; stage_rc(tid * 16 + i * 8192, R, C); const int Rb = Epi::PERM ? ((R & ~31) + perm32(R & 31)) : R;
        voffA[i] = (unsigned)(R * K + C) * 2u; voffB[i] = (unsigned)(Rb * K + C) * 2u; }
    const size_t kstep = (size_t)(BK * 2);
    const size_t hstep = (size_t)HALF * K * 2;
    const size_t tstep = 2 * hstep;
    const unsigned ldsw = (unsigned)wid * 1024u;
    const int aoff = lds_byte(wr * 64 + fr, fq * 8), boff = lds_byte(wc * 32 + fr, fq * 8);
#define PG8_SA(b, h) (((b) * 2 + (h)) * HTB)
#define PG8_SB(b, h) ((4 + (b) * 2 + (h)) * HTB)
#define PG8_STAGE(bufoff, gbase, voff) do { _Pragma("unroll") for (int _i = 0; _i < 2; ++_i) \
        __builtin_amdgcn_global_load_lds((const unsigned*)((const char*)(gbase) + (voff)[_i]), (PG8_LAS unsigned*)(lds + (bufoff) + ldsw + _i * 8192), 16, 0, 0); } while (0)
#define PG8_LDA(dst, b, h) do { _Pragma("unroll") for (int m = 0; m < 4; ++m) _Pragma("unroll") for (int k = 0; k < 2; ++k) dst[m][k] = *(const PG8_LAS bf16x8*)(lds + PG8_SA(b, h) + aoff + m * 2048 + k * 1024); } while (0)
#define PG8_LDB(dst, b, h) do { _Pragma("unroll") for (int n = 0; n < 2; ++n) _Pragma("unroll") for (int k = 0; k < 2; ++k) dst[n][k] = *(const PG8_LAS bf16x8*)(lds + PG8_SB(b, h) + boff + n * 2048 + k * 1024); } while (0)
#define PG8_MMA(ai, bj, At, Bt) do { __builtin_amdgcn_s_setprio(1); _Pragma("unroll") for (int m = 0; m < 4; ++m) _Pragma("unroll") for (int n = 0; n < 2; ++n) _Pragma("unroll") for (int k = 0; k < 2; ++k) \
        acc[ai][bj][m][n] = __builtin_amdgcn_mfma_f32_16x16x32_bf16(Bt[n][k], At[m][k], acc[ai][bj][m][n], 0, 0, 0); __builtin_amdgcn_s_setprio(0); } while (0)
#define PG8_WAIT_V(n) asm volatile("s_waitcnt vmcnt(" #n ")" ::: "memory")
#define PG8_WAIT_L(n) asm volatile("s_waitcnt lgkmcnt(" #n ")" ::: "memory")
#define PG8_BAR __builtin_amdgcn_s_barrier()
#define PG8_SCHED __builtin_amdgcn_sched_barrier(0)
    Unit cur, nxt; int ui = 0;
    if (!S.next(0, cur)) return;
    f32x4 acc[2][2][4][2];
#pragma unroll
    for (int a = 0; a < 2; ++a)
#pragma unroll
        for (int b = 0; b < 2; ++b)
#pragma unroll
            for (int m = 0; m < 4; ++m)
#pragma unroll
                for (int n = 0; n < 2; ++n) acc[a][b][m][n] = (f32x4){0.f, 0.f, 0.f, 0.f};
    bf16x8 At[4][2], B0[2][2], B1[2][2];
    const char* cA = (const char*)g.A + (size_t)cur.pm * tstep; const char* cB = (const char*)g.Bt + (size_t)cur.pn * tstep;
    S.a_ready(cur);
    PG8_STAGE(PG8_SB(0, 0), cB, voffB); PG8_STAGE(PG8_SA(0, 0), cA, voffA); PG8_STAGE(PG8_SB(0, 1), cB + hstep, voffB); PG8_STAGE(PG8_SA(0, 1), cA + hstep, voffA);
    if (wr == 1) PG8_BAR;
    PG8_WAIT_V(4); PG8_BAR;
    PG8_STAGE(PG8_SB(1, 0), cB + kstep, voffB); PG8_STAGE(PG8_SA(1, 0), cA + kstep, voffA); PG8_STAGE(PG8_SB(1, 1), cB + hstep + kstep, voffB);
    PG8_WAIT_V(6); PG8_BAR;
    PG8_STAMP();
    for (;;) {
        const bool has_next = S.next(ui + 1, nxt);
        const char* nA = has_next ? (const char*)g.A + (size_t)nxt.pm * tstep : cA; const char* nB = has_next ? (const char*)g.Bt + (size_t)nxt.pn * tstep : cB;
        for (int t = 0; t < nt; t += 2) {
            const bool last = (t == nt - 2);
            const char* a1 = cA + (size_t)(t + 1) * kstep;
            const char* a2 = last ? nA : cA + (size_t)(t + 2) * kstep; const char* b2 = last ? nB : cB + (size_t)(t + 2) * kstep;
            const char* a3 = a2 + kstep; const char* b3 = b2 + kstep;
            if (last && has_next) S.a_ready(nxt);
            PG8_LDB(B0, 0, 0); PG8_SCHED; PG8_LDA(At, 0, 0); PG8_STAGE(PG8_SA(1, 1), a1 + hstep, voffA);
            PG8_WAIT_L(8); PG8_BAR; PG8_WAIT_L(0); PG8_MMA(0, 0, At, B0); PG8_BAR; PG8_SCHED;
            PG8_LDB(B1, 0, 1); PG8_STAGE(PG8_SB(0, 0), b2, voffB);
            PG8_BAR; PG8_WAIT_L(0); PG8_MMA(0, 1, At, B1); PG8_BAR;
            PG8_LDA(At, 0, 1); PG8_STAGE(PG8_SA(0, 0), a2, voffA);
            PG8_BAR; PG8_WAIT_L(0); PG8_MMA(1, 0, At, B0); PG8_BAR; PG8_SCHED;
            PG8_STAGE(PG8_SB(0, 1), b2 + hstep, voffB);
            PG8_WAIT_V(6); PG8_BAR; PG8_MMA(1, 1, At, B1); PG8_BAR;
            PG8_LDB(B0, 1, 0); PG8_SCHED; PG8_LDA(At, 1, 0); PG8_STAGE(PG8_SA(0, 1), a2 + hstep, voffA);
            PG8_WAIT_L(8); PG8_BAR; PG8_WAIT_L(0); PG8_MMA(0, 0, At, B0); PG8_BAR; PG8_SCHED;
            PG8_LDB(B1, 1, 1); PG8_STAGE(PG8_SB(1, 0), b3, voffB);
            PG8_BAR; PG8_WAIT_L(0); PG8_MMA(0, 1, At, B1); PG8_BAR;
            PG8_LDA(At, 1, 1); PG8_STAGE(PG8_SA(1, 0), a3, voffA);
            PG8_BAR; PG8_WAIT_L(0); PG8_MMA(1, 0, At, B0); PG8_BAR; PG8_SCHED;
            PG8_STAGE(PG8_SB(1, 1), b3 + hstep, voffB);
            PG8_WAIT_V(6); PG8_BAR; PG8_MMA(1, 1, At, B1); PG8_BAR;
        }
        PG8_STAMP();
        if constexpr (!Epi::AFTER_DRAIN) { E(acc, cur, wr, wc, fr, fq); S.done(cur); }
        PG8_STAMP();
        if (!has_next) break;
#pragma unroll
        for (int a = 0; a < 2; ++a)
#pragma unroll
            for (int b = 0; b < 2; ++b)
#pragma unroll
                for (int m = 0; m < 4; ++m)
#pragma unroll
                    for (int n = 0; n < 2; ++n) acc[a][b][m][n] = (f32x4){0.f, 0.f, 0.f, 0.f};
        cur = nxt; cA = nA; cB = nB; ++ui;
    }
    PG8_WAIT_V(0);
    if (wr == 0) PG8_BAR;
    PG8_BAR;
    if constexpr (Epi::AFTER_DRAIN) { E.fused(acc, cur, wr, wc, fr, fq, lds, wid, lane); S.done(cur); }
    PG8_STAMP();
    if (STAMP && wid == 0) { stamps[lane] = lane < nts ? (((unsigned long long)(unsigned)ts_hi << 32) | (unsigned)ts_lo) : 0ull;
        if (lane == 62) stamps[62] = rt_entry; if (lane == 63) stamps[63] = (unsigned long long)wall_clock64(); }
#undef PG8_STAMP
#undef PG8_SA
#undef PG8_SB
#undef PG8_STAGE
#undef PG8_LDA
#undef PG8_LDB
#undef PG8_MMA
#undef PG8_WAIT_V
#undef PG8_WAIT_L
#undef PG8_BAR
#undef PG8_SCHED
}
}

struct EpiProjBf16 {
  static constexpr bool PERM = true, AFTER_DRAIN = false;
  bfr* O; bfr* halo;
  __device__ __forceinline__ void operator()(const f32x4 (&acc)[2][2][4][2], const pg8::Unit& u, int wr, int wc, int fr, int fq) const {
    const int row0 = u.pm * 256 + wr * 64 + fr, col0 = u.pn * 256 + wc * 32 + 8 * fq;
#pragma unroll
    for (int ai = 0; ai < 2; ++ai)
#pragma unroll
      for (int m = 0; m < 4; ++m) {
        const int row = row0 + ai * 128 + m * 16;
        const int bb = row >> 12, ts = row & 4095;
#pragma unroll
        for (int bj = 0; bj < 2; ++bj) {
          const int col = col0 + bj * 128;
          const f32x4 v0 = acc[ai][bj][m][0], v1 = acc[ai][bj][m][1];
          u32x4 w; w.x = pack2(v0[0], v0[1]); w.y = pack2(v0[2], v0[3]); w.z = pack2(v1[0], v1[1]); w.w = pack2(v1[2], v1[3]);
          *(u32x4*)(O + (size_t)(col >> 10) * PLANE + ((size_t)((bb * 8 + ((col >> 7) & 7)) * 4096 + ts)) * 128 + (col & 127)) = w;
          if (halo && (row & 63) >= 61 && col < 3072)
            *(u32x4*)(halo + ((size_t)(row >> 6) * 3 + ((row & 63) - 61)) * 3072 + col) = w;
        }
      }
  }
};
struct EpiResid {
  static constexpr bool PERM = true, AFTER_DRAIN = false;
  bfr* out; const void* xin; int xin_f32; const float* gate;
  __device__ __forceinline__ void operator()(const f32x4 (&acc)[2][2][4][2], const pg8::Unit& u, int wr, int wc, int fr, int fq) const {
    const int row0 = u.pm * 256 + wr * 64 + fr, col0 = u.pn * 256 + wc * 32 + 8 * fq;
    const float* gp = gate + (size_t)((u.pm * 256) >> 12) * 3072 + col0;
    f32x4 gv[2][2];
#pragma unroll
    for (int bj = 0; bj < 2; ++bj)
#pragma unroll
      for (int n = 0; n < 2; ++n) gv[bj][n] = *(const f32x4*)(gp + bj * 128 + n * 4);
#pragma unroll
    for (int ai = 0; ai < 2; ++ai)
#pragma unroll
      for (int m = 0; m < 4; ++m) {
        const size_t ro = (size_t)(row0 + ai * 128 + m * 16) * 1024 + col0;
#pragma unroll
        for (int bj = 0; bj < 2; ++bj) {
          f32x4 x0, x1;
          if (xin_f32) {
            x0 = *(const f32x4*)((const float*)xin + ro + bj * 128);
            x1 = *(const f32x4*)((const float*)xin + ro + bj * 128 + 4);
          } else {
            const u32x4 xb = *(const u32x4*)((const bfr*)xin + ro + bj * 128);
            x0 = (f32x4){__uint_as_float(xb[0] << 16), __uint_as_float(xb[0] & 0xffff0000u), __uint_as_float(xb[1] << 16), __uint_as_float(xb[1] & 0xffff0000u)};
            x1 = (f32x4){__uint_as_float(xb[2] << 16), __uint_as_float(xb[2] & 0xffff0000u), __uint_as_float(xb[3] << 16), __uint_as_float(xb[3] & 0xffff0000u)};
          }
          const f32x4 v0 = x0 + gv[bj][0] * acc[ai][bj][m][0], v1 = x1 + gv[bj][1] * acc[ai][bj][m][1];
          u32x4 w; w.x = pack2(v0[0], v0[1]); w.y = pack2(v0[2], v0[3]); w.z = pack2(v1[0], v1[1]); w.w = pack2(v1[2], v1[3]);
          *(u32x4*)(out + ro + bj * 128) = w;
        }
      }
  }
};

template <int EPI>
DI void gemm_phase(const Params& p, const bfr* __restrict__ A, int lda, const bfr* __restrict__ Bt, int nN, int layer, const void* __restrict__ xin, bfr* __restrict__ xout, char* lds) {
  pg8::Gemm g; g.A = A; g.Bt = Bt; g.M = 16384; g.N = nN * 256; g.K = 1024;
  pg8::StaticOrder S; S.init(g.M, g.N, gridDim.x, obid());
  if (EPI == 2) {
    EpiResid E; E.out = xout; E.xin = xin; E.xin_f32 = (layer == 0) ? 1 : 0; E.gate = (const float*)(ows(p) + O_COND) + (size_t)layer * 4 * 3072 + 2048;
    pg8::gemm_phase<EpiResid, pg8::StaticOrder, false>((PG8_LAS unsigned char*)lds, g, S, E, nullptr);
  } else {
    EpiProjBf16 E; E.O = (bfr*)(ows(p) + O_PROJ); E.halo = (EPI == 1) ? (bfr*)(ows(p) + O_HALO) : nullptr;
    pg8::gemm_phase<EpiProjBf16, pg8::StaticOrder, false>((PG8_LAS unsigned char*)lds, g, S, E, nullptr);
  }
  if (EPI == 1) {
    __syncthreads();
    float* red = (float*)lds;
    const int tid = otid(), lane = tid & 63, wv = tid >> 6, l15 = lane & 15, q = lane >> 4;
    const int mt4 = wv & 3, kh = wv >> 2;
    for (int rt = obid(); rt < 256; rt += gridDim.x) {
      const bfr* Ar = A + (size_t)(rt * 64 + mt4 * 16 + l15) * lda + kh * 512 + q * 8;
      const bfr* Br = Bt + (size_t)(4096 + l15) * 1024 + kh * 512 + q * 8;
      f32x4 acc = (f32x4){0.f, 0.f, 0.f, 0.f};
#pragma unroll 4
      for (int ks = 0; ks < 16; ++ks) acc = MFMA16(*(const bf16x8*)(Ar + ks * 32), *(const bf16x8*)(Br + ks * 32), acc);
      if (kh == 1) *(f32x4*)&red[(mt4 * 64 + lane) * 4] = acc;
      __syncthreads();
      if (kh == 0) {
        f32x4 o = *(const f32x4*)&red[(mt4 * 64 + lane) * 4];
#pragma unroll
        for (int jx = 0; jx < 4; ++jx) ((float*)(ows(p) + O_AB))[(size_t)(rt * 64 + mt4 * 16 + q * 4 + jx) * 16 + l15] = acc[jx] + o[jx];
      }
      __syncthreads();
    }
  }
}

DI void lru_phase(const Params& p, int j, char* lds) {
  const int tid = otid(), lane = tid & 63, wv = tid >> 6, l15 = lane & 15, q = lane >> 4;
  bfr* Xw = (bfr*)lds + wv * (32 * 136);
  float* WAgg = (float*)(lds + 8 * 32 * 136 * 2);
  const bfr* proj = (const bfr*)(ows(p) + O_PROJ);
  bfr* Yb = (bfr*)(ows(p) + O_H);
  const bfr* WG = (const bfr*)(ows(p) + O_WG);
  for (int unit = obid(); unit < 256; unit += gridDim.x) {
    const int xcd = unit & 7, li = unit >> 3, idx = xcd * 4 + (li >> 3), sl = li & 7, b = idx >> 3, gb = idx & 7;
    const int ch = gb * 128 + sl * 16 + l15;
    bf16x8 Bf[2][4];
#pragma unroll
    for (int kq = 0; kq < 2; ++kq)
#pragma unroll
      for (int ks = 0; ks < 4; ++ks) Bf[kq][ks] = *(const bf16x8*)&WG[(size_t)((j * 2 + kq) * 8 + gb) * 16384 + (sl * 16 + l15) * 128 + ks * 32 + q * 8];
    const float gbr = p.lru_gate_b[(j * 2) * 1024 + ch], gbi = p.lru_gate_b[(j * 2 + 1) * 1024 + ch];
    const float sp = softplusf_(-p.lru_lambda[j * 1024 + ch]);
    const int cg = lane & 15, rs = lane >> 4, ccol = gb * 128 + cg * 8;
    float cwv[4][8], cb[8];
#pragma unroll
    for (int tp = 0; tp < 4; ++tp)
#pragma unroll
      for (int e = 0; e < 8; ++e) cwv[tp][e] = p.lru_conv_w[(size_t)(j * 4 + tp) * 1024 + ccol + e];
#pragma unroll
    for (int e = 0; e < 8; ++e) cb[e] = p.lru_conv_b[j * 1024 + ccol + e];
    const bfr* xb_u = proj + (size_t)(b * 8 + gb) * 4096 * 128;
    bfr* yb_u = Yb + (size_t)b * 4096 * 1024;
    const int xo = (wv * 32 + rs * 8 - 3) * 128 + cg * 8;
    const int zo = PLANE + (wv * 32 + q * 4) * 128 + sl * 16 + (l15 & ~1);
    const int zsh = (l15 & 1) * 16;
    const int yo = (wv * 32 + q * 4) * 1024 + ch;
    float carry = 0.f;
    bf16x8 raw[11];
    unsigned zr[8];
#define LRU_LOAD(it)                                                                                   \
  {                                                                                                    \
    const bfr* xit = xb_u + (it) * (256 * 128);                                                        \
    _Pragma("unroll") for (int i = 0; i < 11; ++i) {                                                   \
      const int t = (it) * 256 + wv * 32 + rs * 8 - 3 + i;                                             \
      if (t >= 0) raw[i] = *(const bf16x8*)&xit[xo + i * 128];                                         \
      else raw[i] = (bf16x8){0, 0, 0, 0, 0, 0, 0, 0};                                                  \
    }                                                                                                  \
    _Pragma("unroll") for (int mt = 0; mt < 2; ++mt) _Pragma("unroll") for (int jx = 0; jx < 4; ++jx)  \
      zr[mt * 4 + jx] = *(const unsigned*)&xit[zo + (mt * 16 + jx) * 128];                                               \
  }
    LRU_LOAD(0);
#pragma unroll 1
    for (int it = 0; it < 16; ++it) {
#pragma unroll
      for (int r = 0; r < 8; ++r) {
        float o[8];
#pragma unroll
        for (int e = 0; e < 8; ++e) {
          float s = cb[e];
#pragma unroll
          for (int tp = 0; tp < 4; ++tp) s += cwv[tp][e] * bfe(raw[r + tp], e);
          o[e] = s;
        }
        u32x4 pk; pk[0] = pack2(o[0], o[1]); pk[1] = pack2(o[2], o[3]); pk[2] = pack2(o[4], o[5]); pk[3] = pack2(o[6], o[7]);
        *(u32x4*)&Xw[(rs * 8 + r) * 136 + cg * 8] = pk;
      }
      float zc[8];
#pragma unroll
      for (int i = 0; i < 8; ++i) zc[i] = bf2f((bfr)(zr[i] >> zsh));
      if (it < 15) LRU_LOAD(it + 1);
      f32x4 accr[2], acci[2];
#pragma unroll
      for (int mt = 0; mt < 2; ++mt) {
        accr[mt] = acci[mt] = (f32x4){0.f, 0.f, 0.f, 0.f};
#pragma unroll
        for (int ks = 0; ks < 4; ++ks) {
          bf16x8 af = *(const bf16x8*)&Xw[(mt * 16 + l15) * 136 + ks * 32 + q * 8];
          accr[mt] = MFMA16(af, Bf[0][ks], accr[mt]);
          acci[mt] = MFMA16(af, Bf[1][ks], acci[mt]);
        }
      }
      float av[2][4], bv[2][4];
      float Aex[2], Bex[2], At[2], Bt_[2];
#pragma unroll
      for (int mt = 0; mt < 2; ++mt) {
        float Al = 1.f, Bl = 0.f;
#pragma unroll
        for (int jx = 0; jx < 4; ++jx) {
          const float r = sigmoidf_(accr[mt][jx] + gbr), ig = sigmoidf_(acci[mt][jx] + gbi);
          const float a = __expf(-8.f * r * sp);
          const float mult = __builtin_amdgcn_sqrtf(fmaxf(1.f - a * a, 0.f));
          const float xf = bf2f(Xw[(mt * 16 + q * 4 + jx) * 136 + sl * 16 + l15]);
          const float bt = mult * ig * xf;
          av[mt][jx] = a; bv[mt][jx] = bt;
          Bl = a * Bl + bt; Al *= a;
        }
        float Ai = Al, Bi = Bl;
#pragma unroll
        for (int off = 16; off < 64; off <<= 1) {
          const float Ap = __shfl_up(Ai, off), Bp = __shfl_up(Bi, off);
          if (lane >= off) { Bi = Ai * Bp + Bi; Ai = Ai * Ap; }
        }
        float Ae = __shfl_up(Ai, 16), Be = __shfl_up(Bi, 16);
        if (q == 0) { Ae = 1.f; Be = 0.f; }
        Aex[mt] = Ae; Bex[mt] = Be;
        At[mt] = __shfl(Ai, 48 + l15); Bt_[mt] = __shfl(Bi, 48 + l15);
      }
      float* wa = WAgg + (it & 1) * 256;
      if (q == 0) { wa[(wv * 16 + l15) * 2] = At[0] * At[1]; wa[(wv * 16 + l15) * 2 + 1] = At[1] * Bt_[0] + Bt_[1]; }
      lds_barrier();
      float cin = carry, cnew = carry;
#pragma unroll
      for (int w = 0; w < 8; ++w) {
        const float Aw = wa[(w * 16 + l15) * 2], Bw = wa[(w * 16 + l15) * 2 + 1];
        cnew = Aw * cnew + Bw;
        if (w < wv) cin = Aw * cin + Bw;
      }
      carry = cnew;
      bfr* yit = yb_u + it * (256 * 1024);
#pragma unroll
      for (int mt = 0; mt < 2; ++mt) {
        float h = Aex[mt] * cin + Bex[mt];
#pragma unroll
        for (int jx = 0; jx < 4; ++jx) {
          h = av[mt][jx] * h + bv[mt][jx];
          yit[yo + (mt * 16 + jx) * 1024] = f2bf(h * siluf_(zc[mt * 4 + jx]));
        }
        cin = At[mt] * cin + Bt_[mt];
      }
    }
#undef LRU_LOAD
  }
}

DI bf16x8 ld_perm(const bfr* base) {
  u32x2 lo = *(const u32x2*)base, hi = *(const u32x2*)(base + 16);
  u32x4 r; r[0] = lo[0]; r[1] = lo[1]; r[2] = hi[0]; r[3] = hi[1];
  return __builtin_bit_cast(bf16x8, r);
}
DI bf16x8 pack_cc(const f32x4& a, const f32x4& b) {
  u32x4 r; r[0] = pack2(a[0], a[1]); r[1] = pack2(a[2], a[3]); r[2] = pack2(b[0], b[1]); r[3] = pack2(b[2], b[3]);
  return __builtin_bit_cast(bf16x8, r);
}


template <int NL> DI void row_load(f32x4 (&a)[8], unsigned addr, float& dep) {
  if constexpr (NL == 1) asm volatile("ds_read_b128 %0, %2\n\ts_waitcnt lgkmcnt(0)" : "=&v"(a[0]), "+v"(dep) : "v"(addr) : "memory");
  if constexpr (NL == 2) asm volatile("ds_read_b128 %0, %3\n\tds_read_b128 %1, %3 offset:16\n\ts_waitcnt lgkmcnt(0)" : "=&v"(a[0]), "=&v"(a[1]), "+v"(dep) : "v"(addr) : "memory");
  if constexpr (NL == 3) asm volatile("ds_read_b128 %0, %4\n\tds_read_b128 %1, %4 offset:16\n\tds_read_b128 %2, %4 offset:32\n\ts_waitcnt lgkmcnt(0)" : "=&v"(a[0]), "=&v"(a[1]), "=&v"(a[2]), "+v"(dep) : "v"(addr) : "memory");
  if constexpr (NL == 4) asm volatile("ds_read_b128 %0, %5\n\tds_read_b128 %1, %5 offset:16\n\tds_read_b128 %2, %5 offset:32\n\tds_read_b128 %3, %5 offset:48\n\ts_waitcnt lgkmcnt(0)" : "=&v"(a[0]), "=&v"(a[1]), "=&v"(a[2]), "=&v"(a[3]), "+v"(dep) : "v"(addr) : "memory");
  if constexpr (NL == 5) asm volatile("ds_read_b128 %0, %6\n\tds_read_b128 %1, %6 offset:16\n\tds_read_b128 %2, %6 offset:32\n\tds_read_b128 %3, %6 offset:48\n\tds_read_b128 %4, %6 offset:64\n\ts_waitcnt lgkmcnt(0)" : "=&v"(a[0]), "=&v"(a[1]), "=&v"(a[2]), "=&v"(a[3]), "=&v"(a[4]), "+v"(dep) : "v"(addr) : "memory");
  if constexpr (NL == 6) asm volatile("ds_read_b128 %0, %7\n\tds_read_b128 %1, %7 offset:16\n\tds_read_b128 %2, %7 offset:32\n\tds_read_b128 %3, %7 offset:48\n\tds_read_b128 %4, %7 offset:64\n\tds_read_b128 %5, %7 offset:80\n\ts_waitcnt lgkmcnt(0)" : "=&v"(a[0]), "=&v"(a[1]), "=&v"(a[2]), "=&v"(a[3]), "=&v"(a[4]), "=&v"(a[5]), "+v"(dep) : "v"(addr) : "memory");
  if constexpr (NL == 7) asm volatile("ds_read_b128 %0, %8\n\tds_read_b128 %1, %8 offset:16\n\tds_read_b128 %2, %8 offset:32\n\tds_read_b128 %3, %8 offset:48\n\tds_read_b128 %4, %8 offset:64\n\tds_read_b128 %5, %8 offset:80\n\tds_read_b128 %6, %8 offset:96\n\ts_waitcnt lgkmcnt(0)" : "=&v"(a[0]), "=&v"(a[1]), "=&v"(a[2]), "=&v"(a[3]), "=&v"(a[4]), "=&v"(a[5]), "=&v"(a[6]), "+v"(dep) : "v"(addr) : "memory");
  if constexpr (NL == 8) asm volatile("ds_read_b128 %0, %9\n\tds_read_b128 %1, %9 offset:16\n\tds_read_b128 %2, %9 offset:32\n\tds_read_b128 %3, %9 offset:48\n\tds_read_b128 %4, %9 offset:64\n\tds_read_b128 %5, %9 offset:80\n\tds_read_b128 %6, %9 offset:96\n\tds_read_b128 %7, %9 offset:112\n\ts_waitcnt lgkmcnt(0)" : "=&v"(a[0]), "=&v"(a[1]), "=&v"(a[2]), "=&v"(a[3]), "=&v"(a[4]), "=&v"(a[5]), "=&v"(a[6]), "=&v"(a[7]), "+v"(dep) : "v"(addr) : "memory");
}
template <int I> DI void inv_rows(float (&t)[32], unsigned abase, int j) {
  if constexpr (I < 32) {
    float s = (I == j) ? 1.f : 0.f;
    if constexpr (I > 0) {
      f32x4 a[8];
      row_load<(I + 3) / 4>(a, abase + I * 256, t[I - 1]);
#pragma unroll
      for (int m4 = 0; m4 < I; m4 += 4) {
        s -= a[m4 >> 2][0] * t[m4];
        if (m4 + 1 < I) s -= a[m4 >> 2][1] * t[m4 + 1];
        if (m4 + 2 < I) s -= a[m4 >> 2][2] * t[m4 + 2];
        if (m4 + 3 < I) s -= a[m4 >> 2][3] * t[m4 + 3];
      }
    }
    t[I] = s;
    inv_rows<I + 1>(t, abase, j);
  }
}
DI void tri_invert32(const float* __restrict__ Au, bfr* __restrict__ Ttu, bfr* __restrict__ Tcu, int hf, int lane) {
  const int j = lane & 31;
  const float* Ab = Au + (32 * hf) * 64 + 32 * hf;
  float t[32];
  const unsigned abase = (unsigned)(size_t)Ab;
  inv_rows<0>(t, abase, j);
  if (lane < 32) {
#pragma unroll
    for (int i = 0; i < 32; ++i) Ttu[(32 * hf + i) * 72 + 32 * hf + j] = f2bf(t[i]);
    if (hf == 0) {
#pragma unroll
      for (int i = 0; i < 32; ++i) Ttu[i * 72 + 32 + j] = 0;
#pragma unroll
      for (int i4 = 0; i4 < 4; ++i4) {
        u32x4 pk;
        pk[0] = pack2(t[8 * i4], t[8 * i4 + 1]); pk[1] = pack2(t[8 * i4 + 2], t[8 * i4 + 3]);
        pk[2] = pack2(t[8 * i4 + 4], t[8 * i4 + 5]); pk[3] = pack2(t[8 * i4 + 6], t[8 * i4 + 7]);
        *(u32x4*)&Tcu[j * 40 + 8 * i4] = pk;
      }
    }
  }
}
DI void tri_merge(const float* __restrict__ Au, bfr* __restrict__ Ttu, const bfr* __restrict__ Tcu, int nt2, int lane) {
  const int l15 = lane & 15, q = lane >> 4;
  const f32x4 zero = (f32x4){0.f, 0.f, 0.f, 0.f};
  bf16x8 bfrag = *(const bf16x8*)&Tcu[(nt2 * 16 + l15) * 40 + q * 8];
  f32x4 X[2];
#pragma unroll
  for (int mt = 0; mt < 2; ++mt) {
    const float* ar = Au + (32 + mt * 16 + l15) * 64 + q * 8;
    f32x4 a0 = *(const f32x4*)ar, a1 = *(const f32x4*)(ar + 4);
    X[mt] = MFMA16(pack_cc(a0, a1), bfrag, zero);
  }
  bf16x8 xb = pack_cc(X[0], X[1]);
#pragma unroll
  for (int mt2 = 0; mt2 < 2; ++mt2) {
    bf16x8 a = ld_perm(Ttu + (32 + mt2 * 16 + l15) * 72 + 32 + q * 4);
    f32x4 r = MFMA16(a, xb, zero);
#pragma unroll
    for (int jx = 0; jx < 4; ++jx) Ttu[(32 + mt2 * 16 + q * 4 + jx) * 72 + nt2 * 16 + l15] = f2bf(-r[jx]);
  }
}

DI void gdn_g1(const Params& p, int j, char* lds) {
  float* Asl = (float*)lds;
  bfr* Tt = (bfr*)(lds + 65536);
  bfr* Kt = (bfr*)(lds + 102400);
  bfr* Qt = (bfr*)(lds + 119808);
  bfr* Vt = (bfr*)(lds + 137216);
  float* gc = (float*)(lds + 154624);
  float* be = (float*)(lds + 155648);
  float* cw = (float*)(lds + 156672);
  const int tid0 = otid();
  bfr* proj = (bfr*)(ows(p) + O_PROJ);
  bfr* KDT = (bfr*)(ows(p) + O_H);
  bfr* ATT = (bfr*)(ows(p) + O_ATTN);
  const bfr* HALO = (const bfr*)(ows(p) + O_HALO);
  bfr* SCR = (bfr*)(ows(p) + O_SCR) + (size_t)obid() * (4 * 2 * 8192);
  const float* AB = (const float*)(ows(p) + O_AB);
  float* EL = (float*)(ows(p) + O_ELAST);
  for (int grp = obid(); grp < 256; grp += gridDim.x) {
    const int bh = grp >> 3, b = bh >> 3, h = bh & 7;
    for (int e = tid0; e < 1536; e += 512) {
      int X = e >> 9, rem = e & 511, tap = rem >> 7, c = rem & 127;
      cw[(X * 4 + tap) * 128 + c] = p.gdn_conv_w[(size_t)(j * 4 + tap) * 3072 + X * 1024 + h * 128 + c];
    }
    bf16x8 nxt[3][5];
    float pfx_g = 0.f, pfx_b = 0.f;
#define G1_RAWLOAD(nn)                                                                                         \
  {                                                                                                            \
    const int rg_ = tid0 >> 4, cgi_ = tid0 & 15, r0_ = rg_ * 2;                                                \
    _Pragma("unroll") for (int X = 0; X < 3; ++X) {                                                            \
      _Pragma("unroll") for (int i = 0; i < 5; ++i) {                                                          \
        const int rr = r0_ - 3 + i;                                                                            \
        if (rr >= 0) nxt[X][i] = *(const bf16x8*)&proj[(size_t)X * PLANE + (size_t)(bh * 4096 + (nn) * 64 + rr) * 128 + cgi_ * 8];   \
        else if ((nn) > 0) nxt[X][i] = *(const bf16x8*)&HALO[((size_t)(b * 64 + (nn) - 1) * 3 + 3 + rr) * 3072 + X * 1024 + h * 128 + cgi_ * 8];   \
        else nxt[X][i] = (bf16x8){0, 0, 0, 0, 0, 0, 0, 0};                                                     \
      }                                                                                                        \
    }                                                                                                          \
  }
    G1_RAWLOAD((grp * 8) & 63);
#pragma unroll 1
    for (int half = 0; half < 2; ++half) {
      {
        int tid = tid0; asm volatile("" : "+v"(tid));
        const int lane = tid & 63, wv = tid >> 6;
        if (half == 0) {
          const int un = grp * 8 + wv, n = un & 63, t0 = b * 4096 + n * 64;
          float a_in = AB[(size_t)(t0 + lane) * 16 + h], b_in = AB[(size_t)(t0 + lane) * 16 + 8 + h];
          float g = -__expf(p.gdn_a_log[j * 8 + h]) * softplusf_(a_in + p.gdn_dt_bias[j * 8 + h]);
#pragma unroll
          for (int off = 1; off < 64; off <<= 1) {
            float v = __shfl_up(g, off);
            if (lane >= off) g += v;
          }
          pfx_g = g; pfx_b = sigmoidf_(b_in);
          if (lane == 63) EL[un] = __expf(g);
          if (wv < 4) { gc[wv * 64 + lane] = pfx_g; be[wv * 64 + lane] = pfx_b; }
        } else if (wv >= 4) {
          gc[(wv - 4) * 64 + lane] = pfx_g; be[(wv - 4) * 64 + lane] = pfx_b;
        }
      }
#pragma unroll 1
      for (int u = 0; u < 4; ++u) {
        const int un = grp * 8 + half * 4 + u, n = un & 63, t0 = b * 4096 + n * 64;
        int tid = tid0; asm volatile("" : "+v"(tid));
        const int lane = tid & 63, wv = tid >> 6, l15 = lane & 15, q = lane >> 4;
        const int rg = tid >> 4, cgi = tid & 15, r0 = rg * 2;
        __syncthreads();
        bf16x8 cur[3][5];
#pragma unroll
        for (int X = 0; X < 3; ++X)
#pragma unroll
          for (int i = 0; i < 5; ++i) cur[X][i] = nxt[X][i];
        if (half * 4 + u < 7) G1_RAWLOAD(n + 1);
#pragma unroll
        for (int X = 0; X < 3; ++X) {
          float val[2][8];
#pragma unroll
          for (int rr = 0; rr < 2; ++rr)
#pragma unroll
            for (int e = 0; e < 8; ++e) {
              float sacc = 0.f;
#pragma unroll
              for (int tp = 0; tp < 4; ++tp) sacc += cw[(X * 4 + tp) * 128 + cgi * 8 + e] * bfe(cur[X][rr + tp], e);
              val[rr][e] = siluf_(sacc);
            }
          if (X < 2) {
#pragma unroll
            for (int rr = 0; rr < 2; ++rr) {
              float ss = 0.f;
#pragma unroll
              for (int e = 0; e < 8; ++e) ss += val[rr][e] * val[rr][e];
              ss = sum16(ss);
              float rn = rsqrtf(ss + EPS);
              if (X == 0) rn *= 0.08838834764831845f;
#pragma unroll
              for (int e = 0; e < 8; ++e) val[rr][e] *= rn;
            }
          }
          bfr* Tile = (X == 0) ? Qt : (X == 1 ? Kt : Vt);
#pragma unroll
          for (int rr = 0; rr < 2; ++rr) {
            const int r = r0 + rr;
            u32x4 pk;
            pk[0] = pack2(val[rr][0], val[rr][1]); pk[1] = pack2(val[rr][2], val[rr][3]);
            pk[2] = pack2(val[rr][4], val[rr][5]); pk[3] = pack2(val[rr][6], val[rr][7]);
            *(u32x4*)&Tile[r * 136 + cgi * 8] = pk;
            if (X == 0) {
              const float eg = __expf(gc[u * 64 + r]);
              pk[0] = pack2(val[rr][0] * eg, val[rr][1] * eg); pk[1] = pack2(val[rr][2] * eg, val[rr][3] * eg);
              pk[2] = pack2(val[rr][4] * eg, val[rr][5] * eg); pk[3] = pack2(val[rr][6] * eg, val[rr][7] * eg);
              *(u32x4*)&proj[(size_t)(bh * 4096 + n * 64 + r) * 128 + cgi * 8] = pk;
            }
          }
        }
        lds_barrier();
        {
          const int mt = wv >> 1;
          f32x4 kk[2], qk[2];
          kk[0] = kk[1] = qk[0] = qk[1] = (f32x4){0.f, 0.f, 0.f, 0.f};
#pragma unroll
          for (int ks = 0; ks < 4; ++ks) {
            bf16x8 ak = *(const bf16x8*)&Kt[(mt * 16 + l15) * 136 + ks * 32 + q * 8];
            bf16x8 aq = *(const bf16x8*)&Qt[(mt * 16 + l15) * 136 + ks * 32 + q * 8];
#pragma unroll
            for (int t2 = 0; t2 < 2; ++t2) {
              int nt = (wv & 1) * 2 + t2;
              bf16x8 bk = *(const bf16x8*)&Kt[(nt * 16 + l15) * 136 + ks * 32 + q * 8];
              kk[t2] = MFMA16(bk, ak, kk[t2]);
              qk[t2] = MFMA16(bk, aq, qk[t2]);
            }
          }
          const int i = mt * 16 + l15;
          const float giv = gc[u * 64 + i], bei = be[u * 64 + i];
#pragma unroll
          for (int t2 = 0; t2 < 2; ++t2) {
            const int m0 = ((wv & 1) * 2 + t2) * 16 + q * 4;
            f32x4 av, tv;
#pragma unroll
            for (int jx = 0; jx < 4; ++jx) {
              const int m = m0 + jx;
              const float d = (i >= m) ? __expf(giv - gc[u * 64 + m]) : 0.f;
              av[jx] = (i > m) ? bei * kk[t2][jx] * d : 0.f;
              tv[jx] = qk[t2][jx] * d;
            }
            *(f32x4*)&Asl[u * 4096 + i * 64 + m0] = av;
            u32x2 pk; pk[0] = pack2(tv[0], tv[1]); pk[1] = pack2(tv[2], tv[3]);
            *(u32x2*)&ATT[(size_t)un * 4096 + i * 64 + m0] = pk;
          }
        }
        {
          const int dd = tid >> 2, tq = tid & 3;
          const float glast = gc[u * 64 + 63];
#pragma unroll
          for (int g8 = 0; g8 < 2; ++g8) {
            const int tok0 = tq * 16 + g8 * 8;
            float okd[8], okb[8], ovb[8];
#pragma unroll
            for (int e = 0; e < 8; ++e) {
              const int tok = tok0 + e;
              const float kv = bf2f(Kt[tok * 136 + dd]), vv = bf2f(Vt[tok * 136 + dd]);
              const float gg = gc[u * 64 + tok], bb = be[u * 64 + tok];
              okd[e] = kv * __expf(glast - gg);
              okb[e] = kv * bb * __expf(gg);
              ovb[e] = vv * bb;
            }
            u32x4 pk;
            pk[0] = pack2(okd[0], okd[1]); pk[1] = pack2(okd[2], okd[3]); pk[2] = pack2(okd[4], okd[5]); pk[3] = pack2(okd[6], okd[7]);
            *(u32x4*)&KDT[(size_t)un * 8192 + dd * 64 + tok0] = pk;
            pk[0] = pack2(okb[0], okb[1]); pk[1] = pack2(okb[2], okb[3]); pk[2] = pack2(okb[4], okb[5]); pk[3] = pack2(okb[6], okb[7]);
            *(u32x4*)&SCR[(u * 2 + 0) * 8192 + dd * 64 + tok0] = pk;
            pk[0] = pack2(ovb[0], ovb[1]); pk[1] = pack2(ovb[2], ovb[3]); pk[2] = pack2(ovb[4], ovb[5]); pk[3] = pack2(ovb[6], ovb[7]);
            *(u32x4*)&SCR[(u * 2 + 1) * 8192 + dd * 64 + tok0] = pk;
          }
        }
      }
      __syncthreads();
      {
      int tid = tid0; asm volatile("" : "+v"(tid));
      const int lane = tid & 63, wv = tid >> 6;
      tri_invert32(Asl + (wv >> 1) * 4096, Tt + (wv >> 1) * 4608, Kt + (wv >> 1) * 1280, wv & 1, lane);
      __syncthreads();
      tri_merge(Asl + (wv >> 1) * 4096, Tt + (wv >> 1) * 4608, Kt + (wv >> 1) * 1280, wv & 1, lane);
      __syncthreads();
      }
      {
        int tid = tid0; asm volatile("" : "+v"(tid));
        const int lane = tid & 63, wv = tid >> 6, l15 = lane & 15, q = lane >> 4;
        bf16x8 bkf[4][2], bvf[4][2];
#pragma unroll
        for (int u = 0; u < 4; ++u)
#pragma unroll
          for (int ks = 0; ks < 2; ++ks) {
            bkf[u][ks] = *(const bf16x8*)&SCR[(u * 2) * 8192 + (wv * 16 + l15) * 64 + ks * 32 + q * 8];
            bvf[u][ks] = *(const bf16x8*)&SCR[(u * 2 + 1) * 8192 + (wv * 16 + l15) * 64 + ks * 32 + q * 8];
          }
#pragma unroll
        for (int u = 0; u < 4; ++u) {
          const int n = (grp * 8 + half * 4 + u) & 63;
          f32x4 aw[4], au[4];
#pragma unroll
          for (int i = 0; i < 4; ++i) aw[i] = au[i] = (f32x4){0.f, 0.f, 0.f, 0.f};
#pragma unroll
          for (int ks = 0; ks < 2; ++ks) {
#pragma unroll
            for (int mt = 0; mt < 4; ++mt) {
              bf16x8 a = *(const bf16x8*)&Tt[u * 4608 + (mt * 16 + l15) * 72 + ks * 32 + q * 8];
              aw[mt] = MFMA16(bkf[u][ks], a, aw[mt]);
              au[mt] = MFMA16(bvf[u][ks], a, au[mt]);
            }
          }
          bfr* Wst = (u & 1) ? Kt : (bfr*)Asl;
          bfr* Ust = Wst + 64 * 136;
#pragma unroll
          for (int mt = 0; mt < 4; ++mt) {
            const int i = mt * 16 + l15, dc = wv * 16 + q * 4;
            u32x2 pk; pk[0] = pack2(aw[mt][0], aw[mt][1]); pk[1] = pack2(aw[mt][2], aw[mt][3]);
            *(u32x2*)&Wst[i * 136 + dc] = pk;
            pk[0] = pack2(au[mt][0], au[mt][1]); pk[1] = pack2(au[mt][2], au[mt][3]);
            *(u32x2*)&Ust[i * 136 + dc] = pk;
          }
          lds_barrier();
#pragma unroll
          for (int k = 0; k < 2; ++k) {
            const int id = tid + 512 * k, row = id >> 4, c16 = id & 15;
            const size_t go = (size_t)(bh * 4096 + n * 64 + row) * 128 + c16 * 8;
            *(u32x4*)&proj[(size_t)PLANE + go] = *(const u32x4*)&Wst[row * 136 + c16 * 8];
            *(u32x4*)&proj[(size_t)2 * PLANE + go] = *(const u32x4*)&Ust[row * 136 + c16 * 8];
          }
        }
      }
      __syncthreads();
    }
  }
#undef G1_RAWLOAD
}

DI void gdn_g2(const Params& p, int j, char* lds) {
  bfr* SbT = (bfr*)lds;
  bfr* VbT = (bfr*)(lds + 4352);
  const int tid = otid(), lane = tid & 63, wv = tid >> 6, l15 = lane & 15, q = lane >> 4;
  const bfr* proj = (const bfr*)(ows(p) + O_PROJ);
  const bfr* KDT = (const bfr*)(ows(p) + O_H);
  const bfr* ATT = (const bfr*)(ows(p) + O_ATTN);
  const float* EL = (const float*)(ows(p) + O_ELAST);
  bfr* OB = (bfr*)(ows(p) + O_SCR);
  for (int unit = obid(); unit < 256; unit += gridDim.x) {
    const int xcd = unit & 7, li = unit >> 3, bh = xcd * 4 + (li >> 3), slice = li & 7;
    const int b = bh >> 3, h = bh & 7;
    const int mt = wv & 3;
    const bool lo = wv < 4;
    const float elv = EL[bh * 64 + lane];
    f32x4 S = (f32x4){0.f, 0.f, 0.f, 0.f};
    for (int e = tid; e < 16 * 136; e += 512) SbT[e] = 0;
    bf16x8 A1s[4][4], K2s[4][2], A2s[4][2];
    unsigned urs[4][4];
    const bfr* pa_u = proj + (lo ? (size_t)PLANE : (size_t)0) + (size_t)bh * 4096 * 128;
    const int pa_o = (mt * 16 + l15) * 128 + q * 8;
    const bfr* pu_u = proj + (size_t)2 * PLANE + (size_t)bh * 4096 * 128 + slice * 16;
    const int pu_o = (mt * 16 + q * 4) * 128 + (l15 & ~1);
    const int ush = (l15 & 1) * 16;
    const bfr* kd_u = KDT + (size_t)bh * 64 * 8192;
    const int kd_o = (wv * 16 + l15) * 64 + q * 8;
    const bfr* at_u = ATT + (size_t)bh * 64 * 4096;
    const int at_o = (mt * 16 + l15) * 64 + q * 8;
#define G2_GLOAD(set, n)                                                                                     \
  {                                                                                                          \
    const bfr* pa_n = pa_u + (size_t)(n) * 64 * 128;                                                         \
    _Pragma("unroll") for (int ks = 0; ks < 4; ++ks) A1s[set][ks] = *(const bf16x8*)&pa_n[pa_o + ks * 32];   \
    const bfr* kd_n = kd_u + (n) * 8192;                                                                     \
    K2s[set][0] = *(const bf16x8*)&kd_n[kd_o];                                                               \
    K2s[set][1] = *(const bf16x8*)&kd_n[kd_o + 32];                                                          \
    if (lo) {                                                                                                \
      const bfr* pu_n = pu_u + (size_t)(n) * 64 * 128;                                                       \
      _Pragma("unroll") for (int jx = 0; jx < 4; ++jx) urs[set][jx] = *(const unsigned*)&pu_n[pu_o + jx * 128];               \
    } else {                                                                                                 \
      const bfr* at_n = at_u + (n) * 4096;                                                                   \
      A2s[set][0] = *(const bf16x8*)&at_n[at_o];                                                             \
      A2s[set][1] = *(const bf16x8*)&at_n[at_o + 32];                                                        \
    }                                                                                                        \
  }
#define G2_STEP(n, rs)                                                                                       \
  {                                                                                                          \
    f32x4 acc = (f32x4){0.f, 0.f, 0.f, 0.f};                                                                 \
    _Pragma("unroll") for (int ks = 0; ks < 4; ++ks) {                                                       \
      bf16x8 sb = *(const bf16x8*)&SbT[l15 * 136 + ks * 32 + q * 8];                                         \
      acc = lo ? MFMA16(A1s[rs][ks], sb, acc) : MFMA16(sb, A1s[rs][ks], acc);     \
    }                                                                                                        \
    if (lo) {                                                                                                \
      u32x2 pk;                                                                                              \
      pk[0] = pack2(bf2f((bfr)(urs[rs][0] >> ush)) - acc[0], bf2f((bfr)(urs[rs][1] >> ush)) - acc[1]);       \
      pk[1] = pack2(bf2f((bfr)(urs[rs][2] >> ush)) - acc[2], bf2f((bfr)(urs[rs][3] >> ush)) - acc[3]);       \
      *(u32x2*)&VbT[l15 * 72 + mt * 16 + q * 4] = pk;                                                        \
    }                                                                                                        \
    lds_barrier();                                                                                           \
    bf16x8 vb0 = *(const bf16x8*)&VbT[l15 * 72 + q * 8];                                                     \
    bf16x8 vb1 = *(const bf16x8*)&VbT[l15 * 72 + 32 + q * 8];                                                \
    if (!lo) {                                                                                               \
      acc = MFMA16(vb0, A2s[rs][0], acc);                                                                    \
      acc = MFMA16(vb1, A2s[rs][1], acc);                                                                    \
      u32x2 ok; ok[0] = pack2(acc[0], acc[1]); ok[1] = pack2(acc[2], acc[3]);                                \
      *(u32x2*)&OB[((size_t)(b * 4096 + (n) * 64) + mt * 16 + l15) * 1024 + h * 128 + slice * 16 + q * 4] = ok;  \
    }                                                                                                        \
    const float el = __shfl(elv, (n));                                                                       \
    S = S * el;                                                                                              \
    S = MFMA16(K2s[rs][0], vb0, S);                                                                          \
    S = MFMA16(K2s[rs][1], vb1, S);                                                                          \
    {                                                                                                        \
      u32x2 pk;                                                                                              \
      pk[0] = pack2(S[0], S[1]);                                                                             \
      pk[1] = pack2(S[2], S[3]);                                                                             \
      *(u32x2*)&SbT[l15 * 136 + wv * 16 + q * 4] = pk;                                                       \
    }                                                                                                        \
    if ((n) + 4 < 64) G2_GLOAD(rs, (n) + 4);                                                                 \
    lds_barrier();                                                                                           \
  }
    G2_GLOAD(0, 0);
    G2_GLOAD(1, 1);
    G2_GLOAD(2, 2);
    G2_GLOAD(3, 3);
    __syncthreads();
#pragma unroll 1
    for (int n = 0; n < 64; n += 4) {
      G2_STEP(n, 0);
      G2_STEP(n + 1, 1);
      G2_STEP(n + 2, 2);
      G2_STEP(n + 3, 3);
    }
#undef G2_GLOAD
#undef G2_STEP
  }
}

DI void gdn_g2l(const Params& p, int j, char* lds) {
  constexpr int STG = 51200;
  bfr* SbT = (bfr*)(lds + 3 * STG);
  bfr* VbT = (bfr*)(lds + 3 * STG + 4352);
  const int tid = otid(), lane = tid & 63, wv = tid >> 6, l15 = lane & 15, q = lane >> 4;
  const bfr* proj = (const bfr*)(ows(p) + O_PROJ);
  const bfr* KDT = (const bfr*)(ows(p) + O_H);
  const bfr* ATT = (const bfr*)(ows(p) + O_ATTN);
  const float* EL = (const float*)(ows(p) + O_ELAST);
  bfr* OB = (bfr*)(ows(p) + O_SCR);
  for (int unit = obid(); unit < 256; unit += gridDim.x) {
    const int xcd = unit & 7, li = unit >> 3, bh = xcd * 4 + (li >> 3), slice = li & 7;
    const int b = bh >> 3, h = bh & 7;
    const bool loader = wv >= 4;
    for (int e = tid; e < 16 * 136; e += 512) SbT[e] = 0;
    if (loader) {
      const int lw = __builtin_amdgcn_readfirstlane(wv - 4);
      const bfr* wq_u = proj + (size_t)bh * 4096 * 128;
      const bfr* kd_u = KDT + (size_t)bh * 64 * 8192;
      const int lo_wq = (lane >> 2) * 128 + (lane & 3) * 8, lo_kd = (lane >> 2) * 64 + (lane & 3) * 8;
      const bfr* u_u = proj + (size_t)2 * PLANE + (size_t)bh * 4096 * 128 + slice * 16 + (lw * 32 + (lane >> 1)) * 128 + (lane & 1) * 8;
#define G2L_DMA(c, stg)                                                                                      \
  {                                                                                                          \
    const int cc = (c) < 64 ? (c) : 63;                                                                      \
    const bfr* wq_c = wq_u + (size_t)cc * 64 * 128;                                                          \
    const bfr* kd_c = kd_u + (size_t)cc * 8192;                                                              \
    _Pragma("unroll") for (int i = 0; i < 12; ++i) {                                                         \
      const int blk = lw * 12 + i, X = blk >> 4, idx = blk & 15;                                             \
      const bfr* g = (X == 2) ? (kd_c + ((idx >> 1) * 16 * 64 + (idx & 1) * 32) + lo_kd)                     \
                              : (wq_c + (X == 0 ? (size_t)PLANE : (size_t)0) + ((idx >> 2) * 16 * 128 + (idx & 3) * 32) + lo_wq);  \
      __builtin_amdgcn_global_load_lds((const unsigned*)g, (PG8_LAS unsigned*)(lds + (stg) * STG + blk * 1024), 16, 0, 0);  \
    }                                                                                                        \
    if (lw < 2) __builtin_amdgcn_global_load_lds((const unsigned*)(u_u + (size_t)cc * 64 * 128), (PG8_LAS unsigned*)(lds + (stg) * STG + (48 + lw) * 1024), 16, 0, 0);  \
  }
#define G2L_WAITPREV() { if (lw < 2) asm volatile("s_waitcnt vmcnt(13)" ::: "memory"); else asm volatile("s_waitcnt vmcnt(12)" ::: "memory"); }
      G2L_DMA(0, 0);
      G2L_DMA(1, 1);
      G2L_WAITPREV();
      lds_barrier();
#pragma unroll 1
      for (int n = 0; n < 64; n += 3) {
#pragma unroll
        for (int s3 = 0; s3 < 3; ++s3) {
          if (n + s3 < 64) {
            G2L_DMA(n + s3 + 2, (s3 + 2) % 3);
            lds_barrier();
            G2L_WAITPREV();
            lds_barrier();
          }
        }
      }
      asm volatile("s_waitcnt vmcnt(0)" ::: "memory");
#undef G2L_DMA
#undef G2L_WAITPREV
    } else {
      const int mt = wv;
      const float elv = EL[bh * 64 + lane];
      f32x4 S0 = (f32x4){0.f, 0.f, 0.f, 0.f}, S1 = S0;
      bf16x8 At[4][2];
      const bfr* at_u = ATT + (size_t)bh * 64 * 4096 + (mt * 16 + l15) * 64 + q * 8;
#define G2L_GLOAD(set, c)                                                                                    \
  {                                                                                                          \
    const int cc = (c) < 64 ? (c) : 63;                                                                      \
    At[set][0] = *(const bf16x8*)&at_u[cc * 4096];                                                           \
    At[set][1] = *(const bf16x8*)&at_u[cc * 4096 + 32];                                                      \
  }
#define G2L_STEP(n, stg, rs)                                                                                 \
  {                                                                                                          \
    const char* sb_ = lds + (stg) * STG + l15 * 64 + q * 16;                                                 \
    f32x4 accp = (f32x4){0.f, 0.f, 0.f, 0.f}, acco = accp;                                                   \
    if ((n) > 0) {     \
      accd = MFMA16(vbd0, Atd0, accd);                                                                       \
      accd = MFMA16(vbd1, Atd1, accd);                                                                       \
      u32x2 ok; ok[0] = pack2(accd[0], accd[1]); ok[1] = pack2(accd[2], accd[3]);                            \
      *(u32x2*)&OB[((size_t)(b * 4096 + ((n) - 1) * 64) + mt * 16 + l15) * 1024 + h * 128 + slice * 16 + q * 4] = ok;  \
    }                                                                                                        \
    _Pragma("unroll") for (int ks = 0; ks < 4; ++ks) {                                                       \
      const bf16x8 sb = *(const bf16x8*)&SbT[l15 * 136 + ks * 32 + q * 8];                                   \
      accp = MFMA16(*(const bf16x8*)(sb_ + (mt * 4 + ks) * 1024), sb, accp);                                 \
      acco = MFMA16(sb, *(const bf16x8*)(sb_ + (16 + mt * 4 + ks) * 1024), acco);     \
    }                                                                                                        \
    {                                                                                                        \
      u32x2 pk;                                                                                              \
      const bfr* up_ = (const bfr*)(lds + (stg) * STG + 48 * 1024) + (mt * 16 + q * 4) * 16 + l15;           \
      pk[0] = pack2(bf2f(up_[0]) - accp[0], bf2f(up_[16]) - accp[1]);                                        \
      pk[1] = pack2(bf2f(up_[32]) - accp[2], bf2f(up_[48]) - accp[3]);                                       \
      *(u32x2*)&VbT[l15 * 72 + mt * 16 + q * 4] = pk;                                                        \
    }                                                                                                        \
    lds_barrier();                                                                                           \
    const bf16x8 vb0 = *(const bf16x8*)&VbT[l15 * 72 + q * 8];                                               \
    const bf16x8 vb1 = *(const bf16x8*)&VbT[l15 * 72 + 32 + q * 8];                                          \
    accd = acco; vbd0 = vb0; vbd1 = vb1; Atd0 = At[rs][0]; Atd1 = At[rs][1];                                 \
    const float el = __uint_as_float(__builtin_amdgcn_readlane(__float_as_uint(elv), (n)));       \
    S0 = S0 * el; S1 = S1 * el;                                                                              \
    S0 = MFMA16(*(const bf16x8*)(sb_ + (32 + (2 * mt) * 2 + 0) * 1024), vb0, S0);                            \
    S0 = MFMA16(*(const bf16x8*)(sb_ + (32 + (2 * mt) * 2 + 1) * 1024), vb1, S0);                            \
    S1 = MFMA16(*(const bf16x8*)(sb_ + (32 + (2 * mt + 1) * 2 + 0) * 1024), vb0, S1);                        \
    S1 = MFMA16(*(const bf16x8*)(sb_ + (32 + (2 * mt + 1) * 2 + 1) * 1024), vb1, S1);                        \
    {                                                                                                        \
      u32x2 pk;                                                                                              \
      pk[0] = pack2(S0[0], S0[1]); pk[1] = pack2(S0[2], S0[3]);                                              \
      *(u32x2*)&SbT[l15 * 136 + (2 * mt) * 16 + q * 4] = pk;                                                 \
      pk[0] = pack2(S1[0], S1[1]); pk[1] = pack2(S1[2], S1[3]);                                              \
      *(u32x2*)&SbT[l15 * 136 + (2 * mt + 1) * 16 + q * 4] = pk;                                             \
    }                                                                                                        \
    G2L_GLOAD(rs, (n) + 4);                                                                                  \
    lds_barrier();                                                                                           \
  }
      G2L_GLOAD(0, 0);
      G2L_GLOAD(1, 1);
      G2L_GLOAD(2, 2);
      G2L_GLOAD(3, 3);
      f32x4 accd = (f32x4){0.f, 0.f, 0.f, 0.f};
      bf16x8 vbd0 = (bf16x8){0, 0, 0, 0, 0, 0, 0, 0}, vbd1 = vbd0, Atd0 = vbd0, Atd1 = vbd0;
      lds_barrier();
#pragma unroll 1
      for (int n = 0; n < 60; n += 12) {
        G2L_STEP(n, 0, 0); G2L_STEP(n + 1, 1, 1); G2L_STEP(n + 2, 2, 2); G2L_STEP(n + 3, 0, 3);
        G2L_STEP(n + 4, 1, 0); G2L_STEP(n + 5, 2, 1); G2L_STEP(n + 6, 0, 2); G2L_STEP(n + 7, 1, 3);
        G2L_STEP(n + 8, 2, 0); G2L_STEP(n + 9, 0, 1); G2L_STEP(n + 10, 1, 2); G2L_STEP(n + 11, 2, 3);
      }
      G2L_STEP(60, 0, 0); G2L_STEP(61, 1, 1); G2L_STEP(62, 2, 2); G2L_STEP(63, 0, 3);
      {
        accd = MFMA16(vbd0, Atd0, accd);
        accd = MFMA16(vbd1, Atd1, accd);
        u32x2 ok; ok[0] = pack2(accd[0], accd[1]); ok[1] = pack2(accd[2], accd[3]);
        *(u32x2*)&OB[((size_t)(b * 4096 + 63 * 64) + mt * 16 + l15) * 1024 + h * 128 + slice * 16 + q * 4] = ok;
      }
#undef G2L_GLOAD
#undef G2L_STEP
    }
    __syncthreads();
  }
}

DI void gdn_g3(const Params& p, int j, char* lds) {
  const int tid = otid(), lane = tid & 63, wv = tid >> 6, l15 = lane & 15, q = lane >> 4;
  const bfr* proj = (const bfr*)(ows(p) + O_PROJ);
  bfr* OB = (bfr*)(ows(p) + O_SCR);
  f32x4 g0 = *(const f32x4*)&p.gdn_onorm_g[j * 128 + l15 * 8], g1 = *(const f32x4*)&p.gdn_onorm_g[j * 128 + l15 * 8 + 4];
  const int stride = gridDim.x * 32;
  int pi = (obid() * 8 + wv) * 4 + q;
  bf16x8 ov, zv;
#define G3_LOAD(pp)                                                                                                  \
  {                                                                                                                  \
    const int t_ = (pp) >> 3, h_ = (pp) & 7;                                                                         \
    ov = *(const bf16x8*)&OB[(size_t)t_ * 1024 + h_ * 128 + l15 * 8];                                                \
    zv = *(const bf16x8*)&proj[(size_t)3 * PLANE + (size_t)(((t_ >> 12) * 8 + h_) * 4096 + (t_ & 4095)) * 128 + l15 * 8];  \
  }
  if (pi < 131072) G3_LOAD(pi);
  for (; pi < 131072; pi += stride) {
    const int t = pi >> 3, h = pi & 7;
    const bf16x8 oc = ov, zc = zv;
    if (pi + stride < 131072) G3_LOAD(pi + stride);
    float o[8], ss = 0.f;
#pragma unroll
    for (int e = 0; e < 8; ++e) { o[e] = bfe(oc, e); ss += o[e] * o[e]; }
    ss = sum16(ss);
    const float rstd = rsqrtf(ss * (1.f / 128.f) + EPS);
    float y[8];
#pragma unroll
    for (int e = 0; e < 8; ++e) y[e] = o[e] * rstd * (e < 4 ? g0[e] : g1[e - 4]) * siluf_(bfe(zc, e));
    u32x4 pk;
    pk[0] = pack2(y[0], y[1]); pk[1] = pack2(y[2], y[3]); pk[2] = pack2(y[4], y[5]); pk[3] = pack2(y[6], y[7]);
    *(u32x4*)&OB[(size_t)t * 1024 + h * 128 + l15 * 8] = pk;
  }
#undef G3_LOAD
}


#define XB_TMO      128
#define XB_XCNT(j)  (256  + 64 * (j))
#define XB_XSUB(j)  (1280 + 64 * (j))
#define XB_XGEN(j)  (2304 + 64 * (j))
#define XB_TOP      3328
#define XB_TOPGEN   3392
#define XCD_BAR_WORDS 3456
#define XB_SPIN_CAP (1u << 18)
#define LAS __attribute__((address_space(3)))

__device__ __forceinline__ unsigned xb_ld(unsigned* p)              { return __hip_atomic_load(p, __ATOMIC_RELAXED, __HIP_MEMORY_SCOPE_AGENT); }
__device__ __forceinline__ unsigned xb_add(unsigned* p, unsigned v) { return __hip_atomic_fetch_add(p, v, __ATOMIC_RELAXED, __HIP_MEMORY_SCOPE_AGENT); }
__device__ __forceinline__ unsigned xb_xcc_id() { return (unsigned)__builtin_amdgcn_s_getreg((3 << 11) | 20) & 0xFu; }
#define XB_SPIN(cond, bar) do { unsigned _sp = 0; while (cond) { __builtin_amdgcn_s_sleep(1); \
    if ((++_sp & 255u) == 0u) { if (xb_ld(&(bar)[XB_TMO])) break; if (_sp > XB_SPIN_CAP) { atomicAdd(&(bar)[XB_TMO], 1u); break; } } } } while (0)

struct XcdBarrier {
    unsigned* bar; unsigned x;
    volatile LAS unsigned* st;
};

__device__ __forceinline__ XcdBarrier xcd_barrier_post(unsigned* bar, volatile LAS unsigned* st) {
    XcdBarrier b; b.bar = bar; b.x = xb_xcc_id(); b.st = st;
    if (threadIdx.x == 0) (void)xb_add(&bar[XB_XCNT(b.x)], 1u);
    return b;
}
__device__ __forceinline__ void xcd_barrier_complete(unsigned* bar, unsigned x, unsigned& nloc, unsigned& nx) {
    const unsigned G = gridDim.x * gridDim.y * gridDim.z;
    unsigned sum, cnt, mine, sp = 0u;
    for (;;) {
        sum = 0u; cnt = 0u; mine = 0u;
#pragma unroll
        for (unsigned j = 0; j < 16; ++j) { const unsigned c = xb_ld(&bar[XB_XCNT(j)]); sum += c; cnt += (c > 0u) ? 1u : 0u; mine = (j == x) ? c : mine; }
        if (sum == G) break;
        __builtin_amdgcn_s_sleep(1);
        if ((++sp & 255u) == 0u) { if (xb_ld(&bar[XB_TMO])) break; if (sp > XB_SPIN_CAP) { atomicAdd(&bar[XB_TMO], 1u); break; } }
    }
    nloc = mine > 0u ? mine : 1u; nx = cnt > 0u ? cnt : 1u;
}

__device__ __forceinline__ void xcd_barrier(const XcdBarrier& b) {
    asm volatile("s_waitcnt vmcnt(0)" ::: "memory");
    __syncthreads();
    if (threadIdx.x == 0) {
        unsigned* bar = b.bar;
        __builtin_amdgcn_s_waitcnt(0);
        unsigned nloc = b.st[0], nx = b.st[1];
        if (nloc == 0u) { xcd_barrier_complete(bar, b.x, nloc, nx); b.st[0] = nloc; b.st[1] = nx; }
        const unsigned old = xb_add(&bar[XB_XSUB(b.x)], 1u);
        const unsigned gen = old / nloc;
        if (old + 1u == (gen + 1u) * nloc) {
            __builtin_amdgcn_fence(__ATOMIC_RELEASE, "agent");
            asm volatile("s_waitcnt vmcnt(0)" ::: "memory");
            const unsigned og = xb_add(&bar[XB_TOP], 1u);
            const unsigned tg = og / nx;
            if (og + 1u == (tg + 1u) * nx) xb_add(&bar[XB_TOPGEN], 1u);
            else XB_SPIN(xb_ld(&bar[XB_TOPGEN]) == tg, bar);
            __builtin_amdgcn_fence(__ATOMIC_ACQUIRE, "agent");
            xb_add(&bar[XB_XGEN(b.x)], 1u);
            asm volatile("s_waitcnt vmcnt(0)" ::: "memory");
        } else {
            XB_SPIN(xb_ld(&bar[XB_XGEN(b.x)]) == gen, bar);
            __builtin_amdgcn_fence(__ATOMIC_ACQUIRE, "agent");
            asm volatile("s_waitcnt vmcnt(0)" ::: "memory");
        }
    }
    __syncthreads();
}


DI void run_phase(const Params& p, int ph, char* lds) {
  if (ph == 0) { phase0(p, lds); return; }
  if (ph == NPHASE - 1) { norm_phase(p, 4, ows(p) + O_H, lds); return; }
  int layer, sub;
  if (ph < 5) { layer = 0; sub = ph - 1; }
  else if (ph < 11) { layer = 1; sub = ph - 5; }
  else if (ph < 15) { layer = 2; sub = ph - 11; }
  else { layer = 3; sub = ph - 15; }
  const int j = layer >> 1;
  const bool is_lru = (layer & 1) == 0;
  const bfr* H = (const bfr*)(ows(p) + O_H);
  const void* xcur = (layer == 0) ? (const void*)p.x : (const void*)p.out;
  bfr* xnext = (layer == 3) ? (bfr*)(ows(p) + O_H) : (bfr*)p.out;
  if (is_lru) {
    switch (sub) {
      case 0: norm_phase(p, layer, xcur, lds); break;
      case 1: gemm_phase<0>(p, H, 1024, (const bfr*)(ows(p) + O_WLI) + (size_t)j * 2048 * 1024, 8, layer, nullptr, nullptr, lds); break;
      case 2: lru_phase(p, j, lds); break;
      case 3: gemm_phase<2>(p, H, 1024, (const bfr*)(ows(p) + O_WLO) + (size_t)j * 1024 * 1024, 4, layer, xcur, xnext, lds); break;
    }
  } else {
    switch (sub) {
      case 0: norm_phase(p, layer, xcur, lds); break;
      case 1: gemm_phase<1>(p, H, 1024, (const bfr*)(ows(p) + O_WGI) + (size_t)j * 4224 * 1024, 16, layer, nullptr, nullptr, lds); break;
      case 2: gdn_g1(p, j, lds); break;
#if G2_LOADER
      case 3: gdn_g2l(p, j, lds); break;
#else
      case 3: gdn_g2(p, j, lds); break;
#endif
      case 4: gdn_g3(p, j, lds); break;
      case 5: gemm_phase<2>(p, (const bfr*)(ows(p) + O_SCR), 1024, (const bfr*)(ows(p) + O_WGO) + (size_t)j * 1024 * 1024, 4, layer, xcur, xnext, lds); break;
    }
  }
}

__global__ void __launch_bounds__(512) mega_fwd(Params p) {
  extern __shared__ __attribute__((aligned(16))) char lds[];
#if MK_MODE == 1
  cg::grid_group grid = cg::this_grid();
  if (p.ph_lo < 0) grid.sync();
  volatile LAS unsigned* bst = (volatile LAS unsigned*)(lds + LDS_BYTES - 16);
  if (threadIdx.x == 0) { bst[0] = 0u; bst[1] = 0u; }
  __syncthreads();
  const XcdBarrier xb = xcd_barrier_post((unsigned*)(p.ws + O_BAR), bst);
  for (int ph = p.ph_lo; ph < p.ph_hi; ++ph) {
    if (ph > p.ph_lo) xcd_barrier(xb);
#ifdef PROBE_MASK
    const bool probe = (PROBE_MASK >> ph) & 1;
    long long ts = 0;
    if (probe) ts = wall_clock64();
#endif
    run_phase(p, ph, lds);
#ifdef PROBE_MASK
    if (probe) {
      xcd_barrier(xb);
      if (blockIdx.x == 0 && threadIdx.x == 0) {
        long long dt = wall_clock64() - ts, t1 = wall_clock64();
        while (wall_clock64() - t1 < dt) __builtin_amdgcn_s_sleep(8);
      }
    }
#endif
  }
#else
  for (int ph = p.ph_lo; ph < p.ph_hi; ++ph) run_phase(p, ph, lds);
#endif
}

extern "C" void kernel_launch(void* const* d_in, const int* in_sizes, int n_in, void* d_out, int out_size, void* d_ws, size_t ws_size, hipStream_t stream) {
  static int grid = 0;
  if (grid == 0) {
    if (n_in != 19 || ws_size < WS_END) { fprintf(stderr, "kernel_launch: unexpected inputs (n_in %d, ws %zu)\n", n_in, ws_size); grid = -1; return; }
    int dev = 0, cus = 0, per_cu = 0;
    hipGetDevice(&dev);
    hipDeviceGetAttribute(&cus, hipDeviceAttributeMultiprocessorCount, dev);
    if (hipFuncSetAttribute((const void*)mega_fwd, hipFuncAttributeMaxDynamicSharedMemorySize, LDS_BYTES) != hipSuccess) { fprintf(stderr, "kernel_launch: hipFuncSetAttribute failed\n"); grid = -1; return; }
    hipOccupancyMaxActiveBlocksPerMultiprocessor(&per_cu, (const void*)mega_fwd, 512, LDS_BYTES);
    if (per_cu < 1) { fprintf(stderr, "kernel_launch: occupancy query returned %d\n", per_cu); per_cu = 1; }
    (void)hipGetLastError();
    grid = cus * per_cu;
    if (grid > 256) grid = 256;
  }
  if (grid < 0) return;
  Params p{};
  const float** pp = (const float**)&p;
  for (int i = 0; i < 19; ++i) pp[i] = (const float*)d_in[i];
  p.out = (float*)d_out;
  p.ws = (char*)d_ws;
#if MK_MODE == 1
  p.ph_lo = 0; p.ph_hi = NPHASE;
  if (hipMemsetAsync((char*)d_ws + O_BAR, 0, 16384, stream) != hipSuccess) { fprintf(stderr, "kernel_launch: memset of barrier words failed\n"); return; }
  void* args[] = {&p};
  hipError_t e = hipLaunchCooperativeKernel((const void*)mega_fwd, dim3(grid), dim3(512), args, LDS_BYTES, stream);
  if (e != hipSuccess) fprintf(stderr, "cooperative launch failed: %s (grid %d)\n", hipGetErrorString(e), grid);
#else
  for (int ph = 0; ph < NPHASE; ++ph) {
    p.ph_lo = ph; p.ph_hi = ph + 1;
    hipLaunchKernelGGL(mega_fwd, dim3(grid), dim3(512), LDS_BYTES, stream, p);
  }
#endif
}
```

```cpp
#include <hip/hip_runtime.h>
#include <hip/hip_cooperative_groups.h>
#include <cstdio>
namespace cg = cooperative_groups;

#ifndef G2_LOADER
#define G2_LOADER 1
#endif
#ifndef MK_MODE
#define MK_MODE 1
#endif

typedef unsigned short bfr;
typedef __attribute__((ext_vector_type(8))) short bf16x8;
typedef __attribute__((ext_vector_type(4))) short bf16x4;
typedef __attribute__((ext_vector_type(4))) float f32x4;
typedef __attribute__((ext_vector_type(4))) unsigned u32x4;
typedef __attribute__((ext_vector_type(2))) unsigned u32x2;

#define DI __device__ __forceinline__
#define MFMA16(a, b, c) __builtin_amdgcn_mfma_f32_16x16x32_bf16((a), (b), (c), 0, 0, 0)

constexpr int PLANE = 16384 * 1024;
constexpr float EPS = 1e-6f;
constexpr int NPHASE = 22;
constexpr int LDS_BYTES = 163840;

constexpr size_t O_WLI = 0;
constexpr size_t O_WLO = 8388608;
constexpr size_t O_WGI = 12582912;
constexpr size_t O_WGO = 29884416;
constexpr size_t O_WG = 34078720;
constexpr size_t O_CONDP = 35127296;
constexpr size_t O_H = 36700160;
constexpr size_t O_PROJ = 70254592;
constexpr size_t O_ATTN = 204996608;
constexpr size_t O_HALO = 221773824;
constexpr size_t O_SCR = 226492416;
constexpr size_t O_AB = 260046848;
constexpr size_t O_ELAST = 261095424;
constexpr size_t O_AGG = 261103616;
constexpr size_t O_COND = 263200768;
constexpr size_t O_BAR = 263397376;
constexpr size_t WS_END = 263397376 + 16384;

struct Params {
  const float *x, *c, *ada_w, *ada_b, *norm_g, *final_g;
  const float *lru_in_w, *lru_conv_w, *lru_conv_b, *lru_gate_w, *lru_gate_b, *lru_lambda, *lru_out_w;
  const float *gdn_in_w, *gdn_conv_w, *gdn_a_log, *gdn_dt_bias, *gdn_onorm_g, *gdn_out_w;
  float* out;
  char* ws;
  int ph_lo, ph_hi;
};

DI int otid() { int t = threadIdx.x; asm volatile("" : "+v"(t)); return t; }
DI int obid() { int b = blockIdx.x; asm volatile("" : "+s"(b)); return b; }
DI void lds_barrier() { asm volatile("s_waitcnt lgkmcnt(0)" ::: "memory"); __builtin_amdgcn_s_barrier(); asm volatile("" ::: "memory"); }
typedef float f32x2_t __attribute__((ext_vector_type(2)));
typedef __bf16 bf16x2_t __attribute__((ext_vector_type(2)));
DI unsigned pack2(float a, float b) { f32x2_t v = {a, b}; bf16x2_t r = __builtin_convertvector(v, bf16x2_t); return __builtin_bit_cast(unsigned, r); }
DI bfr f2bf(float x) { return (bfr)(pack2(x, x) & 0xffffu); }
DI float bf2f(bfr b) { return __uint_as_float(((unsigned)b) << 16); }
DI float sum16(float x) {
  x += __uint_as_float(__builtin_amdgcn_update_dpp(0, __float_as_uint(x), 0xB1, 0xF, 0xF, true));
  x += __uint_as_float(__builtin_amdgcn_update_dpp(0, __float_as_uint(x), 0x4E, 0xF, 0xF, true));
  x += __uint_as_float(__builtin_amdgcn_update_dpp(0, __float_as_uint(x), 0x141, 0xF, 0xF, true));
  x += __uint_as_float(__builtin_amdgcn_update_dpp(0, __float_as_uint(x), 0x140, 0xF, 0xF, true));
  return x;
}
DI float sigmoidf_(float x) { return __builtin_amdgcn_rcpf(1.f + __expf(-x)); }
DI float siluf_(float x) { return x * __builtin_amdgcn_rcpf(1.f + __expf(-x)); }
DI float softplusf_(float x) { return x > 20.f ? x : log1pf(expf(x)); }
DI float bfe(const bf16x8& v, int e) { return bf2f((bfr)v[e]); }

DI char* ows(const Params& p) { size_t z = 0; asm volatile("" : "+s"(z)); return p.ws + z; }
DI float cond_get(const Params& p, int layer, int b, int n) {
  const float* cp = (const float*)(ows(p) + O_CONDP);
  float s = p.ada_b[layer * 3072 + n];
#pragma unroll
  for (int sg = 0; sg < 8; ++sg) s += cp[((sg * 4 + layer) * 4 + b) * 3072 + n];
  return s;
}

DI void transpose_tile(const float* __restrict__ src, int ldsrc, int nvalid, bfr* __restrict__ dst, int ldd, int k0, int n0, float* sm) {
  const int tid = otid();
  for (int e = tid; e < 4096; e += 512) {
    int kk = e >> 6, nn = e & 63;
    float v = 0.f;
    if (n0 + nn < nvalid) v = src[(size_t)(k0 + kk) * ldsrc + n0 + nn];
    sm[kk * 65 + nn] = v;
  }
  __syncthreads();
  for (int e = tid; e < 4096; e += 512) {
    int nn = e >> 6, kk = e & 63;
    dst[(size_t)(n0 + nn) * ldd + k0 + kk] = f2bf(sm[kk * 65 + nn]);
  }
  __syncthreads();
}

struct P0Item { const float* src; bfr* dst; int ldsrc, nvalid, ldd, k0, n0; };
DI P0Item p0_decode(const Params& p, int it) {
  P0Item r;
  if (it < 1024) {
    int l = it >> 9, q = it & 511, kt = q >> 5, nt = q & 31;
    r.src = p.lru_in_w + (size_t)l * 1024 * 2048; r.ldsrc = 2048; r.nvalid = 2048; r.dst = (bfr*)(ows(p) + O_WLI) + (size_t)l * 2048 * 1024; r.ldd = 1024; r.k0 = kt * 64; r.n0 = nt * 64;
  } else if (it < 1536) {
    int r0 = it - 1024, l = r0 >> 8, q = r0 & 255, kt = q >> 4, nt = q & 15;
    r.src = p.lru_out_w + (size_t)l * 1024 * 1024; r.ldsrc = 1024; r.nvalid = 1024; r.dst = (bfr*)(ows(p) + O_WLO) + (size_t)l * 1024 * 1024; r.ldd = 1024; r.k0 = kt * 64; r.n0 = nt * 64;
  } else if (it < 3648) {
    int r0 = it - 1536, l = r0 / 1056, q = r0 % 1056, kt = q / 66, nt = q % 66;
    r.src = p.gdn_in_w + (size_t)l * 1024 * 4112; r.ldsrc = 4112; r.nvalid = 4112; r.dst = (bfr*)(ows(p) + O_WGI) + (size_t)l * 4224 * 1024; r.ldd = 1024; r.k0 = kt * 64; r.n0 = nt * 64;
  } else if (it < 4160) {
    int r0 = it - 3648, l = r0 >> 8, q = r0 & 255, kt = q >> 4, nt = q & 15;
    r.src = p.gdn_out_w + (size_t)l * 1024 * 1024; r.ldsrc = 1024; r.nvalid = 1024; r.dst = (bfr*)(ows(p) + O_WGO) + (size_t)l * 1024 * 1024; r.ldd = 1024; r.k0 = kt * 64; r.n0 = nt * 64;
  } else {
    int r0 = it - 4160, mat = r0 >> 2, q = r0 & 3, kt = q >> 1, nt = q & 1;
    r.src = p.lru_gate_w + (size_t)mat * 16384; r.ldsrc = 128; r.nvalid = 128; r.dst = (bfr*)(ows(p) + O_WG) + (size_t)mat * 16384; r.ldd = 128; r.k0 = kt * 64; r.n0 = nt * 64;
  }
  return r;
}

DI void phase0(const Params& p, char* lds) {
  float* sm = (float*)lds;
  const int tid = otid();
  float v[8];
#define P0_LOAD(it_)                                                                                 \
  {                                                                                                  \
    const P0Item t_ = p0_decode(p, (it_));                                                           \
    _Pragma("unroll") for (int i = 0; i < 8; ++i) {                                                  \
      const int e = tid + 512 * i, kk = e >> 6, nn = e & 63;                                         \
      v[i] = (t_.n0 + nn < t_.nvalid) ? __builtin_nontemporal_load(&t_.src[(size_t)(t_.k0 + kk) * t_.ldsrc + t_.n0 + nn]) : 0.f; \
    }                                                                                                \
  }
  if (obid() < 4288) P0_LOAD(obid());
#pragma unroll 1
  for (int it = obid(); it < 4288; it += gridDim.x) {
    const P0Item t = p0_decode(p, it);
#pragma unroll
    for (int i = 0; i < 8; ++i) { const int e = tid + 512 * i; sm[(e >> 6) * 65 + (e & 63)] = v[i]; }
    lds_barrier();
    if (it + (int)gridDim.x < 4288) P0_LOAD(it + gridDim.x);
#pragma unroll
    for (int i = 0; i < 4; ++i) {
      const int e = tid + 512 * i, nn = e >> 5, kp = e & 31;
      *(unsigned*)&t.dst[(size_t)(t.n0 + nn) * t.ldd + t.k0 + 2 * kp] = pack2(sm[(2 * kp) * 65 + nn], sm[(2 * kp + 1) * 65 + nn]);
    }
    lds_barrier();
  }
#undef P0_LOAD
  __syncthreads();
  for (int r0 = obid(); r0 < 192; r0 += gridDim.x) {
    int i = r0 / 48, r = r0 % 48, sg = r / 6, cb = r % 6;
    sm[tid] = siluf_(p.c[(tid >> 7) * 1024 + sg * 128 + (tid & 127)]);
    __syncthreads();
    int n = cb * 512 + tid;
    float a0 = 0.f, a1 = 0.f, a2 = 0.f, a3 = 0.f;
    const float* w = p.ada_w + ((size_t)i * 1024 + sg * 128) * 3072 + n;
#pragma unroll 32
    for (int k = 0; k < 128; ++k) {
      float wv = __builtin_nontemporal_load(&w[(size_t)k * 3072]);
      a0 += sm[k] * wv; a1 += sm[128 + k] * wv; a2 += sm[256 + k] * wv; a3 += sm[384 + k] * wv;
    }
    float* cp = (float*)(ows(p) + O_CONDP);
    cp[((sg * 4 + i) * 4 + 0) * 3072 + n] = a0;
    cp[((sg * 4 + i) * 4 + 1) * 3072 + n] = a1;
    cp[((sg * 4 + i) * 4 + 2) * 3072 + n] = a2;
    cp[((sg * 4 + i) * 4 + 3) * 3072 + n] = a3;
    __syncthreads();
  }
}

DI void norm_phase(const Params& p, int layer, const void* __restrict__ xsrc, char* lds) {
  const float* xs = (const float*)xsrc; const bfr* xsb = (const bfr*)xsrc;
  float* gm = (float*)lds;
  float* sh = gm + 1024;
  const int tid = otid(), lane = tid & 63, wv = tid >> 6;
  bfr* H = (bfr*)(ows(p) + O_H);
  if (layer == 0) {
    float* cd = (float*)(ows(p) + O_COND);
    for (int e = obid() * 512 + tid; e < 4 * 4 * 3072; e += gridDim.x * 512) {
      int n = e % 3072, ib = e / 3072;
      cd[e] = cond_get(p, ib >> 2, ib & 3, n);
    }
  }
  const float* cd = (const float*)(ows(p) + O_COND);
  for (int rt = obid(); rt < 256; rt += gridDim.x) {
    int b = rt >> 6;
    for (int c = tid; c < 1024; c += 512) {
      if (layer == 0) {
        float scale = cond_get(p, layer, b, 1024 + c), shift = cond_get(p, layer, b, c);
        gm[c] = p.norm_g[layer * 1024 + c] * (1.f + scale);
        sh[c] = shift;
      } else if (layer < 4) {
        gm[c] = p.norm_g[layer * 1024 + c] * (1.f + cd[(size_t)(layer * 4 + b) * 3072 + 1024 + c]);
        sh[c] = cd[(size_t)(layer * 4 + b) * 3072 + c];
      } else {
        gm[c] = p.final_g[c];
        sh[c] = 0.f;
      }
    }
    __syncthreads();
    u32x2 rb[2][4][4];
    if (layer != 0) {
#pragma unroll
      for (int g = 0; g < 2; ++g)
#pragma unroll
        for (int r = 0; r < 4; ++r)
#pragma unroll
          for (int jx = 0; jx < 4; ++jx) rb[g][r][jx] = *(const u32x2*)&xsb[((size_t)rt * 64 + wv * 8 + g * 4 + r) * 1024 + jx * 256 + lane * 4];
    }
#pragma unroll
    for (int r4 = 0; r4 < 8; r4 += 4) {
      f32x4 v[4][4];
#pragma unroll
      for (int r = 0; r < 4; ++r)
#pragma unroll
        for (int jx = 0; jx < 4; ++jx) {
          const size_t xi = ((size_t)rt * 64 + wv * 8 + r4 + r) * 1024 + jx * 256 + lane * 4;
          if (layer == 0) v[r][jx] = *(const f32x4*)&xs[xi];
          else {
            const u32x2 xb = rb[r4 >> 2][r][jx];
            v[r][jx] = (f32x4){__uint_as_float(xb[0] << 16), __uint_as_float(xb[0] & 0xffff0000u), __uint_as_float(xb[1] << 16), __uint_as_float(xb[1] & 0xffff0000u)};
          }
        }
#pragma unroll
      for (int r = 0; r < 4; ++r) {
        const size_t row = (size_t)rt * 64 + wv * 8 + r4 + r;
        float ss = 0.f;
#pragma unroll
        for (int jx = 0; jx < 4; ++jx) ss += v[r][jx][0] * v[r][jx][0] + v[r][jx][1] * v[r][jx][1] + v[r][jx][2] * v[r][jx][2] + v[r][jx][3] * v[r][jx][3];
        ss = sum16(ss);
        ss += __shfl_xor(ss, 16);
        ss += __shfl_xor(ss, 32);
        const float rstd = rsqrtf(ss * (1.f / 1024.f) + EPS);
#pragma unroll
        for (int jx = 0; jx < 4; ++jx) {
          const int c = jx * 256 + lane * 4;
          f32x4 g4 = *(const f32x4*)&gm[c], s4 = *(const f32x4*)&sh[c];
          f32x4 y;
#pragma unroll
          for (int e = 0; e < 4; ++e) y[e] = v[r][jx][e] * rstd * g4[e] + s4[e];
          if (layer < 4) {
            u32x2 o2; o2[0] = pack2(y[0], y[1]); o2[1] = pack2(y[2], y[3]);
            *(u32x2*)&H[row * 1024 + c] = o2;
          } else {
            __builtin_nontemporal_store(y, (f32x4*)&p.out[row * 1024 + c]);
          }
        }
      }
    }
    __syncthreads();
  }
}

namespace pg8 {
#define PG8_LAS __attribute__((address_space(3)))
typedef unsigned short bf16_t;
typedef short bf16x8 __attribute__((ext_vector_type(8)));
typedef float f32x4 __attribute__((ext_vector_type(4)));
typedef unsigned u32x4 __attribute__((ext_vector_type(4)));
constexpr int BM = 256, BK = 64, HALF = 128, HTB = HALF * BK * 2  , STAGE_BYTES = 8 * HTB, NXCD = 8, WGM = 8;

__host__ __device__ __forceinline__ int lds_byte(int r, int c) { const int st = (r >> 4) * 2 + (c >> 5), rr = r & 15, cc = c & 31, ob = rr * 64 + cc * 2; return st * 1024 + (ob ^ (((ob >> 9) & 1) << 5)); }
__host__ __device__ __forceinline__ void stage_rc(int b, int& R, int& C) { const int st = b / 1024, sb = b % 1024, swz = sb ^ (((sb >> 9) & 1) << 5); R = (st >> 1) * 16 + swz / 64; C = (st & 1) * 32 + (swz % 64) / 2; }
__host__ __device__ __forceinline__ int perm32(int rho) { const int n = rho >> 4, i = rho & 15; return 8 * (i >> 2) + 4 * n + (i & 3); }

struct Unit { int pm, pn; };
struct Gemm { const bf16_t* A; const bf16_t* Bt; int M, N, K; };

struct StaticOrder {
    int nM, nN, nwg, G, c;
    __host__ __device__ void init(int M, int N, int G_, int c_) { nM = M / BM; nN = N / BM; nwg = nM * nN; G = G_; c = c_; }
    __host__ __device__ bool next(int i, Unit& u) const {
        const long L = (long)i * G + c; if (L >= nwg) return false;
        int wgid = (int)L; { const int q = nwg / NXCD, r = nwg % NXCD, xcd = wgid % NXCD, off = wgid / NXCD; wgid = (xcd < r ? xcd * (q + 1) : r * (q + 1) + (xcd - r) * q) + off; }
        const int nig = WGM * nN, gid = wgid / nig, fm = gid * WGM, gsz = (nM - fm) < WGM ? (nM - fm) : WGM;
        u.pm = fm + ((wgid % nig) % gsz); u.pn = (wgid % nig) / gsz; return true;
    }
    __device__ __forceinline__ void a_ready(const Unit&) const {}
    __device__ __forceinline__ void done(const Unit&) const {}
};
__device__ __forceinline__ unsigned cvt_pk_bf16(float lo, float hi) { unsigned r; asm volatile("v_cvt_pk_bf16_f32 %0, %1, %2" : "=v"(r) : "v"(lo), "v"(hi)); return r; }

template <class Epi, class Sched, bool STAMP = false>
__device__ __forceinline__ void gemm_phase(PG8_LAS unsigned char* lds, const Gemm g, const Sched& S, const Epi& E, unsigned long long* stamps) {
    const int tid = otid(), wid = __builtin_amdgcn_readfirstlane(tid >> 6), lane = tid & 63, wr = wid >> 2, wc = wid & 3, fr = lane & 15, fq = lane >> 4;
    const int K = g.K, nt = K / BK;
    int ts_lo = 0, ts_hi = 0, nts = 0; const unsigned long long rt_entry = STAMP ? (unsigned long long)wall_clock64() : 0ull;
#define PG8_STAMP() do { if (STAMP && wid == 0 && nts < 64) { const unsigned long long _c = (unsigned long long)clock64(); \
        ts_lo = (lane == nts) ? (int)(unsigned)_c : ts_lo; ts_hi = (lane == nts) ? (int)(unsigned)(_c >> 32) : ts_hi; ++nts; } } while (0)
    PG8_STAMP();
    unsigned voffA[2], voffB[2];
#pragma unroll
    for (int i = 0; i < 2; ++i) { int R, C; stage_rc(tid * 16 + i * 8192, R, C); const int Rb = Epi::PERM ? ((R & ~31) + perm32(R & 31)) : R;
        voffA[i] = (unsigned)(R * K + C) * 2u; voffB[i] = (unsigned)(Rb * K + C) * 2u; }
    const size_t kstep = (size_t)(BK * 2);
    const size_t hstep = (size_t)HALF * K * 2;
    const size_t tstep = 2 * hstep;
    const unsigned ldsw = (unsigned)wid * 1024u;
    const int aoff = lds_byte(wr * 64 + fr, fq * 8), boff = lds_byte(wc * 32 + fr, fq * 8);
#define PG8_SA(b, h) (((b) * 2 + (h)) * HTB)
#define PG8_SB(b, h) ((4 + (b) * 2 + (h)) * HTB)
#define PG8_STAGE(bufoff, gbase, voff) do { _Pragma("unroll") for (int _i = 0; _i < 2; ++_i) \
        __builtin_amdgcn_global_load_lds((const unsigned*)((const char*)(gbase) + (voff)[_i]), (PG8_LAS unsigned*)(lds + (bufoff) + ldsw + _i * 8192), 16, 0, 0); } while (0)
#define PG8_LDA(dst, b, h) do { _Pragma("unroll") for (int m = 0; m < 4; ++m) _Pragma("unroll") for (int k = 0; k < 2; ++k) dst[m][k] = *(const PG8_LAS bf16x8*)(lds + PG8_SA(b, h) + aoff + m * 2048 + k * 1024); } while (0)
#define PG8_LDB(dst, b, h) do { _Pragma("unroll") for (int n = 0; n < 2; ++n) _Pragma("unroll") for (int k = 0; k < 2; ++k) dst[n][k] = *(const PG8_LAS bf16x8*)(lds + PG8_SB(b, h) + boff + n * 2048 + k * 1024); } while (0)
#define PG8_MMA(ai, bj, At, Bt) do { __builtin_amdgcn_s_setprio(1); _Pragma("unroll") for (int m = 0; m < 4; ++m) _Pragma("unroll") for (int n = 0; n < 2; ++n) _Pragma("unroll") for (int k = 0; k < 2; ++k) \
        acc[ai][bj][m][n] = __builtin_amdgcn_mfma_f32_16x16x32_bf16(Bt[n][k], At[m][k], acc[ai][bj][m][n], 0, 0, 0); __builtin_amdgcn_s_setprio(0); } while (0)
#define PG8_WAIT_V(n) asm volatile("s_waitcnt vmcnt(" #n ")" ::: "memory")
#define PG8_WAIT_L(n) asm volatile("s_waitcnt lgkmcnt(" #n ")" ::: "memory")
#define PG8_BAR __builtin_amdgcn_s_barrier()
#define PG8_SCHED __builtin_amdgcn_sched_barrier(0)
    Unit cur, nxt; int ui = 0;
    if (!S.next(0, cur)) return;
    f32x4 acc[2][2][4][2];
#pragma unroll
    for (int a = 0; a < 2; ++a)
#pragma unroll
        for (int b = 0; b < 2; ++b)
#pragma unroll
            for (int m = 0; m < 4; ++m)
#pragma unroll
                for (int n = 0; n < 2; ++n) acc[a][b][m][n] = (f32x4){0.f, 0.f, 0.f, 0.f};
    bf16x8 At[4][2], B0[2][2], B1[2][2];
    const char* cA = (const char*)g.A + (size_t)cur.pm * tstep; const char* cB = (const char*)g.Bt + (size_t)cur.pn * tstep;
    S.a_ready(cur);
    PG8_STAGE(PG8_SB(0, 0), cB, voffB); PG8_STAGE(PG8_SA(0, 0), cA, voffA); PG8_STAGE(PG8_SB(0, 1), cB + hstep, voffB); PG8_STAGE(PG8_SA(0, 1), cA + hstep, voffA);
    if (wr == 1) PG8_BAR;
    PG8_WAIT_V(4); PG8_BAR;
    PG8_STAGE(PG8_SB(1, 0), cB + kstep, voffB); PG8_STAGE(PG8_SA(1, 0), cA + kstep, voffA); PG8_STAGE(PG8_SB(1, 1), cB + hstep + kstep, voffB);
    PG8_WAIT_V(6); PG8_BAR;
    PG8_STAMP();
    for (;;) {
        const bool has_next = S.next(ui + 1, nxt);
        const char* nA = has_next ? (const char*)g.A + (size_t)nxt.pm * tstep : cA; const char* nB = has_next ? (const char*)g.Bt + (size_t)nxt.pn * tstep : cB;
        for (int t = 0; t < nt; t += 2) {
            const bool last = (t == nt - 2);
            const char* a1 = cA + (size_t)(t + 1) * kstep;
            const char* a2 = last ? nA : cA + (size_t)(t + 2) * kstep; const char* b2 = last ? nB : cB + (size_t)(t + 2) * kstep;
            const char* a3 = a2 + kstep; const char* b3 = b2 + kstep;
            if (last && has_next) S.a_ready(nxt);
            PG8_LDB(B0, 0, 0); PG8_SCHED; PG8_LDA(At, 0, 0); PG8_STAGE(PG8_SA(1, 1), a1 + hstep, voffA);
            PG8_WAIT_L(8); PG8_BAR; PG8_WAIT_L(0); PG8_MMA(0, 0, At, B0); PG8_BAR; PG8_SCHED;
            PG8_LDB(B1, 0, 1); PG8_STAGE(PG8_SB(0, 0), b2, voffB);
            PG8_BAR; PG8_WAIT_L(0); PG8_MMA(0, 1, At, B1); PG8_BAR;
            PG8_LDA(At, 0, 1); PG8_STAGE(PG8_SA(0, 0), a2, voffA);
            PG8_BAR; PG8_WAIT_L(0); PG8_MMA(1, 0, At, B0); PG8_BAR; PG8_SCHED;
            PG8_STAGE(PG8_SB(0, 1), b2 + hstep, voffB);
            PG8_WAIT_V(6); PG8_BAR; PG8_MMA(1, 1, At, B1); PG8_BAR;
            PG8_LDB(B0, 1, 0); PG8_SCHED; PG8_LDA(At, 1, 0); PG8_STAGE(PG8_SA(0, 1), a2 + hstep, voffA);
            PG8_WAIT_L(8); PG8_BAR; PG8_WAIT_L(0); PG8_MMA(0, 0, At, B0); PG8_BAR; PG8_SCHED;
            PG8_LDB(B1, 1, 1); PG8_STAGE(PG8_SB(1, 0), b3, voffB);
            PG8_BAR; PG8_WAIT_L(0); PG8_MMA(0, 1, At, B1); PG8_BAR;
            PG8_LDA(At, 1, 1); PG8_STAGE(PG8_SA(1, 0), a3, voffA);
            PG8_BAR; PG8_WAIT_L(0); PG8_MMA(1, 0, At, B0); PG8_BAR; PG8_SCHED;
            PG8_STAGE(PG8_SB(1, 1), b3 + hstep, voffB);
            PG8_WAIT_V(6); PG8_BAR; PG8_MMA(1, 1, At, B1); PG8_BAR;
        }
        PG8_STAMP();
        if constexpr (!Epi::AFTER_DRAIN) { E(acc, cur, wr, wc, fr, fq); S.done(cur); }
        PG8_STAMP();
        if (!has_next) break;
#pragma unroll
        for (int a = 0; a < 2; ++a)
#pragma unroll
            for (int b = 0; b < 2; ++b)
#pragma unroll
                for (int m = 0; m < 4; ++m)
#pragma unroll
                    for (int n = 0; n < 2; ++n) acc[a][b][m][n] = (f32x4){0.f, 0.f, 0.f, 0.f};
        cur = nxt; cA = nA; cB = nB; ++ui;
    }
    PG8_WAIT_V(0);
    if (wr == 0) PG8_BAR;
    PG8_BAR;
    if constexpr (Epi::AFTER_DRAIN) { E.fused(acc, cur, wr, wc, fr, fq, lds, wid, lane); S.done(cur); }
    PG8_STAMP();
    if (STAMP && wid == 0) { stamps[lane] = lane < nts ? (((unsigned long long)(unsigned)ts_hi << 32) | (unsigned)ts_lo) : 0ull;
        if (lane == 62) stamps[62] = rt_entry; if (lane == 63) stamps[63] = (unsigned long long)wall_clock64(); }
#undef PG8_STAMP
#undef PG8_SA
#undef PG8_SB
#undef PG8_STAGE
#undef PG8_LDA
#undef PG8_LDB
#undef PG8_MMA
#undef PG8_WAIT_V
#undef PG8_WAIT_L
#undef PG8_BAR
#undef PG8_SCHED
}
}

struct EpiProjBf16 {
  static constexpr bool PERM = true, AFTER_DRAIN = false;
  bfr* O; bfr* halo;
  __device__ __forceinline__ void operator()(const f32x4 (&acc)[2][2][4][2], const pg8::Unit& u, int wr, int wc, int fr, int fq) const {
    const int row0 = u.pm * 256 + wr * 64 + fr, col0 = u.pn * 256 + wc * 32 + 8 * fq;
#pragma unroll
    for (int ai = 0; ai < 2; ++ai)
#pragma unroll
      for (int m = 0; m < 4; ++m) {
        const int row = row0 + ai * 128 + m * 16;
        const int bb = row >> 12, ts = row & 4095;
#pragma unroll
        for (int bj = 0; bj < 2; ++bj) {
          const int col = col0 + bj * 128;
          const f32x4 v0 = acc[ai][bj][m][0], v1 = acc[ai][bj][m][1];
          u32x4 w; w.x = pack2(v0[0], v0[1]); w.y = pack2(v0[2], v0[3]); w.z = pack2(v1[0], v1[1]); w.w = pack2(v1[2], v1[3]);
          *(u32x4*)(O + (size_t)(col >> 10) * PLANE + ((size_t)((bb * 8 + ((col >> 7) & 7)) * 4096 + ts)) * 128 + (col & 127)) = w;
          if (halo && (row & 63) >= 61 && col < 3072)
            *(u32x4*)(halo + ((size_t)(row >> 6) * 3 + ((row & 63) - 61)) * 3072 + col) = w;
        }
      }
  }
};
struct EpiResid {
  static constexpr bool PERM = true, AFTER_DRAIN = false;
  bfr* out; const void* xin; int xin_f32; const float* gate;
  __device__ __forceinline__ void operator()(const f32x4 (&acc)[2][2][4][2], const pg8::Unit& u, int wr, int wc, int fr, int fq) const {
    const int row0 = u.pm * 256 + wr * 64 + fr, col0 = u.pn * 256 + wc * 32 + 8 * fq;
    const float* gp = gate + (size_t)((u.pm * 256) >> 12) * 3072 + col0;
    f32x4 gv[2][2];
#pragma unroll
    for (int bj = 0; bj < 2; ++bj)
#pragma unroll
      for (int n = 0; n < 2; ++n) gv[bj][n] = *(const f32x4*)(gp + bj * 128 + n * 4);
#pragma unroll
    for (int ai = 0; ai < 2; ++ai)
#pragma unroll
      for (int m = 0; m < 4; ++m) {
        const size_t ro = (size_t)(row0 + ai * 128 + m * 16) * 1024 + col0;
#pragma unroll
        for (int bj = 0; bj < 2; ++bj) {
          f32x4 x0, x1;
          if (xin_f32) {
            x0 = *(const f32x4*)((const float*)xin + ro + bj * 128);
            x1 = *(const f32x4*)((const float*)xin + ro + bj * 128 + 4);
          } else {
            const u32x4 xb = *(const u32x4*)((const bfr*)xin + ro + bj * 128);
            x0 = (f32x4){__uint_as_float(xb[0] << 16), __uint_as_float(xb[0] & 0xffff0000u), __uint_as_float(xb[1] << 16), __uint_as_float(xb[1] & 0xffff0000u)};
            x1 = (f32x4){__uint_as_float(xb[2] << 16), __uint_as_float(xb[2] & 0xffff0000u), __uint_as_float(xb[3] << 16), __uint_as_float(xb[3] & 0xffff0000u)};
          }
          const f32x4 v0 = x0 + gv[bj][0] * acc[ai][bj][m][0], v1 = x1 + gv[bj][1] * acc[ai][bj][m][1];
          u32x4 w; w.x = pack2(v0[0], v0[1]); w.y = pack2(v0[2], v0[3]); w.z = pack2(v1[0], v1[1]); w.w = pack2(v1[2], v1[3]);
          *(u32x4*)(out + ro + bj * 128) = w;
        }
      }
  }
};

template <int EPI>
DI void gemm_phase(const Params& p, const bfr* __restrict__ A, int lda, const bfr* __restrict__ Bt, int nN, int layer, const void* __restrict__ xin, bfr* __restrict__ xout, char* lds) {
  pg8::Gemm g; g.A = A; g.Bt = Bt; g.M = 16384; g.N = nN * 256; g.K = 1024;
  pg8::StaticOrder S; S.init(g.M, g.N, gridDim.x, obid());
  if (EPI == 2) {
    EpiResid E; E.out = xout; E.xin = xin; E.xin_f32 = (layer == 0) ? 1 : 0; E.gate = (const float*)(ows(p) + O_COND) + (size_t)layer * 4 * 3072 + 2048;
    pg8::gemm_phase<EpiResid, pg8::StaticOrder, false>((PG8_LAS unsigned char*)lds, g, S, E, nullptr);
  } else {
    EpiProjBf16 E; E.O = (bfr*)(ows(p) + O_PROJ); E.halo = (EPI == 1) ? (bfr*)(ows(p) + O_HALO) : nullptr;
    pg8::gemm_phase<EpiProjBf16, pg8::StaticOrder, false>((PG8_LAS unsigned char*)lds, g, S, E, nullptr);
  }
  if (EPI == 1) {
    __syncthreads();
    float* red = (float*)lds;
    const int tid = otid(), lane = tid & 63, wv = tid >> 6, l15 = lane & 15, q = lane >> 4;
    const int mt4 = wv & 3, kh = wv >> 2;
    for (int rt = obid(); rt < 256; rt += gridDim.x) {
      const bfr* Ar = A + (size_t)(rt * 64 + mt4 * 16 + l15) * lda + kh * 512 + q * 8;
      const bfr* Br = Bt + (size_t)(4096 + l15) * 1024 + kh * 512 + q * 8;
      f32x4 acc = (f32x4){0.f, 0.f, 0.f, 0.f};
#pragma unroll 4
      for (int ks = 0; ks < 16; ++ks) acc = MFMA16(*(const bf16x8*)(Ar + ks * 32), *(const bf16x8*)(Br + ks * 32), acc);
      if (kh == 1) *(f32x4*)&red[(mt4 * 64 + lane) * 4] = acc;
      __syncthreads();
      if (kh == 0) {
        f32x4 o = *(const f32x4*)&red[(mt4 * 64 + lane) * 4];
#pragma unroll
        for (int jx = 0; jx < 4; ++jx) ((float*)(ows(p) + O_AB))[(size_t)(rt * 64 + mt4 * 16 + q * 4 + jx) * 16 + l15] = acc[jx] + o[jx];
      }
      __syncthreads();
    }
  }
}

DI void lru_phase(const Params& p, int j, char* lds) {
  const int tid = otid(), lane = tid & 63, wv = tid >> 6, l15 = lane & 15, q = lane >> 4;
  bfr* Xw = (bfr*)lds + wv * (32 * 136);
  float* WAgg = (float*)(lds + 8 * 32 * 136 * 2);
  const bfr* proj = (const bfr*)(ows(p) + O_PROJ);
  bfr* Yb = (bfr*)(ows(p) + O_H);
  const bfr* WG = (const bfr*)(ows(p) + O_WG);
  for (int unit = obid(); unit < 256; unit += gridDim.x) {
    const int xcd = unit & 7, li = unit >> 3, idx = xcd * 4 + (li >> 3), sl = li & 7, b = idx >> 3, gb = idx & 7;
    const int ch = gb * 128 + sl * 16 + l15;
    bf16x8 Bf[2][4];
#pragma unroll
    for (int kq = 0; kq < 2; ++kq)
#pragma unroll
      for (int ks = 0; ks < 4; ++ks) Bf[kq][ks] = *(const bf16x8*)&WG[(size_t)((j * 2 + kq) * 8 + gb) * 16384 + (sl * 16 + l15) * 128 + ks * 32 + q * 8];
    const float gbr = p.lru_gate_b[(j * 2) * 1024 + ch], gbi = p.lru_gate_b[(j * 2 + 1) * 1024 + ch];
    const float sp = softplusf_(-p.lru_lambda[j * 1024 + ch]);
    const int cg = lane & 15, rs = lane >> 4, ccol = gb * 128 + cg * 8;
    float cwv[4][8], cb[8];
#pragma unroll
    for (int tp = 0; tp < 4; ++tp)
#pragma unroll
      for (int e = 0; e < 8; ++e) cwv[tp][e] = p.lru_conv_w[(size_t)(j * 4 + tp) * 1024 + ccol + e];
#pragma unroll
    for (int e = 0; e < 8; ++e) cb[e] = p.lru_conv_b[j * 1024 + ccol + e];
    const bfr* xb_u = proj + (size_t)(b * 8 + gb) * 4096 * 128;
    bfr* yb_u = Yb + (size_t)b * 4096 * 1024;
    const int xo = (wv * 32 + rs * 8 - 3) * 128 + cg * 8;
    const int zo = PLANE + (wv * 32 + q * 4) * 128 + sl * 16 + (l15 & ~1);
    const int zsh = (l15 & 1) * 16;
    const int yo = (wv * 32 + q * 4) * 1024 + ch;
    float carry = 0.f;
    bf16x8 raw[11];
    unsigned zr[8];
#define LRU_LOAD(it)                                                                                   \
  {                                                                                                    \
    const bfr* xit = xb_u + (it) * (256 * 128);                                                        \
    _Pragma("unroll") for (int i = 0; i < 11; ++i) {                                                   \
      const int t = (it) * 256 + wv * 32 + rs * 8 - 3 + i;                                             \
      if (t >= 0) raw[i] = *(const bf16x8*)&xit[xo + i * 128];                                         \
      else raw[i] = (bf16x8){0, 0, 0, 0, 0, 0, 0, 0};                                                  \
    }                                                                                                  \
    _Pragma("unroll") for (int mt = 0; mt < 2; ++mt) _Pragma("unroll") for (int jx = 0; jx < 4; ++jx)  \
      zr[mt * 4 + jx] = *(const unsigned*)&xit[zo + (mt * 16 + jx) * 128];                                               \
  }
    LRU_LOAD(0);
#pragma unroll 1
    for (int it = 0; it < 16; ++it) {
#pragma unroll
      for (int r = 0; r < 8; ++r) {
        float o[8];
#pragma unroll
        for (int e = 0; e < 8; ++e) {
          float s = cb[e];
#pragma unroll
          for (int tp = 0; tp < 4; ++tp) s += cwv[tp][e] * bfe(raw[r + tp], e);
          o[e] = s;
        }
        u32x4 pk; pk[0] = pack2(o[0], o[1]); pk[1] = pack2(o[2], o[3]); pk[2] = pack2(o[4], o[5]); pk[3] = pack2(o[6], o[7]);
        *(u32x4*)&Xw[(rs * 8 + r) * 136 + cg * 8] = pk;
      }
      float zc[8];
#pragma unroll
      for (int i = 0; i < 8; ++i) zc[i] = bf2f((bfr)(zr[i] >> zsh));
      if (it < 15) LRU_LOAD(it + 1);
      f32x4 accr[2], acci[2];
#pragma unroll
      for (int mt = 0; mt < 2; ++mt) {
        accr[mt] = acci[mt] = (f32x4){0.f, 0.f, 0.f, 0.f};
#pragma unroll
        for (int ks = 0; ks < 4; ++ks) {
          bf16x8 af = *(const bf16x8*)&Xw[(mt * 16 + l15) * 136 + ks * 32 + q * 8];
          accr[mt] = MFMA16(af, Bf[0][ks], accr[mt]);
          acci[mt] = MFMA16(af, Bf[1][ks], acci[mt]);
        }
      }
      float av[2][4], bv[2][4];
      float Aex[2], Bex[2], At[2], Bt_[2];
#pragma unroll
      for (int mt = 0; mt < 2; ++mt) {
        float Al = 1.f, Bl = 0.f;
#pragma unroll
        for (int jx = 0; jx < 4; ++jx) {
          const float r = sigmoidf_(accr[mt][jx] + gbr), ig = sigmoidf_(acci[mt][jx] + gbi);
          const float a = __expf(-8.f * r * sp);
          const float mult = __builtin_amdgcn_sqrtf(fmaxf(1.f - a * a, 0.f));
          const float xf = bf2f(Xw[(mt * 16 + q * 4 + jx) * 136 + sl * 16 + l15]);
          const float bt = mult * ig * xf;
          av[mt][jx] = a; bv[mt][jx] = bt;
          Bl = a * Bl + bt; Al *= a;
        }
        float Ai = Al, Bi = Bl;
#pragma unroll
        for (int off = 16; off < 64; off <<= 1) {
          const float Ap = __shfl_up(Ai, off), Bp = __shfl_up(Bi, off);
          if (lane >= off) { Bi = Ai * Bp + Bi; Ai = Ai * Ap; }
        }
        float Ae = __shfl_up(Ai, 16), Be = __shfl_up(Bi, 16);
        if (q == 0) { Ae = 1.f; Be = 0.f; }
        Aex[mt] = Ae; Bex[mt] = Be;
        At[mt] = __shfl(Ai, 48 + l15); Bt_[mt] = __shfl(Bi, 48 + l15);
      }
      float* wa = WAgg + (it & 1) * 256;
      if (q == 0) { wa[(wv * 16 + l15) * 2] = At[0] * At[1]; wa[(wv * 16 + l15) * 2 + 1] = At[1] * Bt_[0] + Bt_[1]; }
      lds_barrier();
      float cin = carry, cnew = carry;
#pragma unroll
      for (int w = 0; w < 8; ++w) {
        const float Aw = wa[(w * 16 + l15) * 2], Bw = wa[(w * 16 + l15) * 2 + 1];
        cnew = Aw * cnew + Bw;
        if (w < wv) cin = Aw * cin + Bw;
      }
      carry = cnew;
      bfr* yit = yb_u + it * (256 * 1024);
#pragma unroll
      for (int mt = 0; mt < 2; ++mt) {
        float h = Aex[mt] * cin + Bex[mt];
#pragma unroll
        for (int jx = 0; jx < 4; ++jx) {
          h = av[mt][jx] * h + bv[mt][jx];
          yit[yo + (mt * 16 + jx) * 1024] = f2bf(h * siluf_(zc[mt * 4 + jx]));
        }
        cin = At[mt] * cin + Bt_[mt];
      }
    }
#undef LRU_LOAD
  }
}

DI bf16x8 ld_perm(const bfr* base) {
  u32x2 lo = *(const u32x2*)base, hi = *(const u32x2*)(base + 16);
  u32x4 r; r[0] = lo[0]; r[1] = lo[1]; r[2] = hi[0]; r[3] = hi[1];
  return __builtin_bit_cast(bf16x8, r);
}
DI bf16x8 pack_cc(const f32x4& a, const f32x4& b) {
  u32x4 r; r[0] = pack2(a[0], a[1]); r[1] = pack2(a[2], a[3]); r[2] = pack2(b[0], b[1]); r[3] = pack2(b[2], b[3]);
  return __builtin_bit_cast(bf16x8, r);
}


template <int NL> DI void row_load(f32x4 (&a)[8], unsigned addr, float& dep) {
  if constexpr (NL == 1) asm volatile("ds_read_b128 %0, %2\n\ts_waitcnt lgkmcnt(0)" : "=&v"(a[0]), "+v"(dep) : "v"(addr) : "memory");
  if constexpr (NL == 2) asm volatile("ds_read_b128 %0, %3\n\tds_read_b128 %1, %3 offset:16\n\ts_waitcnt lgkmcnt(0)" : "=&v"(a[0]), "=&v"(a[1]), "+v"(dep) : "v"(addr) : "memory");
  if constexpr (NL == 3) asm volatile("ds_read_b128 %0, %4\n\tds_read_b128 %1, %4 offset:16\n\tds_read_b128 %2, %4 offset:32\n\ts_waitcnt lgkmcnt(0)" : "=&v"(a[0]), "=&v"(a[1]), "=&v"(a[2]), "+v"(dep) : "v"(addr) : "memory");
  if constexpr (NL == 4) asm volatile("ds_read_b128 %0, %5\n\tds_read_b128 %1, %5 offset:16\n\tds_read_b128 %2, %5 offset:32\n\tds_read_b128 %3, %5 offset:48\n\ts_waitcnt lgkmcnt(0)" : "=&v"(a[0]), "=&v"(a[1]), "=&v"(a[2]), "=&v"(a[3]), "+v"(dep) : "v"(addr) : "memory");
  if constexpr (NL == 5) asm volatile("ds_read_b128 %0, %6\n\tds_read_b128 %1, %6 offset:16\n\tds_read_b128 %2, %6 offset:32\n\tds_read_b128 %3, %6 offset:48\n\tds_read_b128 %4, %6 offset:64\n\ts_waitcnt lgkmcnt(0)" : "=&v"(a[0]), "=&v"(a[1]), "=&v"(a[2]), "=&v"(a[3]), "=&v"(a[4]), "+v"(dep) : "v"(addr) : "memory");
  if constexpr (NL == 6) asm volatile("ds_read_b128 %0, %7\n\tds_read_b128 %1, %7 offset:16\n\tds_read_b128 %2, %7 offset:32\n\tds_read_b128 %3, %7 offset:48\n\tds_read_b128 %4, %7 offset:64\n\tds_read_b128 %5, %7 offset:80\n\ts_waitcnt lgkmcnt(0)" : "=&v"(a[0]), "=&v"(a[1]), "=&v"(a[2]), "=&v"(a[3]), "=&v"(a[4]), "=&v"(a[5]), "+v"(dep) : "v"(addr) : "memory");
  if constexpr (NL == 7) asm volatile("ds_read_b128 %0, %8\n\tds_read_b128 %1, %8 offset:16\n\tds_read_b128 %2, %8 offset:32\n\tds_read_b128 %3, %8 offset:48\n\tds_read_b128 %4, %8 offset:64\n\tds_read_b128 %5, %8 offset:80\n\tds_read_b128 %6, %8 offset:96\n\ts_waitcnt lgkmcnt(0)" : "=&v"(a[0]), "=&v"(a[1]), "=&v"(a[2]), "=&v"(a[3]), "=&v"(a[4]), "=&v"(a[5]), "=&v"(a[6]), "+v"(dep) : "v"(addr) : "memory");
  if constexpr (NL == 8) asm volatile("ds_read_b128 %0, %9\n\tds_read_b128 %1, %9 offset:16\n\tds_read_b128 %2, %9 offset:32\n\tds_read_b128 %3, %9 offset:48\n\tds_read_b128 %4, %9 offset:64\n\tds_read_b128 %5, %9 offset:80\n\tds_read_b128 %6, %9 offset:96\n\tds_read_b128 %7, %9 offset:112\n\ts_waitcnt lgkmcnt(0)" : "=&v"(a[0]), "=&v"(a[1]), "=&v"(a[2]), "=&v"(a[3]), "=&v"(a[4]), "=&v"(a[5]), "=&v"(a[6]), "=&v"(a[7]), "+v"(dep) : "v"(addr) : "memory");
}
template <int I> DI void inv_rows(float (&t)[32], unsigned abase, int j) {
  if constexpr (I < 32) {
    float s = (I == j) ? 1.f : 0.f;
    if constexpr (I > 0) {
      f32x4 a[8];
      row_load<(I + 3) / 4>(a, abase + I * 256, t[I - 1]);
#pragma unroll
      for (int m4 = 0; m4 < I; m4 += 4) {
        s -= a[m4 >> 2][0] * t[m4];
        if (m4 + 1 < I) s -= a[m4 >> 2][1] * t[m4 + 1];
        if (m4 + 2 < I) s -= a[m4 >> 2][2] * t[m4 + 2];
        if (m4 + 3 < I) s -= a[m4 >> 2][3] * t[m4 + 3];
      }
    }
    t[I] = s;
    inv_rows<I + 1>(t, abase, j);
  }
}
DI void tri_invert32(const float* __restrict__ Au, bfr* __restrict__ Ttu, bfr* __restrict__ Tcu, int hf, int lane) {
  const int j = lane & 31;
  const float* Ab = Au + (32 * hf) * 64 + 32 * hf;
  float t[32];
  const unsigned abase = (unsigned)(size_t)Ab;
  inv_rows<0>(t, abase, j);
  if (lane < 32) {
#pragma unroll
    for (int i = 0; i < 32; ++i) Ttu[(32 * hf + i) * 72 + 32 * hf + j] = f2bf(t[i]);
    if (hf == 0) {
#pragma unroll
      for (int i = 0; i < 32; ++i) Ttu[i * 72 + 32 + j] = 0;
#pragma unroll
      for (int i4 = 0; i4 < 4; ++i4) {
        u32x4 pk;
        pk[0] = pack2(t[8 * i4], t[8 * i4 + 1]); pk[1] = pack2(t[8 * i4 + 2], t[8 * i4 + 3]);
        pk[2] = pack2(t[8 * i4 + 4], t[8 * i4 + 5]); pk[3] = pack2(t[8 * i4 + 6], t[8 * i4 + 7]);
        *(u32x4*)&Tcu[j * 40 + 8 * i4] = pk;
      }
    }
  }
}
DI void tri_merge(const float* __restrict__ Au, bfr* __restrict__ Ttu, const bfr* __restrict__ Tcu, int nt2, int lane) {
  const int l15 = lane & 15, q = lane >> 4;
  const f32x4 zero = (f32x4){0.f, 0.f, 0.f, 0.f};
  bf16x8 bfrag = *(const bf16x8*)&Tcu[(nt2 * 16 + l15) * 40 + q * 8];
  f32x4 X[2];
#pragma unroll
  for (int mt = 0; mt < 2; ++mt) {
    const float* ar = Au + (32 + mt * 16 + l15) * 64 + q * 8;
    f32x4 a0 = *(const f32x4*)ar, a1 = *(const f32x4*)(ar + 4);
    X[mt] = MFMA16(pack_cc(a0, a1), bfrag, zero);
  }
  bf16x8 xb = pack_cc(X[0], X[1]);
#pragma unroll
  for (int mt2 = 0; mt2 < 2; ++mt2) {
    bf16x8 a = ld_perm(Ttu + (32 + mt2 * 16 + l15) * 72 + 32 + q * 4);
    f32x4 r = MFMA16(a, xb, zero);
#pragma unroll
    for (int jx = 0; jx < 4; ++jx) Ttu[(32 + mt2 * 16 + q * 4 + jx) * 72 + nt2 * 16 + l15] = f2bf(-r[jx]);
  }
}

DI void gdn_g1(const Params& p, int j, char* lds) {
  float* Asl = (float*)lds;
  bfr* Tt = (bfr*)(lds + 65536);
  bfr* Kt = (bfr*)(lds + 102400);
  bfr* Qt = (bfr*)(lds + 119808);
  bfr* Vt = (bfr*)(lds + 137216);
  float* gc = (float*)(lds + 154624);
  float* be = (float*)(lds + 155648);
  float* cw = (float*)(lds + 156672);
  const int tid0 = otid();
  bfr* proj = (bfr*)(ows(p) + O_PROJ);
  bfr* KDT = (bfr*)(ows(p) + O_H);
  bfr* ATT = (bfr*)(ows(p) + O_ATTN);
  const bfr* HALO = (const bfr*)(ows(p) + O_HALO);
  bfr* SCR = (bfr*)(ows(p) + O_SCR) + (size_t)obid() * (4 * 2 * 8192);
  const float* AB = (const float*)(ows(p) + O_AB);
  float* EL = (float*)(ows(p) + O_ELAST);
  for (int grp = obid(); grp < 256; grp += gridDim.x) {
    const int bh = grp >> 3, b = bh >> 3, h = bh & 7;
    for (int e = tid0; e < 1536; e += 512) {
      int X = e >> 9, rem = e & 511, tap = rem >> 7, c = rem & 127;
      cw[(X * 4 + tap) * 128 + c] = p.gdn_conv_w[(size_t)(j * 4 + tap) * 3072 + X * 1024 + h * 128 + c];
    }
    bf16x8 nxt[3][5];
    float pfx_g = 0.f, pfx_b = 0.f;
#define G1_RAWLOAD(nn)                                                                                         \
  {                                                                                                            \
    const int rg_ = tid0 >> 4, cgi_ = tid0 & 15, r0_ = rg_ * 2;                                                \
    _Pragma("unroll") for (int X = 0; X < 3; ++X) {                                                            \
      _Pragma("unroll") for (int i = 0; i < 5; ++i) {                                                          \
        const int rr = r0_ - 3 + i;                                                                            \
        if (rr >= 0) nxt[X][i] = *(const bf16x8*)&proj[(size_t)X * PLANE + (size_t)(bh * 4096 + (nn) * 64 + rr) * 128 + cgi_ * 8];   \
        else if ((nn) > 0) nxt[X][i] = *(const bf16x8*)&HALO[((size_t)(b * 64 + (nn) - 1) * 3 + 3 + rr) * 3072 + X * 1024 + h * 128 + cgi_ * 8];   \
        else nxt[X][i] = (bf16x8){0, 0, 0, 0, 0, 0, 0, 0};                                                     \
      }                                                                                                        \
    }                                                                                                          \
  }
    G1_RAWLOAD((grp * 8) & 63);
#pragma unroll 1
    for (int half = 0; half < 2; ++half) {
      {
        int tid = tid0; asm volatile("" : "+v"(tid));
        const int lane = tid & 63, wv = tid >> 6;
        if (half == 0) {
          const int un = grp * 8 + wv, n = un & 63, t0 = b * 4096 + n * 64;
          float a_in = AB[(size_t)(t0 + lane) * 16 + h], b_in = AB[(size_t)(t0 + lane) * 16 + 8 + h];
          float g = -__expf(p.gdn_a_log[j * 8 + h]) * softplusf_(a_in + p.gdn_dt_bias[j * 8 + h]);
#pragma unroll
          for (int off = 1; off < 64; off <<= 1) {
            float v = __shfl_up(g, off);
            if (lane >= off) g += v;
          }
          pfx_g = g; pfx_b = sigmoidf_(b_in);
          if (lane == 63) EL[un] = __expf(g);
          if (wv < 4) { gc[wv * 64 + lane] = pfx_g; be[wv * 64 + lane] = pfx_b; }
        } else if (wv >= 4) {
          gc[(wv - 4) * 64 + lane] = pfx_g; be[(wv - 4) * 64 + lane] = pfx_b;
        }
      }
#pragma unroll 1
      for (int u = 0; u < 4; ++u) {
        const int un = grp * 8 + half * 4 + u, n = un & 63, t0 = b * 4096 + n * 64;
        int tid = tid0; asm volatile("" : "+v"(tid));
        const int lane = tid & 63, wv = tid >> 6, l15 = lane & 15, q = lane >> 4;
        const int rg = tid >> 4, cgi = tid & 15, r0 = rg * 2;
        __syncthreads();
        bf16x8 cur[3][5];
#pragma unroll
        for (int X = 0; X < 3; ++X)
#pragma unroll
          for (int i = 0; i < 5; ++i) cur[X][i] = nxt[X][i];
        if (half * 4 + u < 7) G1_RAWLOAD(n + 1);
#pragma unroll
        for (int X = 0; X < 3; ++X) {
          float val[2][8];
#pragma unroll
          for (int rr = 0; rr < 2; ++rr)
#pragma unroll
            for (int e = 0; e < 8; ++e) {
              float sacc = 0.f;
#pragma unroll
              for (int tp = 0; tp < 4; ++tp) sacc += cw[(X * 4 + tp) * 128 + cgi * 8 + e] * bfe(cur[X][rr + tp], e);
              val[rr][e] = siluf_(sacc);
            }
          if (X < 2) {
#pragma unroll
            for (int rr = 0; rr < 2; ++rr) {
              float ss = 0.f;
#pragma unroll
              for (int e = 0; e < 8; ++e) ss += val[rr][e] * val[rr][e];
              ss = sum16(ss);
              float rn = rsqrtf(ss + EPS);
              if (X == 0) rn *= 0.08838834764831845f;
#pragma unroll
              for (int e = 0; e < 8; ++e) val[rr][e] *= rn;
            }
          }
          bfr* Tile = (X == 0) ? Qt : (X == 1 ? Kt : Vt);
#pragma unroll
          for (int rr = 0; rr < 2; ++rr) {
            const int r = r0 + rr;
            u32x4 pk;
            pk[0] = pack2(val[rr][0], val[rr][1]); pk[1] = pack2(val[rr][2], val[rr][3]);
            pk[2] = pack2(val[rr][4], val[rr][5]); pk[3] = pack2(val[rr][6], val[rr][7]);
            *(u32x4*)&Tile[r * 136 + cgi * 8] = pk;
            if (X == 0) {
              const float eg = __expf(gc[u * 64 + r]);
              pk[0] = pack2(val[rr][0] * eg, val[rr][1] * eg); pk[1] = pack2(val[rr][2] * eg, val[rr][3] * eg);
              pk[2] = pack2(val[rr][4] * eg, val[rr][5] * eg); pk[3] = pack2(val[rr][6] * eg, val[rr][7] * eg);
              *(u32x4*)&proj[(size_t)(bh * 4096 + n * 64 + r) * 128 + cgi * 8] = pk;
            }
          }
        }
        lds_barrier();
        {
          const int mt = wv >> 1;
          f32x4 kk[2], qk[2];
          kk[0] = kk[1] = qk[0] = qk[1] = (f32x4){0.f, 0.f, 0.f, 0.f};
#pragma unroll
          for (int ks = 0; ks < 4; ++ks) {
            bf16x8 ak = *(const bf16x8*)&Kt[(mt * 16 + l15) * 136 + ks * 32 + q * 8];
            bf16x8 aq = *(const bf16x8*)&Qt[(mt * 16 + l15) * 136 + ks * 32 + q * 8];
#pragma unroll
            for (int t2 = 0; t2 < 2; ++t2) {
              int nt = (wv & 1) * 2 + t2;
              bf16x8 bk = *(const bf16x8*)&Kt[(nt * 16 + l15) * 136 + ks * 32 + q * 8];
              kk[t2] = MFMA16(bk, ak, kk[t2]);
              qk[t2] = MFMA16(bk, aq, qk[t2]);
            }
          }
          const int i = mt * 16 + l15;
          const float giv = gc[u * 64 + i], bei = be[u * 64 + i];
#pragma unroll
          for (int t2 = 0; t2 < 2; ++t2) {
            const int m0 = ((wv & 1) * 2 + t2) * 16 + q * 4;
            f32x4 av, tv;
#pragma unroll
            for (int jx = 0; jx < 4; ++jx) {
              const int m = m0 + jx;
              const float d = (i >= m) ? __expf(giv - gc[u * 64 + m]) : 0.f;
              av[jx] = (i > m) ? bei * kk[t2][jx] * d : 0.f;
              tv[jx] = qk[t2][jx] * d;
            }
            *(f32x4*)&Asl[u * 4096 + i * 64 + m0] = av;
            u32x2 pk; pk[0] = pack2(tv[0], tv[1]); pk[1] = pack2(tv[2], tv[3]);
            *(u32x2*)&ATT[(size_t)un * 4096 + i * 64 + m0] = pk;
          }
        }
        {
          const int dd = tid >> 2, tq = tid & 3;
          const float glast = gc[u * 64 + 63];
#pragma unroll
          for (int g8 = 0; g8 < 2; ++g8) {
            const int tok0 = tq * 16 + g8 * 8;
            float okd[8], okb[8], ovb[8];
#pragma unroll
            for (int e = 0; e < 8; ++e) {
              const int tok = tok0 + e;
              const float kv = bf2f(Kt[tok * 136 + dd]), vv = bf2f(Vt[tok * 136 + dd]);
              const float gg = gc[u * 64 + tok], bb = be[u * 64 + tok];
              okd[e] = kv * __expf(glast - gg);
              okb[e] = kv * bb * __expf(gg);
              ovb[e] = vv * bb;
            }
            u32x4 pk;
            pk[0] = pack2(okd[0], okd[1]); pk[1] = pack2(okd[2], okd[3]); pk[2] = pack2(okd[4], okd[5]); pk[3] = pack2(okd[6], okd[7]);
            *(u32x4*)&KDT[(size_t)un * 8192 + dd * 64 + tok0] = pk;
            pk[0] = pack2(okb[0], okb[1]); pk[1] = pack2(okb[2], okb[3]); pk[2] = pack2(okb[4], okb[5]); pk[3] = pack2(okb[6], okb[7]);
            *(u32x4*)&SCR[(u * 2 + 0) * 8192 + dd * 64 + tok0] = pk;
            pk[0] = pack2(ovb[0], ovb[1]); pk[1] = pack2(ovb[2], ovb[3]); pk[2] = pack2(ovb[4], ovb[5]); pk[3] = pack2(ovb[6], ovb[7]);
            *(u32x4*)&SCR[(u * 2 + 1) * 8192 + dd * 64 + tok0] = pk;
          }
        }
      }
      __syncthreads();
      {
      int tid = tid0; asm volatile("" : "+v"(tid));
      const int lane = tid & 63, wv = tid >> 6;
      tri_invert32(Asl + (wv >> 1) * 4096, Tt + (wv >> 1) * 4608, Kt + (wv >> 1) * 1280, wv & 1, lane);
      __syncthreads();
      tri_merge(Asl + (wv >> 1) * 4096, Tt + (wv >> 1) * 4608, Kt + (wv >> 1) * 1280, wv & 1, lane);
      __syncthreads();
      }
      {
        int tid = tid0; asm volatile("" : "+v"(tid));
        const int lane = tid & 63, wv = tid >> 6, l15 = lane & 15, q = lane >> 4;
        bf16x8 bkf[4][2], bvf[4][2];
#pragma unroll
        for (int u = 0; u < 4; ++u)
#pragma unroll
          for (int ks = 0; ks < 2; ++ks) {
            bkf[u][ks] = *(const bf16x8*)&SCR[(u * 2) * 8192 + (wv * 16 + l15) * 64 + ks * 32 + q * 8];
            bvf[u][ks] = *(const bf16x8*)&SCR[(u * 2 + 1) * 8192 + (wv * 16 + l15) * 64 + ks * 32 + q * 8];
          }
#pragma unroll
        for (int u = 0; u < 4; ++u) {
          const int n = (grp * 8 + half * 4 + u) & 63;
          f32x4 aw[4], au[4];
#pragma unroll
          for (int i = 0; i < 4; ++i) aw[i] = au[i] = (f32x4){0.f, 0.f, 0.f, 0.f};
#pragma unroll
          for (int ks = 0; ks < 2; ++ks) {
#pragma unroll
            for (int mt = 0; mt < 4; ++mt) {
              bf16x8 a = *(const bf16x8*)&Tt[u * 4608 + (mt * 16 + l15) * 72 + ks * 32 + q * 8];
              aw[mt] = MFMA16(bkf[u][ks], a, aw[mt]);
              au[mt] = MFMA16(bvf[u][ks], a, au[mt]);
            }
          }
          bfr* Wst = (u & 1) ? Kt : (bfr*)Asl;
          bfr* Ust = Wst + 64 * 136;
#pragma unroll
          for (int mt = 0; mt < 4; ++mt) {
            const int i = mt * 16 + l15, dc = wv * 16 + q * 4;
            u32x2 pk; pk[0] = pack2(aw[mt][0], aw[mt][1]); pk[1] = pack2(aw[mt][2], aw[mt][3]);
            *(u32x2*)&Wst[i * 136 + dc] = pk;
            pk[0] = pack2(au[mt][0], au[mt][1]); pk[1] = pack2(au[mt][2], au[mt][3]);
            *(u32x2*)&Ust[i * 136 + dc] = pk;
          }
          lds_barrier();
#pragma unroll
          for (int k = 0; k < 2; ++k) {
            const int id = tid + 512 * k, row = id >> 4, c16 = id & 15;
            const size_t go = (size_t)(bh * 4096 + n * 64 + row) * 128 + c16 * 8;
            *(u32x4*)&proj[(size_t)PLANE + go] = *(const u32x4*)&Wst[row * 136 + c16 * 8];
            *(u32x4*)&proj[(size_t)2 * PLANE + go] = *(const u32x4*)&Ust[row * 136 + c16 * 8];
          }
        }
      }
      __syncthreads();
    }
  }
#undef G1_RAWLOAD
}

DI void gdn_g2(const Params& p, int j, char* lds) {
  bfr* SbT = (bfr*)lds;
  bfr* VbT = (bfr*)(lds + 4352);
  const int tid = otid(), lane = tid & 63, wv = tid >> 6, l15 = lane & 15, q = lane >> 4;
  const bfr* proj = (const bfr*)(ows(p) + O_PROJ);
  const bfr* KDT = (const bfr*)(ows(p) + O_H);
  const bfr* ATT = (const bfr*)(ows(p) + O_ATTN);
  const float* EL = (const float*)(ows(p) + O_ELAST);
  bfr* OB = (bfr*)(ows(p) + O_SCR);
  for (int unit = obid(); unit < 256; unit += gridDim.x) {
    const int xcd = unit & 7, li = unit >> 3, bh = xcd * 4 + (li >> 3), slice = li & 7;
    const int b = bh >> 3, h = bh & 7;
    const int mt = wv & 3;
    const bool lo = wv < 4;
    const float elv = EL[bh * 64 + lane];
    f32x4 S = (f32x4){0.f, 0.f, 0.f, 0.f};
    for (int e = tid; e < 16 * 136; e += 512) SbT[e] = 0;
    bf16x8 A1s[4][4], K2s[4][2], A2s[4][2];
    unsigned urs[4][4];
    const bfr* pa_u = proj + (lo ? (size_t)PLANE : (size_t)0) + (size_t)bh * 4096 * 128;
    const int pa_o = (mt * 16 + l15) * 128 + q * 8;
    const bfr* pu_u = proj + (size_t)2 * PLANE + (size_t)bh * 4096 * 128 + slice * 16;
    const int pu_o = (mt * 16 + q * 4) * 128 + (l15 & ~1);
    const int ush = (l15 & 1) * 16;
    const bfr* kd_u = KDT + (size_t)bh * 64 * 8192;
    const int kd_o = (wv * 16 + l15) * 64 + q * 8;
    const bfr* at_u = ATT + (size_t)bh * 64 * 4096;
    const int at_o = (mt * 16 + l15) * 64 + q * 8;
#define G2_GLOAD(set, n)                                                                                     \
  {                                                                                                          \
    const bfr* pa_n = pa_u + (size_t)(n) * 64 * 128;                                                         \
    _Pragma("unroll") for (int ks = 0; ks < 4; ++ks) A1s[set][ks] = *(const bf16x8*)&pa_n[pa_o + ks * 32];   \
    const bfr* kd_n = kd_u + (n) * 8192;                                                                     \
    K2s[set][0] = *(const bf16x8*)&kd_n[kd_o];                                                               \
    K2s[set][1] = *(const bf16x8*)&kd_n[kd_o + 32];                                                          \
    if (lo) {                                                                                                \
      const bfr* pu_n = pu_u + (size_t)(n) * 64 * 128;                                                       \
      _Pragma("unroll") for (int jx = 0; jx < 4; ++jx) urs[set][jx] = *(const unsigned*)&pu_n[pu_o + jx * 128];               \
    } else {                                                                                                 \
      const bfr* at_n = at_u + (n) * 4096;                                                                   \
      A2s[set][0] = *(const bf16x8*)&at_n[at_o];                                                             \
      A2s[set][1] = *(const bf16x8*)&at_n[at_o + 32];                                                        \
    }                                                                                                        \
  }
#define G2_STEP(n, rs)                                                                                       \
  {                                                                                                          \
    f32x4 acc = (f32x4){0.f, 0.f, 0.f, 0.f};                                                                 \
    _Pragma("unroll") for (int ks = 0; ks < 4; ++ks) {                                                       \
      bf16x8 sb = *(const bf16x8*)&SbT[l15 * 136 + ks * 32 + q * 8];                                         \
      acc = lo ? MFMA16(A1s[rs][ks], sb, acc) : MFMA16(sb, A1s[rs][ks], acc);     \
    }                                                                                                        \
    if (lo) {                                                                                                \
      u32x2 pk;                                                                                              \
      pk[0] = pack2(bf2f((bfr)(urs[rs][0] >> ush)) - acc[0], bf2f((bfr)(urs[rs][1] >> ush)) - acc[1]);       \
      pk[1] = pack2(bf2f((bfr)(urs[rs][2] >> ush)) - acc[2], bf2f((bfr)(urs[rs][3] >> ush)) - acc[3]);       \
      *(u32x2*)&VbT[l15 * 72 + mt * 16 + q * 4] = pk;                                                        \
    }                                                                                                        \
    lds_barrier();                                                                                           \
    bf16x8 vb0 = *(const bf16x8*)&VbT[l15 * 72 + q * 8];                                                     \
    bf16x8 vb1 = *(const bf16x8*)&VbT[l15 * 72 + 32 + q * 8];                                                \
    if (!lo) {                                                                                               \
      acc = MFMA16(vb0, A2s[rs][0], acc);                                                                    \
      acc = MFMA16(vb1, A2s[rs][1], acc);                                                                    \
      u32x2 ok; ok[0] = pack2(acc[0], acc[1]); ok[1] = pack2(acc[2], acc[3]);                                \
      *(u32x2*)&OB[((size_t)(b * 4096 + (n) * 64) + mt * 16 + l15) * 1024 + h * 128 + slice * 16 + q * 4] = ok;  \
    }                                                                                                        \
    const float el = __shfl(elv, (n));                                                                       \
    S = S * el;                                                                                              \
    S = MFMA16(K2s[rs][0], vb0, S);                                                                          \
    S = MFMA16(K2s[rs][1], vb1, S);                                                                          \
    {                                                                                                        \
      u32x2 pk;                                                                                              \
      pk[0] = pack2(S[0], S[1]);                                                                             \
      pk[1] = pack2(S[2], S[3]);                                                                             \
      *(u32x2*)&SbT[l15 * 136 + wv * 16 + q * 4] = pk;                                                       \
    }                                                                                                        \
    if ((n) + 4 < 64) G2_GLOAD(rs, (n) + 4);                                                                 \
    lds_barrier();                                                                                           \
  }
    G2_GLOAD(0, 0);
    G2_GLOAD(1, 1);
    G2_GLOAD(2, 2);
    G2_GLOAD(3, 3);
    __syncthreads();
#pragma unroll 1
    for (int n = 0; n < 64; n += 4) {
      G2_STEP(n, 0);
      G2_STEP(n + 1, 1);
      G2_STEP(n + 2, 2);
      G2_STEP(n + 3, 3);
    }
#undef G2_GLOAD
#undef G2_STEP
  }
}

DI void gdn_g2l(const Params& p, int j, char* lds) {
  constexpr int STG = 51200;
  bfr* SbT = (bfr*)(lds + 3 * STG);
  bfr* VbT = (bfr*)(lds + 3 * STG + 4352);
  const int tid = otid(), lane = tid & 63, wv = tid >> 6, l15 = lane & 15, q = lane >> 4;
  const bfr* proj = (const bfr*)(ows(p) + O_PROJ);
  const bfr* KDT = (const bfr*)(ows(p) + O_H);
  const bfr* ATT = (const bfr*)(ows(p) + O_ATTN);
  const float* EL = (const float*)(ows(p) + O_ELAST);
  bfr* OB = (bfr*)(ows(p) + O_SCR);
  for (int unit = obid(); unit < 256; unit += gridDim.x) {
    const int xcd = unit & 7, li = unit >> 3, bh = xcd * 4 + (li >> 3), slice = li & 7;
    const int b = bh >> 3, h = bh & 7;
    const bool loader = wv >= 4;
    for (int e = tid; e < 16 * 136; e += 512) SbT[e] = 0;
    if (loader) {
      const int lw = __builtin_amdgcn_readfirstlane(wv - 4);
      const bfr* wq_u = proj + (size_t)bh * 4096 * 128;
      const bfr* kd_u = KDT + (size_t)bh * 64 * 8192;
      const int lo_wq = (lane >> 2) * 128 + (lane & 3) * 8, lo_kd = (lane >> 2) * 64 + (lane & 3) * 8;
      const bfr* u_u = proj + (size_t)2 * PLANE + (size_t)bh * 4096 * 128 + slice * 16 + (lw * 32 + (lane >> 1)) * 128 + (lane & 1) * 8;
#define G2L_DMA(c, stg)                                                                                      \
  {                                                                                                          \
    const int cc = (c) < 64 ? (c) : 63;                                                                      \
    const bfr* wq_c = wq_u + (size_t)cc * 64 * 128;                                                          \
    const bfr* kd_c = kd_u + (size_t)cc * 8192;                                                              \
    _Pragma("unroll") for (int i = 0; i < 12; ++i) {                                                         \
      const int blk = lw * 12 + i, X = blk >> 4, idx = blk & 15;                                             \
      const bfr* g = (X == 2) ? (kd_c + ((idx >> 1) * 16 * 64 + (idx & 1) * 32) + lo_kd)                     \
                              : (wq_c + (X == 0 ? (size_t)PLANE : (size_t)0) + ((idx >> 2) * 16 * 128 + (idx & 3) * 32) + lo_wq);  \
      __builtin_amdgcn_global_load_lds((const unsigned*)g, (PG8_LAS unsigned*)(lds + (stg) * STG + blk * 1024), 16, 0, 0);  \
    }                                                                                                        \
    if (lw < 2) __builtin_amdgcn_global_load_lds((const unsigned*)(u_u + (size_t)cc * 64 * 128), (PG8_LAS unsigned*)(lds + (stg) * STG + (48 + lw) * 1024), 16, 0, 0);  \
  }
#define G2L_WAITPREV() { if (lw < 2) asm volatile("s_waitcnt vmcnt(13)" ::: "memory"); else asm volatile("s_waitcnt vmcnt(12)" ::: "memory"); }
      G2L_DMA(0, 0);
      G2L_DMA(1, 1);
      G2L_WAITPREV();
      lds_barrier();
#pragma unroll 1
      for (int n = 0; n < 64; n += 3) {
#pragma unroll
        for (int s3 = 0; s3 < 3; ++s3) {
          if (n + s3 < 64) {
            G2L_DMA(n + s3 + 2, (s3 + 2) % 3);
            lds_barrier();
            G2L_WAITPREV();
            lds_barrier();
          }
        }
      }
      asm volatile("s_waitcnt vmcnt(0)" ::: "memory");
#undef G2L_DMA
#undef G2L_WAITPREV
    } else {
      const int mt = wv;
      const float elv = EL[bh * 64 + lane];
      f32x4 S0 = (f32x4){0.f, 0.f, 0.f, 0.f}, S1 = S0;
      bf16x8 At[4][2];
      const bfr* at_u = ATT + (size_t)bh * 64 * 4096 + (mt * 16 + l15) * 64 + q * 8;
#define G2L_GLOAD(set, c)                                                                                    \
  {                                                                                                          \
    const int cc = (c) < 64 ? (c) : 63;                                                                      \
    At[set][0] = *(const bf16x8*)&at_u[cc * 4096];                                                           \
    At[set][1] = *(const bf16x8*)&at_u[cc * 4096 + 32];                                                      \
  }
#define G2L_STEP(n, stg, rs)                                                                                 \
  {                                                                                                          \
    const char* sb_ = lds + (stg) * STG + l15 * 64 + q * 16;                                                 \
    f32x4 accp = (f32x4){0.f, 0.f, 0.f, 0.f}, acco = accp;                                                   \
    if ((n) > 0) {     \
      accd = MFMA16(vbd0, Atd0, accd);                                                                       \
      accd = MFMA16(vbd1, Atd1, accd);                                                                       \
      u32x2 ok; ok[0] = pack2(accd[0], accd[1]); ok[1] = pack2(accd[2], accd[3]);                            \
      *(u32x2*)&OB[((size_t)(b * 4096 + ((n) - 1) * 64) + mt * 16 + l15) * 1024 + h * 128 + slice * 16 + q * 4] = ok;  \
    }                                                                                                        \
    _Pragma("unroll") for (int ks = 0; ks < 4; ++ks) {                                                       \
      const bf16x8 sb = *(const bf16x8*)&SbT[l15 * 136 + ks * 32 + q * 8];                                   \
      accp = MFMA16(*(const bf16x8*)(sb_ + (mt * 4 + ks) * 1024), sb, accp);                                 \
      acco = MFMA16(sb, *(const bf16x8*)(sb_ + (16 + mt * 4 + ks) * 1024), acco);     \
    }                                                                                                        \
    {                                                                                                        \
      u32x2 pk;                                                                                              \
      const bfr* up_ = (const bfr*)(lds + (stg) * STG + 48 * 1024) + (mt * 16 + q * 4) * 16 + l15;           \
      pk[0] = pack2(bf2f(up_[0]) - accp[0], bf2f(up_[16]) - accp[1]);                                        \
      pk[1] = pack2(bf2f(up_[32]) - accp[2], bf2f(up_[48]) - accp[3]);                                       \
      *(u32x2*)&VbT[l15 * 72 + mt * 16 + q * 4] = pk;                                                        \
    }                                                                                                        \
    lds_barrier();                                                                                           \
    const bf16x8 vb0 = *(const bf16x8*)&VbT[l15 * 72 + q * 8];                                               \
    const bf16x8 vb1 = *(const bf16x8*)&VbT[l15 * 72 + 32 + q * 8];                                          \
    accd = acco; vbd0 = vb0; vbd1 = vb1; Atd0 = At[rs][0]; Atd1 = At[rs][1];                                 \
    const float el = __uint_as_float(__builtin_amdgcn_readlane(__float_as_uint(elv), (n)));       \
    S0 = S0 * el; S1 = S1 * el;                                                                              \
    S0 = MFMA16(*(const bf16x8*)(sb_ + (32 + (2 * mt) * 2 + 0) * 1024), vb0, S0);                            \
    S0 = MFMA16(*(const bf16x8*)(sb_ + (32 + (2 * mt) * 2 + 1) * 1024), vb1, S0);                            \
    S1 = MFMA16(*(const bf16x8*)(sb_ + (32 + (2 * mt + 1) * 2 + 0) * 1024), vb0, S1);                        \
    S1 = MFMA16(*(const bf16x8*)(sb_ + (32 + (2 * mt + 1) * 2 + 1) * 1024), vb1, S1);                        \
    {                                                                                                        \
      u32x2 pk;                                                                                              \
      pk[0] = pack2(S0[0], S0[1]); pk[1] = pack2(S0[2], S0[3]);                                              \
      *(u32x2*)&SbT[l15 * 136 + (2 * mt) * 16 + q * 4] = pk;                                                 \
      pk[0] = pack2(S1[0], S1[1]); pk[1] = pack2(S1[2], S1[3]);                                              \
      *(u32x2*)&SbT[l15 * 136 + (2 * mt + 1) * 16 + q * 4] = pk;                                             \
    }                                                                                                        \
    G2L_GLOAD(rs, (n) + 4);                                                                                  \
    lds_barrier();                                                                                           \
  }
      G2L_GLOAD(0, 0);
      G2L_GLOAD(1, 1);
      G2L_GLOAD(2, 2);
      G2L_GLOAD(3, 3);
      f32x4 accd = (f32x4){0.f, 0.f, 0.f, 0.f};
      bf16x8 vbd0 = (bf16x8){0, 0, 0, 0, 0, 0, 0, 0}, vbd1 = vbd0, Atd0 = vbd0, Atd1 = vbd0;
      lds_barrier();
#pragma unroll 1
      for (int n = 0; n < 60; n += 12) {
        G2L_STEP(n, 0, 0); G2L_STEP(n + 1, 1, 1); G2L_STEP(n + 2, 2, 2); G2L_STEP(n + 3, 0, 3);
        G2L_STEP(n + 4, 1, 0); G2L_STEP(n + 5, 2, 1); G2L_STEP(n + 6, 0, 2); G2L_STEP(n + 7, 1, 3);
        G2L_STEP(n + 8, 2, 0); G2L_STEP(n + 9, 0, 1); G2L_STEP(n + 10, 1, 2); G2L_STEP(n + 11, 2, 3);
      }
      G2L_STEP(60, 0, 0); G2L_STEP(61, 1, 1); G2L_STEP(62, 2, 2); G2L_STEP(63, 0, 3);
      {
        accd = MFMA16(vbd0, Atd0, accd);
        accd = MFMA16(vbd1, Atd1, accd);
        u32x2 ok; ok[0] = pack2(accd[0], accd[1]); ok[1] = pack2(accd[2], accd[3]);
        *(u32x2*)&OB[((size_t)(b * 4096 + 63 * 64) + mt * 16 + l15) * 1024 + h * 128 + slice * 16 + q * 4] = ok;
      }
#undef G2L_GLOAD
#undef G2L_STEP
    }
    __syncthreads();
  }
}

DI void gdn_g3(const Params& p, int j, char* lds) {
  const int tid = otid(), lane = tid & 63, wv = tid >> 6, l15 = lane & 15, q = lane >> 4;
  const bfr* proj = (const bfr*)(ows(p) + O_PROJ);
  bfr* OB = (bfr*)(ows(p) + O_SCR);
  f32x4 g0 = *(const f32x4*)&p.gdn_onorm_g[j * 128 + l15 * 8], g1 = *(const f32x4*)&p.gdn_onorm_g[j * 128 + l15 * 8 + 4];
  const int stride = gridDim.x * 32;
  int pi = (obid() * 8 + wv) * 4 + q;
  bf16x8 ov, zv;
#define G3_LOAD(pp)                                                                                                  \
  {                                                                                                                  \
    const int t_ = (pp) >> 3, h_ = (pp) & 7;                                                                         \
    ov = __builtin_nontemporal_load((const bf16x8*)&OB[(size_t)t_ * 1024 + h_ * 128 + l15 * 8]);                     \
    zv = __builtin_nontemporal_load((const bf16x8*)&proj[(size_t)3 * PLANE + (size_t)(((t_ >> 12) * 8 + h_) * 4096 + (t_ & 4095)) * 128 + l15 * 8]);  \
  }
  if (pi < 131072) G3_LOAD(pi);
  for (; pi < 131072; pi += stride) {
    const int t = pi >> 3, h = pi & 7;
    const bf16x8 oc = ov, zc = zv;
    if (pi + stride < 131072) G3_LOAD(pi + stride);
    float o[8], ss = 0.f;
#pragma unroll
    for (int e = 0; e < 8; ++e) { o[e] = bfe(oc, e); ss += o[e] * o[e]; }
    ss = sum16(ss);
    const float rstd = rsqrtf(ss * (1.f / 128.f) + EPS);
    float y[8];
#pragma unroll
    for (int e = 0; e < 8; ++e) y[e] = o[e] * rstd * (e < 4 ? g0[e] : g1[e - 4]) * siluf_(bfe(zc, e));
    u32x4 pk;
    pk[0] = pack2(y[0], y[1]); pk[1] = pack2(y[2], y[3]); pk[2] = pack2(y[4], y[5]); pk[3] = pack2(y[6], y[7]);
    *(u32x4*)&OB[(size_t)t * 1024 + h * 128 + l15 * 8] = pk;
  }
#undef G3_LOAD
}


#define XB_TMO      128
#define XB_XCNT(j)  (256  + 64 * (j))
#define XB_XSUB(j)  (1280 + 64 * (j))
#define XB_XGEN(j)  (2304 + 64 * (j))
#define XB_TOP      3328
#define XB_TOPGEN   3392
#define XCD_BAR_WORDS 3456
#define XB_SPIN_CAP (1u << 18)
#define LAS __attribute__((address_space(3)))

__device__ __forceinline__ unsigned xb_ld(unsigned* p)              { return __hip_atomic_load(p, __ATOMIC_RELAXED, __HIP_MEMORY_SCOPE_AGENT); }
__device__ __forceinline__ unsigned xb_add(unsigned* p, unsigned v) { return __hip_atomic_fetch_add(p, v, __ATOMIC_RELAXED, __HIP_MEMORY_SCOPE_AGENT); }
__device__ __forceinline__ unsigned xb_xcc_id() { return (unsigned)__builtin_amdgcn_s_getreg((3 << 11) | 20) & 0xFu; }
#define XB_SPIN(cond, bar) do { unsigned _sp = 0; while (cond) { __builtin_amdgcn_s_sleep(1); \
    if ((++_sp & 255u) == 0u) { if (xb_ld(&(bar)[XB_TMO])) break; if (_sp > XB_SPIN_CAP) { atomicAdd(&(bar)[XB_TMO], 1u); break; } } } } while (0)

struct XcdBarrier {
    unsigned* bar; unsigned x;
    volatile LAS unsigned* st;
};

__device__ __forceinline__ XcdBarrier xcd_barrier_post(unsigned* bar, volatile LAS unsigned* st) {
    XcdBarrier b; b.bar = bar; b.x = xb_xcc_id(); b.st = st;
    if (threadIdx.x == 0) (void)xb_add(&bar[XB_XCNT(b.x)], 1u);
    return b;
}
__device__ __forceinline__ void xcd_barrier_complete(unsigned* bar, unsigned x, unsigned& nloc, unsigned& nx) {
    const unsigned G = gridDim.x * gridDim.y * gridDim.z;
    unsigned sum, cnt, mine, sp = 0u;
    for (;;) {
        sum = 0u; cnt = 0u; mine = 0u;
#pragma unroll
        for (unsigned j = 0; j < 16; ++j) { const unsigned c = xb_ld(&bar[XB_XCNT(j)]); sum += c; cnt += (c > 0u) ? 1u : 0u; mine = (j == x) ? c : mine; }
        if (sum == G) break;
        __builtin_amdgcn_s_sleep(1);
        if ((++sp & 255u) == 0u) { if (xb_ld(&bar[XB_TMO])) break; if (sp > XB_SPIN_CAP) { atomicAdd(&bar[XB_TMO], 1u); break; } }
    }
    nloc = mine > 0u ? mine : 1u; nx = cnt > 0u ? cnt : 1u;
}

__device__ __forceinline__ void xcd_barrier(const XcdBarrier& b) {
    asm volatile("s_waitcnt vmcnt(0)" ::: "memory");
    __syncthreads();
    if (threadIdx.x == 0) {
        unsigned* bar = b.bar;
        __builtin_amdgcn_s_waitcnt(0);
        unsigned nloc = b.st[0], nx = b.st[1];
        if (nloc == 0u) { xcd_barrier_complete(bar, b.x, nloc, nx); b.st[0] = nloc; b.st[1] = nx; }
        const unsigned old = xb_add(&bar[XB_XSUB(b.x)], 1u);
        const unsigned gen = old / nloc;
        if (old + 1u == (gen + 1u) * nloc) {
            __builtin_amdgcn_fence(__ATOMIC_RELEASE, "agent");
            asm volatile("s_waitcnt vmcnt(0)" ::: "memory");
            const unsigned og = xb_add(&bar[XB_TOP], 1u);
            const unsigned tg = og / nx;
            if (og + 1u == (tg + 1u) * nx) xb_add(&bar[XB_TOPGEN], 1u);
            else XB_SPIN(xb_ld(&bar[XB_TOPGEN]) == tg, bar);
            __builtin_amdgcn_fence(__ATOMIC_ACQUIRE, "agent");
            xb_add(&bar[XB_XGEN(b.x)], 1u);
            asm volatile("s_waitcnt vmcnt(0)" ::: "memory");
        } else {
            XB_SPIN(xb_ld(&bar[XB_XGEN(b.x)]) == gen, bar);
            __builtin_amdgcn_fence(__ATOMIC_ACQUIRE, "agent");
            asm volatile("s_waitcnt vmcnt(0)" ::: "memory");
        }
    }
    __syncthreads();
}


DI void run_phase(const Params& p, int ph, char* lds) {
  if (ph == 0) { phase0(p, lds); return; }
  if (ph == NPHASE - 1) { norm_phase(p, 4, ows(p) + O_H, lds); return; }
  int layer, sub;
  if (ph < 5) { layer = 0; sub = ph - 1; }
  else if (ph < 11) { layer = 1; sub = ph - 5; }
  else if (ph < 15) { layer = 2; sub = ph - 11; }
  else { layer = 3; sub = ph - 15; }
  const int j = layer >> 1;
  const bool is_lru = (layer & 1) == 0;
  const bfr* H = (const bfr*)(ows(p) + O_H);
  const void* xcur = (layer == 0) ? (const void*)p.x : (const void*)p.out;
  bfr* xnext = (layer == 3) ? (bfr*)(ows(p) + O_H) : (bfr*)p.out;
  if (is_lru) {
    switch (sub) {
      case 0: norm_phase(p, layer, xcur, lds); break;
      case 1: gemm_phase<0>(p, H, 1024, (const bfr*)(ows(p) + O_WLI) + (size_t)j * 2048 * 1024, 8, layer, nullptr, nullptr, lds); break;
      case 2: lru_phase(p, j, lds); break;
      case 3: gemm_phase<2>(p, H, 1024, (const bfr*)(ows(p) + O_WLO) + (size_t)j * 1024 * 1024, 4, layer, xcur, xnext, lds); break;
    }
  } else {
    switch (sub) {
      case 0: norm_phase(p, layer, xcur, lds); break;
      case 1: gemm_phase<1>(p, H, 1024, (const bfr*)(ows(p) + O_WGI) + (size_t)j * 4224 * 1024, 16, layer, nullptr, nullptr, lds); break;
      case 2: gdn_g1(p, j, lds); break;
#if G2_LOADER
      case 3: gdn_g2l(p, j, lds); break;
#else
      case 3: gdn_g2(p, j, lds); break;
#endif
      case 4: gdn_g3(p, j, lds); break;
      case 5: gemm_phase<2>(p, (const bfr*)(ows(p) + O_SCR), 1024, (const bfr*)(ows(p) + O_WGO) + (size_t)j * 1024 * 1024, 4, layer, xcur, xnext, lds); break;
    }
  }
}

__global__ void __launch_bounds__(512) mega_fwd(Params p) {
  extern __shared__ __attribute__((aligned(16))) char lds[];
#if MK_MODE == 1
  cg::grid_group grid = cg::this_grid();
  if (p.ph_lo < 0) grid.sync();
  volatile LAS unsigned* bst = (volatile LAS unsigned*)(lds + LDS_BYTES - 16);
  if (threadIdx.x == 0) { bst[0] = 0u; bst[1] = 0u; }
  __syncthreads();
  const XcdBarrier xb = xcd_barrier_post((unsigned*)(p.ws + O_BAR), bst);
  for (int ph = p.ph_lo; ph < p.ph_hi; ++ph) {
    if (ph > p.ph_lo) xcd_barrier(xb);
#ifdef PROBE_MASK
    const bool probe = (PROBE_MASK >> ph) & 1;
    long long ts = 0;
    if (probe) ts = wall_clock64();
#endif
    run_phase(p, ph, lds);
#ifdef PROBE_MASK
    if (probe) {
      xcd_barrier(xb);
      if (blockIdx.x == 0 && threadIdx.x == 0) {
        long long dt = wall_clock64() - ts, t1 = wall_clock64();
        while (wall_clock64() - t1 < dt) __builtin_amdgcn_s_sleep(8);
      }
    }
#endif
  }
#else
  for (int ph = p.ph_lo; ph < p.ph_hi; ++ph) run_phase(p, ph, lds);
#endif
}

extern "C" void kernel_launch(void* const* d_in, const int* in_sizes, int n_in, void* d_out, int out_size, void* d_ws, size_t ws_size, hipStream_t stream) {
  static int grid = 0;
  if (grid == 0) {
    if (n_in != 19 || ws_size < WS_END) { fprintf(stderr, "kernel_launch: unexpected inputs (n_in %d, ws %zu)\n", n_in, ws_size); grid = -1; return; }
    int dev = 0, cus = 0, per_cu = 0;
    hipGetDevice(&dev);
    hipDeviceGetAttribute(&cus, hipDeviceAttributeMultiprocessorCount, dev);
    if (hipFuncSetAttribute((const void*)mega_fwd, hipFuncAttributeMaxDynamicSharedMemorySize, LDS_BYTES) != hipSuccess) { fprintf(stderr, "kernel_launch: hipFuncSetAttribute failed\n"); grid = -1; return; }
    hipOccupancyMaxActiveBlocksPerMultiprocessor(&per_cu, (const void*)mega_fwd, 512, LDS_BYTES);
    if (per_cu < 1) { fprintf(stderr, "kernel_launch: occupancy query returned %d\n", per_cu); per_cu = 1; }
    (void)hipGetLastError();
    grid = cus * per_cu;
    if (grid > 256) grid = 256;
  }
  if (grid < 0) return;
  Params p{};
  const float** pp = (const float**)&p;
  for (int i = 0; i < 19; ++i) pp[i] = (const float*)d_in[i];
  p.out = (float*)d_out;
  p.ws = (char*)d_ws;
#if MK_MODE == 1
  p.ph_lo = 0; p.ph_hi = NPHASE;
  if (hipMemsetAsync((char*)d_ws + O_BAR, 0, 16384, stream) != hipSuccess) { fprintf(stderr, "kernel_launch: memset of barrier words failed\n"); return; }
  void* args[] = {&p};
  hipError_t e = hipLaunchCooperativeKernel((const void*)mega_fwd, dim3(grid), dim3(512), args, LDS_BYTES, stream);
  if (e != hipSuccess) fprintf(stderr, "cooperative launch failed: %s (grid %d)\n", hipGetErrorString(e), grid);
#else
  for (int ph = 0; ph < NPHASE; ++ph) {
    p.ph_lo = ph; p.ph_hi = ph + 1;
    hipLaunchKernelGGL(mega_fwd, dim3(grid), dim3(512), LDS_BYTES, stream, p);
  }
#endif
}
```

```cpp
#include <hip/hip_runtime.h>
#include <hip/hip_cooperative_groups.h>
#include <cstdio>
namespace cg = cooperative_groups;

#ifndef G2_LOADER
#define G2_LOADER 1
#endif
#ifndef MK_MODE
#define MK_MODE 1
#endif

typedef unsigned short bfr;
typedef __attribute__((ext_vector_type(8))) short bf16x8;
typedef __attribute__((ext_vector_type(4))) short bf16x4;
typedef __attribute__((ext_vector_type(4))) float f32x4;
typedef __attribute__((ext_vector_type(4))) unsigned u32x4;
typedef __attribute__((ext_vector_type(2))) unsigned u32x2;

#define DI __device__ __forceinline__
#define MFMA16(a, b, c) __builtin_amdgcn_mfma_f32_16x16x32_bf16((a), (b), (c), 0, 0, 0)

constexpr int PLANE = 16384 * 1024;
constexpr float EPS = 1e-6f;
constexpr int NPHASE = 22;
constexpr int LDS_BYTES = 163840;

constexpr size_t O_WLI = 0;
constexpr size_t O_WLO = 8388608;
constexpr size_t O_WGI = 12582912;
constexpr size_t O_WGO = 29884416;
constexpr size_t O_WG = 34078720;
constexpr size_t O_CONDP = 35127296;
constexpr size_t O_H = 36700160;
constexpr size_t O_PROJ = 70254592;
constexpr size_t O_ATTN = 204996608;
constexpr size_t O_HALO = 221773824;
constexpr size_t O_SCR = 226492416;
constexpr size_t O_AB = 260046848;
constexpr size_t O_ELAST = 261095424;
constexpr size_t O_AGG = 261103616;
constexpr size_t O_COND = 263200768;
constexpr size_t O_BAR = 263397376;
constexpr size_t WS_END = 263397376 + 16384;

struct Params {
  const float *x, *c, *ada_w, *ada_b, *norm_g, *final_g;
  const float *lru_in_w, *lru_conv_w, *lru_conv_b, *lru_gate_w, *lru_gate_b, *lru_lambda, *lru_out_w;
  const float *gdn_in_w, *gdn_conv_w, *gdn_a_log, *gdn_dt_bias, *gdn_onorm_g, *gdn_out_w;
  float* out;
  char* ws;
  int ph_lo, ph_hi;
};

DI int otid() { int t = threadIdx.x; asm volatile("" : "+v"(t)); return t; }
DI int obid() { int b = blockIdx.x; asm volatile("" : "+s"(b)); return b; }
DI void lds_barrier() { asm volatile("s_waitcnt lgkmcnt(0)" ::: "memory"); __builtin_amdgcn_s_barrier(); asm volatile("" ::: "memory"); }
typedef float f32x2_t __attribute__((ext_vector_type(2)));
typedef __bf16 bf16x2_t __attribute__((ext_vector_type(2)));
DI unsigned pack2(float a, float b) { f32x2_t v = {a, b}; bf16x2_t r = __builtin_convertvector(v, bf16x2_t); return __builtin_bit_cast(unsigned, r); }
DI bfr f2bf(float x) { return (bfr)(pack2(x, x) & 0xffffu); }
DI float bf2f(bfr b) { return __uint_as_float(((unsigned)b) << 16); }
DI float sum16(float x) {
  x += __uint_as_float(__builtin_amdgcn_update_dpp(0, __float_as_uint(x), 0xB1, 0xF, 0xF, true));
  x += __uint_as_float(__builtin_amdgcn_update_dpp(0, __float_as_uint(x), 0x4E, 0xF, 0xF, true));
  x += __uint_as_float(__builtin_amdgcn_update_dpp(0, __float_as_uint(x), 0x141, 0xF, 0xF, true));
  x += __uint_as_float(__builtin_amdgcn_update_dpp(0, __float_as_uint(x), 0x140, 0xF, 0xF, true));
  return x;
}
DI float sigmoidf_(float x) { return __builtin_amdgcn_rcpf(1.f + __expf(-x)); }
DI float siluf_(float x) { return x * __builtin_amdgcn_rcpf(1.f + __expf(-x)); }
DI float softplusf_(float x) { return x > 20.f ? x : log1pf(expf(x)); }
DI float bfe(const bf16x8& v, int e) { return bf2f((bfr)v[e]); }

DI char* ows(const Params& p) { size_t z = 0; asm volatile("" : "+s"(z)); return p.ws + z; }
DI float cond_get(const Params& p, int layer, int b, int n) {
  const float* cp = (const float*)(ows(p) + O_CONDP);
  float s = p.ada_b[layer * 3072 + n];
#pragma unroll
  for (int sg = 0; sg < 8; ++sg) s += cp[((sg * 4 + layer) * 4 + b) * 3072 + n];
  return s;
}

DI void transpose_tile(const float* __restrict__ src, int ldsrc, int nvalid, bfr* __restrict__ dst, int ldd, int k0, int n0, float* sm) {
  const int tid = otid();
  for (int e = tid; e < 4096; e += 512) {
    int kk = e >> 6, nn = e & 63;
    float v = 0.f;
    if (n0 + nn < nvalid) v = src[(size_t)(k0 + kk) * ldsrc + n0 + nn];
    sm[kk * 65 + nn] = v;
  }
  __syncthreads();
  for (int e = tid; e < 4096; e += 512) {
    int nn = e >> 6, kk = e & 63;
    dst[(size_t)(n0 + nn) * ldd + k0 + kk] = f2bf(sm[kk * 65 + nn]);
  }
  __syncthreads();
}

struct P0Item { const float* src; bfr* dst; int ldsrc, nvalid, ldd, k0, n0; };
DI P0Item p0_decode(const Params& p, int it) {
  P0Item r;
  if (it < 1024) {
    int l = it >> 9, q = it & 511, kt = q >> 5, nt = q & 31;
    r.src = p.lru_in_w + (size_t)l * 1024 * 2048; r.ldsrc = 2048; r.nvalid = 2048; r.dst = (bfr*)(ows(p) + O_WLI) + (size_t)l * 2048 * 1024; r.ldd = 1024; r.k0 = kt * 64; r.n0 = nt * 64;
  } else if (it < 1536) {
    int r0 = it - 1024, l = r0 >> 8, q = r0 & 255, kt = q >> 4, nt = q & 15;
    r.src = p.lru_out_w + (size_t)l * 1024 * 1024; r.ldsrc = 1024; r.nvalid = 1024; r.dst = (bfr*)(ows(p) + O_WLO) + (size_t)l * 1024 * 1024; r.ldd = 1024; r.k0 = kt * 64; r.n0 = nt * 64;
  } else if (it < 3648) {
    int r0 = it - 1536, l = r0 / 1056, q = r0 % 1056, kt = q / 66, nt = q % 66;
    r.src = p.gdn_in_w + (size_t)l * 1024 * 4112; r.ldsrc = 4112; r.nvalid = 4112; r.dst = (bfr*)(ows(p) + O_WGI) + (size_t)l * 4224 * 1024; r.ldd = 1024; r.k0 = kt * 64; r.n0 = nt * 64;
  } else if (it < 4160) {
    int r0 = it - 3648, l = r0 >> 8, q = r0 & 255, kt = q >> 4, nt = q & 15;
    r.src = p.gdn_out_w + (size_t)l * 1024 * 1024; r.ldsrc = 1024; r.nvalid = 1024; r.dst = (bfr*)(ows(p) + O_WGO) + (size_t)l * 1024 * 1024; r.ldd = 1024; r.k0 = kt * 64; r.n0 = nt * 64;
  } else {
    int r0 = it - 4160, mat = r0 >> 2, q = r0 & 3, kt = q >> 1, nt = q & 1;
    r.src = p.lru_gate_w + (size_t)mat * 16384; r.ldsrc = 128; r.nvalid = 128; r.dst = (bfr*)(ows(p) + O_WG) + (size_t)mat * 16384; r.ldd = 128; r.k0 = kt * 64; r.n0 = nt * 64;
  }
  return r;
}

DI void phase0(const Params& p, char* lds) {
  float* sm = (float*)lds;
  const int tid = otid();
  float v[8];
#define P0_LOAD(it_)                                                                                 \
  {                                                                                                  \
    const P0Item t_ = p0_decode(p, (it_));                                                           \
    _Pragma("unroll") for (int i = 0; i < 8; ++i) {                                                  \
      const int e = tid + 512 * i, kk = e >> 6, nn = e & 63;                                         \
      v[i] = (t_.n0 + nn < t_.nvalid) ? __builtin_nontemporal_load(&t_.src[(size_t)(t_.k0 + kk) * t_.ldsrc + t_.n0 + nn]) : 0.f; \
    }                                                                                                \
  }
  if (obid() < 4288) P0_LOAD(obid());
#pragma unroll 1
  for (int it = obid(); it < 4288; it += gridDim.x) {
    const P0Item t = p0_decode(p, it);
#pragma unroll
    for (int i = 0; i < 8; ++i) { const int e = tid + 512 * i; sm[(e >> 6) * 65 + (e & 63)] = v[i]; }
    lds_barrier();
    if (it + (int)gridDim.x < 4288) P0_LOAD(it + gridDim.x);
#pragma unroll
    for (int i = 0; i < 4; ++i) {
      const int e = tid + 512 * i, nn = e >> 5, kp = e & 31;
      *(unsigned*)&t.dst[(size_t)(t.n0 + nn) * t.ldd + t.k0 + 2 * kp] = pack2(sm[(2 * kp) * 65 + nn], sm[(2 * kp + 1) * 65 + nn]);
    }
    lds_barrier();
  }
#undef P0_LOAD
  __syncthreads();
  for (int r0 = obid(); r0 < 192; r0 += gridDim.x) {
    int i = r0 / 48, r = r0 % 48, sg = r / 6, cb = r % 6;
    sm[tid] = siluf_(p.c[(tid >> 7) * 1024 + sg * 128 + (tid & 127)]);
    __syncthreads();
    int n = cb * 512 + tid;
    float a0 = 0.f, a1 = 0.f, a2 = 0.f, a3 = 0.f;
    const float* w = p.ada_w + ((size_t)i * 1024 + sg * 128) * 3072 + n;
#pragma unroll 32
    for (int k = 0; k < 128; ++k) {
      float wv = __builtin_nontemporal_load(&w[(size_t)k * 3072]);
      a0 += sm[k] * wv; a1 += sm[128 + k] * wv; a2 += sm[256 + k] * wv; a3 += sm[384 + k] * wv;
    }
    float* cp = (float*)(ows(p) + O_CONDP);
    cp[((sg * 4 + i) * 4 + 0) * 3072 + n] = a0;
    cp[((sg * 4 + i) * 4 + 1) * 3072 + n] = a1;
    cp[((sg * 4 + i) * 4 + 2) * 3072 + n] = a2;
    cp[((sg * 4 + i) * 4 + 3) * 3072 + n] = a3;
    __syncthreads();
  }
}

DI void norm_phase(const Params& p, int layer, const void* __restrict__ xsrc, char* lds) {
  const float* xs = (const float*)xsrc; const bfr* xsb = (const bfr*)xsrc;
  float* gm = (float*)lds;
  float* sh = gm + 1024;
  const int tid = otid(), lane = tid & 63, wv = tid >> 6;
  bfr* H = (bfr*)(ows(p) + O_H);
  if (layer == 0) {
    float* cd = (float*)(ows(p) + O_COND);
    for (int e = obid() * 512 + tid; e < 4 * 4 * 3072; e += gridDim.x * 512) {
      int n = e % 3072, ib = e / 3072;
      cd[e] = cond_get(p, ib >> 2, ib & 3, n);
    }
  }
  const float* cd = (const float*)(ows(p) + O_COND);
  for (int rt = obid(); rt < 256; rt += gridDim.x) {
    int b = rt >> 6;
    for (int c = tid; c < 1024; c += 512) {
      if (layer == 0) {
        float scale = cond_get(p, layer, b, 1024 + c), shift = cond_get(p, layer, b, c);
        gm[c] = p.norm_g[layer * 1024 + c] * (1.f + scale);
        sh[c] = shift;
      } else if (layer < 4) {
        gm[c] = p.norm_g[layer * 1024 + c] * (1.f + cd[(size_t)(layer * 4 + b) * 3072 + 1024 + c]);
        sh[c] = cd[(size_t)(layer * 4 + b) * 3072 + c];
      } else {
        gm[c] = p.final_g[c];
        sh[c] = 0.f;
      }
    }
    __syncthreads();
    u32x2 rb[2][4][4];
    if (layer != 0) {
#pragma unroll
      for (int g = 0; g < 2; ++g)
#pragma unroll
        for (int r = 0; r < 4; ++r)
#pragma unroll
          for (int jx = 0; jx < 4; ++jx) rb[g][r][jx] = *(const u32x2*)&xsb[((size_t)rt * 64 + wv * 8 + g * 4 + r) * 1024 + jx * 256 + lane * 4];
    }
#pragma unroll
    for (int r4 = 0; r4 < 8; r4 += 4) {
      f32x4 v[4][4];
#pragma unroll
      for (int r = 0; r < 4; ++r)
#pragma unroll
        for (int jx = 0; jx < 4; ++jx) {
          const size_t xi = ((size_t)rt * 64 + wv * 8 + r4 + r) * 1024 + jx * 256 + lane * 4;
          if (layer == 0) v[r][jx] = *(const f32x4*)&xs[xi];
          else {
            const u32x2 xb = rb[r4 >> 2][r][jx];
            v[r][jx] = (f32x4){__uint_as_float(xb[0] << 16), __uint_as_float(xb[0] & 0xffff0000u), __uint_as_float(xb[1] << 16), __uint_as_float(xb[1] & 0xffff0000u)};
          }
        }
#pragma unroll
      for (int r = 0; r < 4; ++r) {
        const size_t row = (size_t)rt * 64 + wv * 8 + r4 + r;
        float ss = 0.f;
#pragma unroll
        for (int jx = 0; jx < 4; ++jx) ss += v[r][jx][0] * v[r][jx][0] + v[r][jx][1] * v[r][jx][1] + v[r][jx][2] * v[r][jx][2] + v[r][jx][3] * v[r][jx][3];
        ss = sum16(ss);
        ss += __shfl_xor(ss, 16);
        ss += __shfl_xor(ss, 32);
        const float rstd = rsqrtf(ss * (1.f / 1024.f) + EPS);
#pragma unroll
        for (int jx = 0; jx < 4; ++jx) {
          const int c = jx * 256 + lane * 4;
          f32x4 g4 = *(const f32x4*)&gm[c], s4 = *(const f32x4*)&sh[c];
          f32x4 y;
#pragma unroll
          for (int e = 0; e < 4; ++e) y[e] = v[r][jx][e] * rstd * g4[e] + s4[e];
          if (layer < 4) {
            u32x2 o2; o2[0] = pack2(y[0], y[1]); o2[1] = pack2(y[2], y[3]);
            *(u32x2*)&H[row * 1024 + c] = o2;
          } else {
            __builtin_nontemporal_store(y, (f32x4*)&p.out[row * 1024 + c]);
          }
        }
      }
    }
    __syncthreads();
  }
}

namespace pg8 {
#define PG8_LAS __attribute__((address_space(3)))
typedef unsigned short bf16_t;
typedef short bf16x8 __attribute__((ext_vector_type(8)));
typedef float f32x4 __attribute__((ext_vector_type(4)));
typedef unsigned u32x4 __attribute__((ext_vector_type(4)));
constexpr int BM = 256, BK = 64, HALF = 128, HTB = HALF * BK * 2  , STAGE_BYTES = 8 * HTB, NXCD = 8, WGM = 8;

__host__ __device__ __forceinline__ int lds_byte(int r, int c) { const int st = (r >> 4) * 2 + (c >> 5), rr = r & 15, cc = c & 31, ob = rr * 64 + cc * 2; return st * 1024 + (ob ^ (((ob >> 9) & 1) << 5)); }
__host__ __device__ __forceinline__ void stage_rc(int b, int& R, int& C) { const int st = b / 1024, sb = b % 1024, swz = sb ^ (((sb >> 9) & 1) << 5); R = (st >> 1) * 16 + swz / 64; C = (st & 1) * 32 + (swz % 64) / 2; }
__host__ __device__ __forceinline__ int perm32(int rho) { const int n = rho >> 4, i = rho & 15; return 8 * (i >> 2) + 4 * n + (i & 3); }

struct Unit { int pm, pn; };
struct Gemm { const bf16_t* A; const bf16_t* Bt; int M, N, K; };

struct StaticOrder {
    int nM, nN, nwg, G, c;
    __host__ __device__ void init(int M, int N, int G_, int c_) { nM = M / BM; nN = N / BM; nwg = nM * nN; G = G_; c = c_; }
    __host__ __device__ bool next(int i, Unit& u) const {
        const long L = (long)i * G + c; if (L >= nwg) return false;
        int wgid = (int)L; { const int q = nwg / NXCD, r = nwg % NXCD, xcd = wgid % NXCD, off = wgid / NXCD; wgid = (xcd < r ? xcd * (q + 1) : r * (q + 1) + (xcd - r) * q) + off; }
        const int nig = WGM * nN, gid = wgid / nig, fm = gid * WGM, gsz = (nM - fm) < WGM ? (nM - fm) : WGM;
        u.pm = fm + ((wgid % nig) % gsz); u.pn = (wgid % nig) / gsz; return true;
    }
    __device__ __forceinline__ void a_ready(const Unit&) const {}
    __device__ __forceinline__ void done(const Unit&) const {}
};
__device__ __forceinline__ unsigned cvt_pk_bf16(float lo, float hi) { unsigned r; asm volatile("v_cvt_pk_bf16_f32 %0, %1, %2" : "=v"(r) : "v"(lo), "v"(hi)); return r; }

template <class Epi, class Sched, bool STAMP = false>
__device__ __forceinline__ void gemm_phase(PG8_LAS unsigned char* lds, const Gemm g, const Sched& S, const Epi& E, unsigned long long* stamps) {
    const int tid = otid(), wid = __builtin_amdgcn_readfirstlane(tid >> 6), lane = tid & 63, wr = wid >> 2, wc = wid & 3, fr = lane & 15, fq = lane >> 4;
    const int K = g.K, nt = K / BK;
    int ts_lo = 0, ts_hi = 0, nts = 0; const unsigned long long rt_entry = STAMP ? (unsigned long long)wall_clock64() : 0ull;
#define PG8_STAMP() do { if (STAMP && wid == 0 && nts < 64) { const unsigned long long _c = (unsigned long long)clock64(); \
        ts_lo = (lane == nts) ? (int)(unsigned)_c : ts_lo; ts_hi = (lane == nts) ? (int)(unsigned)(_c >> 32) : ts_hi; ++nts; } } while (0)
    PG8_STAMP();
    unsigned voffA[2], voffB[2];
#pragma unroll
    for (int i = 0; i < 2; ++i) { int R, C; stage_rc(tid * 16 + i * 8192, R, C); const int Rb = Epi::PERM ? ((R & ~31) + perm32(R & 31)) : R;
        voffA[i] = (unsigned)(R * K + C) * 2u; voffB[i] = (unsigned)(Rb * K + C) * 2u; }
    const size_t kstep = (size_t)(BK * 2);
    const size_t hstep = (size_t)HALF * K * 2;
    const size_t tstep = 2 * hstep;
    const unsigned ldsw = (unsigned)wid * 1024u;
    const int aoff = lds_byte(wr * 64 + fr, fq * 8), boff = lds_byte(wc * 32 + fr, fq * 8);
#define PG8_SA(b, h) (((b) * 2 + (h)) * HTB)
#define PG8_SB(b, h) ((4 + (b) * 2 + (h)) * HTB)
#define PG8_STAGE(bufoff, gbase, voff) do { _Pragma("unroll") for (int _i = 0; _i < 2; ++_i) \
        __builtin_amdgcn_global_load_lds((const unsigned*)((const char*)(gbase) + (voff)[_i]), (PG8_LAS unsigned*)(lds + (bufoff) + ldsw + _i * 8192), 16, 0, 0); } while (0)
#define PG8_LDA(dst, b, h) do { _Pragma("unroll") for (int m = 0; m < 4; ++m) _Pragma("unroll") for (int k = 0; k < 2; ++k) dst[m][k] = *(const PG8_LAS bf16x8*)(lds + PG8_SA(b, h) + aoff + m * 2048 + k * 1024); } while (0)
#define PG8_LDB(dst, b, h) do { _Pragma("unroll") for (int n = 0; n < 2; ++n) _Pragma("unroll") for (int k = 0; k < 2; ++k) dst[n][k] = *(const PG8_LAS bf16x8*)(lds + PG8_SB(b, h) + boff + n * 2048 + k * 1024); } while (0)
#define PG8_MMA(ai, bj, At, Bt) do { __builtin_amdgcn_s_setprio(1); _Pragma("unroll") for (int m = 0; m < 4; ++m) _Pragma("unroll") for (int n = 0; n < 2; ++n) _Pragma("unroll") for (int k = 0; k < 2; ++k) \
        acc[ai][bj][m][n] = __builtin_amdgcn_mfma_f32_16x16x32_bf16(Bt[n][k], At[m][k], acc[ai][bj][m][n], 0, 0, 0); __builtin_amdgcn_s_setprio(0); } while (0)
#define PG8_WAIT_V(n) asm volatile("s_waitcnt vmcnt(" #n ")" ::: "memory")
#define PG8_WAIT_L(n) asm volatile("s_waitcnt lgkmcnt(" #n ")" ::: "memory")
#define PG8_BAR __builtin_amdgcn_s_barrier()
#define PG8_SCHED __builtin_amdgcn_sched_barrier(0)
    Unit cur, nxt; int ui = 0;
    if (!S.next(0, cur)) return;
    f32x4 acc[2][2][4][2];
#pragma unroll
    for (int a = 0; a < 2; ++a)
#pragma unroll
        for (int b = 0; b < 2; ++b)
#pragma unroll
            for (int m = 0; m < 4; ++m)
#pragma unroll
                for (int n = 0; n < 2; ++n) acc[a][b][m][n] = (f32x4){0.f, 0.f, 0.f, 0.f};
    bf16x8 At[4][2], B0[2][2], B1[2][2];
    const char* cA = (const char*)g.A + (size_t)cur.pm * tstep; const char* cB = (const char*)g.Bt + (size_t)cur.pn * tstep;
    S.a_ready(cur);
    PG8_STAGE(PG8_SB(0, 0), cB, voffB); PG8_STAGE(PG8_SA(0, 0), cA, voffA); PG8_STAGE(PG8_SB(0, 1), cB + hstep, voffB); PG8_STAGE(PG8_SA(0, 1), cA + hstep, voffA);
    if (wr == 1) PG8_BAR;
    PG8_WAIT_V(4); PG8_BAR;
    PG8_STAGE(PG8_SB(1, 0), cB + kstep, voffB); PG8_STAGE(PG8_SA(1, 0), cA + kstep, voffA); PG8_STAGE(PG8_SB(1, 1), cB + hstep + kstep, voffB);
    PG8_WAIT_V(6); PG8_BAR;
    PG8_STAMP();
    for (;;) {
        const bool has_next = S.next(ui + 1, nxt);
        const char* nA = has_next ? (const char*)g.A + (size_t)nxt.pm * tstep : cA; const char* nB = has_next ? (const char*)g.Bt + (size_t)nxt.pn * tstep : cB;
        for (int t = 0; t < nt; t += 2) {
            const bool last = (t == nt - 2);
            const char* a1 = cA + (size_t)(t + 1) * kstep;
            const char* a2 = last ? nA : cA + (size_t)(t + 2) * kstep; const char* b2 = last ? nB : cB + (size_t)(t + 2) * kstep;
            const char* a3 = a2 + kstep; const char* b3 = b2 + kstep;
            if (last && has_next) S.a_ready(nxt);
            PG8_LDB(B0, 0, 0); PG8_SCHED; PG8_LDA(At, 0, 0); PG8_STAGE(PG8_SA(1, 1), a1 + hstep, voffA);
            PG8_WAIT_L(8); PG8_BAR; PG8_WAIT_L(0); PG8_MMA(0, 0, At, B0); PG8_BAR; PG8_SCHED;
            PG8_LDB(B1, 0, 1); PG8_STAGE(PG8_SB(0, 0), b2, voffB);
            PG8_BAR; PG8_WAIT_L(0); PG8_MMA(0, 1, At, B1); PG8_BAR;
            PG8_LDA(At, 0, 1); PG8_STAGE(PG8_SA(0, 0), a2, voffA);
            PG8_BAR; PG8_WAIT_L(0); PG8_MMA(1, 0, At, B0); PG8_BAR; PG8_SCHED;
            PG8_STAGE(PG8_SB(0, 1), b2 + hstep, voffB);
            PG8_WAIT_V(6); PG8_BAR; PG8_MMA(1, 1, At, B1); PG8_BAR;
            PG8_LDB(B0, 1, 0); PG8_SCHED; PG8_LDA(At, 1, 0); PG8_STAGE(PG8_SA(0, 1), a2 + hstep, voffA);
            PG8_WAIT_L(8); PG8_BAR; PG8_WAIT_L(0); PG8_MMA(0, 0, At, B0); PG8_BAR; PG8_SCHED;
            PG8_LDB(B1, 1, 1); PG8_STAGE(PG8_SB(1, 0), b3, voffB);
            PG8_BAR; PG8_WAIT_L(0); PG8_MMA(0, 1, At, B1); PG8_BAR;
            PG8_LDA(At, 1, 1); PG8_STAGE(PG8_SA(1, 0), a3, voffA);
            PG8_BAR; PG8_WAIT_L(0); PG8_MMA(1, 0, At, B0); PG8_BAR; PG8_SCHED;
            PG8_STAGE(PG8_SB(1, 1), b3 + hstep, voffB);
            PG8_WAIT_V(6); PG8_BAR; PG8_MMA(1, 1, At, B1); PG8_BAR;
        }
        PG8_STAMP();
        if constexpr (!Epi::AFTER_DRAIN) { E(acc, cur, wr, wc, fr, fq); S.done(cur); }
        PG8_STAMP();
        if (!has_next) break;
#pragma unroll
        for (int a = 0; a < 2; ++a)
#pragma unroll
            for (int b = 0; b < 2; ++b)
#pragma unroll
                for (int m = 0; m < 4; ++m)
#pragma unroll
                    for (int n = 0; n < 2; ++n) acc[a][b][m][n] = (f32x4){0.f, 0.f, 0.f, 0.f};
        cur = nxt; cA = nA; cB = nB; ++ui;
    }
    PG8_WAIT_V(0);
    if (wr == 0) PG8_BAR;
    PG8_BAR;
    if constexpr (Epi::AFTER_DRAIN) { E.fused(acc, cur, wr, wc, fr, fq, lds, wid, lane); S.done(cur); }
    PG8_STAMP();
    if (STAMP && wid == 0) { stamps[lane] = lane < nts ? (((unsigned long long)(unsigned)ts_hi << 32) | (unsigned)ts_lo) : 0ull;
        if (lane == 62) stamps[62] = rt_entry; if (lane == 63) stamps[63] = (unsigned long long)wall_clock64(); }
#undef PG8_STAMP
#undef PG8_SA
#undef PG8_SB
#undef PG8_STAGE
#undef PG8_LDA
#undef PG8_LDB
#undef PG8_MMA
#undef PG8_WAIT_V
#undef PG8_WAIT_L
#undef PG8_BAR
#undef PG8_SCHED
}
}

struct EpiProjBf16 {
  static constexpr bool PERM = true, AFTER_DRAIN = false;
  bfr* O; bfr* halo;
  __device__ __forceinline__ void operator()(const f32x4 (&acc)[2][2][4][2], const pg8::Unit& u, int wr, int wc, int fr, int fq) const {
    const int row0 = u.pm * 256 + wr * 64 + fr, col0 = u.pn * 256 + wc * 32 + 8 * fq;
#pragma unroll
    for (int ai = 0; ai < 2; ++ai)
#pragma unroll
      for (int m = 0; m < 4; ++m) {
        const int row = row0 + ai * 128 + m * 16;
        const int bb = row >> 12, ts = row & 4095;
#pragma unroll
        for (int bj = 0; bj < 2; ++bj) {
          const int col = col0 + bj * 128;
          const f32x4 v0 = acc[ai][bj][m][0], v1 = acc[ai][bj][m][1];
          u32x4 w; w.x = pack2(v0[0], v0[1]); w.y = pack2(v0[2], v0[3]); w.z = pack2(v1[0], v1[1]); w.w = pack2(v1[2], v1[3]);
          *(u32x4*)(O + (size_t)(col >> 10) * PLANE + ((size_t)((bb * 8 + ((col >> 7) & 7)) * 4096 + ts)) * 128 + (col & 127)) = w;
          if (halo && (row & 63) >= 61 && col < 3072)
            *(u32x4*)(halo + ((size_t)(row >> 6) * 3 + ((row & 63) - 61)) * 3072 + col) = w;
        }
      }
  }
};
struct EpiResid {
  static constexpr bool PERM = true, AFTER_DRAIN = false;
  bfr* out; const void* xin; int xin_f32; const float* gate;
  __device__ __forceinline__ void operator()(const f32x4 (&acc)[2][2][4][2], const pg8::Unit& u, int wr, int wc, int fr, int fq) const {
    const int row0 = u.pm * 256 + wr * 64 + fr, col0 = u.pn * 256 + wc * 32 + 8 * fq;
    const float* gp = gate + (size_t)((u.pm * 256) >> 12) * 3072 + col0;
    f32x4 gv[2][2];
#pragma unroll
    for (int bj = 0; bj < 2; ++bj)
#pragma unroll
      for (int n = 0; n < 2; ++n) gv[bj][n] = *(const f32x4*)(gp + bj * 128 + n * 4);
#pragma unroll
    for (int ai = 0; ai < 2; ++ai)
#pragma unroll
      for (int m = 0; m < 4; ++m) {
        const size_t ro = (size_t)(row0 + ai * 128 + m * 16) * 1024 + col0;
#pragma unroll
        for (int bj = 0; bj < 2; ++bj) {
          f32x4 x0, x1;
          if (xin_f32) {
            x0 = *(const f32x4*)((const float*)xin + ro + bj * 128);
            x1 = *(const f32x4*)((const float*)xin + ro + bj * 128 + 4);
          } else {
            const u32x4 xb = *(const u32x4*)((const bfr*)xin + ro + bj * 128);
            x0 = (f32x4){__uint_as_float(xb[0] << 16), __uint_as_float(xb[0] & 0xffff0000u), __uint_as_float(xb[1] << 16), __uint_as_float(xb[1] & 0xffff0000u)};
            x1 = (f32x4){__uint_as_float(xb[2] << 16), __uint_as_float(xb[2] & 0xffff0000u), __uint_as_float(xb[3] << 16), __uint_as_float(xb[3] & 0xffff0000u)};
          }
          const f32x4 v0 = x0 + gv[bj][0] * acc[ai][bj][m][0], v1 = x1 + gv[bj][1] * acc[ai][bj][m][1];
          u32x4 w; w.x = pack2(v0[0], v0[1]); w.y = pack2(v0[2], v0[3]); w.z = pack2(v1[0], v1[1]); w.w = pack2(v1[2], v1[3]);
          *(u32x4*)(out + ro + bj * 128) = w;
        }
      }
  }
};

template <int EPI>
DI void gemm_phase(const Params& p, const bfr* __restrict__ A, int lda, const bfr* __restrict__ Bt, int nN, int layer, const void* __restrict__ xin, bfr* __restrict__ xout, char* lds) {
  pg8::Gemm g; g.A = A; g.Bt = Bt; g.M = 16384; g.N = nN * 256; g.K = 1024;
  pg8::StaticOrder S; S.init(g.M, g.N, gridDim.x, obid());
  if (EPI == 2) {
    EpiResid E; E.out = xout; E.xin = xin; E.xin_f32 = (layer == 0) ? 1 : 0; E.gate = (const float*)(ows(p) + O_COND) + (size_t)layer * 4 * 3072 + 2048;
    pg8::gemm_phase<EpiResid, pg8::StaticOrder, false>((PG8_LAS unsigned char*)lds, g, S, E, nullptr);
  } else {
    EpiProjBf16 E; E.O = (bfr*)(ows(p) + O_PROJ); E.halo = (EPI == 1) ? (bfr*)(ows(p) + O_HALO) : nullptr;
    pg8::gemm_phase<EpiProjBf16, pg8::StaticOrder, false>((PG8_LAS unsigned char*)lds, g, S, E, nullptr);
  }
  if (EPI == 1) {
    __syncthreads();
    float* red = (float*)lds;
    const int tid = otid(), lane = tid & 63, wv = tid >> 6, l15 = lane & 15, q = lane >> 4;
    const int mt4 = wv & 3, kh = wv >> 2;
    for (int rt = obid(); rt < 256; rt += gridDim.x) {
      const bfr* Ar = A + (size_t)(rt * 64 + mt4 * 16 + l15) * lda + kh * 512 + q * 8;
      const bfr* Br = Bt + (size_t)(4096 + l15) * 1024 + kh * 512 + q * 8;
      f32x4 acc = (f32x4){0.f, 0.f, 0.f, 0.f};
#pragma unroll 4
      for (int ks = 0; ks < 16; ++ks) acc = MFMA16(*(const bf16x8*)(Ar + ks * 32), *(const bf16x8*)(Br + ks * 32), acc);
      if (kh == 1) *(f32x4*)&red[(mt4 * 64 + lane) * 4] = acc;
      __syncthreads();
      if (kh == 0) {
        f32x4 o = *(const f32x4*)&red[(mt4 * 64 + lane) * 4];
#pragma unroll
        for (int jx = 0; jx < 4; ++jx) ((float*)(ows(p) + O_AB))[(size_t)(rt * 64 + mt4 * 16 + q * 4 + jx) * 16 + l15] = acc[jx] + o[jx];
      }
      __syncthreads();
    }
  }
}

DI void lru_phase(const Params& p, int j, char* lds) {
  const int tid = otid(), lane = tid & 63, wv = tid >> 6, l15 = lane & 15, q = lane >> 4;
  bfr* Xw = (bfr*)lds + wv * (32 * 136);
  float* WAgg = (float*)(lds + 8 * 32 * 136 * 2);
  const bfr* proj = (const bfr*)(ows(p) + O_PROJ);
  bfr* Yb = (bfr*)(ows(p) + O_H);
  const bfr* WG = (const bfr*)(ows(p) + O_WG);
  for (int unit = obid(); unit < 256; unit += gridDim.x) {
    const int xcd = unit & 7, li = unit >> 3, idx = xcd * 4 + (li >> 3), sl = li & 7, b = idx >> 3, gb = idx & 7;
    const int ch = gb * 128 + sl * 16 + l15;
    bf16x8 Bf[2][4];
#pragma unroll
    for (int kq = 0; kq < 2; ++kq)
#pragma unroll
      for (int ks = 0; ks < 4; ++ks) Bf[kq][ks] = *(const bf16x8*)&WG[(size_t)((j * 2 + kq) * 8 + gb) * 16384 + (sl * 16 + l15) * 128 + ks * 32 + q * 8];
    const float gbr = p.lru_gate_b[(j * 2) * 1024 + ch], gbi = p.lru_gate_b[(j * 2 + 1) * 1024 + ch];
    const float sp = softplusf_(-p.lru_lambda[j * 1024 + ch]);
    const int cg = lane & 15, rs = lane >> 4, ccol = gb * 128 + cg * 8;
    float cwv[4][8], cb[8];
#pragma unroll
    for (int tp = 0; tp < 4; ++tp)
#pragma unroll
      for (int e = 0; e < 8; ++e) cwv[tp][e] = p.lru_conv_w[(size_t)(j * 4 + tp) * 1024 + ccol + e];
#pragma unroll
    for (int e = 0; e < 8; ++e) cb[e] = p.lru_conv_b[j * 1024 + ccol + e];
    const bfr* xb_u = proj + (size_t)(b * 8 + gb) * 4096 * 128;
    bfr* yb_u = Yb + (size_t)b * 4096 * 1024;
    const int xo = (wv * 32 + rs * 8 - 3) * 128 + cg * 8;
    const int zo = PLANE + (wv * 32 + q * 4) * 128 + sl * 16 + (l15 & ~1);
    const int zsh = (l15 & 1) * 16;
    const int yo = (wv * 32 + q * 4) * 1024 + ch;
    float carry = 0.f;
    bf16x8 raw[11];
    unsigned zr[8];
#define LRU_LOAD(it)                                                                                   \
  {                                                                                                    \
    const bfr* xit = xb_u + (it) * (256 * 128);                                                        \
    _Pragma("unroll") for (int i = 0; i < 11; ++i) {                                                   \
      const int t = (it) * 256 + wv * 32 + rs * 8 - 3 + i;                                             \
      if (t >= 0) raw[i] = *(const bf16x8*)&xit[xo + i * 128];                                         \
      else raw[i] = (bf16x8){0, 0, 0, 0, 0, 0, 0, 0};                                                  \
    }                                                                                                  \
    _Pragma("unroll") for (int mt = 0; mt < 2; ++mt) _Pragma("unroll") for (int jx = 0; jx < 4; ++jx)  \
      zr[mt * 4 + jx] = *(const unsigned*)&xit[zo + (mt * 16 + jx) * 128];                                               \
  }
    LRU_LOAD(0);
#pragma unroll 1
    for (int it = 0; it < 16; ++it) {
#pragma unroll
      for (int r = 0; r < 8; ++r) {
        float o[8];
#pragma unroll
        for (int e = 0; e < 8; ++e) {
          float s = cb[e];
#pragma unroll
          for (int tp = 0; tp < 4; ++tp) s += cwv[tp][e] * bfe(raw[r + tp], e);
          o[e] = s;
        }
        u32x4 pk; pk[0] = pack2(o[0], o[1]); pk[1] = pack2(o[2], o[3]); pk[2] = pack2(o[4], o[5]); pk[3] = pack2(o[6], o[7]);
        *(u32x4*)&Xw[(rs * 8 + r) * 136 + cg * 8] = pk;
      }
      float zc[8];
#pragma unroll
      for (int i = 0; i < 8; ++i) zc[i] = bf2f((bfr)(zr[i] >> zsh));
      if (it < 15) LRU_LOAD(it + 1);
      f32x4 accr[2], acci[2];
#pragma unroll
      for (int mt = 0; mt < 2; ++mt) {
        accr[mt] = acci[mt] = (f32x4){0.f, 0.f, 0.f, 0.f};
#pragma unroll
        for (int ks = 0; ks < 4; ++ks) {
          bf16x8 af = *(const bf16x8*)&Xw[(mt * 16 + l15) * 136 + ks * 32 + q * 8];
          accr[mt] = MFMA16(af, Bf[0][ks], accr[mt]);
          acci[mt] = MFMA16(af, Bf[1][ks], acci[mt]);
        }
      }
      float av[2][4], bv[2][4];
      float Aex[2], Bex[2], At[2], Bt_[2];
#pragma unroll
      for (int mt = 0; mt < 2; ++mt) {
        float Al = 1.f, Bl = 0.f;
#pragma unroll
        for (int jx = 0; jx < 4; ++jx) {
          const float r = sigmoidf_(accr[mt][jx] + gbr), ig = sigmoidf_(acci[mt][jx] + gbi);
          const float a = __expf(-8.f * r * sp);
          const float mult = __builtin_amdgcn_sqrtf(fmaxf(1.f - a * a, 0.f));
          const float xf = bf2f(Xw[(mt * 16 + q * 4 + jx) * 136 + sl * 16 + l15]);
          const float bt = mult * ig * xf;
          av[mt][jx] = a; bv[mt][jx] = bt;
          Bl = a * Bl + bt; Al *= a;
        }
        float Ai = Al, Bi = Bl;
#pragma unroll
        for (int off = 16; off < 64; off <<= 1) {
          const float Ap = __shfl_up(Ai, off), Bp = __shfl_up(Bi, off);
          if (lane >= off) { Bi = Ai * Bp + Bi; Ai = Ai * Ap; }
        }
        float Ae = __shfl_up(Ai, 16), Be = __shfl_up(Bi, 16);
        if (q == 0) { Ae = 1.f; Be = 0.f; }
        Aex[mt] = Ae; Bex[mt] = Be;
        At[mt] = __shfl(Ai, 48 + l15); Bt_[mt] = __shfl(Bi, 48 + l15);
      }
      float* wa = WAgg + (it & 1) * 256;
      if (q == 0) { wa[(wv * 16 + l15) * 2] = At[0] * At[1]; wa[(wv * 16 + l15) * 2 + 1] = At[1] * Bt_[0] + Bt_[1]; }
      lds_barrier();
      float cin = carry, cnew = carry;
#pragma unroll
      for (int w = 0; w < 8; ++w) {
        const float Aw = wa[(w * 16 + l15) * 2], Bw = wa[(w * 16 + l15) * 2 + 1];
        cnew = Aw * cnew + Bw;
        if (w < wv) cin = Aw * cin + Bw;
      }
      carry = cnew;
      bfr* yit = yb_u + it * (256 * 1024);
#pragma unroll
      for (int mt = 0; mt < 2; ++mt) {
        float h = Aex[mt] * cin + Bex[mt];
#pragma unroll
        for (int jx = 0; jx < 4; ++jx) {
          h = av[mt][jx] * h + bv[mt][jx];
          yit[yo + (mt * 16 + jx) * 1024] = f2bf(h * siluf_(zc[mt * 4 + jx]));
        }
        cin = At[mt] * cin + Bt_[mt];
      }
    }
#undef LRU_LOAD
  }
}

DI bf16x8 ld_perm(const bfr* base) {
  u32x2 lo = *(const u32x2*)base, hi = *(const u32x2*)(base + 16);
  u32x4 r; r[0] = lo[0]; r[1] = lo[1]; r[2] = hi[0]; r[3] = hi[1];
  return __builtin_bit_cast(bf16x8, r);
}
DI bf16x8 pack_cc(const f32x4& a, const f32x4& b) {
  u32x4 r; r[0] = pack2(a[0], a[1]); r[1] = pack2(a[2], a[3]); r[2] = pack2(b[0], b[1]); r[3] = pack2(b[2], b[3]);
  return __builtin_bit_cast(bf16x8, r);
}


template <int NL> DI void row_load(f32x4 (&a)[8], unsigned addr, float& dep) {
  if constexpr (NL == 1) asm volatile("ds_read_b128 %0, %2\n\ts_waitcnt lgkmcnt(0)" : "=&v"(a[0]), "+v"(dep) : "v"(addr) : "memory");
  if constexpr (NL == 2) asm volatile("ds_read_b128 %0, %3\n\tds_read_b128 %1, %3 offset:16\n\ts_waitcnt lgkmcnt(0)" : "=&v"(a[0]), "=&v"(a[1]), "+v"(dep) : "v"(addr) : "memory");
  if constexpr (NL == 3) asm volatile("ds_read_b128 %0, %4\n\tds_read_b128 %1, %4 offset:16\n\tds_read_b128 %2, %4 offset:32\n\ts_waitcnt lgkmcnt(0)" : "=&v"(a[0]), "=&v"(a[1]), "=&v"(a[2]), "+v"(dep) : "v"(addr) : "memory");
  if constexpr (NL == 4) asm volatile("ds_read_b128 %0, %5\n\tds_read_b128 %1, %5 offset:16\n\tds_read_b128 %2, %5 offset:32\n\tds_read_b128 %3, %5 offset:48\n\ts_waitcnt lgkmcnt(0)" : "=&v"(a[0]), "=&v"(a[1]), "=&v"(a[2]), "=&v"(a[3]), "+v"(dep) : "v"(addr) : "memory");
  if constexpr (NL == 5) asm volatile("ds_read_b128 %0, %6\n\tds_read_b128 %1, %6 offset:16\n\tds_read_b128 %2, %6 offset:32\n\tds_read_b128 %3, %6 offset:48\n\tds_read_b128 %4, %6 offset:64\n\ts_waitcnt lgkmcnt(0)" : "=&v"(a[0]), "=&v"(a[1]), "=&v"(a[2]), "=&v"(a[3]), "=&v"(a[4]), "+v"(dep) : "v"(addr) : "memory");
  if constexpr (NL == 6) asm volatile("ds_read_b128 %0, %7\n\tds_read_b128 %1, %7 offset:16\n\tds_read_b128 %2, %7 offset:32\n\tds_read_b128 %3, %7 offset:48\n\tds_read_b128 %4, %7 offset:64\n\tds_read_b128 %5, %7 offset:80\n\ts_waitcnt lgkmcnt(0)" : "=&v"(a[0]), "=&v"(a[1]), "=&v"(a[2]), "=&v"(a[3]), "=&v"(a[4]), "=&v"(a[5]), "+v"(dep) : "v"(addr) : "memory");
  if constexpr (NL == 7) asm volatile("ds_read_b128 %0, %8\n\tds_read_b128 %1, %8 offset:16\n\tds_read_b128 %2, %8 offset:32\n\tds_read_b128 %3, %8 offset:48\n\tds_read_b128 %4, %8 offset:64\n\tds_read_b128 %5, %8 offset:80\n\tds_read_b128 %6, %8 offset:96\n\ts_waitcnt lgkmcnt(0)" : "=&v"(a[0]), "=&v"(a[1]), "=&v"(a[2]), "=&v"(a[3]), "=&v"(a[4]), "=&v"(a[5]), "=&v"(a[6]), "+v"(dep) : "v"(addr) : "memory");
  if constexpr (NL == 8) asm volatile("ds_read_b128 %0, %9\n\tds_read_b128 %1, %9 offset:16\n\tds_read_b128 %2, %9 offset:32\n\tds_read_b128 %3, %9 offset:48\n\tds_read_b128 %4, %9 offset:64\n\tds_read_b128 %5, %9 offset:80\n\tds_read_b128 %6, %9 offset:96\n\tds_read_b128 %7, %9 offset:112\n\ts_waitcnt lgkmcnt(0)" : "=&v"(a[0]), "=&v"(a[1]), "=&v"(a[2]), "=&v"(a[3]), "=&v"(a[4]), "=&v"(a[5]), "=&v"(a[6]), "=&v"(a[7]), "+v"(dep) : "v"(addr) : "memory");
}
template <int I> DI void inv_rows(float (&t)[32], unsigned abase, int j) {
  if constexpr (I < 32) {
    float s = (I == j) ? 1.f : 0.f;
    if constexpr (I > 0) {
      f32x4 a[8];
      row_load<(I + 3) / 4>(a, abase + I * 256, t[I - 1]);
#pragma unroll
      for (int m4 = 0; m4 < I; m4 += 4) {
        s -= a[m4 >> 2][0] * t[m4];
        if (m4 + 1 < I) s -= a[m4 >> 2][1] * t[m4 + 1];
        if (m4 + 2 < I) s -= a[m4 >> 2][2] * t[m4 + 2];
        if (m4 + 3 < I) s -= a[m4 >> 2][3] * t[m4 + 3];
      }
    }
    t[I] = s;
    inv_rows<I + 1>(t, abase, j);
  }
}
DI void tri_invert32(const float* __restrict__ Au, bfr* __restrict__ Ttu, bfr* __restrict__ Tcu, int hf, int lane) {
  const int j = lane & 31;
  const float* Ab = Au + (32 * hf) * 64 + 32 * hf;
  float t[32];
  const unsigned abase = (unsigned)(size_t)Ab;
  inv_rows<0>(t, abase, j);
  if (lane < 32) {
#pragma unroll
    for (int i = 0; i < 32; ++i) Ttu[(32 * hf + i) * 72 + 32 * hf + j] = f2bf(t[i]);
    if (hf == 0) {
#pragma unroll
      for (int i = 0; i < 32; ++i) Ttu[i * 72 + 32 + j] = 0;
#pragma unroll
      for (int i4 = 0; i4 < 4; ++i4) {
        u32x4 pk;
        pk[0] = pack2(t[8 * i4], t[8 * i4 + 1]); pk[1] = pack2(t[8 * i4 + 2], t[8 * i4 + 3]);
        pk[2] = pack2(t[8 * i4 + 4], t[8 * i4 + 5]); pk[3] = pack2(t[8 * i4 + 6], t[8 * i4 + 7]);
        *(u32x4*)&Tcu[j * 40 + 8 * i4] = pk;
      }
    }
  }
}
DI void tri_merge(const float* __restrict__ Au, bfr* __restrict__ Ttu, const bfr* __restrict__ Tcu, int nt2, int lane) {
  const int l15 = lane & 15, q = lane >> 4;
  const f32x4 zero = (f32x4){0.f, 0.f, 0.f, 0.f};
  bf16x8 bfrag = *(const bf16x8*)&Tcu[(nt2 * 16 + l15) * 40 + q * 8];
  f32x4 X[2];
#pragma unroll
  for (int mt = 0; mt < 2; ++mt) {
    const float* ar = Au + (32 + mt * 16 + l15) * 64 + q * 8;
    f32x4 a0 = *(const f32x4*)ar, a1 = *(const f32x4*)(ar + 4);
    X[mt] = MFMA16(pack_cc(a0, a1), bfrag, zero);
  }
  bf16x8 xb = pack_cc(X[0], X[1]);
#pragma unroll
  for (int mt2 = 0; mt2 < 2; ++mt2) {
    bf16x8 a = ld_perm(Ttu + (32 + mt2 * 16 + l15) * 72 + 32 + q * 4);
    f32x4 r = MFMA16(a, xb, zero);
#pragma unroll
    for (int jx = 0; jx < 4; ++jx) Ttu[(32 + mt2 * 16 + q * 4 + jx) * 72 + nt2 * 16 + l15] = f2bf(-r[jx]);
  }
}

DI void gdn_g1(const Params& p, int j, char* lds) {
  float* Asl = (float*)lds;
  bfr* Tt = (bfr*)(lds + 65536);
  bfr* Kt = (bfr*)(lds + 102400);
  bfr* Qt = (bfr*)(lds + 119808);
  bfr* Vt = (bfr*)(lds + 137216);
  float* gc = (float*)(lds + 154624);
  float* be = (float*)(lds + 155648);
  float* cw = (float*)(lds + 156672);
  const int tid0 = otid();
  bfr* proj = (bfr*)(ows(p) + O_PROJ);
  bfr* KDT = (bfr*)(ows(p) + O_H);
  bfr* ATT = (bfr*)(ows(p) + O_ATTN);
  const bfr* HALO = (const bfr*)(ows(p) + O_HALO);
  bfr* SCR = (bfr*)(ows(p) + O_SCR) + (size_t)obid() * (4 * 2 * 8192);
  const float* AB = (const float*)(ows(p) + O_AB);
  float* EL = (float*)(ows(p) + O_ELAST);
  for (int grp = obid(); grp < 256; grp += gridDim.x) {
    const int bh = grp >> 3, b = bh >> 3, h = bh & 7;
    for (int e = tid0; e < 1536; e += 512) {
      int X = e >> 9, rem = e & 511, tap = rem >> 7, c = rem & 127;
      cw[(X * 4 + tap) * 128 + c] = p.gdn_conv_w[(size_t)(j * 4 + tap) * 3072 + X * 1024 + h * 128 + c];
    }
    bf16x8 nxt[3][5];
    float pfx_g = 0.f, pfx_b = 0.f;
#define G1_RAWLOAD(nn)                                                                                         \
  {                                                                                                            \
    const int rg_ = tid0 >> 4, cgi_ = tid0 & 15, r0_ = rg_ * 2;                                                \
    _Pragma("unroll") for (int X = 0; X < 3; ++X) {                                                            \
      _Pragma("unroll") for (int i = 0; i < 5; ++i) {                                                          \
        const int rr = r0_ - 3 + i;                                                                            \
        if (rr >= 0) nxt[X][i] = *(const bf16x8*)&proj[(size_t)X * PLANE + (size_t)(bh * 4096 + (nn) * 64 + rr) * 128 + cgi_ * 8];   \
        else if ((nn) > 0) nxt[X][i] = *(const bf16x8*)&HALO[((size_t)(b * 64 + (nn) - 1) * 3 + 3 + rr) * 3072 + X * 1024 + h * 128 + cgi_ * 8];   \
        else nxt[X][i] = (bf16x8){0, 0, 0, 0, 0, 0, 0, 0};                                                     \
      }                                                                                                        \
    }                                                                                                          \
  }
    G1_RAWLOAD((grp * 8) & 63);
#pragma unroll 1
    for (int half = 0; half < 2; ++half) {
      {
        int tid = tid0; asm volatile("" : "+v"(tid));
        const int lane = tid & 63, wv = tid >> 6;
        if (half == 0) {
          const int un = grp * 8 + wv, n = un & 63, t0 = b * 4096 + n * 64;
          float a_in = AB[(size_t)(t0 + lane) * 16 + h], b_in = AB[(size_t)(t0 + lane) * 16 + 8 + h];
          float g = -__expf(p.gdn_a_log[j * 8 + h]) * softplusf_(a_in + p.gdn_dt_bias[j * 8 + h]);
#pragma unroll
          for (int off = 1; off < 64; off <<= 1) {
            float v = __shfl_up(g, off);
            if (lane >= off) g += v;
          }
          pfx_g = g; pfx_b = sigmoidf_(b_in);
          if (lane == 63) EL[un] = __expf(g);
          if (wv < 4) { gc[wv * 64 + lane] = pfx_g; be[wv * 64 + lane] = pfx_b; }
        } else if (wv >= 4) {
          gc[(wv - 4) * 64 + lane] = pfx_g; be[(wv - 4) * 64 + lane] = pfx_b;
        }
      }
#pragma unroll 1
      for (int u = 0; u < 4; ++u) {
        const int un = grp * 8 + half * 4 + u, n = un & 63, t0 = b * 4096 + n * 64;
        int tid = tid0; asm volatile("" : "+v"(tid));
        const int lane = tid & 63, wv = tid >> 6, l15 = lane & 15, q = lane >> 4;
        const int rg = tid >> 4, cgi = tid & 15, r0 = rg * 2;
        __syncthreads();
        bf16x8 cur[3][5];
#pragma unroll
        for (int X = 0; X < 3; ++X)
#pragma unroll
          for (int i = 0; i < 5; ++i) cur[X][i] = nxt[X][i];
        if (half * 4 + u < 7) G1_RAWLOAD(n + 1);
#pragma unroll
        for (int X = 0; X < 3; ++X) {
          float val[2][8];
#pragma unroll
          for (int rr = 0; rr < 2; ++rr)
#pragma unroll
            for (int e = 0; e < 8; ++e) {
              float sacc = 0.f;
#pragma unroll
              for (int tp = 0; tp < 4; ++tp) sacc += cw[(X * 4 + tp) * 128 + cgi * 8 + e] * bfe(cur[X][rr + tp], e);
              val[rr][e] = siluf_(sacc);
            }
          if (X < 2) {
#pragma unroll
            for (int rr = 0; rr < 2; ++rr) {
              float ss = 0.f;
#pragma unroll
              for (int e = 0; e < 8; ++e) ss += val[rr][e] * val[rr][e];
              ss = sum16(ss);
              float rn = rsqrtf(ss + EPS);
              if (X == 0) rn *= 0.08838834764831845f;
#pragma unroll
              for (int e = 0; e < 8; ++e) val[rr][e] *= rn;
            }
          }
          bfr* Tile = (X == 0) ? Qt : (X == 1 ? Kt : Vt);
#pragma unroll
          for (int rr = 0; rr < 2; ++rr) {
            const int r = r0 + rr;
            u32x4 pk;
            pk[0] = pack2(val[rr][0], val[rr][1]); pk[1] = pack2(val[rr][2], val[rr][3]);
            pk[2] = pack2(val[rr][4], val[rr][5]); pk[3] = pack2(val[rr][6], val[rr][7]);
            *(u32x4*)&Tile[r * 136 + cgi * 8] = pk;
            if (X == 0) {
              const float eg = __expf(gc[u * 64 + r]);
              pk[0] = pack2(val[rr][0] * eg, val[rr][1] * eg); pk[1] = pack2(val[rr][2] * eg, val[rr][3] * eg);
              pk[2] = pack2(val[rr][4] * eg, val[rr][5] * eg); pk[3] = pack2(val[rr][6] * eg, val[rr][7] * eg);
              *(u32x4*)&proj[(size_t)(bh * 4096 + n * 64 + r) * 128 + cgi * 8] = pk;
            }
          }
        }
        lds_barrier();
        {
          const int mt = wv >> 1;
          f32x4 kk[2], qk[2];
          kk[0] = kk[1] = qk[0] = qk[1] = (f32x4){0.f, 0.f, 0.f, 0.f};
#pragma unroll
          for (int ks = 0; ks < 4; ++ks) {
            bf16x8 ak = *(const bf16x8*)&Kt[(mt * 16 + l15) * 136 + ks * 32 + q * 8];
            bf16x8 aq = *(const bf16x8*)&Qt[(mt * 16 + l15) * 136 + ks * 32 + q * 8];
#pragma unroll
            for (int t2 = 0; t2 < 2; ++t2) {
              int nt = (wv & 1) * 2 + t2;
              bf16x8 bk = *(const bf16x8*)&Kt[(nt * 16 + l15) * 136 + ks * 32 + q * 8];
              kk[t2] = MFMA16(bk, ak, kk[t2]);
              qk[t2] = MFMA16(bk, aq, qk[t2]);
            }
          }
          const int i = mt * 16 + l15;
          const float giv = gc[u * 64 + i], bei = be[u * 64 + i];
#pragma unroll
          for (int t2 = 0; t2 < 2; ++t2) {
            const int m0 = ((wv & 1) * 2 + t2) * 16 + q * 4;
            f32x4 av, tv;
#pragma unroll
            for (int jx = 0; jx < 4; ++jx) {
              const int m = m0 + jx;
              const float d = (i >= m) ? __expf(giv - gc[u * 64 + m]) : 0.f;
              av[jx] = (i > m) ? bei * kk[t2][jx] * d : 0.f;
              tv[jx] = qk[t2][jx] * d;
            }
            *(f32x4*)&Asl[u * 4096 + i * 64 + m0] = av;
            u32x2 pk; pk[0] = pack2(tv[0], tv[1]); pk[1] = pack2(tv[2], tv[3]);
            *(u32x2*)&ATT[(size_t)un * 4096 + i * 64 + m0] = pk;
          }
        }
        {
          const int dd = tid >> 2, tq = tid & 3;
          const float glast = gc[u * 64 + 63];
#pragma unroll
          for (int g8 = 0; g8 < 2; ++g8) {
            const int tok0 = tq * 16 + g8 * 8;
            float okd[8], okb[8], ovb[8];
#pragma unroll
            for (int e = 0; e < 8; ++e) {
              const int tok = tok0 + e;
              const float kv = bf2f(Kt[tok * 136 + dd]), vv = bf2f(Vt[tok * 136 + dd]);
              const float gg = gc[u * 64 + tok], bb = be[u * 64 + tok];
              okd[e] = kv * __expf(glast - gg);
              okb[e] = kv * bb * __expf(gg);
              ovb[e] = vv * bb;
            }
            u32x4 pk;
            pk[0] = pack2(okd[0], okd[1]); pk[1] = pack2(okd[2], okd[3]); pk[2] = pack2(okd[4], okd[5]); pk[3] = pack2(okd[6], okd[7]);
            *(u32x4*)&KDT[(size_t)un * 8192 + dd * 64 + tok0] = pk;
            pk[0] = pack2(okb[0], okb[1]); pk[1] = pack2(okb[2], okb[3]); pk[2] = pack2(okb[4], okb[5]); pk[3] = pack2(okb[6], okb[7]);
            *(u32x4*)&SCR[(u * 2 + 0) * 8192 + dd * 64 + tok0] = pk;
            pk[0] = pack2(ovb[0], ovb[1]); pk[1] = pack2(ovb[2], ovb[3]); pk[2] = pack2(ovb[4], ovb[5]); pk[3] = pack2(ovb[6], ovb[7]);
            *(u32x4*)&SCR[(u * 2 + 1) * 8192 + dd * 64 + tok0] = pk;
          }
        }
      }
      __syncthreads();
      {
      int tid = tid0; asm volatile("" : "+v"(tid));
      const int lane = tid & 63, wv = tid >> 6;
      tri_invert32(Asl + (wv >> 1) * 4096, Tt + (wv >> 1) * 4608, Kt + (wv >> 1) * 1280, wv & 1, lane);
      __syncthreads();
      tri_merge(Asl + (wv >> 1) * 4096, Tt + (wv >> 1) * 4608, Kt + (wv >> 1) * 1280, wv & 1, lane);
      __syncthreads();
      }
      {
        int tid = tid0; asm volatile("" : "+v"(tid));
        const int lane = tid & 63, wv = tid >> 6, l15 = lane & 15, q = lane >> 4;
        bf16x8 bkf[4][2], bvf[4][2];
#pragma unroll
        for (int u = 0; u < 4; ++u)
#pragma unroll
          for (int ks = 0; ks < 2; ++ks) {
            bkf[u][ks] = *(const bf16x8*)&SCR[(u * 2) * 8192 + (wv * 16 + l15) * 64 + ks * 32 + q * 8];
            bvf[u][ks] = *(const bf16x8*)&SCR[(u * 2 + 1) * 8192 + (wv * 16 + l15) * 64 + ks * 32 + q * 8];
          }
#pragma unroll
        for (int u = 0; u < 4; ++u) {
          const int n = (grp * 8 + half * 4 + u) & 63;
          f32x4 aw[4], au[4];
#pragma unroll
          for (int i = 0; i < 4; ++i) aw[i] = au[i] = (f32x4){0.f, 0.f, 0.f, 0.f};
#pragma unroll
          for (int ks = 0; ks < 2; ++ks) {
#pragma unroll
            for (int mt = 0; mt < 4; ++mt) {
              bf16x8 a = *(const bf16x8*)&Tt[u * 4608 + (mt * 16 + l15) * 72 + ks * 32 + q * 8];
              aw[mt] = MFMA16(bkf[u][ks], a, aw[mt]);
              au[mt] = MFMA16(bvf[u][ks], a, au[mt]);
            }
          }
          bfr* Wst = (u & 1) ? Kt : (bfr*)Asl;
          bfr* Ust = Wst + 64 * 136;
#pragma unroll
          for (int mt = 0; mt < 4; ++mt) {
            const int i = mt * 16 + l15, dc = wv * 16 + q * 4;
            u32x2 pk; pk[0] = pack2(aw[mt][0], aw[mt][1]); pk[1] = pack2(aw[mt][2], aw[mt][3]);
            *(u32x2*)&Wst[i * 136 + dc] = pk;
            pk[0] = pack2(au[mt][0], au[mt][1]); pk[1] = pack2(au[mt][2], au[mt][3]);
            *(u32x2*)&Ust[i * 136 + dc] = pk;
          }
          lds_barrier();
#pragma unroll
          for (int k = 0; k < 2; ++k) {
            const int id = tid + 512 * k, row = id >> 4, c16 = id & 15;
            const size_t go = (size_t)(bh * 4096 + n * 64 + row) * 128 + c16 * 8;
            *(u32x4*)&proj[(size_t)PLANE + go] = *(const u32x4*)&Wst[row * 136 + c16 * 8];
            *(u32x4*)&proj[(size_t)2 * PLANE + go] = *(const u32x4*)&Ust[row * 136 + c16 * 8];
          }
        }
      }
      __syncthreads();
    }
  }
#undef G1_RAWLOAD
}

DI void gdn_g2(const Params& p, int j, char* lds) {
  bfr* SbT = (bfr*)lds;
  bfr* VbT = (bfr*)(lds + 4352);
  const int tid = otid(), lane = tid & 63, wv = tid >> 6, l15 = lane & 15, q = lane >> 4;
  const bfr* proj = (const bfr*)(ows(p) + O_PROJ);
  const bfr* KDT = (const bfr*)(ows(p) + O_H);
  const bfr* ATT = (const bfr*)(ows(p) + O_ATTN);
  const float* EL = (const float*)(ows(p) + O_ELAST);
  bfr* OB = (bfr*)(ows(p) + O_SCR);
  for (int unit = obid(); unit < 256; unit += gridDim.x) {
    const int xcd = unit & 7, li = unit >> 3, bh = xcd * 4 + (li >> 3), slice = li & 7;
    const int b = bh >> 3, h = bh & 7;
    const int mt = wv & 3;
    const bool lo = wv < 4;
    const float elv = EL[bh * 64 + lane];
    f32x4 S = (f32x4){0.f, 0.f, 0.f, 0.f};
    for (int e = tid; e < 16 * 136; e += 512) SbT[e] = 0;
    bf16x8 A1s[4][4], K2s[4][2], A2s[4][2];
    unsigned urs[4][4];
    const bfr* pa_u = proj + (lo ? (size_t)PLANE : (size_t)0) + (size_t)bh * 4096 * 128;
    const int pa_o = (mt * 16 + l15) * 128 + q * 8;
    const bfr* pu_u = proj + (size_t)2 * PLANE + (size_t)bh * 4096 * 128 + slice * 16;
    const int pu_o = (mt * 16 + q * 4) * 128 + (l15 & ~1);
    const int ush = (l15 & 1) * 16;
    const bfr* kd_u = KDT + (size_t)bh * 64 * 8192;
    const int kd_o = (wv * 16 + l15) * 64 + q * 8;
    const bfr* at_u = ATT + (size_t)bh * 64 * 4096;
    const int at_o = (mt * 16 + l15) * 64 + q * 8;
#define G2_GLOAD(set, n)                                                                                     \
  {                                                                                                          \
    const bfr* pa_n = pa_u + (size_t)(n) * 64 * 128;                                                         \
    _Pragma("unroll") for (int ks = 0; ks < 4; ++ks) A1s[set][ks] = *(const bf16x8*)&pa_n[pa_o + ks * 32];   \
    const bfr* kd_n = kd_u + (n) * 8192;                                                                     \
    K2s[set][0] = *(const bf16x8*)&kd_n[kd_o];                                                               \
    K2s[set][1] = *(const bf16x8*)&kd_n[kd_o + 32];                                                          \
    if (lo) {                                                                                                \
      const bfr* pu_n = pu_u + (size_t)(n) * 64 * 128;                                                       \
      _Pragma("unroll") for (int jx = 0; jx < 4; ++jx) urs[set][jx] = *(const unsigned*)&pu_n[pu_o + jx * 128];               \
    } else {                                                                                                 \
      const bfr* at_n = at_u + (n) * 4096;                                                                   \
      A2s[set][0] = *(const bf16x8*)&at_n[at_o];                                                             \
      A2s[set][1] = *(const bf16x8*)&at_n[at_o + 32];                                                        \
    }                                                                                                        \
  }
#define G2_STEP(n, rs)                                                                                       \
  {                                                                                                          \
    f32x4 acc = (f32x4){0.f, 0.f, 0.f, 0.f};                                                                 \
    _Pragma("unroll") for (int ks = 0; ks < 4; ++ks) {                                                       \
      bf16x8 sb = *(const bf16x8*)&SbT[l15 * 136 + ks * 32 + q * 8];                                         \
      acc = lo ? MFMA16(A1s[rs][ks], sb, acc) : MFMA16(sb, A1s[rs][ks], acc);     \
    }                                                                                                        \
    if (lo) {                                                                                                \
      u32x2 pk;                                                                                              \
      pk[0] = pack2(bf2f((bfr)(urs[rs][0] >> ush)) - acc[0], bf2f((bfr)(urs[rs][1] >> ush)) - acc[1]);       \
      pk[1] = pack2(bf2f((bfr)(urs[rs][2] >> ush)) - acc[2], bf2f((bfr)(urs[rs][3] >> ush)) - acc[3]);       \
      *(u32x2*)&VbT[l15 * 72 + mt * 16 + q * 4] = pk;                                                        \
    }                                                                                                        \
    lds_barrier();                                                                                           \
    bf16x8 vb0 = *(const bf16x8*)&VbT[l15 * 72 + q * 8];                                                     \
    bf16x8 vb1 = *(const bf16x8*)&VbT[l15 * 72 + 32 + q * 8];                                                \
    if (!lo) {                                                                                               \
      acc = MFMA16(vb0, A2s[rs][0], acc);                                                                    \
      acc = MFMA16(vb1, A2s[rs][1], acc);                                                                    \
      u32x2 ok; ok[0] = pack2(acc[0], acc[1]); ok[1] = pack2(acc[2], acc[3]);                                \
      *(u32x2*)&OB[((size_t)(b * 4096 + (n) * 64) + mt * 16 + l15) * 1024 + h * 128 + slice * 16 + q * 4] = ok;  \
    }                                                                                                        \
    const float el = __shfl(elv, (n));                                                                       \
    S = S * el;                                                                                              \
    S = MFMA16(K2s[rs][0], vb0, S);                                                                          \
    S = MFMA16(K2s[rs][1], vb1, S);                                                                          \
    {                                                                                                        \
      u32x2 pk;                                                                                              \
      pk[0] = pack2(S[0], S[1]);                                                                             \
      pk[1] = pack2(S[2], S[3]);                                                                             \
      *(u32x2*)&SbT[l15 * 136 + wv * 16 + q * 4] = pk;                                                       \
    }                                                                                                        \
    if ((n) + 4 < 64) G2_GLOAD(rs, (n) + 4);                                                                 \
    lds_barrier();                                                                                           \
  }
    G2_GLOAD(0, 0);
    G2_GLOAD(1, 1);
    G2_GLOAD(2, 2);
    G2_GLOAD(3, 3);
    __syncthreads();
#pragma unroll 1
    for (int n = 0; n < 64; n += 4) {
      G2_STEP(n, 0);
      G2_STEP(n + 1, 1);
      G2_STEP(n + 2, 2);
      G2_STEP(n + 3, 3);
    }
#undef G2_GLOAD
#undef G2_STEP
  }
}

DI void gdn_g2l(const Params& p, int j, char* lds) {
  constexpr int STG = 51200;
  bfr* SbT = (bfr*)(lds + 3 * STG);
  bfr* VbT = (bfr*)(lds + 3 * STG + 4352);
  const int tid = otid(), lane = tid & 63, wv = tid >> 6, l15 = lane & 15, q = lane >> 4;
  const bfr* proj = (const bfr*)(ows(p) + O_PROJ);
  const bfr* KDT = (const bfr*)(ows(p) + O_H);
  const bfr* ATT = (const bfr*)(ows(p) + O_ATTN);
  const float* EL = (const float*)(ows(p) + O_ELAST);
  bfr* OB = (bfr*)(ows(p) + O_SCR);
  for (int unit = obid(); unit < 256; unit += gridDim.x) {
    const int xcd = unit & 7, li = unit >> 3, bh = xcd * 4 + (li >> 3), slice = li & 7;
    const int b = bh >> 3, h = bh & 7;
    const bool loader = wv >= 4;
    for (int e = tid; e < 16 * 136; e += 512) SbT[e] = 0;
    if (loader) {
      const int lw = __builtin_amdgcn_readfirstlane(wv - 4);
      const bfr* wq_u = proj + (size_t)bh * 4096 * 128;
      const bfr* kd_u = KDT + (size_t)bh * 64 * 8192;
      const int lo_wq = (lane >> 2) * 128 + (lane & 3) * 8, lo_kd = (lane >> 2) * 64 + (lane & 3) * 8;
      const bfr* u_u = proj + (size_t)2 * PLANE + (size_t)bh * 4096 * 128 + slice * 16 + (lw * 32 + (lane >> 1)) * 128 + (lane & 1) * 8;
#define G2L_DMA(c, stg)                                                                                      \
  {                                                                                                          \
    const int cc = (c) < 64 ? (c) : 63;                                                                      \
    const bfr* wq_c = wq_u + (size_t)cc * 64 * 128;                                                          \
    const bfr* kd_c = kd_u + (size_t)cc * 8192;                                                              \
    _Pragma("unroll") for (int i = 0; i < 12; ++i) {                                                         \
      const int blk = lw * 12 + i, X = blk >> 4, idx = blk & 15;                                             \
      const bfr* g = (X == 2) ? (kd_c + ((idx >> 1) * 16 * 64 + (idx & 1) * 32) + lo_kd)                     \
                              : (wq_c + (X == 0 ? (size_t)PLANE : (size_t)0) + ((idx >> 2) * 16 * 128 + (idx & 3) * 32) + lo_wq);  \
      __builtin_amdgcn_global_load_lds((const unsigned*)g, (PG8_LAS unsigned*)(lds + (stg) * STG + blk * 1024), 16, 0, 0);  \
    }                                                                                                        \
    if (lw < 2) __builtin_amdgcn_global_load_lds((const unsigned*)(u_u + (size_t)cc * 64 * 128), (PG8_LAS unsigned*)(lds + (stg) * STG + (48 + lw) * 1024), 16, 0, 0);  \
  }
#define G2L_WAITPREV() { if (lw < 2) asm volatile("s_waitcnt vmcnt(13)" ::: "memory"); else asm volatile("s_waitcnt vmcnt(12)" ::: "memory"); }
      G2L_DMA(0, 0);
      G2L_DMA(1, 1);
      G2L_WAITPREV();
      lds_barrier();
#pragma unroll 1
      for (int n = 0; n < 64; n += 3) {
#pragma unroll
        for (int s3 = 0; s3 < 3; ++s3) {
          if (n + s3 < 64) {
            G2L_DMA(n + s3 + 2, (s3 + 2) % 3);
            lds_barrier();
            G2L_WAITPREV();
            lds_barrier();
          }
        }
      }
      asm volatile("s_waitcnt vmcnt(0)" ::: "memory");
#undef G2L_DMA
#undef G2L_WAITPREV
    } else {
      const int mt = wv;
      const float elv = EL[bh * 64 + lane];
      f32x4 S0 = (f32x4){0.f, 0.f, 0.f, 0.f}, S1 = S0;
      bf16x8 At[4][2];
      const bfr* at_u = ATT + (size_t)bh * 64 * 4096 + (mt * 16 + l15) * 64 + q * 8;
#define G2L_GLOAD(set, c)                                                                                    \
  {                                                                                                          \
    const int cc = (c) < 64 ? (c) : 63;                                                                      \
    At[set][0] = *(const bf16x8*)&at_u[cc * 4096];                                                           \
    At[set][1] = *(const bf16x8*)&at_u[cc * 4096 + 32];                                                      \
  }
#define G2L_STEP(n, stg, rs)                                                                                 \
  {                                                                                                          \
    const char* sb_ = lds + (stg) * STG + l15 * 64 + q * 16;                                                 \
    f32x4 accp = (f32x4){0.f, 0.f, 0.f, 0.f}, acco = accp;                                                   \
    if ((n) > 0) {     \
      accd = MFMA16(vbd0, Atd0, accd);                                                                       \
      accd = MFMA16(vbd1, Atd1, accd);                                                                       \
      u32x2 ok; ok[0] = pack2(accd[0], accd[1]); ok[1] = pack2(accd[2], accd[3]);                            \
      *(u32x2*)&OB[((size_t)(b * 4096 + ((n) - 1) * 64) + mt * 16 + l15) * 1024 + h * 128 + slice * 16 + q * 4] = ok;  \
    }                                                                                                        \
    _Pragma("unroll") for (int ks = 0; ks < 4; ++ks) {                                                       \
      const bf16x8 sb = *(const bf16x8*)&SbT[l15 * 136 + ks * 32 + q * 8];                                   \
      accp = MFMA16(*(const bf16x8*)(sb_ + (mt * 4 + ks) * 1024), sb, accp);                                 \
      acco = MFMA16(sb, *(const bf16x8*)(sb_ + (16 + mt * 4 + ks) * 1024), acco);     \
    }                                                                                                        \
    {                                                                                                        \
      u32x2 pk;                                                                                              \
      const bfr* up_ = (const bfr*)(lds + (stg) * STG + 48 * 1024) + (mt * 16 + q * 4) * 16 + l15;           \
      pk[0] = pack2(bf2f(up_[0]) - accp[0], bf2f(up_[16]) - accp[1]);                                        \
      pk[1] = pack2(bf2f(up_[32]) - accp[2], bf2f(up_[48]) - accp[3]);                                       \
      *(u32x2*)&VbT[l15 * 72 + mt * 16 + q * 4] = pk;                                                        \
    }                                                                                                        \
    lds_barrier();                                                                                           \
    const bf16x8 vb0 = *(const bf16x8*)&VbT[l15 * 72 + q * 8];                                               \
    const bf16x8 vb1 = *(const bf16x8*)&VbT[l15 * 72 + 32 + q * 8];                                          \
    accd = acco; vbd0 = vb0; vbd1 = vb1; Atd0 = At[rs][0]; Atd1 = At[rs][1];                                 \
    const float el = __uint_as_float(__builtin_amdgcn_readlane(__float_as_uint(elv), (n)));       \
    S0 = S0 * el; S1 = S1 * el;                                                                              \
    S0 = MFMA16(*(const bf16x8*)(sb_ + (32 + (2 * mt) * 2 + 0) * 1024), vb0, S0);                            \
    S0 = MFMA16(*(const bf16x8*)(sb_ + (32 + (2 * mt) * 2 + 1) * 1024), vb1, S0);                            \
    S1 = MFMA16(*(const bf16x8*)(sb_ + (32 + (2 * mt + 1) * 2 + 0) * 1024), vb0, S1);                        \
    S1 = MFMA16(*(const bf16x8*)(sb_ + (32 + (2 * mt + 1) * 2 + 1) * 1024), vb1, S1);                        \
    {                                                                                                        \
      u32x2 pk;                                                                                              \
      pk[0] = pack2(S0[0], S0[1]); pk[1] = pack2(S0[2], S0[3]);                                              \
      *(u32x2*)&SbT[l15 * 136 + (2 * mt) * 16 + q * 4] = pk;                                                 \
      pk[0] = pack2(S1[0], S1[1]); pk[1] = pack2(S1[2], S1[3]);                                              \
      *(u32x2*)&SbT[l15 * 136 + (2 * mt + 1) * 16 + q * 4] = pk;                                             \
    }                                                                                                        \
    G2L_GLOAD(rs, (n) + 4);                                                                                  \
    lds_barrier();                                                                                           \
  }
      G2L_GLOAD(0, 0);
      G2L_GLOAD(1, 1);
      G2L_GLOAD(2, 2);
      G2L_GLOAD(3, 3);
      f32x4 accd = (f32x4){0.f, 0.f, 0.f, 0.f};
      bf16x8 vbd0 = (bf16x8){0, 0, 0, 0, 0, 0, 0, 0}, vbd1 = vbd0, Atd0 = vbd0, Atd1 = vbd0;
      lds_barrier();
#pragma unroll 1
      for (int n = 0; n < 60; n += 12) {
        G2L_STEP(n, 0, 0); G2L_STEP(n + 1, 1, 1); G2L_STEP(n + 2, 2, 2); G2L_STEP(n + 3, 0, 3);
        G2L_STEP(n + 4, 1, 0); G2L_STEP(n + 5, 2, 1); G2L_STEP(n + 6, 0, 2); G2L_STEP(n + 7, 1, 3);
        G2L_STEP(n + 8, 2, 0); G2L_STEP(n + 9, 0, 1); G2L_STEP(n + 10, 1, 2); G2L_STEP(n + 11, 2, 3);
      }
      G2L_STEP(60, 0, 0); G2L_STEP(61, 1, 1); G2L_STEP(62, 2, 2); G2L_STEP(63, 0, 3);
      {
        accd = MFMA16(vbd0, Atd0, accd);
        accd = MFMA16(vbd1, Atd1, accd);
        u32x2 ok; ok[0] = pack2(accd[0], accd[1]); ok[1] = pack2(accd[2], accd[3]);
        *(u32x2*)&OB[((size_t)(b * 4096 + 63 * 64) + mt * 16 + l15) * 1024 + h * 128 + slice * 16 + q * 4] = ok;
      }
#undef G2L_GLOAD
#undef G2L_STEP
    }
    __syncthreads();
  }
}

DI void gdn_g3(const Params& p, int j, char* lds) {
  const int tid = otid(), lane = tid & 63, wv = tid >> 6, l15 = lane & 15, q = lane >> 4;
  const bfr* proj = (const bfr*)(ows(p) + O_PROJ);
  bfr* OB = (bfr*)(ows(p) + O_SCR);
  f32x4 g0 = *(const f32x4*)&p.gdn_onorm_g[j * 128 + l15 * 8], g1 = *(const f32x4*)&p.gdn_onorm_g[j * 128 + l15 * 8 + 4];
  const int stride = gridDim.x * 32;
  int pi = (obid() * 8 + wv) * 4 + q;
  bf16x8 ov, zv;
#define G3_LOAD(pp)                                                                                                  \
  {                                                                                                                  \
    const int t_ = (pp) >> 3, h_ = (pp) & 7;                                                                         \
    ov = __builtin_nontemporal_load((const bf16x8*)&OB[(size_t)t_ * 1024 + h_ * 128 + l15 * 8]);                     \
    zv = __builtin_nontemporal_load((const bf16x8*)&proj[(size_t)3 * PLANE + (size_t)(((t_ >> 12) * 8 + h_) * 4096 + (t_ & 4095)) * 128 + l15 * 8]);  \
  }
  bf16x8 ov2 = (bf16x8){0, 0, 0, 0, 0, 0, 0, 0}, zv2 = ov2;
  if (pi < 131072) G3_LOAD(pi);
  if (pi + stride < 131072) { const bf16x8 o1 = ov, z1 = zv; G3_LOAD(pi + stride); ov2 = ov; zv2 = zv; ov = o1; zv = z1; }
  for (; pi < 131072; pi += stride) {
    const int t = pi >> 3, h = pi & 7;
    const bf16x8 oc = ov, zc = zv;
    ov = ov2; zv = zv2;
    if (pi + 2 * stride < 131072) { const bf16x8 o1 = ov, z1 = zv; G3_LOAD(pi + 2 * stride); ov2 = ov; zv2 = zv; ov = o1; zv = z1; }
    float o[8], ss = 0.f;
#pragma unroll
    for (int e = 0; e < 8; ++e) { o[e] = bfe(oc, e); ss += o[e] * o[e]; }
    ss = sum16(ss);
    const float rstd = rsqrtf(ss * (1.f / 128.f) + EPS);
    float y[8];
#pragma unroll
    for (int e = 0; e < 8; ++e) y[e] = o[e] * rstd * (e < 4 ? g0[e] : g1[e - 4]) * siluf_(bfe(zc, e));
    u32x4 pk;
    pk[0] = pack2(y[0], y[1]); pk[1] = pack2(y[2], y[3]); pk[2] = pack2(y[4], y[5]); pk[3] = pack2(y[6], y[7]);
    *(u32x4*)&OB[(size_t)t * 1024 + h * 128 + l15 * 8] = pk;
  }
#undef G3_LOAD
}


#define XB_TMO      128
#define XB_XCNT(j)  (256  + 64 * (j))
#define XB_XSUB(j)  (1280 + 64 * (j))
#define XB_XGEN(j)  (2304 + 64 * (j))
#define XB_TOP      3328
#define XB_TOPGEN   3392
#define XCD_BAR_WORDS 3456
#define XB_SPIN_CAP (1u << 18)
#define LAS __attribute__((address_space(3)))

__device__ __forceinline__ unsigned xb_ld(unsigned* p)              { return __hip_atomic_load(p, __ATOMIC_RELAXED, __HIP_MEMORY_SCOPE_AGENT); }
__device__ __forceinline__ unsigned xb_add(unsigned* p, unsigned v) { return __hip_atomic_fetch_add(p, v, __ATOMIC_RELAXED, __HIP_MEMORY_SCOPE_AGENT); }
__device__ __forceinline__ unsigned xb_xcc_id() { return (unsigned)__builtin_amdgcn_s_getreg((3 << 11) | 20) & 0xFu; }
#define XB_SPIN(cond, bar) do { unsigned _sp = 0; while (cond) { __builtin_amdgcn_s_sleep(1); \
    if ((++_sp & 255u) == 0u) { if (xb_ld(&(bar)[XB_TMO])) break; if (_sp > XB_SPIN_CAP) { atomicAdd(&(bar)[XB_TMO], 1u); break; } } } } while (0)

struct XcdBarrier {
    unsigned* bar; unsigned x;
    volatile LAS unsigned* st;
};

__device__ __forceinline__ XcdBarrier xcd_barrier_post(unsigned* bar, volatile LAS unsigned* st) {
    XcdBarrier b; b.bar = bar; b.x = xb_xcc_id(); b.st = st;
    if (threadIdx.x == 0) (void)xb_add(&bar[XB_XCNT(b.x)], 1u);
    return b;
}
__device__ __forceinline__ void xcd_barrier_complete(unsigned* bar, unsigned x, unsigned& nloc, unsigned& nx) {
    const unsigned G = gridDim.x * gridDim.y * gridDim.z;
    unsigned sum, cnt, mine, sp = 0u;
    for (;;) {
        sum = 0u; cnt = 0u; mine = 0u;
#pragma unroll
        for (unsigned j = 0; j < 16; ++j) { const unsigned c = xb_ld(&bar[XB_XCNT(j)]); sum += c; cnt += (c > 0u) ? 1u : 0u; mine = (j == x) ? c : mine; }
        if (sum == G) break;
        __builtin_amdgcn_s_sleep(1);
        if ((++sp & 255u) == 0u) { if (xb_ld(&bar[XB_TMO])) break; if (sp > XB_SPIN_CAP) { atomicAdd(&bar[XB_TMO], 1u); break; } }
    }
    nloc = mine > 0u ? mine : 1u; nx = cnt > 0u ? cnt : 1u;
}

__device__ __forceinline__ void xcd_barrier(const XcdBarrier& b) {
    asm volatile("s_waitcnt vmcnt(0)" ::: "memory");
    __syncthreads();
    if (threadIdx.x == 0) {
        unsigned* bar = b.bar;
        __builtin_amdgcn_s_waitcnt(0);
        unsigned nloc = b.st[0], nx = b.st[1];
        if (nloc == 0u) { xcd_barrier_complete(bar, b.x, nloc, nx); b.st[0] = nloc; b.st[1] = nx; }
        const unsigned old = xb_add(&bar[XB_XSUB(b.x)], 1u);
        const unsigned gen = old / nloc;
        if (old + 1u == (gen + 1u) * nloc) {
            __builtin_amdgcn_fence(__ATOMIC_RELEASE, "agent");
            asm volatile("s_waitcnt vmcnt(0)" ::: "memory");
            const unsigned og = xb_add(&bar[XB_TOP], 1u);
            const unsigned tg = og / nx;
            if (og + 1u == (tg + 1u) * nx) xb_add(&bar[XB_TOPGEN], 1u);
            else XB_SPIN(xb_ld(&bar[XB_TOPGEN]) == tg, bar);
            __builtin_amdgcn_fence(__ATOMIC_ACQUIRE, "agent");
            xb_add(&bar[XB_XGEN(b.x)], 1u);
            asm volatile("s_waitcnt vmcnt(0)" ::: "memory");
        } else {
            XB_SPIN(xb_ld(&bar[XB_XGEN(b.x)]) == gen, bar);
            __builtin_amdgcn_fence(__ATOMIC_ACQUIRE, "agent");
            asm volatile("s_waitcnt vmcnt(0)" ::: "memory");
        }
    }
    __syncthreads();
}


DI void run_phase(const Params& p, int ph, char* lds) {
  if (ph == 0) { phase0(p, lds); return; }
  if (ph == NPHASE - 1) { norm_phase(p, 4, ows(p) + O_H, lds); return; }
  int layer, sub;
  if (ph < 5) { layer = 0; sub = ph - 1; }
  else if (ph < 11) { layer = 1; sub = ph - 5; }
  else if (ph < 15) { layer = 2; sub = ph - 11; }
  else { layer = 3; sub = ph - 15; }
  const int j = layer >> 1;
  const bool is_lru = (layer & 1) == 0;
  const bfr* H = (const bfr*)(ows(p) + O_H);
  const void* xcur = (layer == 0) ? (const void*)p.x : (const void*)p.out;
  bfr* xnext = (layer == 3) ? (bfr*)(ows(p) + O_H) : (bfr*)p.out;
  if (is_lru) {
    switch (sub) {
      case 0: norm_phase(p, layer, xcur, lds); break;
      case 1: gemm_phase<0>(p, H, 1024, (const bfr*)(ows(p) + O_WLI) + (size_t)j * 2048 * 1024, 8, layer, nullptr, nullptr, lds); break;
      case 2: lru_phase(p, j, lds); break;
      case 3: gemm_phase<2>(p, H, 1024, (const bfr*)(ows(p) + O_WLO) + (size_t)j * 1024 * 1024, 4, layer, xcur, xnext, lds); break;
    }
  } else {
    switch (sub) {
      case 0: norm_phase(p, layer, xcur, lds); break;
      case 1: gemm_phase<1>(p, H, 1024, (const bfr*)(ows(p) + O_WGI) + (size_t)j * 4224 * 1024, 16, layer, nullptr, nullptr, lds); break;
      case 2: gdn_g1(p, j, lds); break;
#if G2_LOADER
      case 3: gdn_g2l(p, j, lds); break;
#else
      case 3: gdn_g2(p, j, lds); break;
#endif
      case 4: gdn_g3(p, j, lds); break;
      case 5: gemm_phase<2>(p, (const bfr*)(ows(p) + O_SCR), 1024, (const bfr*)(ows(p) + O_WGO) + (size_t)j * 1024 * 1024, 4, layer, xcur, xnext, lds); break;
    }
  }
}

__global__ void __launch_bounds__(512) mega_fwd(Params p) {
  extern __shared__ __attribute__((aligned(16))) char lds[];
#if MK_MODE == 1
  cg::grid_group grid = cg::this_grid();
  if (p.ph_lo < 0) grid.sync();
  volatile LAS unsigned* bst = (volatile LAS unsigned*)(lds + LDS_BYTES - 16);
  if (threadIdx.x == 0) { bst[0] = 0u; bst[1] = 0u; }
  __syncthreads();
  const XcdBarrier xb = xcd_barrier_post((unsigned*)(p.ws + O_BAR), bst);
  for (int ph = p.ph_lo; ph < p.ph_hi; ++ph) {
    if (ph > p.ph_lo) xcd_barrier(xb);
#ifdef PROBE_MASK
    const bool probe = (PROBE_MASK >> ph) & 1;
    long long ts = 0;
    if (probe) ts = wall_clock64();
#endif
    run_phase(p, ph, lds);
#ifdef PROBE_MASK
    if (probe) {
      xcd_barrier(xb);
      if (blockIdx.x == 0 && threadIdx.x == 0) {
        long long dt = wall_clock64() - ts, t1 = wall_clock64();
        while (wall_clock64() - t1 < dt) __builtin_amdgcn_s_sleep(8);
      }
    }
#endif
  }
#else
  for (int ph = p.ph_lo; ph < p.ph_hi; ++ph) run_phase(p, ph, lds);
#endif
}

extern "C" void kernel_launch(void* const* d_in, const int* in_sizes, int n_in, void* d_out, int out_size, void* d_ws, size_t ws_size, hipStream_t stream) {
  static int grid = 0;
  if (grid == 0) {
    if (n_in != 19 || ws_size < WS_END) { fprintf(stderr, "kernel_launch: unexpected inputs (n_in %d, ws %zu)\n", n_in, ws_size); grid = -1; return; }
    int dev = 0, cus = 0, per_cu = 0;
    hipGetDevice(&dev);
    hipDeviceGetAttribute(&cus, hipDeviceAttributeMultiprocessorCount, dev);
    if (hipFuncSetAttribute((const void*)mega_fwd, hipFuncAttributeMaxDynamicSharedMemorySize, LDS_BYTES) != hipSuccess) { fprintf(stderr, "kernel_launch: hipFuncSetAttribute failed\n"); grid = -1; return; }
    hipOccupancyMaxActiveBlocksPerMultiprocessor(&per_cu, (const void*)mega_fwd, 512, LDS_BYTES);
    if (per_cu < 1) { fprintf(stderr, "kernel_launch: occupancy query returned %d\n", per_cu); per_cu = 1; }
    (void)hipGetLastError();
    grid = cus * per_cu;
    if (grid > 256) grid = 256;
  }
  if (grid < 0) return;
  Params p{};
  const float** pp = (const float**)&p;
  for (int i = 0; i < 19; ++i) pp[i] = (const float*)d_in[i];
  p.out = (float*)d_out;
  p.ws = (char*)d_ws;
#if MK_MODE == 1
  p.ph_lo = 0; p.ph_hi = NPHASE;
  if (hipMemsetAsync((char*)d_ws + O_BAR, 0, 16384, stream) != hipSuccess) { fprintf(stderr, "kernel_launch: memset of barrier words failed\n"); return; }
  void* args[] = {&p};
  hipError_t e = hipLaunchCooperativeKernel((const void*)mega_fwd, dim3(grid), dim3(512), args, LDS_BYTES, stream);
  if (e != hipSuccess) fprintf(stderr, "cooperative launch failed: %s (grid %d)\n", hipGetErrorString(e), grid);
#else
  for (int ph = 0; ph < NPHASE; ++ph) {
    p.ph_lo = ph; p.ph_hi = ph + 1;
    hipLaunchKernelGGL(mega_fwd, dim3(grid), dim3(512), LDS_BYTES, stream, p);
  }
#endif
}
```

```cpp
#include <hip/hip_runtime.h>
#include <hip/hip_cooperative_groups.h>
#include <cstdio>
namespace cg = cooperative_groups;

#ifndef G2_LOADER
#define G2_LOADER 1
#endif
#ifndef MK_MODE
#define MK_MODE 1
#endif

typedef unsigned short bfr;
typedef __attribute__((ext_vector_type(8))) short bf16x8;
typedef __attribute__((ext_vector_type(4))) short bf16x4;
typedef __attribute__((ext_vector_type(4))) float f32x4;
typedef __attribute__((ext_vector_type(4))) unsigned u32x4;
typedef __attribute__((ext_vector_type(2))) unsigned u32x2;

#define DI __device__ __forceinline__
#define MFMA16(a, b, c) __builtin_amdgcn_mfma_f32_16x16x32_bf16((a), (b), (c), 0, 0, 0)

constexpr int PLANE = 16384 * 1024;
constexpr float EPS = 1e-6f;
constexpr int NPHASE = 22;
constexpr int LDS_BYTES = 163840;

constexpr size_t O_WLI = 0;
constexpr size_t O_WLO = 8388608;
constexpr size_t O_WGI = 12582912;
constexpr size_t O_WGO = 29884416;
constexpr size_t O_WG = 34078720;
constexpr size_t O_CONDP = 35127296;
constexpr size_t O_H = 36700160;
constexpr size_t O_PROJ = 70254592;
constexpr size_t O_ATTN = 204996608;
constexpr size_t O_HALO = 221773824;
constexpr size_t O_SCR = 226492416;
constexpr size_t O_AB = 260046848;
constexpr size_t O_ELAST = 261095424;
constexpr size_t O_AGG = 261103616;
constexpr size_t O_COND = 263200768;
constexpr size_t O_BAR = 263397376;
constexpr size_t WS_END = 263397376 + 16384;

struct Params {
  const float *x, *c, *ada_w, *ada_b, *norm_g, *final_g;
  const float *lru_in_w, *lru_conv_w, *lru_conv_b, *lru_gate_w, *lru_gate_b, *lru_lambda, *lru_out_w;
  const float *gdn_in_w, *gdn_conv_w, *gdn_a_log, *gdn_dt_bias, *gdn_onorm_g, *gdn_out_w;
  float* out;
  char* ws;
  int ph_lo, ph_hi;
};

DI int otid() { int t = threadIdx.x; asm volatile("" : "+v"(t)); return t; }
DI int obid() { int b = blockIdx.x; asm volatile("" : "+s"(b)); return b; }
DI void lds_barrier() { asm volatile("s_waitcnt lgkmcnt(0)" ::: "memory"); __builtin_amdgcn_s_barrier(); asm volatile("" ::: "memory"); }
typedef float f32x2_t __attribute__((ext_vector_type(2)));
typedef __bf16 bf16x2_t __attribute__((ext_vector_type(2)));
DI unsigned pack2(float a, float b) { f32x2_t v = {a, b}; bf16x2_t r = __builtin_convertvector(v, bf16x2_t); return __builtin_bit_cast(unsigned, r); }
DI bfr f2bf(float x) { return (bfr)(pack2(x, x) & 0xffffu); }
DI float bf2f(bfr b) { return __uint_as_float(((unsigned)b) << 16); }
DI float sum16(float x) {
  x += __uint_as_float(__builtin_amdgcn_update_dpp(0, __float_as_uint(x), 0xB1, 0xF, 0xF, true));
  x += __uint_as_float(__builtin_amdgcn_update_dpp(0, __float_as_uint(x), 0x4E, 0xF, 0xF, true));
  x += __uint_as_float(__builtin_amdgcn_update_dpp(0, __float_as_uint(x), 0x141, 0xF, 0xF, true));
  x += __uint_as_float(__builtin_amdgcn_update_dpp(0, __float_as_uint(x), 0x140, 0xF, 0xF, true));
  return x;
}
DI float sigmoidf_(float x) { return __builtin_amdgcn_rcpf(1.f + __expf(-x)); }
DI float siluf_(float x) { return x * __builtin_amdgcn_rcpf(1.f + __expf(-x)); }
DI float softplusf_(float x) { return x > 20.f ? x : log1pf(expf(x)); }
DI float bfe(const bf16x8& v, int e) { return bf2f((bfr)v[e]); }

DI char* ows(const Params& p) { size_t z = 0; asm volatile("" : "+s"(z)); return p.ws + z; }
DI float cond_get(const Params& p, int layer, int b, int n) {
  const float* cp = (const float*)(ows(p) + O_CONDP);
  float s = p.ada_b[layer * 3072 + n];
#pragma unroll
  for (int sg = 0; sg < 8; ++sg) s += cp[((sg * 4 + layer) * 4 + b) * 3072 + n];
  return s;
}

DI void transpose_tile(const float* __restrict__ src, int ldsrc, int nvalid, bfr* __restrict__ dst, int ldd, int k0, int n0, float* sm) {
  const int tid = otid();
  for (int e = tid; e < 4096; e += 512) {
    int kk = e >> 6, nn = e & 63;
    float v = 0.f;
    if (n0 + nn < nvalid) v = src[(size_t)(k0 + kk) * ldsrc + n0 + nn];
    sm[kk * 65 + nn] = v;
  }
  __syncthreads();
  for (int e = tid; e < 4096; e += 512) {
    int nn = e >> 6, kk = e & 63;
    dst[(size_t)(n0 + nn) * ldd + k0 + kk] = f2bf(sm[kk * 65 + nn]);
  }
  __syncthreads();
}

struct P0Item { const float* src; bfr* dst; int ldsrc, nvalid, ldd, k0, n0; };
DI P0Item p0_decode(const Params& p, int it) {
  P0Item r;
  if (it < 1024) {
    int l = it >> 9, q = it & 511, kt = q >> 5, nt = q & 31;
    r.src = p.lru_in_w + (size_t)l * 1024 * 2048; r.ldsrc = 2048; r.nvalid = 2048; r.dst = (bfr*)(ows(p) + O_WLI) + (size_t)l * 2048 * 1024; r.ldd = 1024; r.k0 = kt * 64; r.n0 = nt * 64;
  } else if (it < 1536) {
    int r0 = it - 1024, l = r0 >> 8, q = r0 & 255, kt = q >> 4, nt = q & 15;
    r.src = p.lru_out_w + (size_t)l * 1024 * 1024; r.ldsrc = 1024; r.nvalid = 1024; r.dst = (bfr*)(ows(p) + O_WLO) + (size_t)l * 1024 * 1024; r.ldd = 1024; r.k0 = kt * 64; r.n0 = nt * 64;
  } else if (it < 3648) {
    int r0 = it - 1536, l = r0 / 1056, q = r0 % 1056, kt = q / 66, nt = q % 66;
    r.src = p.gdn_in_w + (size_t)l * 1024 * 4112; r.ldsrc = 4112; r.nvalid = 4112; r.dst = (bfr*)(ows(p) + O_WGI) + (size_t)l * 4224 * 1024; r.ldd = 1024; r.k0 = kt * 64; r.n0 = nt * 64;
  } else if (it < 4160) {
    int r0 = it - 3648, l = r0 >> 8, q = r0 & 255, kt = q >> 4, nt = q & 15;
    r.src = p.gdn_out_w + (size_t)l * 1024 * 1024; r.ldsrc = 1024; r.nvalid = 1024; r.dst = (bfr*)(ows(p) + O_WGO) + (size_t)l * 1024 * 1024; r.ldd = 1024; r.k0 = kt * 64; r.n0 = nt * 64;
  } else {
    int r0 = it - 4160, mat = r0 >> 2, q = r0 & 3, kt = q >> 1, nt = q & 1;
    r.src = p.lru_gate_w + (size_t)mat * 16384; r.ldsrc = 128; r.nvalid = 128; r.dst = (bfr*)(ows(p) + O_WG) + (size_t)mat * 16384; r.ldd = 128; r.k0 = kt * 64; r.n0 = nt * 64;
  }
  return r;
}

DI void phase0(const Params& p, char* lds) {
  float* sm = (float*)lds;
  const int tid = otid();
  float v[8];
#define P0_LOAD(it_)                                                                                 \
  {                                                                                                  \
    const P0Item t_ = p0_decode(p, (it_));                                                           \
    _Pragma("unroll") for (int i = 0; i < 8; ++i) {                                                  \
      const int e = tid + 512 * i, kk = e >> 6, nn = e & 63;                                         \
      v[i] = (t_.n0 + nn < t_.nvalid) ? __builtin_nontemporal_load(&t_.src[(size_t)(t_.k0 + kk) * t_.ldsrc + t_.n0 + nn]) : 0.f; \
    }                                                                                                \
  }
  if (obid() < 4288) P0_LOAD(obid());
#pragma unroll 1
  for (int it = obid(); it < 4288; it += gridDim.x) {
    const P0Item t = p0_decode(p, it);
#pragma unroll
    for (int i = 0; i < 8; ++i) { const int e = tid + 512 * i; sm[(e >> 6) * 65 + (e & 63)] = v[i]; }
    lds_barrier();
    if (it + (int)gridDim.x < 4288) P0_LOAD(it + gridDim.x);
#pragma unroll
    for (int i = 0; i < 4; ++i) {
      const int e = tid + 512 * i, nn = e >> 5, kp = e & 31;
      *(unsigned*)&t.dst[(size_t)(t.n0 + nn) * t.ldd + t.k0 + 2 * kp] = pack2(sm[(2 * kp) * 65 + nn], sm[(2 * kp + 1) * 65 + nn]);
    }
    lds_barrier();
  }
#undef P0_LOAD
  __syncthreads();
  for (int r0 = obid(); r0 < 192; r0 += gridDim.x) {
    int i = r0 / 48, r = r0 % 48, sg = r / 6, cb = r % 6;
    sm[tid] = siluf_(p.c[(tid >> 7) * 1024 + sg * 128 + (tid & 127)]);
    __syncthreads();
    int n = cb * 512 + tid;
    float a0 = 0.f, a1 = 0.f, a2 = 0.f, a3 = 0.f;
    const float* w = p.ada_w + ((size_t)i * 1024 + sg * 128) * 3072 + n;
#pragma unroll 32
    for (int k = 0; k < 128; ++k) {
      float wv = __builtin_nontemporal_load(&w[(size_t)k * 3072]);
      a0 += sm[k] * wv; a1 += sm[128 + k] * wv; a2 += sm[256 + k] * wv; a3 += sm[384 + k] * wv;
    }
    float* cp = (float*)(ows(p) + O_CONDP);
    cp[((sg * 4 + i) * 4 + 0) * 3072 + n] = a0;
    cp[((sg * 4 + i) * 4 + 1) * 3072 + n] = a1;
    cp[((sg * 4 + i) * 4 + 2) * 3072 + n] = a2;
    cp[((sg * 4 + i) * 4 + 3) * 3072 + n] = a3;
    __syncthreads();
  }
}

DI void norm_phase(const Params& p, int layer, const void* __restrict__ xsrc, char* lds) {
  const float* xs = (const float*)xsrc; const bfr* xsb = (const bfr*)xsrc;
  float* gm = (float*)lds;
  float* sh = gm + 1024;
  const int tid = otid(), lane = tid & 63, wv = tid >> 6;
  bfr* H = (bfr*)(ows(p) + O_H);
  if (layer == 0) {
    float* cd = (float*)(ows(p) + O_COND);
    for (int e = obid() * 512 + tid; e < 4 * 4 * 3072; e += gridDim.x * 512) {
      int n = e % 3072, ib = e / 3072;
      cd[e] = cond_get(p, ib >> 2, ib & 3, n);
    }
  }
  const float* cd = (const float*)(ows(p) + O_COND);
  for (int rt = obid(); rt < 256; rt += gridDim.x) {
    int b = rt >> 6;
    for (int c = tid; c < 1024; c += 512) {
      if (layer == 0) {
        float scale = cond_get(p, layer, b, 1024 + c), shift = cond_get(p, layer, b, c);
        gm[c] = p.norm_g[layer * 1024 + c] * (1.f + scale);
        sh[c] = shift;
      } else if (layer < 4) {
        gm[c] = p.norm_g[layer * 1024 + c] * (1.f + cd[(size_t)(layer * 4 + b) * 3072 + 1024 + c]);
        sh[c] = cd[(size_t)(layer * 4 + b) * 3072 + c];
      } else {
        gm[c] = p.final_g[c];
        sh[c] = 0.f;
      }
    }
    __syncthreads();
    u32x2 rb[2][4][4];
    if (layer != 0) {
#pragma unroll
      for (int g = 0; g < 2; ++g)
#pragma unroll
        for (int r = 0; r < 4; ++r)
#pragma unroll
          for (int jx = 0; jx < 4; ++jx) rb[g][r][jx] = *(const u32x2*)&xsb[((size_t)rt * 64 + wv * 8 + g * 4 + r) * 1024 + jx * 256 + lane * 4];
    }
#pragma unroll
    for (int r4 = 0; r4 < 8; r4 += 4) {
      f32x4 v[4][4];
#pragma unroll
      for (int r = 0; r < 4; ++r)
#pragma unroll
        for (int jx = 0; jx < 4; ++jx) {
          const size_t xi = ((size_t)rt * 64 + wv * 8 + r4 + r) * 1024 + jx * 256 + lane * 4;
          if (layer == 0) v[r][jx] = *(const f32x4*)&xs[xi];
          else {
            const u32x2 xb = rb[r4 >> 2][r][jx];
            v[r][jx] = (f32x4){__uint_as_float(xb[0] << 16), __uint_as_float(xb[0] & 0xffff0000u), __uint_as_float(xb[1] << 16), __uint_as_float(xb[1] & 0xffff0000u)};
          }
        }
#pragma unroll
      for (int r = 0; r < 4; ++r) {
        const size_t row = (size_t)rt * 64 + wv * 8 + r4 + r;
        float ss = 0.f;
#pragma unroll
        for (int jx = 0; jx < 4; ++jx) ss += v[r][jx][0] * v[r][jx][0] + v[r][jx][1] * v[r][jx][1] + v[r][jx][2] * v[r][jx][2] + v[r][jx][3] * v[r][jx][3];
        ss = sum16(ss);
        ss += __shfl_xor(ss, 16);
        ss += __shfl_xor(ss, 32);
        const float rstd = rsqrtf(ss * (1.f / 1024.f) + EPS);
#pragma unroll
        for (int jx = 0; jx < 4; ++jx) {
          const int c = jx * 256 + lane * 4;
          f32x4 g4 = *(const f32x4*)&gm[c], s4 = *(const f32x4*)&sh[c];
          f32x4 y;
#pragma unroll
          for (int e = 0; e < 4; ++e) y[e] = v[r][jx][e] * rstd * g4[e] + s4[e];
          if (layer < 4) {
            u32x2 o2; o2[0] = pack2(y[0], y[1]); o2[1] = pack2(y[2], y[3]);
            *(u32x2*)&H[row * 1024 + c] = o2;
          } else {
            __builtin_nontemporal_store(y, (f32x4*)&p.out[row * 1024 + c]);
          }
        }
      }
    }
    __syncthreads();
  }
}

namespace pg8 {
#define PG8_LAS __attribute__((address_space(3)))
typedef unsigned short bf16_t;
typedef short bf16x8 __attribute__((ext_vector_type(8)));
typedef float f32x4 __attribute__((ext_vector_type(4)));
typedef unsigned u32x4 __attribute__((ext_vector_type(4)));
constexpr int BM = 256, BK = 64, HALF = 128, HTB = HALF * BK * 2  , STAGE_BYTES = 8 * HTB, NXCD = 8, WGM = 8;

__host__ __device__ __forceinline__ int lds_byte(int r, int c) { const int st = (r >> 4) * 2 + (c >> 5), rr = r & 15, cc = c & 31, ob = rr * 64 + cc * 2; return st * 1024 + (ob ^ (((ob >> 9) & 1) << 5)); }
__host__ __device__ __forceinline__ void stage_rc(int b, int& R, int& C) { const int st = b / 1024, sb = b % 1024, swz = sb ^ (((sb >> 9) & 1) << 5); R = (st >> 1) * 16 + swz / 64; C = (st & 1) * 32 + (swz % 64) / 2; }
__host__ __device__ __forceinline__ int perm32(int rho) { const int n = rho >> 4, i = rho & 15; return 8 * (i >> 2) + 4 * n + (i & 3); }

struct Unit { int pm, pn; };
struct Gemm { const bf16_t* A; const bf16_t* Bt; int M, N, K; };

struct StaticOrder {
    int nM, nN, nwg, G, c;
    __host__ __device__ void init(int M, int N, int G_, int c_) { nM = M / BM; nN = N / BM; nwg = nM * nN; G = G_; c = c_; }
    __host__ __device__ bool next(int i, Unit& u) const {
        const long L = (long)i * G + c; if (L >= nwg) return false;
        int wgid = (int)L; { const int q = nwg / NXCD, r = nwg % NXCD, xcd = wgid % NXCD, off = wgid / NXCD; wgid = (xcd < r ? xcd * (q + 1) : r * (q + 1) + (xcd - r) * q) + off; }
        const int nig = WGM * nN, gid = wgid / nig, fm = gid * WGM, gsz = (nM - fm) < WGM ? (nM - fm) : WGM;
        u.pm = fm + ((wgid % nig) % gsz); u.pn = (wgid % nig) / gsz; return true;
    }
    __device__ __forceinline__ void a_ready(const Unit&) const {}
    __device__ __forceinline__ void done(const Unit&) const {}
};
__device__ __forceinline__ unsigned cvt_pk_bf16(float lo, float hi) { unsigned r; asm volatile("v_cvt_pk_bf16_f32 %0, %1, %2" : "=v"(r) : "v"(lo), "v"(hi)); return r; }

template <class Epi, class Sched, bool STAMP = false>
__device__ __forceinline__ void gemm_phase(PG8_LAS unsigned char* lds, const Gemm g, const Sched& S, const Epi& E, unsigned long long* stamps) {
    const int tid = otid(), wid = __builtin_amdgcn_readfirstlane(tid >> 6), lane = tid & 63, wr = wid >> 2, wc = wid & 3, fr = lane & 15, fq = lane >> 4;
    const int K = g.K, nt = K / BK;
    int ts_lo = 0, ts_hi = 0, nts = 0; const unsigned long long rt_entry = STAMP ? (unsigned long long)wall_clock64() : 0ull;
#define PG8_STAMP() do { if (STAMP && wid == 0 && nts < 64) { const unsigned long long _c = (unsigned long long)clock64(); \
        ts_lo = (lane == nts) ? (int)(unsigned)_c : ts_lo; ts_hi = (lane == nts) ? (int)(unsigned)(_c >> 32) : ts_hi; ++nts; } } while (0)
    PG8_STAMP();
    unsigned voffA[2], voffB[2];
#pragma unroll
    for (int i = 0; i < 2; ++i) { int R, C; stage_rc(tid * 16 + i * 8192, R, C); const int Rb = Epi::PERM ? ((R & ~31) + perm32(R & 31)) : R;
        voffA[i] = (unsigned)(R * K + C) * 2u; voffB[i] = (unsigned)(Rb * K + C) * 2u; }
    const size_t kstep = (size_t)(BK * 2);
    const size_t hstep = (size_t)HALF * K * 2;
    const size_t tstep = 2 * hstep;
    const unsigned ldsw = (unsigned)wid * 1024u;
    const int aoff = lds_byte(wr * 64 + fr, fq * 8), boff = lds_byte(wc * 32 + fr, fq * 8);
#define PG8_SA(b, h) (((b) * 2 + (h)) * HTB)
#define PG8_SB(b, h) ((4 + (b) * 2 + (h)) * HTB)
#define PG8_STAGE(bufoff, gbase, voff) do { _Pragma("unroll") for (int _i = 0; _i < 2; ++_i) \
        __builtin_amdgcn_global_load_lds((const unsigned*)((const char*)(gbase) + (voff)[_i]), (PG8_LAS unsigned*)(lds + (bufoff) + ldsw + _i * 8192), 16, 0, 0); } while (0)
#define PG8_LDA(dst, b, h) do { _Pragma("unroll") for (int m = 0; m < 4; ++m) _Pragma("unroll") for (int k = 0; k < 2; ++k) dst[m][k] = *(const PG8_LAS bf16x8*)(lds + PG8_SA(b, h) + aoff + m * 2048 + k * 1024); } while (0)
#define PG8_LDB(dst, b, h) do { _Pragma("unroll") for (int n = 0; n < 2; ++n) _Pragma("unroll") for (int k = 0; k < 2; ++k) dst[n][k] = *(const PG8_LAS bf16x8*)(lds + PG8_SB(b, h) + boff + n * 2048 + k * 1024); } while (0)
#define PG8_MMA(ai, bj, At, Bt) do { __builtin_amdgcn_s_setprio(1); _Pragma("unroll") for (int m = 0; m < 4; ++m) _Pragma("unroll") for (int n = 0; n < 2; ++n) _Pragma("unroll") for (int k = 0; k < 2; ++k) \
        acc[ai][bj][m][n] = __builtin_amdgcn_mfma_f32_16x16x32_bf16(Bt[n][k], At[m][k], acc[ai][bj][m][n], 0, 0, 0); __builtin_amdgcn_s_setprio(0); } while (0)
#define PG8_WAIT_V(n) asm volatile("s_waitcnt vmcnt(" #n ")" ::: "memory")
#define PG8_WAIT_L(n) asm volatile("s_waitcnt lgkmcnt(" #n ")" ::: "memory")
#define PG8_BAR __builtin_amdgcn_s_barrier()
#define PG8_SCHED __builtin_amdgcn_sched_barrier(0)
    Unit cur, nxt; int ui = 0;
    if (!S.next(0, cur)) return;
    f32x4 acc[2][2][4][2];
#pragma unroll
    for (int a = 0; a < 2; ++a)
#pragma unroll
        for (int b = 0; b < 2; ++b)
#pragma unroll
            for (int m = 0; m < 4; ++m)
#pragma unroll
                for (int n = 0; n < 2; ++n) acc[a][b][m][n] = (f32x4){0.f, 0.f, 0.f, 0.f};
    bf16x8 At[4][2], B0[2][2], B1[2][2];
    const char* cA = (const char*)g.A + (size_t)cur.pm * tstep; const char* cB = (const char*)g.Bt + (size_t)cur.pn * tstep;
    S.a_ready(cur);
    PG8_STAGE(PG8_SB(0, 0), cB, voffB); PG8_STAGE(PG8_SA(0, 0), cA, voffA); PG8_STAGE(PG8_SB(0, 1), cB + hstep, voffB); PG8_STAGE(PG8_SA(0, 1), cA + hstep, voffA);
    if (wr == 1) PG8_BAR;
    PG8_WAIT_V(4); PG8_BAR;
    PG8_STAGE(PG8_SB(1, 0), cB + kstep, voffB); PG8_STAGE(PG8_SA(1, 0), cA + kstep, voffA); PG8_STAGE(PG8_SB(1, 1), cB + hstep + kstep, voffB);
    PG8_WAIT_V(6); PG8_BAR;
    PG8_STAMP();
    for (;;) {
        const bool has_next = S.next(ui + 1, nxt);
        const char* nA = has_next ? (const char*)g.A + (size_t)nxt.pm * tstep : cA; const char* nB = has_next ? (const char*)g.Bt + (size_t)nxt.pn * tstep : cB;
        for (int t = 0; t < nt; t += 2) {
            const bool last = (t == nt - 2);
            const char* a1 = cA + (size_t)(t + 1) * kstep;
            const char* a2 = last ? nA : cA + (size_t)(t + 2) * kstep; const char* b2 = last ? nB : cB + (size_t)(t + 2) * kstep;
            const char* a3 = a2 + kstep; const char* b3 = b2 + kstep;
            if (last && has_next) S.a_ready(nxt);
            PG8_LDB(B0, 0, 0); PG8_SCHED; PG8_LDA(At, 0, 0); PG8_STAGE(PG8_SA(1, 1), a1 + hstep, voffA);
            PG8_WAIT_L(8); PG8_BAR; PG8_WAIT_L(0); PG8_MMA(0, 0, At, B0); PG8_BAR; PG8_SCHED;
            PG8_LDB(B1, 0, 1); PG8_STAGE(PG8_SB(0, 0), b2, voffB);
            PG8_BAR; PG8_WAIT_L(0); PG8_MMA(0, 1, At, B1); PG8_BAR;
            PG8_LDA(At, 0, 1); PG8_STAGE(PG8_SA(0, 0), a2, voffA);
            PG8_BAR; PG8_WAIT_L(0); PG8_MMA(1, 0, At, B0); PG8_BAR; PG8_SCHED;
            PG8_STAGE(PG8_SB(0, 1), b2 + hstep, voffB);
            PG8_WAIT_V(6); PG8_BAR; PG8_MMA(1, 1, At, B1); PG8_BAR;
            PG8_LDB(B0, 1, 0); PG8_SCHED; PG8_LDA(At, 1, 0); PG8_STAGE(PG8_SA(0, 1), a2 + hstep, voffA);
            PG8_WAIT_L(8); PG8_BAR; PG8_WAIT_L(0); PG8_MMA(0, 0, At, B0); PG8_BAR; PG8_SCHED;
            PG8_LDB(B1, 1, 1); PG8_STAGE(PG8_SB(1, 0), b3, voffB);
            PG8_BAR; PG8_WAIT_L(0); PG8_MMA(0, 1, At, B1); PG8_BAR;
            PG8_LDA(At, 1, 1); PG8_STAGE(PG8_SA(1, 0), a3, voffA);
            PG8_BAR; PG8_WAIT_L(0); PG8_MMA(1, 0, At, B0); PG8_BAR; PG8_SCHED;
            PG8_STAGE(PG8_SB(1, 1), b3 + hstep, voffB);
            PG8_WAIT_V(6); PG8_BAR; PG8_MMA(1, 1, At, B1); PG8_BAR;
        }
        PG8_STAMP();
        if constexpr (!Epi::AFTER_DRAIN) { E(acc, cur, wr, wc, fr, fq); S.done(cur); }
        PG8_STAMP();
        if (!has_next) break;
#pragma unroll
        for (int a = 0; a < 2; ++a)
#pragma unroll
            for (int b = 0; b < 2; ++b)
#pragma unroll
                for (int m = 0; m < 4; ++m)
#pragma unroll
                    for (int n = 0; n < 2; ++n) acc[a][b][m][n] = (f32x4){0.f, 0.f, 0.f, 0.f};
        cur = nxt; cA = nA; cB = nB; ++ui;
    }
    PG8_WAIT_V(0);
    if (wr == 0) PG8_BAR;
    PG8_BAR;
    if constexpr (Epi::AFTER_DRAIN) { E.fused(acc, cur, wr, wc, fr, fq, lds, wid, lane); S.done(cur); }
    PG8_STAMP();
    if (STAMP && wid == 0) { stamps[lane] = lane < nts ? (((unsigned long long)(unsigned)ts_hi << 32) | (unsigned)ts_lo) : 0ull;
        if (lane == 62) stamps[62] = rt_entry; if (lane == 63) stamps[63] = (unsigned long long)wall_clock64(); }
#undef PG8_STAMP
#undef PG8_SA
#undef PG8_SB
#undef PG8_STAGE
#undef PG8_LDA
#undef PG8_LDB
#undef PG8_MMA
#undef PG8_WAIT_V
#undef PG8_WAIT_L
#undef PG8_BAR
#undef PG8_SCHED
}
}

struct EpiProjBf16 {
  static constexpr bool PERM = true, AFTER_DRAIN = false;
  bfr* O; bfr* halo;
  __device__ __forceinline__ void operator()(const f32x4 (&acc)[2][2][4][2], const pg8::Unit& u, int wr, int wc, int fr, int fq) const {
    const int row0 = u.pm * 256 + wr * 64 + fr, col0 = u.pn * 256 + wc * 32 + 8 * fq;
#pragma unroll
    for (int ai = 0; ai < 2; ++ai)
#pragma unroll
      for (int m = 0; m < 4; ++m) {
        const int row = row0 + ai * 128 + m * 16;
        const int bb = row >> 12, ts = row & 4095;
#pragma unroll
        for (int bj = 0; bj < 2; ++bj) {
          const int col = col0 + bj * 128;
          const f32x4 v0 = acc[ai][bj][m][0], v1 = acc[ai][bj][m][1];
          u32x4 w; w.x = pack2(v0[0], v0[1]); w.y = pack2(v0[2], v0[3]); w.z = pack2(v1[0], v1[1]); w.w = pack2(v1[2], v1[3]);
          *(u32x4*)(O + (size_t)(col >> 10) * PLANE + ((size_t)((bb * 8 + ((col >> 7) & 7)) * 4096 + ts)) * 128 + (col & 127)) = w;
          if (halo && (row & 63) >= 61 && col < 3072)
            *(u32x4*)(halo + ((size_t)(row >> 6) * 3 + ((row & 63) - 61)) * 3072 + col) = w;
        }
      }
  }
};
struct EpiResid {
  static constexpr bool PERM = true, AFTER_DRAIN = false;
  bfr* out; const void* xin; int xin_f32; const float* gate;
  __device__ __forceinline__ void operator()(const f32x4 (&acc)[2][2][4][2], const pg8::Unit& u, int wr, int wc, int fr, int fq) const {
    const int row0 = u.pm * 256 + wr * 64 + fr, col0 = u.pn * 256 + wc * 32 + 8 * fq;
    const float* gp = gate + (size_t)((u.pm * 256) >> 12) * 3072 + col0;
    f32x4 gv[2][2];
#pragma unroll
    for (int bj = 0; bj < 2; ++bj)
#pragma unroll
      for (int n = 0; n < 2; ++n) gv[bj][n] = *(const f32x4*)(gp + bj * 128 + n * 4);
#pragma unroll
    for (int ai = 0; ai < 2; ++ai)
#pragma unroll
      for (int m = 0; m < 4; ++m) {
        const size_t ro = (size_t)(row0 + ai * 128 + m * 16) * 1024 + col0;
#pragma unroll
        for (int bj = 0; bj < 2; ++bj) {
          f32x4 x0, x1;
          if (xin_f32) {
            x0 = __builtin_nontemporal_load((const f32x4*)((const float*)xin + ro + bj * 128));
            x1 = __builtin_nontemporal_load((const f32x4*)((const float*)xin + ro + bj * 128 + 4));
          } else {
            const u32x4 xb = *(const u32x4*)((const bfr*)xin + ro + bj * 128);
            x0 = (f32x4){__uint_as_float(xb[0] << 16), __uint_as_float(xb[0] & 0xffff0000u), __uint_as_float(xb[1] << 16), __uint_as_float(xb[1] & 0xffff0000u)};
            x1 = (f32x4){__uint_as_float(xb[2] << 16), __uint_as_float(xb[2] & 0xffff0000u), __uint_as_float(xb[3] << 16), __uint_as_float(xb[3] & 0xffff0000u)};
          }
          const f32x4 v0 = x0 + gv[bj][0] * acc[ai][bj][m][0], v1 = x1 + gv[bj][1] * acc[ai][bj][m][1];
          u32x4 w; w.x = pack2(v0[0], v0[1]); w.y = pack2(v0[2], v0[3]); w.z = pack2(v1[0], v1[1]); w.w = pack2(v1[2], v1[3]);
          *(u32x4*)(out + ro + bj * 128) = w;
        }
      }
  }
};

template <int EPI>
DI void gemm_phase(const Params& p, const bfr* __restrict__ A, int lda, const bfr* __restrict__ Bt, int nN, int layer, const void* __restrict__ xin, bfr* __restrict__ xout, char* lds) {
  pg8::Gemm g; g.A = A; g.Bt = Bt; g.M = 16384; g.N = nN * 256; g.K = 1024;
  pg8::StaticOrder S; S.init(g.M, g.N, gridDim.x, obid());
  if (EPI == 2) {
    EpiResid E; E.out = xout; E.xin = xin; E.xin_f32 = (layer == 0) ? 1 : 0; E.gate = (const float*)(ows(p) + O_COND) + (size_t)layer * 4 * 3072 + 2048;
    pg8::gemm_phase<EpiResid, pg8::StaticOrder, false>((PG8_LAS unsigned char*)lds, g, S, E, nullptr);
  } else {
    EpiProjBf16 E; E.O = (bfr*)(ows(p) + O_PROJ); E.halo = (EPI == 1) ? (bfr*)(ows(p) + O_HALO) : nullptr;
    pg8::gemm_phase<EpiProjBf16, pg8::StaticOrder, false>((PG8_LAS unsigned char*)lds, g, S, E, nullptr);
  }
  if (EPI == 1) {
    __syncthreads();
    float* red = (float*)lds;
    const int tid = otid(), lane = tid & 63, wv = tid >> 6, l15 = lane & 15, q = lane >> 4;
    const int mt4 = wv & 3, kh = wv >> 2;
    for (int rt = obid(); rt < 256; rt += gridDim.x) {
      const bfr* Ar = A + (size_t)(rt * 64 + mt4 * 16 + l15) * lda + kh * 512 + q * 8;
      const bfr* Br = Bt + (size_t)(4096 + l15) * 1024 + kh * 512 + q * 8;
      f32x4 acc = (f32x4){0.f, 0.f, 0.f, 0.f};
#pragma unroll 4
      for (int ks = 0; ks < 16; ++ks) acc = MFMA16(*(const bf16x8*)(Ar + ks * 32), *(const bf16x8*)(Br + ks * 32), acc);
      if (kh == 1) *(f32x4*)&red[(mt4 * 64 + lane) * 4] = acc;
      __syncthreads();
      if (kh == 0) {
        f32x4 o = *(const f32x4*)&red[(mt4 * 64 + lane) * 4];
#pragma unroll
        for (int jx = 0; jx < 4; ++jx) ((float*)(ows(p) + O_AB))[(size_t)(rt * 64 + mt4 * 16 + q * 4 + jx) * 16 + l15] = acc[jx] + o[jx];
      }
      __syncthreads();
    }
  }
}

DI void lru_phase(const Params& p, int j, char* lds) {
  const int tid = otid(), lane = tid & 63, wv = tid >> 6, l15 = lane & 15, q = lane >> 4;
  bfr* Xw = (bfr*)lds + wv * (32 * 136);
  float* WAgg = (float*)(lds + 8 * 32 * 136 * 2);
  const bfr* proj = (const bfr*)(ows(p) + O_PROJ);
  bfr* Yb = (bfr*)(ows(p) + O_H);
  const bfr* WG = (const bfr*)(ows(p) + O_WG);
  for (int unit = obid(); unit < 256; unit += gridDim.x) {
    const int xcd = unit & 7, li = unit >> 3, idx = xcd * 4 + (li >> 3), sl = li & 7, b = idx >> 3, gb = idx & 7;
    const int ch = gb * 128 + sl * 16 + l15;
    bf16x8 Bf[2][4];
#pragma unroll
    for (int kq = 0; kq < 2; ++kq)
#pragma unroll
      for (int ks = 0; ks < 4; ++ks) Bf[kq][ks] = *(const bf16x8*)&WG[(size_t)((j * 2 + kq) * 8 + gb) * 16384 + (sl * 16 + l15) * 128 + ks * 32 + q * 8];
    const float gbr = p.lru_gate_b[(j * 2) * 1024 + ch], gbi = p.lru_gate_b[(j * 2 + 1) * 1024 + ch];
    const float sp = softplusf_(-p.lru_lambda[j * 1024 + ch]);
    const int cg = lane & 15, rs = lane >> 4, ccol = gb * 128 + cg * 8;
    float cwv[4][8], cb[8];
#pragma unroll
    for (int tp = 0; tp < 4; ++tp)
#pragma unroll
      for (int e = 0; e < 8; ++e) cwv[tp][e] = p.lru_conv_w[(size_t)(j * 4 + tp) * 1024 + ccol + e];
#pragma unroll
    for (int e = 0; e < 8; ++e) cb[e] = p.lru_conv_b[j * 1024 + ccol + e];
    const bfr* xb_u = proj + (size_t)(b * 8 + gb) * 4096 * 128;
    bfr* yb_u = Yb + (size_t)b * 4096 * 1024;
    const int xo = (wv * 32 + rs * 8 - 3) * 128 + cg * 8;
    const int zo = PLANE + (wv * 32 + q * 4) * 128 + sl * 16 + (l15 & ~1);
    const int zsh = (l15 & 1) * 16;
    const int yo = (wv * 32 + q * 4) * 1024 + ch;
    float carry = 0.f;
    bf16x8 raw[11];
    unsigned zr[8];
#define LRU_LOAD(it)                                                                                   \
  {                                                                                                    \
    const bfr* xit = xb_u + (it) * (256 * 128);                                                        \
    _Pragma("unroll") for (int i = 0; i < 11; ++i) {                                                   \
      const int t = (it) * 256 + wv * 32 + rs * 8 - 3 + i;                                             \
      if (t >= 0) raw[i] = *(const bf16x8*)&xit[xo + i * 128];                                         \
      else raw[i] = (bf16x8){0, 0, 0, 0, 0, 0, 0, 0};                                                  \
    }                                                                                                  \
    _Pragma("unroll") for (int mt = 0; mt < 2; ++mt) _Pragma("unroll") for (int jx = 0; jx < 4; ++jx)  \
      zr[mt * 4 + jx] = *(const unsigned*)&xit[zo + (mt * 16 + jx) * 128];                                               \
  }
    LRU_LOAD(0);
#pragma unroll 1
    for (int it = 0; it < 16; ++it) {
#pragma unroll
      for (int r = 0; r < 8; ++r) {
        float o[8];
#pragma unroll
        for (int e = 0; e < 8; ++e) {
          float s = cb[e];
#pragma unroll
          for (int tp = 0; tp < 4; ++tp) s += cwv[tp][e] * bfe(raw[r + tp], e);
          o[e] = s;
        }
        u32x4 pk; pk[0] = pack2(o[0], o[1]); pk[1] = pack2(o[2], o[3]); pk[2] = pack2(o[4], o[5]); pk[3] = pack2(o[6], o[7]);
        *(u32x4*)&Xw[(rs * 8 + r) * 136 + cg * 8] = pk;
      }
      float zc[8];
#pragma unroll
      for (int i = 0; i < 8; ++i) zc[i] = bf2f((bfr)(zr[i] >> zsh));
      if (it < 15) LRU_LOAD(it + 1);
      f32x4 accr[2], acci[2];
#pragma unroll
      for (int mt = 0; mt < 2; ++mt) {
        accr[mt] = acci[mt] = (f32x4){0.f, 0.f, 0.f, 0.f};
#pragma unroll
        for (int ks = 0; ks < 4; ++ks) {
          bf16x8 af = *(const bf16x8*)&Xw[(mt * 16 + l15) * 136 + ks * 32 + q * 8];
          accr[mt] = MFMA16(af, Bf[0][ks], accr[mt]);
          acci[mt] = MFMA16(af, Bf[1][ks], acci[mt]);
        }
      }
      float av[2][4], bv[2][4];
      float Aex[2], Bex[2], At[2], Bt_[2];
#pragma unroll
      for (int mt = 0; mt < 2; ++mt) {
        float Al = 1.f, Bl = 0.f;
#pragma unroll
        for (int jx = 0; jx < 4; ++jx) {
          const float r = sigmoidf_(accr[mt][jx] + gbr), ig = sigmoidf_(acci[mt][jx] + gbi);
          const float a = __expf(-8.f * r * sp);
          const float mult = __builtin_amdgcn_sqrtf(fmaxf(1.f - a * a, 0.f));
          const float xf = bf2f(Xw[(mt * 16 + q * 4 + jx) * 136 + sl * 16 + l15]);
          const float bt = mult * ig * xf;
          av[mt][jx] = a; bv[mt][jx] = bt;
          Bl = a * Bl + bt; Al *= a;
        }
        float Ai = Al, Bi = Bl;
#pragma unroll
        for (int off = 16; off < 64; off <<= 1) {
          const float Ap = __shfl_up(Ai, off), Bp = __shfl_up(Bi, off);
          if (lane >= off) { Bi = Ai * Bp + Bi; Ai = Ai * Ap; }
        }
        float Ae = __shfl_up(Ai, 16), Be = __shfl_up(Bi, 16);
        if (q == 0) { Ae = 1.f; Be = 0.f; }
        Aex[mt] = Ae; Bex[mt] = Be;
        At[mt] = __shfl(Ai, 48 + l15); Bt_[mt] = __shfl(Bi, 48 + l15);
      }
      float* wa = WAgg + (it & 1) * 256;
      if (q == 0) { wa[(wv * 16 + l15) * 2] = At[0] * At[1]; wa[(wv * 16 + l15) * 2 + 1] = At[1] * Bt_[0] + Bt_[1]; }
      lds_barrier();
      float cin = carry, cnew = carry;
#pragma unroll
      for (int w = 0; w < 8; ++w) {
        const float Aw = wa[(w * 16 + l15) * 2], Bw = wa[(w * 16 + l15) * 2 + 1];
        cnew = Aw * cnew + Bw;
        if (w < wv) cin = Aw * cin + Bw;
      }
      carry = cnew;
      bfr* yit = yb_u + it * (256 * 1024);
#pragma unroll
      for (int mt = 0; mt < 2; ++mt) {
        float h = Aex[mt] * cin + Bex[mt];
#pragma unroll
        for (int jx = 0; jx < 4; ++jx) {
          h = av[mt][jx] * h + bv[mt][jx];
          yit[yo + (mt * 16 + jx) * 1024] = f2bf(h * siluf_(zc[mt * 4 + jx]));
        }
        cin = At[mt] * cin + Bt_[mt];
      }
    }
#undef LRU_LOAD
  }
}

DI bf16x8 ld_perm(const bfr* base) {
  u32x2 lo = *(const u32x2*)base, hi = *(const u32x2*)(base + 16);
  u32x4 r; r[0] = lo[0]; r[1] = lo[1]; r[2] = hi[0]; r[3] = hi[1];
  return __builtin_bit_cast(bf16x8, r);
}
DI bf16x8 pack_cc(const f32x4& a, const f32x4& b) {
  u32x4 r; r[0] = pack2(a[0], a[1]); r[1] = pack2(a[2], a[3]); r[2] = pack2(b[0], b[1]); r[3] = pack2(b[2], b[3]);
  return __builtin_bit_cast(bf16x8, r);
}


template <int NL> DI void row_load(f32x4 (&a)[8], unsigned addr, float& dep) {
  if constexpr (NL == 1) asm volatile("ds_read_b128 %0, %2\n\ts_waitcnt lgkmcnt(0)" : "=&v"(a[0]), "+v"(dep) : "v"(addr) : "memory");
  if constexpr (NL == 2) asm volatile("ds_read_b128 %0, %3\n\tds_read_b128 %1, %3 offset:16\n\ts_waitcnt lgkmcnt(0)" : "=&v"(a[0]), "=&v"(a[1]), "+v"(dep) : "v"(addr) : "memory");
  if constexpr (NL == 3) asm volatile("ds_read_b128 %0, %4\n\tds_read_b128 %1, %4 offset:16\n\tds_read_b128 %2, %4 offset:32\n\ts_waitcnt lgkmcnt(0)" : "=&v"(a[0]), "=&v"(a[1]), "=&v"(a[2]), "+v"(dep) : "v"(addr) : "memory");
  if constexpr (NL == 4) asm volatile("ds_read_b128 %0, %5\n\tds_read_b128 %1, %5 offset:16\n\tds_read_b128 %2, %5 offset:32\n\tds_read_b128 %3, %5 offset:48\n\ts_waitcnt lgkmcnt(0)" : "=&v"(a[0]), "=&v"(a[1]), "=&v"(a[2]), "=&v"(a[3]), "+v"(dep) : "v"(addr) : "memory");
  if constexpr (NL == 5) asm volatile("ds_read_b128 %0, %6\n\tds_read_b128 %1, %6 offset:16\n\tds_read_b128 %2, %6 offset:32\n\tds_read_b128 %3, %6 offset:48\n\tds_read_b128 %4, %6 offset:64\n\ts_waitcnt lgkmcnt(0)" : "=&v"(a[0]), "=&v"(a[1]), "=&v"(a[2]), "=&v"(a[3]), "=&v"(a[4]), "+v"(dep) : "v"(addr) : "memory");
  if constexpr (NL == 6) asm volatile("ds_read_b128 %0, %7\n\tds_read_b128 %1, %7 offset:16\n\tds_read_b128 %2, %7 offset:32\n\tds_read_b128 %3, %7 offset:48\n\tds_read_b128 %4, %7 offset:64\n\tds_read_b128 %5, %7 offset:80\n\ts_waitcnt lgkmcnt(0)" : "=&v"(a[0]), "=&v"(a[1]), "=&v"(a[2]), "=&v"(a[3]), "=&v"(a[4]), "=&v"(a[5]), "+v"(dep) : "v"(addr) : "memory");
  if constexpr (NL == 7) asm volatile("ds_read_b128 %0, %8\n\tds_read_b128 %1, %8 offset:16\n\tds_read_b128 %2, %8 offset:32\n\tds_read_b128 %3, %8 offset:48\n\tds_read_b128 %4, %8 offset:64\n\tds_read_b128 %5, %8 offset:80\n\tds_read_b128 %6, %8 offset:96\n\ts_waitcnt lgkmcnt(0)" : "=&v"(a[0]), "=&v"(a[1]), "=&v"(a[2]), "=&v"(a[3]), "=&v"(a[4]), "=&v"(a[5]), "=&v"(a[6]), "+v"(dep) : "v"(addr) : "memory");
  if constexpr (NL == 8) asm volatile("ds_read_b128 %0, %9\n\tds_read_b128 %1, %9 offset:16\n\tds_read_b128 %2, %9 offset:32\n\tds_read_b128 %3, %9 offset:48\n\tds_read_b128 %4, %9 offset:64\n\tds_read_b128 %5, %9 offset:80\n\tds_read_b128 %6, %9 offset:96\n\tds_read_b128 %7, %9 offset:112\n\ts_waitcnt lgkmcnt(0)" : "=&v"(a[0]), "=&v"(a[1]), "=&v"(a[2]), "=&v"(a[3]), "=&v"(a[4]), "=&v"(a[5]), "=&v"(a[6]), "=&v"(a[7]), "+v"(dep) : "v"(addr) : "memory");
}
template <int I> DI void inv_rows(float (&t)[32], unsigned abase, int j) {
  if constexpr (I < 32) {
    float s = (I == j) ? 1.f : 0.f;
    if constexpr (I > 0) {
      f32x4 a[8];
      row_load<(I + 3) / 4>(a, abase + I * 256, t[I - 1]);
#pragma unroll
      for (int m4 = 0; m4 < I; m4 += 4) {
        s -= a[m4 >> 2][0] * t[m4];
        if (m4 + 1 < I) s -= a[m4 >> 2][1] * t[m4 + 1];
        if (m4 + 2 < I) s -= a[m4 >> 2][2] * t[m4 + 2];
        if (m4 + 3 < I) s -= a[m4 >> 2][3] * t[m4 + 3];
      }
    }
    t[I] = s;
    inv_rows<I + 1>(t, abase, j);
  }
}
DI void tri_invert32(const float* __restrict__ Au, bfr* __restrict__ Ttu, bfr* __restrict__ Tcu, int hf, int lane) {
  const int j = lane & 31;
  const float* Ab = Au + (32 * hf) * 64 + 32 * hf;
  float t[32];
  const unsigned abase = (unsigned)(size_t)Ab;
  inv_rows<0>(t, abase, j);
  if (lane < 32) {
#pragma unroll
    for (int i = 0; i < 32; ++i) Ttu[(32 * hf + i) * 72 + 32 * hf + j] = f2bf(t[i]);
    if (hf == 0) {
#pragma unroll
      for (int i = 0; i < 32; ++i) Ttu[i * 72 + 32 + j] = 0;
#pragma unroll
      for (int i4 = 0; i4 < 4; ++i4) {
        u32x4 pk;
        pk[0] = pack2(t[8 * i4], t[8 * i4 + 1]); pk[1] = pack2(t[8 * i4 + 2], t[8 * i4 + 3]);
        pk[2] = pack2(t[8 * i4 + 4], t[8 * i4 + 5]); pk[3] = pack2(t[8 * i4 + 6], t[8 * i4 + 7]);
        *(u32x4*)&Tcu[j * 40 + 8 * i4] = pk;
      }
    }
  }
}
DI void tri_merge(const float* __restrict__ Au, bfr* __restrict__ Ttu, const bfr* __restrict__ Tcu, int nt2, int lane) {
  const int l15 = lane & 15, q = lane >> 4;
  const f32x4 zero = (f32x4){0.f, 0.f, 0.f, 0.f};
  bf16x8 bfrag = *(const bf16x8*)&Tcu[(nt2 * 16 + l15) * 40 + q * 8];
  f32x4 X[2];
#pragma unroll
  for (int mt = 0; mt < 2; ++mt) {
    const float* ar = Au + (32 + mt * 16 + l15) * 64 + q * 8;
    f32x4 a0 = *(const f32x4*)ar, a1 = *(const f32x4*)(ar + 4);
    X[mt] = MFMA16(pack_cc(a0, a1), bfrag, zero);
  }
  bf16x8 xb = pack_cc(X[0], X[1]);
#pragma unroll
  for (int mt2 = 0; mt2 < 2; ++mt2) {
    bf16x8 a = ld_perm(Ttu + (32 + mt2 * 16 + l15) * 72 + 32 + q * 4);
    f32x4 r = MFMA16(a, xb, zero);
#pragma unroll
    for (int jx = 0; jx < 4; ++jx) Ttu[(32 + mt2 * 16 + q * 4 + jx) * 72 + nt2 * 16 + l15] = f2bf(-r[jx]);
  }
}

DI void gdn_g1(const Params& p, int j, char* lds) {
  float* Asl = (float*)lds;
  bfr* Tt = (bfr*)(lds + 65536);
  bfr* Kt = (bfr*)(lds + 102400);
  bfr* Qt = (bfr*)(lds + 119808);
  bfr* Vt = (bfr*)(lds + 137216);
  float* gc = (float*)(lds + 154624);
  float* be = (float*)(lds + 155648);
  float* cw = (float*)(lds + 156672);
  const int tid0 = otid();
  bfr* proj = (bfr*)(ows(p) + O_PROJ);
  bfr* KDT = (bfr*)(ows(p) + O_H);
  bfr* ATT = (bfr*)(ows(p) + O_ATTN);
  const bfr* HALO = (const bfr*)(ows(p) + O_HALO);
  bfr* SCR = (bfr*)(ows(p) + O_SCR) + (size_t)obid() * (4 * 2 * 8192);
  const float* AB = (const float*)(ows(p) + O_AB);
  float* EL = (float*)(ows(p) + O_ELAST);
  for (int grp = obid(); grp < 256; grp += gridDim.x) {
    const int bh = grp >> 3, b = bh >> 3, h = bh & 7;
    for (int e = tid0; e < 1536; e += 512) {
      int X = e >> 9, rem = e & 511, tap = rem >> 7, c = rem & 127;
      cw[(X * 4 + tap) * 128 + c] = p.gdn_conv_w[(size_t)(j * 4 + tap) * 3072 + X * 1024 + h * 128 + c];
    }
    bf16x8 nxt[3][5];
    float pfx_g = 0.f, pfx_b = 0.f;
#define G1_RAWLOAD(nn)                                                                                         \
  {                                                                                                            \
    const int rg_ = tid0 >> 4, cgi_ = tid0 & 15, r0_ = rg_ * 2;                                                \
    _Pragma("unroll") for (int X = 0; X < 3; ++X) {                                                            \
      _Pragma("unroll") for (int i = 0; i < 5; ++i) {                                                          \
        const int rr = r0_ - 3 + i;                                                                            \
        if (rr >= 0) nxt[X][i] = *(const bf16x8*)&proj[(size_t)X * PLANE + (size_t)(bh * 4096 + (nn) * 64 + rr) * 128 + cgi_ * 8];   \
        else if ((nn) > 0) nxt[X][i] = *(const bf16x8*)&HALO[((size_t)(b * 64 + (nn) - 1) * 3 + 3 + rr) * 3072 + X * 1024 + h * 128 + cgi_ * 8];   \
        else nxt[X][i] = (bf16x8){0, 0, 0, 0, 0, 0, 0, 0};                                                     \
      }                                                                                                        \
    }                                                                                                          \
  }
    G1_RAWLOAD((grp * 8) & 63);
#pragma unroll 1
    for (int half = 0; half < 2; ++half) {
      {
        int tid = tid0; asm volatile("" : "+v"(tid));
        const int lane = tid & 63, wv = tid >> 6;
        if (half == 0) {
          const int un = grp * 8 + wv, n = un & 63, t0 = b * 4096 + n * 64;
          float a_in = AB[(size_t)(t0 + lane) * 16 + h], b_in = AB[(size_t)(t0 + lane) * 16 + 8 + h];
          float g = -__expf(p.gdn_a_log[j * 8 + h]) * softplusf_(a_in + p.gdn_dt_bias[j * 8 + h]);
#pragma unroll
          for (int off = 1; off < 64; off <<= 1) {
            float v = __shfl_up(g, off);
            if (lane >= off) g += v;
          }
          pfx_g = g; pfx_b = sigmoidf_(b_in);
          if (lane == 63) EL[un] = __expf(g);
          if (wv < 4) { gc[wv * 64 + lane] = pfx_g; be[wv * 64 + lane] = pfx_b; }
        } else if (wv >= 4) {
          gc[(wv - 4) * 64 + lane] = pfx_g; be[(wv - 4) * 64 + lane] = pfx_b;
        }
      }
#pragma unroll 1
      for (int u = 0; u < 4; ++u) {
        const int un = grp * 8 + half * 4 + u, n = un & 63, t0 = b * 4096 + n * 64;
        int tid = tid0; asm volatile("" : "+v"(tid));
        const int lane = tid & 63, wv = tid >> 6, l15 = lane & 15, q = lane >> 4;
        const int rg = tid >> 4, cgi = tid & 15, r0 = rg * 2;
        __syncthreads();
        bf16x8 cur[3][5];
#pragma unroll
        for (int X = 0; X < 3; ++X)
#pragma unroll
          for (int i = 0; i < 5; ++i) cur[X][i] = nxt[X][i];
        if (half * 4 + u < 7) G1_RAWLOAD(n + 1);
#pragma unroll
        for (int X = 0; X < 3; ++X) {
          float val[2][8];
#pragma unroll
          for (int rr = 0; rr < 2; ++rr)
#pragma unroll
            for (int e = 0; e < 8; ++e) {
              float sacc = 0.f;
#pragma unroll
              for (int tp = 0; tp < 4; ++tp) sacc += cw[(X * 4 + tp) * 128 + cgi * 8 + e] * bfe(cur[X][rr + tp], e);
              val[rr][e] = siluf_(sacc);
            }
          if (X < 2) {
#pragma unroll
            for (int rr = 0; rr < 2; ++rr) {
              float ss = 0.f;
#pragma unroll
              for (int e = 0; e < 8; ++e) ss += val[rr][e] * val[rr][e];
              ss = sum16(ss);
              float rn = rsqrtf(ss + EPS);
              if (X == 0) rn *= 0.08838834764831845f;
#pragma unroll
              for (int e = 0; e < 8; ++e) val[rr][e] *= rn;
            }
          }
          bfr* Tile = (X == 0) ? Qt : (X == 1 ? Kt : Vt);
#pragma unroll
          for (int rr = 0; rr < 2; ++rr) {
            const int r = r0 + rr;
            u32x4 pk;
            pk[0] = pack2(val[rr][0], val[rr][1]); pk[1] = pack2(val[rr][2], val[rr][3]);
            pk[2] = pack2(val[rr][4], val[rr][5]); pk[3] = pack2(val[rr][6], val[rr][7]);
            *(u32x4*)&Tile[r * 136 + cgi * 8] = pk;
            if (X == 0) {
              const float eg = __expf(gc[u * 64 + r]);
              pk[0] = pack2(val[rr][0] * eg, val[rr][1] * eg); pk[1] = pack2(val[rr][2] * eg, val[rr][3] * eg);
              pk[2] = pack2(val[rr][4] * eg, val[rr][5] * eg); pk[3] = pack2(val[rr][6] * eg, val[rr][7] * eg);
              *(u32x4*)&proj[(size_t)(bh * 4096 + n * 64 + r) * 128 + cgi * 8] = pk;
            }
          }
        }
        lds_barrier();
        {
          const int mt = wv >> 1;
          f32x4 kk[2], qk[2];
          kk[0] = kk[1] = qk[0] = qk[1] = (f32x4){0.f, 0.f, 0.f, 0.f};
#pragma unroll
          for (int ks = 0; ks < 4; ++ks) {
            bf16x8 ak = *(const bf16x8*)&Kt[(mt * 16 + l15) * 136 + ks * 32 + q * 8];
            bf16x8 aq = *(const bf16x8*)&Qt[(mt * 16 + l15) * 136 + ks * 32 + q * 8];
#pragma unroll
            for (int t2 = 0; t2 < 2; ++t2) {
              int nt = (wv & 1) * 2 + t2;
              bf16x8 bk = *(const bf16x8*)&Kt[(nt * 16 + l15) * 136 + ks * 32 + q * 8];
              kk[t2] = MFMA16(bk, ak, kk[t2]);
              qk[t2] = MFMA16(bk, aq, qk[t2]);
            }
          }
          const int i = mt * 16 + l15;
          const float giv = gc[u * 64 + i], bei = be[u * 64 + i];
#pragma unroll
          for (int t2 = 0; t2 < 2; ++t2) {
            const int m0 = ((wv & 1) * 2 + t2) * 16 + q * 4;
            f32x4 av, tv;
#pragma unroll
            for (int jx = 0; jx < 4; ++jx) {
              const int m = m0 + jx;
              const float d = (i >= m) ? __expf(giv - gc[u * 64 + m]) : 0.f;
              av[jx] = (i > m) ? bei * kk[t2][jx] * d : 0.f;
              tv[jx] = qk[t2][jx] * d;
            }
            *(f32x4*)&Asl[u * 4096 + i * 64 + m0] = av;
            u32x2 pk; pk[0] = pack2(tv[0], tv[1]); pk[1] = pack2(tv[2], tv[3]);
            *(u32x2*)&ATT[(size_t)un * 4096 + i * 64 + m0] = pk;
          }
        }
        {
          const int dd = tid >> 2, tq = tid & 3;
          const float glast = gc[u * 64 + 63];
#pragma unroll
          for (int g8 = 0; g8 < 2; ++g8) {
            const int tok0 = tq * 16 + g8 * 8;
            float okd[8], okb[8], ovb[8];
#pragma unroll
            for (int e = 0; e < 8; ++e) {
              const int tok = tok0 + e;
              const float kv = bf2f(Kt[tok * 136 + dd]), vv = bf2f(Vt[tok * 136 + dd]);
              const float gg = gc[u * 64 + tok], bb = be[u * 64 + tok];
              okd[e] = kv * __expf(glast - gg);
              okb[e] = kv * bb * __expf(gg);
              ovb[e] = vv * bb;
            }
            u32x4 pk;
            pk[0] = pack2(okd[0], okd[1]); pk[1] = pack2(okd[2], okd[3]); pk[2] = pack2(okd[4], okd[5]); pk[3] = pack2(okd[6], okd[7]);
            *(u32x4*)&KDT[(size_t)un * 8192 + dd * 64 + tok0] = pk;
            pk[0] = pack2(okb[0], okb[1]); pk[1] = pack2(okb[2], okb[3]); pk[2] = pack2(okb[4], okb[5]); pk[3] = pack2(okb[6], okb[7]);
            *(u32x4*)&SCR[(u * 2 + 0) * 8192 + dd * 64 + tok0] = pk;
            pk[0] = pack2(ovb[0], ovb[1]); pk[1] = pack2(ovb[2], ovb[3]); pk[2] = pack2(ovb[4], ovb[5]); pk[3] = pack2(ovb[6], ovb[7]);
            *(u32x4*)&SCR[(u * 2 + 1) * 8192 + dd * 64 + tok0] = pk;
          }
        }
      }
      __syncthreads();
      {
      int tid = tid0; asm volatile("" : "+v"(tid));
      const int lane = tid & 63, wv = tid >> 6;
      tri_invert32(Asl + (wv >> 1) * 4096, Tt + (wv >> 1) * 4608, Kt + (wv >> 1) * 1280, wv & 1, lane);
      __syncthreads();
      tri_merge(Asl + (wv >> 1) * 4096, Tt + (wv >> 1) * 4608, Kt + (wv >> 1) * 1280, wv & 1, lane);
      __syncthreads();
      }
      {
        int tid = tid0; asm volatile("" : "+v"(tid));
        const int lane = tid & 63, wv = tid >> 6, l15 = lane & 15, q = lane >> 4;
        bf16x8 bkf[4][2], bvf[4][2];
#pragma unroll
        for (int u = 0; u < 4; ++u)
#pragma unroll
          for (int ks = 0; ks < 2; ++ks) {
            bkf[u][ks] = *(const bf16x8*)&SCR[(u * 2) * 8192 + (wv * 16 + l15) * 64 + ks * 32 + q * 8];
            bvf[u][ks] = *(const bf16x8*)&SCR[(u * 2 + 1) * 8192 + (wv * 16 + l15) * 64 + ks * 32 + q * 8];
          }
#pragma unroll
        for (int u = 0; u < 4; ++u) {
          const int n = (grp * 8 + half * 4 + u) & 63;
          f32x4 aw[4], au[4];
#pragma unroll
          for (int i = 0; i < 4; ++i) aw[i] = au[i] = (f32x4){0.f, 0.f, 0.f, 0.f};
#pragma unroll
          for (int ks = 0; ks < 2; ++ks) {
#pragma unroll
            for (int mt = 0; mt < 4; ++mt) {
              bf16x8 a = *(const bf16x8*)&Tt[u * 4608 + (mt * 16 + l15) * 72 + ks * 32 + q * 8];
              aw[mt] = MFMA16(bkf[u][ks], a, aw[mt]);
              au[mt] = MFMA16(bvf[u][ks], a, au[mt]);
            }
          }
          bfr* Wst = (u & 1) ? Kt : (bfr*)Asl;
          bfr* Ust = Wst + 64 * 136;
#pragma unroll
          for (int mt = 0; mt < 4; ++mt) {
            const int i = mt * 16 + l15, dc = wv * 16 + q * 4;
            u32x2 pk; pk[0] = pack2(aw[mt][0], aw[mt][1]); pk[1] = pack2(aw[mt][2], aw[mt][3]);
            *(u32x2*)&Wst[i * 136 + dc] = pk;
            pk[0] = pack2(au[mt][0], au[mt][1]); pk[1] = pack2(au[mt][2], au[mt][3]);
            *(u32x2*)&Ust[i * 136 + dc] = pk;
          }
          lds_barrier();
#pragma unroll
          for (int k = 0; k < 2; ++k) {
            const int id = tid + 512 * k, row = id >> 4, c16 = id & 15;
            const size_t go = (size_t)(bh * 4096 + n * 64 + row) * 128 + c16 * 8;
            *(u32x4*)&proj[(size_t)PLANE + go] = *(const u32x4*)&Wst[row * 136 + c16 * 8];
            *(u32x4*)&proj[(size_t)2 * PLANE + go] = *(const u32x4*)&Ust[row * 136 + c16 * 8];
          }
        }
      }
      __syncthreads();
    }
  }
#undef G1_RAWLOAD
}

DI void gdn_g2(const Params& p, int j, char* lds) {
  bfr* SbT = (bfr*)lds;
  bfr* VbT = (bfr*)(lds + 4352);
  const int tid = otid(), lane = tid & 63, wv = tid >> 6, l15 = lane & 15, q = lane >> 4;
  const bfr* proj = (const bfr*)(ows(p) + O_PROJ);
  const bfr* KDT = (const bfr*)(ows(p) + O_H);
  const bfr* ATT = (const bfr*)(ows(p) + O_ATTN);
  const float* EL = (const float*)(ows(p) + O_ELAST);
  bfr* OB = (bfr*)(ows(p) + O_SCR);
  for (int unit = obid(); unit < 256; unit += gridDim.x) {
    const int xcd = unit & 7, li = unit >> 3, bh = xcd * 4 + (li >> 3), slice = li & 7;
    const int b = bh >> 3, h = bh & 7;
    const int mt = wv & 3;
    const bool lo = wv < 4;
    const float elv = EL[bh * 64 + lane];
    f32x4 S = (f32x4){0.f, 0.f, 0.f, 0.f};
    for (int e = tid; e < 16 * 136; e += 512) SbT[e] = 0;
    bf16x8 A1s[4][4], K2s[4][2], A2s[4][2];
    unsigned urs[4][4];
    const bfr* pa_u = proj + (lo ? (size_t)PLANE : (size_t)0) + (size_t)bh * 4096 * 128;
    const int pa_o = (mt * 16 + l15) * 128 + q * 8;
    const bfr* pu_u = proj + (size_t)2 * PLANE + (size_t)bh * 4096 * 128 + slice * 16;
    const int pu_o = (mt * 16 + q * 4) * 128 + (l15 & ~1);
    const int ush = (l15 & 1) * 16;
    const bfr* kd_u = KDT + (size_t)bh * 64 * 8192;
    const int kd_o = (wv * 16 + l15) * 64 + q * 8;
    const bfr* at_u = ATT + (size_t)bh * 64 * 4096;
    const int at_o = (mt * 16 + l15) * 64 + q * 8;
#define G2_GLOAD(set, n)                                                                                     \
  {                                                                                                          \
    const bfr* pa_n = pa_u + (size_t)(n) * 64 * 128;                                                         \
    _Pragma("unroll") for (int ks = 0; ks < 4; ++ks) A1s[set][ks] = *(const bf16x8*)&pa_n[pa_o + ks * 32];   \
    const bfr* kd_n = kd_u + (n) * 8192;                                                                     \
    K2s[set][0] = *(const bf16x8*)&kd_n[kd_o];                                                               \
    K2s[set][1] = *(const bf16x8*)&kd_n[kd_o + 32];                                                          \
    if (lo) {                                                                                                \
      const bfr* pu_n = pu_u + (size_t)(n) * 64 * 128;                                                       \
      _Pragma("unroll") for (int jx = 0; jx < 4; ++jx) urs[set][jx] = *(const unsigned*)&pu_n[pu_o + jx * 128];               \
    } else {                                                                                                 \
      const bfr* at_n = at_u + (n) * 4096;                                                                   \
      A2s[set][0] = *(const bf16x8*)&at_n[at_o];                                                             \
      A2s[set][1] = *(const bf16x8*)&at_n[at_o + 32];                                                        \
    }                                                                                                        \
  }
#define G2_STEP(n, rs)                                                                                       \
  {                                                                                                          \
    f32x4 acc = (f32x4){0.f, 0.f, 0.f, 0.f};                                                                 \
    _Pragma("unroll") for (int ks = 0; ks < 4; ++ks) {                                                       \
      bf16x8 sb = *(const bf16x8*)&SbT[l15 * 136 + ks * 32 + q * 8];                                         \
      acc = lo ? MFMA16(A1s[rs][ks], sb, acc) : MFMA16(sb, A1s[rs][ks], acc);     \
    }                                                                                                        \
    if (lo) {                                                                                                \
      u32x2 pk;                                                                                              \
      pk[0] = pack2(bf2f((bfr)(urs[rs][0] >> ush)) - acc[0], bf2f((bfr)(urs[rs][1] >> ush)) - acc[1]);       \
      pk[1] = pack2(bf2f((bfr)(urs[rs][2] >> ush)) - acc[2], bf2f((bfr)(urs[rs][3] >> ush)) - acc[3]);       \
      *(u32x2*)&VbT[l15 * 72 + mt * 16 + q * 4] = pk;                                                        \
    }                                                                                                        \
    lds_barrier();                                                                                           \
    bf16x8 vb0 = *(const bf16x8*)&VbT[l15 * 72 + q * 8];                                                     \
    bf16x8 vb1 = *(const bf16x8*)&VbT[l15 * 72 + 32 + q * 8];                                                \
    if (!lo) {                                                                                               \
      acc = MFMA16(vb0, A2s[rs][0], acc);                                                                    \
      acc = MFMA16(vb1, A2s[rs][1], acc);                                                                    \
      u32x2 ok; ok[0] = pack2(acc[0], acc[1]); ok[1] = pack2(acc[2], acc[3]);                                \
      *(u32x2*)&OB[((size_t)(b * 4096 + (n) * 64) + mt * 16 + l15) * 1024 + h * 128 + slice * 16 + q * 4] = ok;  \
    }                                                                                                        \
    const float el = __shfl(elv, (n));                                                                       \
    S = S * el;                                                                                              \
    S = MFMA16(K2s[rs][0], vb0, S);                                                                          \
    S = MFMA16(K2s[rs][1], vb1, S);                                                                          \
    {                                                                                                        \
      u32x2 pk;                                                                                              \
      pk[0] = pack2(S[0], S[1]);                                                                             \
      pk[1] = pack2(S[2], S[3]);                                                                             \
      *(u32x2*)&SbT[l15 * 136 + wv * 16 + q * 4] = pk;                                                       \
    }                                                                                                        \
    if ((n) + 4 < 64) G2_GLOAD(rs, (n) + 4);                                                                 \
    lds_barrier();                                                                                           \
  }
    G2_GLOAD(0, 0);
    G2_GLOAD(1, 1);
    G2_GLOAD(2, 2);
    G2_GLOAD(3, 3);
    __syncthreads();
#pragma unroll 1
    for (int n = 0; n < 64; n += 4) {
      G2_STEP(n, 0);
      G2_STEP(n + 1, 1);
      G2_STEP(n + 2, 2);
      G2_STEP(n + 3, 3);
    }
#undef G2_GLOAD
#undef G2_STEP
  }
}

DI void gdn_g2l(const Params& p, int j, char* lds) {
  constexpr int STG = 51200;
  bfr* SbT = (bfr*)(lds + 3 * STG);
  bfr* VbT = (bfr*)(lds + 3 * STG + 4352);
  const int tid = otid(), lane = tid & 63, wv = tid >> 6, l15 = lane & 15, q = lane >> 4;
  const bfr* proj = (const bfr*)(ows(p) + O_PROJ);
  const bfr* KDT = (const bfr*)(ows(p) + O_H);
  const bfr* ATT = (const bfr*)(ows(p) + O_ATTN);
  const float* EL = (const float*)(ows(p) + O_ELAST);
  bfr* OB = (bfr*)(ows(p) + O_SCR);
  for (int unit = obid(); unit < 256; unit += gridDim.x) {
    const int xcd = unit & 7, li = unit >> 3, bh = xcd * 4 + (li >> 3), slice = li & 7;
    const int b = bh >> 3, h = bh & 7;
    const bool loader = wv >= 4;
    for (int e = tid; e < 16 * 136; e += 512) SbT[e] = 0;
    if (loader) {
      const int lw = __builtin_amdgcn_readfirstlane(wv - 4);
      const bfr* wq_u = proj + (size_t)bh * 4096 * 128;
      const bfr* kd_u = KDT + (size_t)bh * 64 * 8192;
      const int lo_wq = (lane >> 2) * 128 + (lane & 3) * 8, lo_kd = (lane >> 2) * 64 + (lane & 3) * 8;
      const bfr* u_u = proj + (size_t)2 * PLANE + (size_t)bh * 4096 * 128 + slice * 16 + (lw * 32 + (lane >> 1)) * 128 + (lane & 1) * 8;
#define G2L_DMA(c, stg)                                                                                      \
  {                                                                                                          \
    const int cc = (c) < 64 ? (c) : 63;                                                                      \
    const bfr* wq_c = wq_u + (size_t)cc * 64 * 128;                                                          \
    const bfr* kd_c = kd_u + (size_t)cc * 8192;                                                              \
    _Pragma("unroll") for (int i = 0; i < 12; ++i) {                                                         \
      const int blk = lw * 12 + i, X = blk >> 4, idx = blk & 15;                                             \
      const bfr* g = (X == 2) ? (kd_c + ((idx >> 1) * 16 * 64 + (idx & 1) * 32) + lo_kd)                     \
                              : (wq_c + (X == 0 ? (size_t)PLANE : (size_t)0) + ((idx >> 2) * 16 * 128 + (idx & 3) * 32) + lo_wq);  \
      __builtin_amdgcn_global_load_lds((const unsigned*)g, (PG8_LAS unsigned*)(lds + (stg) * STG + blk * 1024), 16, 0, 0);  \
    }                                                                                                        \
    if (lw < 2) __builtin_amdgcn_global_load_lds((const unsigned*)(u_u + (size_t)cc * 64 * 128), (PG8_LAS unsigned*)(lds + (stg) * STG + (48 + lw) * 1024), 16, 0, 0);  \
  }
#define G2L_WAITPREV() { if (lw < 2) asm volatile("s_waitcnt vmcnt(13)" ::: "memory"); else asm volatile("s_waitcnt vmcnt(12)" ::: "memory"); }
      G2L_DMA(0, 0);
      G2L_DMA(1, 1);
      G2L_WAITPREV();
      lds_barrier();
#pragma unroll 1
      for (int n = 0; n < 64; n += 3) {
#pragma unroll
        for (int s3 = 0; s3 < 3; ++s3) {
          if (n + s3 < 64) {
            G2L_DMA(n + s3 + 2, (s3 + 2) % 3);
            lds_barrier();
            G2L_WAITPREV();
            lds_barrier();
          }
        }
      }
      asm volatile("s_waitcnt vmcnt(0)" ::: "memory");
#undef G2L_DMA
#undef G2L_WAITPREV
    } else {
      const int mt = wv;
      const float elv = EL[bh * 64 + lane];
      f32x4 S0 = (f32x4){0.f, 0.f, 0.f, 0.f}, S1 = S0;
      bf16x8 At[4][2];
      const bfr* at_u = ATT + (size_t)bh * 64 * 4096 + (mt * 16 + l15) * 64 + q * 8;
#define G2L_GLOAD(set, c)                                                                                    \
  {                                                                                                          \
    const int cc = (c) < 64 ? (c) : 63;                                                                      \
    At[set][0] = *(const bf16x8*)&at_u[cc * 4096];                                                           \
    At[set][1] = *(const bf16x8*)&at_u[cc * 4096 + 32];                                                      \
  }
#define G2L_STEP(n, stg, rs)                                                                                 \
  {                                                                                                          \
    const char* sb_ = lds + (stg) * STG + l15 * 64 + q * 16;                                                 \
    f32x4 accp = (f32x4){0.f, 0.f, 0.f, 0.f}, acco = accp;                                                   \
    if ((n) > 0) {     \
      accd = MFMA16(vbd0, Atd0, accd);                                                                       \
      accd = MFMA16(vbd1, Atd1, accd);                                                                       \
      u32x2 ok; ok[0] = pack2(accd[0], accd[1]); ok[1] = pack2(accd[2], accd[3]);                            \
      *(u32x2*)&OB[((size_t)(b * 4096 + ((n) - 1) * 64) + mt * 16 + l15) * 1024 + h * 128 + slice * 16 + q * 4] = ok;  \
    }                                                                                                        \
    _Pragma("unroll") for (int ks = 0; ks < 4; ++ks) {                                                       \
      const bf16x8 sb = *(const bf16x8*)&SbT[l15 * 136 + ks * 32 + q * 8];                                   \
      accp = MFMA16(*(const bf16x8*)(sb_ + (mt * 4 + ks) * 1024), sb, accp);                                 \
      acco = MFMA16(sb, *(const bf16x8*)(sb_ + (16 + mt * 4 + ks) * 1024), acco);     \
    }                                                                                                        \
    {                                                                                                        \
      u32x2 pk;                                                                                              \
      const bfr* up_ = (const bfr*)(lds + (stg) * STG + 48 * 1024) + (mt * 16 + q * 4) * 16 + l15;           \
      pk[0] = pack2(bf2f(up_[0]) - accp[0], bf2f(up_[16]) - accp[1]);                                        \
      pk[1] = pack2(bf2f(up_[32]) - accp[2], bf2f(up_[48]) - accp[3]);                                       \
      *(u32x2*)&VbT[l15 * 72 + mt * 16 + q * 4] = pk;                                                        \
    }                                                                                                        \
    lds_barrier();                                                                                           \
    const bf16x8 vb0 = *(const bf16x8*)&VbT[l15 * 72 + q * 8];                                               \
    const bf16x8 vb1 = *(const bf16x8*)&VbT[l15 * 72 + 32 + q * 8];                                          \
    accd = acco; vbd0 = vb0; vbd1 = vb1; Atd0 = At[rs][0]; Atd1 = At[rs][1];                                 \
    const float el = __uint_as_float(__builtin_amdgcn_readlane(__float_as_uint(elv), (n)));       \
    S0 = S0 * el; S1 = S1 * el;                                                                              \
    S0 = MFMA16(*(const bf16x8*)(sb_ + (32 + (2 * mt) * 2 + 0) * 1024), vb0, S0);                            \
    S0 = MFMA16(*(const bf16x8*)(sb_ + (32 + (2 * mt) * 2 + 1) * 1024), vb1, S0);                            \
    S1 = MFMA16(*(const bf16x8*)(sb_ + (32 + (2 * mt + 1) * 2 + 0) * 1024), vb0, S1);                        \
    S1 = MFMA16(*(const bf16x8*)(sb_ + (32 + (2 * mt + 1) * 2 + 1) * 1024), vb1, S1);                        \
    {                                                                                                        \
      u32x2 pk;                                                                                              \
      pk[0] = pack2(S0[0], S0[1]); pk[1] = pack2(S0[2], S0[3]);                                              \
      *(u32x2*)&SbT[l15 * 136 + (2 * mt) * 16 + q * 4] = pk;                                                 \
      pk[0] = pack2(S1[0], S1[1]); pk[1] = pack2(S1[2], S1[3]);                                              \
      *(u32x2*)&SbT[l15 * 136 + (2 * mt + 1) * 16 + q * 4] = pk;                                             \
    }                                                                                                        \
    G2L_GLOAD(rs, (n) + 4);                                                                                  \
    lds_barrier();                                                                                           \
  }
      G2L_GLOAD(0, 0);
      G2L_GLOAD(1, 1);
      G2L_GLOAD(2, 2);
      G2L_GLOAD(3, 3);
      f32x4 accd = (f32x4){0.f, 0.f, 0.f, 0.f};
      bf16x8 vbd0 = (bf16x8){0, 0, 0, 0, 0, 0, 0, 0}, vbd1 = vbd0, Atd0 = vbd0, Atd1 = vbd0;
      lds_barrier();
#pragma unroll 1
      for (int n = 0; n < 60; n += 12) {
        G2L_STEP(n, 0, 0); G2L_STEP(n + 1, 1, 1); G2L_STEP(n + 2, 2, 2); G2L_STEP(n + 3, 0, 3);
        G2L_STEP(n + 4, 1, 0); G2L_STEP(n + 5, 2, 1); G2L_STEP(n + 6, 0, 2); G2L_STEP(n + 7, 1, 3);
        G2L_STEP(n + 8, 2, 0); G2L_STEP(n + 9, 0, 1); G2L_STEP(n + 10, 1, 2); G2L_STEP(n + 11, 2, 3);
      }
      G2L_STEP(60, 0, 0); G2L_STEP(61, 1, 1); G2L_STEP(62, 2, 2); G2L_STEP(63, 0, 3);
      {
        accd = MFMA16(vbd0, Atd0, accd);
        accd = MFMA16(vbd1, Atd1, accd);
        u32x2 ok; ok[0] = pack2(accd[0], accd[1]); ok[1] = pack2(accd[2], accd[3]);
        *(u32x2*)&OB[((size_t)(b * 4096 + 63 * 64) + mt * 16 + l15) * 1024 + h * 128 + slice * 16 + q * 4] = ok;
      }
#undef G2L_GLOAD
#undef G2L_STEP
    }
    __syncthreads();
  }
}

DI void gdn_g3(const Params& p, int j, char* lds) {
  const int tid = otid(), lane = tid & 63, wv = tid >> 6, l15 = lane & 15, q = lane >> 4;
  const bfr* proj = (const bfr*)(ows(p) + O_PROJ);
  bfr* OB = (bfr*)(ows(p) + O_SCR);
  f32x4 g0 = *(const f32x4*)&p.gdn_onorm_g[j * 128 + l15 * 8], g1 = *(const f32x4*)&p.gdn_onorm_g[j * 128 + l15 * 8 + 4];
  const int stride = gridDim.x * 32;
  int pi = (obid() * 8 + wv) * 4 + q;
  bf16x8 ov, zv;
#define G3_LOAD(pp)                                                                                                  \
  {                                                                                                                  \
    const int t_ = (pp) >> 3, h_ = (pp) & 7;                                                                         \
    ov = __builtin_nontemporal_load((const bf16x8*)&OB[(size_t)t_ * 1024 + h_ * 128 + l15 * 8]);                     \
    zv = __builtin_nontemporal_load((const bf16x8*)&proj[(size_t)3 * PLANE + (size_t)(((t_ >> 12) * 8 + h_) * 4096 + (t_ & 4095)) * 128 + l15 * 8]);  \
  }
  bf16x8 ov2 = (bf16x8){0, 0, 0, 0, 0, 0, 0, 0}, zv2 = ov2;
  if (pi < 131072) G3_LOAD(pi);
  if (pi + stride < 131072) { const bf16x8 o1 = ov, z1 = zv; G3_LOAD(pi + stride); ov2 = ov; zv2 = zv; ov = o1; zv = z1; }
  for (; pi < 131072; pi += stride) {
    const int t = pi >> 3, h = pi & 7;
    const bf16x8 oc = ov, zc = zv;
    ov = ov2; zv = zv2;
    if (pi + 2 * stride < 131072) { const bf16x8 o1 = ov, z1 = zv; G3_LOAD(pi + 2 * stride); ov2 = ov; zv2 = zv; ov = o1; zv = z1; }
    float o[8], ss = 0.f;
#pragma unroll
    for (int e = 0; e < 8; ++e) { o[e] = bfe(oc, e); ss += o[e] * o[e]; }
    ss = sum16(ss);
    const float rstd = rsqrtf(ss * (1.f / 128.f) + EPS);
    float y[8];
#pragma unroll
    for (int e = 0; e < 8; ++e) y[e] = o[e] * rstd * (e < 4 ? g0[e] : g1[e - 4]) * siluf_(bfe(zc, e));
    u32x4 pk;
    pk[0] = pack2(y[0], y[1]); pk[1] = pack2(y[2], y[3]); pk[2] = pack2(y[4], y[5]); pk[3] = pack2(y[6], y[7]);
    *(u32x4*)&OB[(size_t)t * 1024 + h * 128 + l15 * 8] = pk;
  }
#undef G3_LOAD
}


#define XB_TMO      128
#define XB_XCNT(j)  (256  + 64 * (j))
#define XB_XSUB(j)  (1280 + 64 * (j))
#define XB_XGEN(j)  (2304 + 64 * (j))
#define XB_TOP      3328
#define XB_TOPGEN   3392
#define XCD_BAR_WORDS 3456
#define XB_SPIN_CAP (1u << 18)
#define LAS __attribute__((address_space(3)))

__device__ __forceinline__ unsigned xb_ld(unsigned* p)              { return __hip_atomic_load(p, __ATOMIC_RELAXED, __HIP_MEMORY_SCOPE_AGENT); }
__device__ __forceinline__ unsigned xb_add(unsigned* p, unsigned v) { return __hip_atomic_fetch_add(p, v, __ATOMIC_RELAXED, __HIP_MEMORY_SCOPE_AGENT); }
__device__ __forceinline__ unsigned xb_xcc_id() { return (unsigned)__builtin_amdgcn_s_getreg((3 << 11) | 20) & 0xFu; }
#define XB_SPIN(cond, bar) do { unsigned _sp = 0; while (cond) { __builtin_amdgcn_s_sleep(1); \
    if ((++_sp & 255u) == 0u) { if (xb_ld(&(bar)[XB_TMO])) break; if (_sp > XB_SPIN_CAP) { atomicAdd(&(bar)[XB_TMO], 1u); break; } } } } while (0)

struct XcdBarrier {
    unsigned* bar; unsigned x;
    volatile LAS unsigned* st;
};

__device__ __forceinline__ XcdBarrier xcd_barrier_post(unsigned* bar, volatile LAS unsigned* st) {
    XcdBarrier b; b.bar = bar; b.x = xb_xcc_id(); b.st = st;
    if (threadIdx.x == 0) (void)xb_add(&bar[XB_XCNT(b.x)], 1u);
    return b;
}
__device__ __forceinline__ void xcd_barrier_complete(unsigned* bar, unsigned x, unsigned& nloc, unsigned& nx) {
    const unsigned G = gridDim.x * gridDim.y * gridDim.z;
    unsigned sum, cnt, mine, sp = 0u;
    for (;;) {
        sum = 0u; cnt = 0u; mine = 0u;
#pragma unroll
        for (unsigned j = 0; j < 16; ++j) { const unsigned c = xb_ld(&bar[XB_XCNT(j)]); sum += c; cnt += (c > 0u) ? 1u : 0u; mine = (j == x) ? c : mine; }
        if (sum == G) break;
        __builtin_amdgcn_s_sleep(1);
        if ((++sp & 255u) == 0u) { if (xb_ld(&bar[XB_TMO])) break; if (sp > XB_SPIN_CAP) { atomicAdd(&bar[XB_TMO], 1u); break; } }
    }
    nloc = mine > 0u ? mine : 1u; nx = cnt > 0u ? cnt : 1u;
}

__device__ __forceinline__ void xcd_barrier(const XcdBarrier& b) {
    asm volatile("s_waitcnt vmcnt(0)" ::: "memory");
    __syncthreads();
    if (threadIdx.x == 0) {
        unsigned* bar = b.bar;
        __builtin_amdgcn_s_waitcnt(0);
        unsigned nloc = b.st[0], nx = b.st[1];
        if (nloc == 0u) { xcd_barrier_complete(bar, b.x, nloc, nx); b.st[0] = nloc; b.st[1] = nx; }
        const unsigned old = xb_add(&bar[XB_XSUB(b.x)], 1u);
        const unsigned gen = old / nloc;
        if (old + 1u == (gen + 1u) * nloc) {
            __builtin_amdgcn_fence(__ATOMIC_RELEASE, "agent");
            asm volatile("s_waitcnt vmcnt(0)" ::: "memory");
            const unsigned og = xb_add(&bar[XB_TOP], 1u);
            const unsigned tg = og / nx;
            if (og + 1u == (tg + 1u) * nx) xb_add(&bar[XB_TOPGEN], 1u);
            else XB_SPIN(xb_ld(&bar[XB_TOPGEN]) == tg, bar);
            __builtin_amdgcn_fence(__ATOMIC_ACQUIRE, "agent");
            xb_add(&bar[XB_XGEN(b.x)], 1u);
            asm volatile("s_waitcnt vmcnt(0)" ::: "memory");
        } else {
            XB_SPIN(xb_ld(&bar[XB_XGEN(b.x)]) == gen, bar);
            __builtin_amdgcn_fence(__ATOMIC_ACQUIRE, "agent");
            asm volatile("s_waitcnt vmcnt(0)" ::: "memory");
        }
    }
    __syncthreads();
}


DI void run_phase(const Params& p, int ph, char* lds) {
  if (ph == 0) { phase0(p, lds); return; }
  if (ph == NPHASE - 1) { norm_phase(p, 4, ows(p) + O_H, lds); return; }
  int layer, sub;
  if (ph < 5) { layer = 0; sub = ph - 1; }
  else if (ph < 11) { layer = 1; sub = ph - 5; }
  else if (ph < 15) { layer = 2; sub = ph - 11; }
  else { layer = 3; sub = ph - 15; }
  const int j = layer >> 1;
  const bool is_lru = (layer & 1) == 0;
  const bfr* H = (const bfr*)(ows(p) + O_H);
  const void* xcur = (layer == 0) ? (const void*)p.x : (const void*)p.out;
  bfr* xnext = (layer == 3) ? (bfr*)(ows(p) + O_H) : (bfr*)p.out;
  if (is_lru) {
    switch (sub) {
      case 0: norm_phase(p, layer, xcur, lds); break;
      case 1: gemm_phase<0>(p, H, 1024, (const bfr*)(ows(p) + O_WLI) + (size_t)j * 2048 * 1024, 8, layer, nullptr, nullptr, lds); break;
      case 2: lru_phase(p, j, lds); break;
      case 3: gemm_phase<2>(p, H, 1024, (const bfr*)(ows(p) + O_WLO) + (size_t)j * 1024 * 1024, 4, layer, xcur, xnext, lds); break;
    }
  } else {
    switch (sub) {
      case 0: norm_phase(p, layer, xcur, lds); break;
      case 1: gemm_phase<1>(p, H, 1024, (const bfr*)(ows(p) + O_WGI) + (size_t)j * 4224 * 1024, 16, layer, nullptr, nullptr, lds); break;
      case 2: gdn_g1(p, j, lds); break;
#if G2_LOADER
      case 3: gdn_g2l(p, j, lds); break;
#else
      case 3: gdn_g2(p, j, lds); break;
#endif
      case 4: gdn_g3(p, j, lds); break;
      case 5: gemm_phase<2>(p, (const bfr*)(ows(p) + O_SCR), 1024, (const bfr*)(ows(p) + O_WGO) + (size_t)j * 1024 * 1024, 4, layer, xcur, xnext, lds); break;
    }
  }
}

__global__ void __launch_bounds__(512) mega_fwd(Params p) {
  extern __shared__ __attribute__((aligned(16))) char lds[];
#if MK_MODE == 1
  cg::grid_group grid = cg::this_grid();
  if (p.ph_lo < 0) grid.sync();
  volatile LAS unsigned* bst = (volatile LAS unsigned*)(lds + LDS_BYTES - 16);
  if (threadIdx.x == 0) { bst[0] = 0u; bst[1] = 0u; }
  __syncthreads();
  const XcdBarrier xb = xcd_barrier_post((unsigned*)(p.ws + O_BAR), bst);
  for (int ph = p.ph_lo; ph < p.ph_hi; ++ph) {
    if (ph > p.ph_lo) xcd_barrier(xb);
#ifdef PROBE_MASK
    const bool probe = (PROBE_MASK >> ph) & 1;
    long long ts = 0;
    if (probe) ts = wall_clock64();
#endif
    run_phase(p, ph, lds);
#ifdef PROBE_MASK
    if (probe) {
      xcd_barrier(xb);
      if (blockIdx.x == 0 && threadIdx.x == 0) {
        long long dt = wall_clock64() - ts, t1 = wall_clock64();
        while (wall_clock64() - t1 < dt) __builtin_amdgcn_s_sleep(8);
      }
    }
#endif
  }
#else
  for (int ph = p.ph_lo; ph < p.ph_hi; ++ph) run_phase(p, ph, lds);
#endif
}

extern "C" void kernel_launch(void* const* d_in, const int* in_sizes, int n_in, void* d_out, int out_size, void* d_ws, size_t ws_size, hipStream_t stream) {
  static int grid = 0;
  if (grid == 0) {
    if (n_in != 19 || ws_size < WS_END) { fprintf(stderr, "kernel_launch: unexpected inputs (n_in %d, ws %zu)\n", n_in, ws_size); grid = -1; return; }
    int dev = 0, cus = 0, per_cu = 0;
    hipGetDevice(&dev);
    hipDeviceGetAttribute(&cus, hipDeviceAttributeMultiprocessorCount, dev);
    if (hipFuncSetAttribute((const void*)mega_fwd, hipFuncAttributeMaxDynamicSharedMemorySize, LDS_BYTES) != hipSuccess) { fprintf(stderr, "kernel_launch: hipFuncSetAttribute failed\n"); grid = -1; return; }
    hipOccupancyMaxActiveBlocksPerMultiprocessor(&per_cu, (const void*)mega_fwd, 512, LDS_BYTES);
    if (per_cu < 1) { fprintf(stderr, "kernel_launch: occupancy query returned %d\n", per_cu); per_cu = 1; }
    (void)hipGetLastError();
    grid = cus * per_cu;
    if (grid > 256) grid = 256;
  }
  if (grid < 0) return;
  Params p{};
  const float** pp = (const float**)&p;
  for (int i = 0; i < 19; ++i) pp[i] = (const float*)d_in[i];
  p.out = (float*)d_out;
  p.ws = (char*)d_ws;
#if MK_MODE == 1
  p.ph_lo = 0; p.ph_hi = NPHASE;
  if (hipMemsetAsync((char*)d_ws + O_BAR, 0, 16384, stream) != hipSuccess) { fprintf(stderr, "kernel_launch: memset of barrier words failed\n"); return; }
  void* args[] = {&p};
  hipError_t e = hipLaunchCooperativeKernel((const void*)mega_fwd, dim3(grid), dim3(512), args, LDS_BYTES, stream);
  if (e != hipSuccess) fprintf(stderr, "cooperative launch failed: %s (grid %d)\n", hipGetErrorString(e), grid);
#else
  for (int ph = 0; ph < NPHASE; ++ph) {
    p.ph_lo = ph; p.ph_hi = ph + 1;
    hipLaunchKernelGGL(mega_fwd, dim3(grid), dim3(512), LDS_BYTES, stream, p);
  }
#endif
}
```

```cpp
#include <hip/hip_runtime.h>
#include <hip/hip_cooperative_groups.h>
#include <cstdio>
namespace cg = cooperative_groups;

#ifndef G2_LOADER
#define G2_LOADER 1
#endif
#ifndef MK_MODE
#define MK_MODE 1
#endif

typedef unsigned short bfr;
typedef __attribute__((ext_vector_type(8))) short bf16x8;
typedef __attribute__((ext_vector_type(4))) short bf16x4;
typedef __attribute__((ext_vector_type(4))) float f32x4;
typedef __attribute__((ext_vector_type(4))) unsigned u32x4;
typedef __attribute__((ext_vector_type(2))) unsigned u32x2;

#define DI __device__ __forceinline__
#define MFMA16(a, b, c) __builtin_amdgcn_mfma_f32_16x16x32_bf16((a), (b), (c), 0, 0, 0)

constexpr int PLANE = 16384 * 1024;
constexpr float EPS = 1e-6f;
constexpr int NPHASE = 22;
constexpr int LDS_BYTES = 163840;

constexpr size_t O_WLI = 0;
constexpr size_t O_WLO = 8388608;
constexpr size_t O_WGI = 12582912;
constexpr size_t O_WGO = 29884416;
constexpr size_t O_WG = 34078720;
constexpr size_t O_CONDP = 35127296;
constexpr size_t O_H = 36700160;
constexpr size_t O_PROJ = 70254592;
constexpr size_t O_ATTN = 204996608;
constexpr size_t O_HALO = 221773824;
constexpr size_t O_SCR = 226492416;
constexpr size_t O_AB = 260046848;
constexpr size_t O_ELAST = 261095424;
constexpr size_t O_AGG = 261103616;
constexpr size_t O_COND = 263200768;
constexpr size_t O_BAR = 263397376;
constexpr size_t WS_END = 263397376 + 16384;

struct Params {
  const float *x, *c, *ada_w, *ada_b, *norm_g, *final_g;
  const float *lru_in_w, *lru_conv_w, *lru_conv_b, *lru_gate_w, *lru_gate_b, *lru_lambda, *lru_out_w;
  const float *gdn_in_w, *gdn_conv_w, *gdn_a_log, *gdn_dt_bias, *gdn_onorm_g, *gdn_out_w;
  float* out;
  char* ws;
  int ph_lo, ph_hi;
};

DI int otid() { int t = threadIdx.x; asm volatile("" : "+v"(t)); return t; }
DI int obid() { int b = blockIdx.x; asm volatile("" : "+s"(b)); return b; }
DI void lds_barrier() { asm volatile("s_waitcnt lgkmcnt(0)" ::: "memory"); __builtin_amdgcn_s_barrier(); asm volatile("" ::: "memory"); }
typedef float f32x2_t __attribute__((ext_vector_type(2)));
typedef __bf16 bf16x2_t __attribute__((ext_vector_type(2)));
DI unsigned pack2(float a, float b) { f32x2_t v = {a, b}; bf16x2_t r = __builtin_convertvector(v, bf16x2_t); return __builtin_bit_cast(unsigned, r); }
DI bfr f2bf(float x) { return (bfr)(pack2(x, x) & 0xffffu); }
DI float bf2f(bfr b) { return __uint_as_float(((unsigned)b) << 16); }
DI float sum16(float x) {
  x += __uint_as_float(__builtin_amdgcn_update_dpp(0, __float_as_uint(x), 0xB1, 0xF, 0xF, true));
  x += __uint_as_float(__builtin_amdgcn_update_dpp(0, __float_as_uint(x), 0x4E, 0xF, 0xF, true));
  x += __uint_as_float(__builtin_amdgcn_update_dpp(0, __float_as_uint(x), 0x141, 0xF, 0xF, true));
  x += __uint_as_float(__builtin_amdgcn_update_dpp(0, __float_as_uint(x), 0x140, 0xF, 0xF, true));
  return x;
}
DI float sigmoidf_(float x) { return __builtin_amdgcn_rcpf(1.f + __expf(-x)); }
DI float siluf_(float x) { return x * __builtin_amdgcn_rcpf(1.f + __expf(-x)); }
DI float softplusf_(float x) { return x > 20.f ? x : log1pf(expf(x)); }
DI float bfe(const bf16x8& v, int e) { return bf2f((bfr)v[e]); }

DI char* ows(const Params& p) { size_t z = 0; asm volatile("" : "+s"(z)); return p.ws + z; }
DI float cond_get(const Params& p, int layer, int b, int n) {
  const float* cp = (const float*)(ows(p) + O_CONDP);
  float s = p.ada_b[layer * 3072 + n];
#pragma unroll
  for (int sg = 0; sg < 8; ++sg) s += cp[((sg * 4 + layer) * 4 + b) * 3072 + n];
  return s;
}

DI void transpose_tile(const float* __restrict__ src, int ldsrc, int nvalid, bfr* __restrict__ dst, int ldd, int k0, int n0, float* sm) {
  const int tid = otid();
  for (int e = tid; e < 4096; e += 512) {
    int kk = e >> 6, nn = e & 63;
    float v = 0.f;
    if (n0 + nn < nvalid) v = src[(size_t)(k0 + kk) * ldsrc + n0 + nn];
    sm[kk * 65 + nn] = v;
  }
  __syncthreads();
  for (int e = tid; e < 4096; e += 512) {
    int nn = e >> 6, kk = e & 63;
    dst[(size_t)(n0 + nn) * ldd + k0 + kk] = f2bf(sm[kk * 65 + nn]);
  }
  __syncthreads();
}

struct P0Item { const float* src; bfr* dst; int ldsrc, nvalid, ldd, k0, n0; };
DI P0Item p0_decode(const Params& p, int it) {
  P0Item r;
  if (it < 1024) {
    int l = it >> 9, q = it & 511, kt = q >> 5, nt = q & 31;
    r.src = p.lru_in_w + (size_t)l * 1024 * 2048; r.ldsrc = 2048; r.nvalid = 2048; r.dst = (bfr*)(ows(p) + O_WLI) + (size_t)l * 2048 * 1024; r.ldd = 1024; r.k0 = kt * 64; r.n0 = nt * 64;
  } else if (it < 1536) {
    int r0 = it - 1024, l = r0 >> 8, q = r0 & 255, kt = q >> 4, nt = q & 15;
    r.src = p.lru_out_w + (size_t)l * 1024 * 1024; r.ldsrc = 1024; r.nvalid = 1024; r.dst = (bfr*)(ows(p) + O_WLO) + (size_t)l * 1024 * 1024; r.ldd = 1024; r.k0 = kt * 64; r.n0 = nt * 64;
  } else if (it < 3648) {
    int r0 = it - 1536, l = r0 / 1056, q = r0 % 1056, kt = q / 66, nt = q % 66;
    r.src = p.gdn_in_w + (size_t)l * 1024 * 4112; r.ldsrc = 4112; r.nvalid = 4112; r.dst = (bfr*)(ows(p) + O_WGI) + (size_t)l * 4224 * 1024; r.ldd = 1024; r.k0 = kt * 64; r.n0 = nt * 64;
  } else if (it < 4160) {
    int r0 = it - 3648, l = r0 >> 8, q = r0 & 255, kt = q >> 4, nt = q & 15;
    r.src = p.gdn_out_w + (size_t)l * 1024 * 1024; r.ldsrc = 1024; r.nvalid = 1024; r.dst = (bfr*)(ows(p) + O_WGO) + (size_t)l * 1024 * 1024; r.ldd = 1024; r.k0 = kt * 64; r.n0 = nt * 64;
  } else {
    int r0 = it - 4160, mat = r0 >> 2, q = r0 & 3, kt = q >> 1, nt = q & 1;
    r.src = p.lru_gate_w + (size_t)mat * 16384; r.ldsrc = 128; r.nvalid = 128; r.dst = (bfr*)(ows(p) + O_WG) + (size_t)mat * 16384; r.ldd = 128; r.k0 = kt * 64; r.n0 = nt * 64;
  }
  return r;
}

DI void phase0(const Params& p, char* lds) {
  float* sm = (float*)lds;
  const int tid = otid();
  float v[8];
#define P0_LOAD(it_)                                                                                 \
  {                                                                                                  \
    const P0Item t_ = p0_decode(p, (it_));                                                           \
    _Pragma("unroll") for (int i = 0; i < 8; ++i) {                                                  \
      const int e = tid + 512 * i, kk = e >> 6, nn = e & 63;                                         \
      v[i] = (t_.n0 + nn < t_.nvalid) ? __builtin_nontemporal_load(&t_.src[(size_t)(t_.k0 + kk) * t_.ldsrc + t_.n0 + nn]) : 0.f; \
    }                                                                                                \
  }
  if (obid() < 4288) P0_LOAD(obid());
#pragma unroll 1
  for (int it = obid(); it < 4288; it += gridDim.x) {
    const P0Item t = p0_decode(p, it);
#pragma unroll
    for (int i = 0; i < 8; ++i) { const int e = tid + 512 * i; sm[(e >> 6) * 65 + (e & 63)] = v[i]; }
    lds_barrier();
    if (it + (int)gridDim.x < 4288) P0_LOAD(it + gridDim.x);
#pragma unroll
    for (int i = 0; i < 4; ++i) {
      const int e = tid + 512 * i, nn = e >> 5, kp = e & 31;
      *(unsigned*)&t.dst[(size_t)(t.n0 + nn) * t.ldd + t.k0 + 2 * kp] = pack2(sm[(2 * kp) * 65 + nn], sm[(2 * kp + 1) * 65 + nn]);
    }
    lds_barrier();
  }
#undef P0_LOAD
  __syncthreads();
  for (int r0 = obid(); r0 < 192; r0 += gridDim.x) {
    int i = r0 / 48, r = r0 % 48, sg = r / 6, cb = r % 6;
    sm[tid] = siluf_(p.c[(tid >> 7) * 1024 + sg * 128 + (tid & 127)]);
    __syncthreads();
    int n = cb * 512 + tid;
    float a0 = 0.f, a1 = 0.f, a2 = 0.f, a3 = 0.f;
    const float* w = p.ada_w + ((size_t)i * 1024 + sg * 128) * 3072 + n;
#pragma unroll 32
    for (int k = 0; k < 128; ++k) {
      float wv = __builtin_nontemporal_load(&w[(size_t)k * 3072]);
      a0 += sm[k] * wv; a1 += sm[128 + k] * wv; a2 += sm[256 + k] * wv; a3 += sm[384 + k] * wv;
    }
    float* cp = (float*)(ows(p) + O_CONDP);
    cp[((sg * 4 + i) * 4 + 0) * 3072 + n] = a0;
    cp[((sg * 4 + i) * 4 + 1) * 3072 + n] = a1;
    cp[((sg * 4 + i) * 4 + 2) * 3072 + n] = a2;
    cp[((sg * 4 + i) * 4 + 3) * 3072 + n] = a3;
    __syncthreads();
  }
}

DI void norm_phase(const Params& p, int layer, const void* __restrict__ xsrc, char* lds) {
  const float* xs = (const float*)xsrc; const bfr* xsb = (const bfr*)xsrc;
  float* gm = (float*)lds;
  float* sh = gm + 1024;
  const int tid = otid(), lane = tid & 63, wv = tid >> 6;
  bfr* H = (bfr*)(ows(p) + O_H);
  if (layer == 0) {
    float* cd = (float*)(ows(p) + O_COND);
    for (int e = obid() * 512 + tid; e < 4 * 4 * 3072; e += gridDim.x * 512) {
      int n = e % 3072, ib = e / 3072;
      cd[e] = cond_get(p, ib >> 2, ib & 3, n);
    }
  }
  const float* cd = (const float*)(ows(p) + O_COND);
  for (int rt = obid(); rt < 256; rt += gridDim.x) {
    int b = rt >> 6;
    for (int c = tid; c < 1024; c += 512) {
      if (layer == 0) {
        float scale = cond_get(p, layer, b, 1024 + c), shift = cond_get(p, layer, b, c);
        gm[c] = p.norm_g[layer * 1024 + c] * (1.f + scale);
        sh[c] = shift;
      } else if (layer < 4) {
        gm[c] = p.norm_g[layer * 1024 + c] * (1.f + cd[(size_t)(layer * 4 + b) * 3072 + 1024 + c]);
        sh[c] = cd[(size_t)(layer * 4 + b) * 3072 + c];
      } else {
        gm[c] = p.final_g[c];
        sh[c] = 0.f;
      }
    }
    __syncthreads();
    u32x2 rb[2][4][4];
    if (layer != 0) {
#pragma unroll
      for (int g = 0; g < 2; ++g)
#pragma unroll
        for (int r = 0; r < 4; ++r)
#pragma unroll
          for (int jx = 0; jx < 4; ++jx) {
            const u32x2* xp = (const u32x2*)&xsb[((size_t)rt * 64 + wv * 8 + g * 4 + r) * 1024 + jx * 256 + lane * 4];
            rb[g][r][jx] = (layer == 4) ? __builtin_nontemporal_load(xp) : *xp;
          }
    }
#pragma unroll
    for (int r4 = 0; r4 < 8; r4 += 4) {
      f32x4 v[4][4];
#pragma unroll
      for (int r = 0; r < 4; ++r)
#pragma unroll
        for (int jx = 0; jx < 4; ++jx) {
          const size_t xi = ((size_t)rt * 64 + wv * 8 + r4 + r) * 1024 + jx * 256 + lane * 4;
          if (layer == 0) v[r][jx] = *(const f32x4*)&xs[xi];
          else {
            const u32x2 xb = rb[r4 >> 2][r][jx];
            v[r][jx] = (f32x4){__uint_as_float(xb[0] << 16), __uint_as_float(xb[0] & 0xffff0000u), __uint_as_float(xb[1] << 16), __uint_as_float(xb[1] & 0xffff0000u)};
          }
        }
#pragma unroll
      for (int r = 0; r < 4; ++r) {
        const size_t row = (size_t)rt * 64 + wv * 8 + r4 + r;
        float ss = 0.f;
#pragma unroll
        for (int jx = 0; jx < 4; ++jx) ss += v[r][jx][0] * v[r][jx][0] + v[r][jx][1] * v[r][jx][1] + v[r][jx][2] * v[r][jx][2] + v[r][jx][3] * v[r][jx][3];
        ss = sum16(ss);
        ss += __shfl_xor(ss, 16);
        ss += __shfl_xor(ss, 32);
        const float rstd = rsqrtf(ss * (1.f / 1024.f) + EPS);
#pragma unroll
        for (int jx = 0; jx < 4; ++jx) {
          const int c = jx * 256 + lane * 4;
          f32x4 g4 = *(const f32x4*)&gm[c], s4 = *(const f32x4*)&sh[c];
          f32x4 y;
#pragma unroll
          for (int e = 0; e < 4; ++e) y[e] = v[r][jx][e] * rstd * g4[e] + s4[e];
          if (layer < 4) {
            u32x2 o2; o2[0] = pack2(y[0], y[1]); o2[1] = pack2(y[2], y[3]);
            *(u32x2*)&H[row * 1024 + c] = o2;
          } else {
            __builtin_nontemporal_store(y, (f32x4*)&p.out[row * 1024 + c]);
          }
        }
      }
    }
    __syncthreads();
  }
}

namespace pg8 {
#define PG8_LAS __attribute__((address_space(3)))
typedef unsigned short bf16_t;
typedef short bf16x8 __attribute__((ext_vector_type(8)));
typedef float f32x4 __attribute__((ext_vector_type(4)));
typedef unsigned u32x4 __attribute__((ext_vector_type(4)));
constexpr int BM = 256, BK = 64, HALF = 128, HTB = HALF * BK * 2  , STAGE_BYTES = 8 * HTB, NXCD = 8, WGM = 8;

__host__ __device__ __forceinline__ int lds_byte(int r, int c) { const int st = (r >> 4) * 2 + (c >> 5), rr = r & 15, cc = c & 31, ob = rr * 64 + cc * 2; return st * 1024 + (ob ^ (((ob >> 9) & 1) << 5)); }
__host__ __device__ __forceinline__ void stage_rc(int b, int& R, int& C) { const int st = b / 1024, sb = b % 1024, swz = sb ^ (((sb >> 9) & 1) << 5); R = (st >> 1) * 16 + swz / 64; C = (st & 1) * 32 + (swz % 64) / 2; }
__host__ __device__ __forceinline__ int perm32(int rho) { const int n = rho >> 4, i = rho & 15; return 8 * (i >> 2) + 4 * n + (i & 3); }

struct Unit { int pm, pn; };
struct Gemm { const bf16_t* A; const bf16_t* Bt; int M, N, K; };

struct StaticOrder {
    int nM, nN, nwg, G, c;
    __host__ __device__ void init(int M, int N, int G_, int c_) { nM = M / BM; nN = N / BM; nwg = nM * nN; G = G_; c = c_; }
    __host__ __device__ bool next(int i, Unit& u) const {
        const long L = (long)i * G + c; if (L >= nwg) return false;
        int wgid = (int)L; { const int q = nwg / NXCD, r = nwg % NXCD, xcd = wgid % NXCD, off = wgid / NXCD; wgid = (xcd < r ? xcd * (q + 1) : r * (q + 1) + (xcd - r) * q) + off; }
        const int nig = WGM * nN, gid = wgid / nig, fm = gid * WGM, gsz = (nM - fm) < WGM ? (nM - fm) : WGM;
        u.pm = fm + ((wgid % nig) % gsz); u.pn = (wgid % nig) / gsz; return true;
    }
    __device__ __forceinline__ void a_ready(const Unit&) const {}
    __device__ __forceinline__ void done(const Unit&) const {}
};
__device__ __forceinline__ unsigned cvt_pk_bf16(float lo, float hi) { unsigned r; asm volatile("v_cvt_pk_bf16_f32 %0, %1, %2" : "=v"(r) : "v"(lo), "v"(hi)); return r; }

template <class Epi, class Sched, bool STAMP = false>
__device__ __forceinline__ void gemm_phase(PG8_LAS unsigned char* lds, const Gemm g, const Sched& S, const Epi& E, unsigned long long* stamps) {
    const int tid = otid(), wid = __builtin_amdgcn_readfirstlane(tid >> 6), lane = tid & 63, wr = wid >> 2, wc = wid & 3, fr = lane & 15, fq = lane >> 4;
    const int K = g.K, nt = K / BK;
    int ts_lo = 0, ts_hi = 0, nts = 0; const unsigned long long rt_entry = STAMP ? (unsigned long long)wall_clock64() : 0ull;
#define PG8_STAMP() do { if (STAMP && wid == 0 && nts < 64) { const unsigned long long _c = (unsigned long long)clock64(); \
        ts_lo = (lane == nts) ? (int)(unsigned)_c : ts_lo; ts_hi = (lane == nts) ? (int)(unsigned)(_c >> 32) : ts_hi; ++nts; } } while (0)
    PG8_STAMP();
    unsigned voffA[2], voffB[2];
#pragma unroll
    for (int i = 0; i < 2; ++i) { int R, C; stage_rc(tid * 16 + i * 8192, R, C); const int Rb = Epi::PERM ? ((R & ~31) + perm32(R & 31)) : R;
        voffA[i] = (unsigned)(R * K + C) * 2u; voffB[i] = (unsigned)(Rb * K + C) * 2u; }
    const size_t kstep = (size_t)(BK * 2);
    const size_t hstep = (size_t)HALF * K * 2;
    const size_t tstep = 2 * hstep;
    const unsigned ldsw = (unsigned)wid * 1024u;
    const int aoff = lds_byte(wr * 64 + fr, fq * 8), boff = lds_byte(wc * 32 + fr, fq * 8);
#define PG8_SA(b, h) (((b) * 2 + (h)) * HTB)
#define PG8_SB(b, h) ((4 + (b) * 2 + (h)) * HTB)
#define PG8_STAGE(bufoff, gbase, voff) do { _Pragma("unroll") for (int _i = 0; _i < 2; ++_i) \
        __builtin_amdgcn_global_load_lds((const unsigned*)((const char*)(gbase) + (voff)[_i]), (PG8_LAS unsigned*)(lds + (bufoff) + ldsw + _i * 8192), 16, 0, 0); } while (0)
#define PG8_LDA(dst, b, h) do { _Pragma("unroll") for (int m = 0; m < 4; ++m) _Pragma("unroll") for (int k = 0; k < 2; ++k) dst[m][k] = *(const PG8_LAS bf16x8*)(lds + PG8_SA(b, h) + aoff + m * 2048 + k * 1024); } while (0)
#define PG8_LDB(dst, b, h) do { _Pragma("unroll") for (int n = 0; n < 2; ++n) _Pragma("unroll") for (int k = 0; k < 2; ++k) dst[n][k] = *(const PG8_LAS bf16x8*)(lds + PG8_SB(b, h) + boff + n * 2048 + k * 1024); } while (0)
#define PG8_MMA(ai, bj, At, Bt) do { __builtin_amdgcn_s_setprio(1); _Pragma("unroll") for (int m = 0; m < 4; ++m) _Pragma("unroll") for (int n = 0; n < 2; ++n) _Pragma("unroll") for (int k = 0; k < 2; ++k) \
        acc[ai][bj][m][n] = __builtin_amdgcn_mfma_f32_16x16x32_bf16(Bt[n][k], At[m][k], acc[ai][bj][m][n], 0, 0, 0); __builtin_amdgcn_s_setprio(0); } while (0)
#define PG8_WAIT_V(n) asm volatile("s_waitcnt vmcnt(" #n ")" ::: "memory")
#define PG8_WAIT_L(n) asm volatile("s_waitcnt lgkmcnt(" #n ")" ::: "memory")
#define PG8_BAR __builtin_amdgcn_s_barrier()
#define PG8_SCHED __builtin_amdgcn_sched_barrier(0)
    Unit cur, nxt; int ui = 0;
    if (!S.next(0, cur)) return;
    f32x4 acc[2][2][4][2];
#pragma unroll
    for (int a = 0; a < 2; ++a)
#pragma unroll
        for (int b = 0; b < 2; ++b)
#pragma unroll
            for (int m = 0; m < 4; ++m)
#pragma unroll
                for (int n = 0; n < 2; ++n) acc[a][b][m][n] = (f32x4){0.f, 0.f, 0.f, 0.f};
    bf16x8 At[4][2], B0[2][2], B1[2][2];
    const char* cA = (const char*)g.A + (size_t)cur.pm * tstep; const char* cB = (const char*)g.Bt + (size_t)cur.pn * tstep;
    S.a_ready(cur);
    PG8_STAGE(PG8_SB(0, 0), cB, voffB); PG8_STAGE(PG8_SA(0, 0), cA, voffA); PG8_STAGE(PG8_SB(0, 1), cB + hstep, voffB); PG8_STAGE(PG8_SA(0, 1), cA + hstep, voffA);
    if (wr == 1) PG8_BAR;
    PG8_WAIT_V(4); PG8_BAR;
    PG8_STAGE(PG8_SB(1, 0), cB + kstep, voffB); PG8_STAGE(PG8_SA(1, 0), cA + kstep, voffA); PG8_STAGE(PG8_SB(1, 1), cB + hstep + kstep, voffB);
    PG8_WAIT_V(6); PG8_BAR;
    PG8_STAMP();
    for (;;) {
        const bool has_next = S.next(ui + 1, nxt);
        const char* nA = has_next ? (const char*)g.A + (size_t)nxt.pm * tstep : cA; const char* nB = has_next ? (const char*)g.Bt + (size_t)nxt.pn * tstep : cB;
        for (int t = 0; t < nt; t += 2) {
            const bool last = (t == nt - 2);
            const char* a1 = cA + (size_t)(t + 1) * kstep;
            const char* a2 = last ? nA : cA + (size_t)(t + 2) * kstep; const char* b2 = last ? nB : cB + (size_t)(t + 2) * kstep;
            const char* a3 = a2 + kstep; const char* b3 = b2 + kstep;
            if (last && has_next) S.a_ready(nxt);
            PG8_LDB(B0, 0, 0); PG8_SCHED; PG8_LDA(At, 0, 0); PG8_STAGE(PG8_SA(1, 1), a1 + hstep, voffA);
            PG8_WAIT_L(8); PG8_BAR; PG8_WAIT_L(0); PG8_MMA(0, 0, At, B0); PG8_BAR; PG8_SCHED;
            PG8_LDB(B1, 0, 1); PG8_STAGE(PG8_SB(0, 0), b2, voffB);
            PG8_BAR; PG8_WAIT_L(0); PG8_MMA(0, 1, At, B1); PG8_BAR;
            PG8_LDA(At, 0, 1); PG8_STAGE(PG8_SA(0, 0), a2, voffA);
            PG8_BAR; PG8_WAIT_L(0); PG8_MMA(1, 0, At, B0); PG8_BAR; PG8_SCHED;
            PG8_STAGE(PG8_SB(0, 1), b2 + hstep, voffB);
            PG8_WAIT_V(6); PG8_BAR; PG8_MMA(1, 1, At, B1); PG8_BAR;
            PG8_LDB(B0, 1, 0); PG8_SCHED; PG8_LDA(At, 1, 0); PG8_STAGE(PG8_SA(0, 1), a2 + hstep, voffA);
            PG8_WAIT_L(8); PG8_BAR; PG8_WAIT_L(0); PG8_MMA(0, 0, At, B0); PG8_BAR; PG8_SCHED;
            PG8_LDB(B1, 1, 1); PG8_STAGE(PG8_SB(1, 0), b3, voffB);
            PG8_BAR; PG8_WAIT_L(0); PG8_MMA(0, 1, At, B1); PG8_BAR;
            PG8_LDA(At, 1, 1); PG8_STAGE(PG8_SA(1, 0), a3, voffA);
            PG8_BAR; PG8_WAIT_L(0); PG8_MMA(1, 0, At, B0); PG8_BAR; PG8_SCHED;
            PG8_STAGE(PG8_SB(1, 1), b3 + hstep, voffB);
            PG8_WAIT_V(6); PG8_BAR; PG8_MMA(1, 1, At, B1); PG8_BAR;
        }
        PG8_STAMP();
        if constexpr (!Epi::AFTER_DRAIN) { E(acc, cur, wr, wc, fr, fq); S.done(cur); }
        PG8_STAMP();
        if (!has_next) break;
#pragma unroll
        for (int a = 0; a < 2; ++a)
#pragma unroll
            for (int b = 0; b < 2; ++b)
#pragma unroll
                for (int m = 0; m < 4; ++m)
#pragma unroll
                    for (int n = 0; n < 2; ++n) acc[a][b][m][n] = (f32x4){0.f, 0.f, 0.f, 0.f};
        cur = nxt; cA = nA; cB = nB; ++ui;
    }
    PG8_WAIT_V(0);
    if (wr == 0) PG8_BAR;
    PG8_BAR;
    if constexpr (Epi::AFTER_DRAIN) { E.fused(acc, cur, wr, wc, fr, fq, lds, wid, lane); S.done(cur); }
    PG8_STAMP();
    if (STAMP && wid == 0) { stamps[lane] = lane < nts ? (((unsigned long long)(unsigned)ts_hi << 32) | (unsigned)ts_lo) : 0ull;
        if (lane == 62) stamps[62] = rt_entry; if (lane == 63) stamps[63] = (unsigned long long)wall_clock64(); }
#undef PG8_STAMP
#undef PG8_SA
#undef PG8_SB
#undef PG8_STAGE
#undef PG8_LDA
#undef PG8_LDB
#undef PG8_MMA
#undef PG8_WAIT_V
#undef PG8_WAIT_L
#undef PG8_BAR
#undef PG8_SCHED
}
}

struct EpiProjBf16 {
  static constexpr bool PERM = true, AFTER_DRAIN = false;
  bfr* O; bfr* halo;
  __device__ __forceinline__ void operator()(const f32x4 (&acc)[2][2][4][2], const pg8::Unit& u, int wr, int wc, int fr, int fq) const {
    const int row0 = u.pm * 256 + wr * 64 + fr, col0 = u.pn * 256 + wc * 32 + 8 * fq;
#pragma unroll
    for (int ai = 0; ai < 2; ++ai)
#pragma unroll
      for (int m = 0; m < 4; ++m) {
        const int row = row0 + ai * 128 + m * 16;
        const int bb = row >> 12, ts = row & 4095;
#pragma unroll
        for (int bj = 0; bj < 2; ++bj) {
          const int col = col0 + bj * 128;
          const f32x4 v0 = acc[ai][bj][m][0], v1 = acc[ai][bj][m][1];
          u32x4 w; w.x = pack2(v0[0], v0[1]); w.y = pack2(v0[2], v0[3]); w.z = pack2(v1[0], v1[1]); w.w = pack2(v1[2], v1[3]);
          *(u32x4*)(O + (size_t)(col >> 10) * PLANE + ((size_t)((bb * 8 + ((col >> 7) & 7)) * 4096 + ts)) * 128 + (col & 127)) = w;
          if (halo && (row & 63) >= 61 && col < 3072)
            *(u32x4*)(halo + ((size_t)(row >> 6) * 3 + ((row & 63) - 61)) * 3072 + col) = w;
        }
      }
  }
};
struct EpiResid {
  static constexpr bool PERM = true, AFTER_DRAIN = false;
  bfr* out; const void* xin; int xin_f32; const float* gate;
  __device__ __forceinline__ void operator()(const f32x4 (&acc)[2][2][4][2], const pg8::Unit& u, int wr, int wc, int fr, int fq) const {
    const int row0 = u.pm * 256 + wr * 64 + fr, col0 = u.pn * 256 + wc * 32 + 8 * fq;
    const float* gp = gate + (size_t)((u.pm * 256) >> 12) * 3072 + col0;
    f32x4 gv[2][2];
#pragma unroll
    for (int bj = 0; bj < 2; ++bj)
#pragma unroll
      for (int n = 0; n < 2; ++n) gv[bj][n] = *(const f32x4*)(gp + bj * 128 + n * 4);
#pragma unroll
    for (int ai = 0; ai < 2; ++ai)
#pragma unroll
      for (int m = 0; m < 4; ++m) {
        const size_t ro = (size_t)(row0 + ai * 128 + m * 16) * 1024 + col0;
#pragma unroll
        for (int bj = 0; bj < 2; ++bj) {
          f32x4 x0, x1;
          if (xin_f32) {
            x0 = __builtin_nontemporal_load((const f32x4*)((const float*)xin + ro + bj * 128));
            x1 = __builtin_nontemporal_load((const f32x4*)((const float*)xin + ro + bj * 128 + 4));
          } else {
            const u32x4 xb = *(const u32x4*)((const bfr*)xin + ro + bj * 128);
            x0 = (f32x4){__uint_as_float(xb[0] << 16), __uint_as_float(xb[0] & 0xffff0000u), __uint_as_float(xb[1] << 16), __uint_as_float(xb[1] & 0xffff0000u)};
            x1 = (f32x4){__uint_as_float(xb[2] << 16), __uint_as_float(xb[2] & 0xffff0000u), __uint_as_float(xb[3] << 16), __uint_as_float(xb[3] & 0xffff0000u)};
          }
          const f32x4 v0 = x0 + gv[bj][0] * acc[ai][bj][m][0], v1 = x1 + gv[bj][1] * acc[ai][bj][m][1];
          u32x4 w; w.x = pack2(v0[0], v0[1]); w.y = pack2(v0[2], v0[3]); w.z = pack2(v1[0], v1[1]); w.w = pack2(v1[2], v1[3]);
          *(u32x4*)(out + ro + bj * 128) = w;
        }
      }
  }
};

template <int EPI>
DI void gemm_phase(const Params& p, const bfr* __restrict__ A, int lda, const bfr* __restrict__ Bt, int nN, int layer, const void* __restrict__ xin, bfr* __restrict__ xout, char* lds) {
  pg8::Gemm g; g.A = A; g.Bt = Bt; g.M = 16384; g.N = nN * 256; g.K = 1024;
  pg8::StaticOrder S; S.init(g.M, g.N, gridDim.x, obid());
  if (EPI == 2) {
    EpiResid E; E.out = xout; E.xin = xin; E.xin_f32 = (layer == 0) ? 1 : 0; E.gate = (const float*)(ows(p) + O_COND) + (size_t)layer * 4 * 3072 + 2048;
    pg8::gemm_phase<EpiResid, pg8::StaticOrder, false>((PG8_LAS unsigned char*)lds, g, S, E, nullptr);
  } else {
    EpiProjBf16 E; E.O = (bfr*)(ows(p) + O_PROJ); E.halo = (EPI == 1) ? (bfr*)(ows(p) + O_HALO) : nullptr;
    pg8::gemm_phase<EpiProjBf16, pg8::StaticOrder, false>((PG8_LAS unsigned char*)lds, g, S, E, nullptr);
  }
  if (EPI == 1) {
    __syncthreads();
    float* red = (float*)lds;
    const int tid = otid(), lane = tid & 63, wv = tid >> 6, l15 = lane & 15, q = lane >> 4;
    const int mt4 = wv & 3, kh = wv >> 2;
    for (int rt = obid(); rt < 256; rt += gridDim.x) {
      const bfr* Ar = A + (size_t)(rt * 64 + mt4 * 16 + l15) * lda + kh * 512 + q * 8;
      const bfr* Br = Bt + (size_t)(4096 + l15) * 1024 + kh * 512 + q * 8;
      f32x4 acc = (f32x4){0.f, 0.f, 0.f, 0.f};
#pragma unroll 4
      for (int ks = 0; ks < 16; ++ks) acc = MFMA16(*(const bf16x8*)(Ar + ks * 32), *(const bf16x8*)(Br + ks * 32), acc);
      if (kh == 1) *(f32x4*)&red[(mt4 * 64 + lane) * 4] = acc;
      __syncthreads();
      if (kh == 0) {
        f32x4 o = *(const f32x4*)&red[(mt4 * 64 + lane) * 4];
#pragma unroll
        for (int jx = 0; jx < 4; ++jx) ((float*)(ows(p) + O_AB))[(size_t)(rt * 64 + mt4 * 16 + q * 4 + jx) * 16 + l15] = acc[jx] + o[jx];
      }
      __syncthreads();
    }
  }
}

DI void lru_phase(const Params& p, int j, char* lds) {
  const int tid = otid(), lane = tid & 63, wv = tid >> 6, l15 = lane & 15, q = lane >> 4;
  bfr* Xw = (bfr*)lds + wv * (32 * 136);
  float* WAgg = (float*)(lds + 8 * 32 * 136 * 2);
  const bfr* proj = (const bfr*)(ows(p) + O_PROJ);
  bfr* Yb = (bfr*)(ows(p) + O_H);
  const bfr* WG = (const bfr*)(ows(p) + O_WG);
  for (int unit = obid(); unit < 256; unit += gridDim.x) {
    const int xcd = unit & 7, li = unit >> 3, idx = xcd * 4 + (li >> 3), sl = li & 7, b = idx >> 3, gb = idx & 7;
    const int ch = gb * 128 + sl * 16 + l15;
    bf16x8 Bf[2][4];
#pragma unroll
    for (int kq = 0; kq < 2; ++kq)
#pragma unroll
      for (int ks = 0; ks < 4; ++ks) Bf[kq][ks] = *(const bf16x8*)&WG[(size_t)((j * 2 + kq) * 8 + gb) * 16384 + (sl * 16 + l15) * 128 + ks * 32 + q * 8];
    const float gbr = p.lru_gate_b[(j * 2) * 1024 + ch], gbi = p.lru_gate_b[(j * 2 + 1) * 1024 + ch];
    const float sp = softplusf_(-p.lru_lambda[j * 1024 + ch]);
    const int cg = lane & 15, rs = lane >> 4, ccol = gb * 128 + cg * 8;
    float cwv[4][8], cb[8];
#pragma unroll
    for (int tp = 0; tp < 4; ++tp)
#pragma unroll
      for (int e = 0; e < 8; ++e) cwv[tp][e] = p.lru_conv_w[(size_t)(j * 4 + tp) * 1024 + ccol + e];
#pragma unroll
    for (int e = 0; e < 8; ++e) cb[e] = p.lru_conv_b[j * 1024 + ccol + e];
    const bfr* xb_u = proj + (size_t)(b * 8 + gb) * 4096 * 128;
    bfr* yb_u = Yb + (size_t)b * 4096 * 1024;
    const int xo = (wv * 32 + rs * 8 - 3) * 128 + cg * 8;
    const int zo = PLANE + (wv * 32 + q * 4) * 128 + sl * 16 + (l15 & ~1);
    const int zsh = (l15 & 1) * 16;
    const int yo = (wv * 32 + q * 4) * 1024 + ch;
    float carry = 0.f;
    bf16x8 raw[11];
    unsigned zr[8];
#define LRU_LOAD(it)                                                                                   \
  {                                                                                                    \
    const bfr* xit = xb_u + (it) * (256 * 128);                                                        \
    _Pragma("unroll") for (int i = 0; i < 11; ++i) {                                                   \
      const int t = (it) * 256 + wv * 32 + rs * 8 - 3 + i;                                             \
      if (t >= 0) raw[i] = *(const bf16x8*)&xit[xo + i * 128];                                         \
      else raw[i] = (bf16x8){0, 0, 0, 0, 0, 0, 0, 0};                                                  \
    }                                                                                                  \
    _Pragma("unroll") for (int mt = 0; mt < 2; ++mt) _Pragma("unroll") for (int jx = 0; jx < 4; ++jx)  \
      zr[mt * 4 + jx] = *(const unsigned*)&xit[zo + (mt * 16 + jx) * 128];                                               \
  }
    LRU_LOAD(0);
#pragma unroll 1
    for (int it = 0; it < 16; ++it) {
#pragma unroll
      for (int r = 0; r < 8; ++r) {
        float o[8];
#pragma unroll
        for (int e = 0; e < 8; ++e) {
          float s = cb[e];
#pragma unroll
          for (int tp = 0; tp < 4; ++tp) s += cwv[tp][e] * bfe(raw[r + tp], e);
          o[e] = s;
        }
        u32x4 pk; pk[0] = pack2(o[0], o[1]); pk[1] = pack2(o[2], o[3]); pk[2] = pack2(o[4], o[5]); pk[3] = pack2(o[6], o[7]);
        *(u32x4*)&Xw[(rs * 8 + r) * 136 + cg * 8] = pk;
      }
      float zc[8];
#pragma unroll
      for (int i = 0; i < 8; ++i) zc[i] = bf2f((bfr)(zr[i] >> zsh));
      if (it < 15) LRU_LOAD(it + 1);
      f32x4 accr[2], acci[2];
#pragma unroll
      for (int mt = 0; mt < 2; ++mt) {
        accr[mt] = acci[mt] = (f32x4){0.f, 0.f, 0.f, 0.f};
#pragma unroll
        for (int ks = 0; ks < 4; ++ks) {
          bf16x8 af = *(const bf16x8*)&Xw[(mt * 16 + l15) * 136 + ks * 32 + q * 8];
          accr[mt] = MFMA16(af, Bf[0][ks], accr[mt]);
          acci[mt] = MFMA16(af, Bf[1][ks], acci[mt]);
        }
      }
      float av[2][4], bv[2][4];
      float Aex[2], Bex[2], At[2], Bt_[2];
#pragma unroll
      for (int mt = 0; mt < 2; ++mt) {
        float Al = 1.f, Bl = 0.f;
#pragma unroll
        for (int jx = 0; jx < 4; ++jx) {
          const float r = sigmoidf_(accr[mt][jx] + gbr), ig = sigmoidf_(acci[mt][jx] + gbi);
          const float a = __expf(-8.f * r * sp);
          const float mult = __builtin_amdgcn_sqrtf(fmaxf(1.f - a * a, 0.f));
          const float xf = bf2f(Xw[(mt * 16 + q * 4 + jx) * 136 + sl * 16 + l15]);
          const float bt = mult * ig * xf;
          av[mt][jx] = a; bv[mt][jx] = bt;
          Bl = a * Bl + bt; Al *= a;
        }
        float Ai = Al, Bi = Bl;
#pragma unroll
        for (int off = 16; off < 64; off <<= 1) {
          const float Ap = __shfl_up(Ai, off), Bp = __shfl_up(Bi, off);
          if (lane >= off) { Bi = Ai * Bp + Bi; Ai = Ai * Ap; }
        }
        float Ae = __shfl_up(Ai, 16), Be = __shfl_up(Bi, 16);
        if (q == 0) { Ae = 1.f; Be = 0.f; }
        Aex[mt] = Ae; Bex[mt] = Be;
        At[mt] = __shfl(Ai, 48 + l15); Bt_[mt] = __shfl(Bi, 48 + l15);
      }
      float* wa = WAgg + (it & 1) * 256;
      if (q == 0) { wa[(wv * 16 + l15) * 2] = At[0] * At[1]; wa[(wv * 16 + l15) * 2 + 1] = At[1] * Bt_[0] + Bt_[1]; }
      lds_barrier();
      float cin = carry, cnew = carry;
#pragma unroll
      for (int w = 0; w < 8; ++w) {
        const float Aw = wa[(w * 16 + l15) * 2], Bw = wa[(w * 16 + l15) * 2 + 1];
        cnew = Aw * cnew + Bw;
        if (w < wv) cin = Aw * cin + Bw;
      }
      carry = cnew;
      bfr* yit = yb_u + it * (256 * 1024);
#pragma unroll
      for (int mt = 0; mt < 2; ++mt) {
        float h = Aex[mt] * cin + Bex[mt];
#pragma unroll
        for (int jx = 0; jx < 4; ++jx) {
          h = av[mt][jx] * h + bv[mt][jx];
          yit[yo + (mt * 16 + jx) * 1024] = f2bf(h * siluf_(zc[mt * 4 + jx]));
        }
        cin = At[mt] * cin + Bt_[mt];
      }
    }
#undef LRU_LOAD
  }
}

DI bf16x8 ld_perm(const bfr* base) {
  u32x2 lo = *(const u32x2*)base, hi = *(const u32x2*)(base + 16);
  u32x4 r; r[0] = lo[0]; r[1] = lo[1]; r[2] = hi[0]; r[3] = hi[1];
  return __builtin_bit_cast(bf16x8, r);
}
DI bf16x8 pack_cc(const f32x4& a, const f32x4& b) {
  u32x4 r; r[0] = pack2(a[0], a[1]); r[1] = pack2(a[2], a[3]); r[2] = pack2(b[0], b[1]); r[3] = pack2(b[2], b[3]);
  return __builtin_bit_cast(bf16x8, r);
}


template <int NL> DI void row_load(f32x4 (&a)[8], unsigned addr, float& dep) {
  if constexpr (NL == 1) asm volatile("ds_read_b128 %0, %2\n\ts_waitcnt lgkmcnt(0)" : "=&v"(a[0]), "+v"(dep) : "v"(addr) : "memory");
  if constexpr (NL == 2) asm volatile("ds_read_b128 %0, %3\n\tds_read_b128 %1, %3 offset:16\n\ts_waitcnt lgkmcnt(0)" : "=&v"(a[0]), "=&v"(a[1]), "+v"(dep) : "v"(addr) : "memory");
  if constexpr (NL == 3) asm volatile("ds_read_b128 %0, %4\n\tds_read_b128 %1, %4 offset:16\n\tds_read_b128 %2, %4 offset:32\n\ts_waitcnt lgkmcnt(0)" : "=&v"(a[0]), "=&v"(a[1]), "=&v"(a[2]), "+v"(dep) : "v"(addr) : "memory");
  if constexpr (NL == 4) asm volatile("ds_read_b128 %0, %5\n\tds_read_b128 %1, %5 offset:16\n\tds_read_b128 %2, %5 offset:32\n\tds_read_b128 %3, %5 offset:48\n\ts_waitcnt lgkmcnt(0)" : "=&v"(a[0]), "=&v"(a[1]), "=&v"(a[2]), "=&v"(a[3]), "+v"(dep) : "v"(addr) : "memory");
  if constexpr (NL == 5) asm volatile("ds_read_b128 %0, %6\n\tds_read_b128 %1, %6 offset:16\n\tds_read_b128 %2, %6 offset:32\n\tds_read_b128 %3, %6 offset:48\n\tds_read_b128 %4, %6 offset:64\n\ts_waitcnt lgkmcnt(0)" : "=&v"(a[0]), "=&v"(a[1]), "=&v"(a[2]), "=&v"(a[3]), "=&v"(a[4]), "+v"(dep) : "v"(addr) : "memory");
  if constexpr (NL == 6) asm volatile("ds_read_b128 %0, %7\n\tds_read_b128 %1, %7 offset:16\n\tds_read_b128 %2, %7 offset:32\n\tds_read_b128 %3, %7 offset:48\n\tds_read_b128 %4, %7 offset:64\n\tds_read_b128 %5, %7 offset:80\n\ts_waitcnt lgkmcnt(0)" : "=&v"(a[0]), "=&v"(a[1]), "=&v"(a[2]), "=&v"(a[3]), "=&v"(a[4]), "=&v"(a[5]), "+v"(dep) : "v"(addr) : "memory");
  if constexpr (NL == 7) asm volatile("ds_read_b128 %0, %8\n\tds_read_b128 %1, %8 offset:16\n\tds_read_b128 %2, %8 offset:32\n\tds_read_b128 %3, %8 offset:48\n\tds_read_b128 %4, %8 offset:64\n\tds_read_b128 %5, %8 offset:80\n\tds_read_b128 %6, %8 offset:96\n\ts_waitcnt lgkmcnt(0)" : "=&v"(a[0]), "=&v"(a[1]), "=&v"(a[2]), "=&v"(a[3]), "=&v"(a[4]), "=&v"(a[5]), "=&v"(a[6]), "+v"(dep) : "v"(addr) : "memory");
  if constexpr (NL == 8) asm volatile("ds_read_b128 %0, %9\n\tds_read_b128 %1, %9 offset:16\n\tds_read_b128 %2, %9 offset:32\n\tds_read_b128 %3, %9 offset:48\n\tds_read_b128 %4, %9 offset:64\n\tds_read_b128 %5, %9 offset:80\n\tds_read_b128 %6, %9 offset:96\n\tds_read_b128 %7, %9 offset:112\n\ts_waitcnt lgkmcnt(0)" : "=&v"(a[0]), "=&v"(a[1]), "=&v"(a[2]), "=&v"(a[3]), "=&v"(a[4]), "=&v"(a[5]), "=&v"(a[6]), "=&v"(a[7]), "+v"(dep) : "v"(addr) : "memory");
}
template <int I> DI void inv_rows(float (&t)[32], unsigned abase, int j) {
  if constexpr (I < 32) {
    float s = (I == j) ? 1.f : 0.f;
    if constexpr (I > 0) {
      f32x4 a[8];
      row_load<(I + 3) / 4>(a, abase + I * 256, t[I - 1]);
#pragma unroll
      for (int m4 = 0; m4 < I; m4 += 4) {
        s -= a[m4 >> 2][0] * t[m4];
        if (m4 + 1 < I) s -= a[m4 >> 2][1] * t[m4 + 1];
        if (m4 + 2 < I) s -= a[m4 >> 2][2] * t[m4 + 2];
        if (m4 + 3 < I) s -= a[m4 >> 2][3] * t[m4 + 3];
      }
    }
    t[I] = s;
    inv_rows<I + 1>(t, abase, j);
  }
}
DI void tri_invert32(const float* __restrict__ Au, bfr* __restrict__ Ttu, bfr* __restrict__ Tcu, int hf, int lane) {
  const int j = lane & 31;
  const float* Ab = Au + (32 * hf) * 64 + 32 * hf;
  float t[32];
  const unsigned abase = (unsigned)(size_t)Ab;
  inv_rows<0>(t, abase, j);
  if (lane < 32) {
#pragma unroll
    for (int i = 0; i < 32; ++i) Ttu[(32 * hf + i) * 72 + 32 * hf + j] = f2bf(t[i]);
    if (hf == 0) {
#pragma unroll
      for (int i = 0; i < 32; ++i) Ttu[i * 72 + 32 + j] = 0;
#pragma unroll
      for (int i4 = 0; i4 < 4; ++i4) {
        u32x4 pk;
        pk[0] = pack2(t[8 * i4], t[8 * i4 + 1]); pk[1] = pack2(t[8 * i4 + 2], t[8 * i4 + 3]);
        pk[2] = pack2(t[8 * i4 + 4], t[8 * i4 + 5]); pk[3] = pack2(t[8 * i4 + 6], t[8 * i4 + 7]);
        *(u32x4*)&Tcu[j * 40 + 8 * i4] = pk;
      }
    }
  }
}
DI void tri_merge(const float* __restrict__ Au, bfr* __restrict__ Ttu, const bfr* __restrict__ Tcu, int nt2, int lane) {
  const int l15 = lane & 15, q = lane >> 4;
  const f32x4 zero = (f32x4){0.f, 0.f, 0.f, 0.f};
  bf16x8 bfrag = *(const bf16x8*)&Tcu[(nt2 * 16 + l15) * 40 + q * 8];
  f32x4 X[2];
#pragma unroll
  for (int mt = 0; mt < 2; ++mt) {
    const float* ar = Au + (32 + mt * 16 + l15) * 64 + q * 8;
    f32x4 a0 = *(const f32x4*)ar, a1 = *(const f32x4*)(ar + 4);
    X[mt] = MFMA16(pack_cc(a0, a1), bfrag, zero);
  }
  bf16x8 xb = pack_cc(X[0], X[1]);
#pragma unroll
  for (int mt2 = 0; mt2 < 2; ++mt2) {
    bf16x8 a = ld_perm(Ttu + (32 + mt2 * 16 + l15) * 72 + 32 + q * 4);
    f32x4 r = MFMA16(a, xb, zero);
#pragma unroll
    for (int jx = 0; jx < 4; ++jx) Ttu[(32 + mt2 * 16 + q * 4 + jx) * 72 + nt2 * 16 + l15] = f2bf(-r[jx]);
  }
}

DI void gdn_g1(const Params& p, int j, char* lds) {
  float* Asl = (float*)lds;
  bfr* Tt = (bfr*)(lds + 65536);
  bfr* Kt = (bfr*)(lds + 102400);
  bfr* Qt = (bfr*)(lds + 119808);
  bfr* Vt = (bfr*)(lds + 137216);
  float* gc = (float*)(lds + 154624);
  float* be = (float*)(lds + 155648);
  float* cw = (float*)(lds + 156672);
  const int tid0 = otid();
  bfr* proj = (bfr*)(ows(p) + O_PROJ);
  bfr* KDT = (bfr*)(ows(p) + O_H);
  bfr* ATT = (bfr*)(ows(p) + O_ATTN);
  const bfr* HALO = (const bfr*)(ows(p) + O_HALO);
  bfr* SCR = (bfr*)(ows(p) + O_SCR) + (size_t)obid() * (4 * 2 * 8192);
  const float* AB = (const float*)(ows(p) + O_AB);
  float* EL = (float*)(ows(p) + O_ELAST);
  for (int grp = obid(); grp < 256; grp += gridDim.x) {
    const int bh = grp >> 3, b = bh >> 3, h = bh & 7;
    for (int e = tid0; e < 1536; e += 512) {
      int X = e >> 9, rem = e & 511, tap = rem >> 7, c = rem & 127;
      cw[(X * 4 + tap) * 128 + c] = p.gdn_conv_w[(size_t)(j * 4 + tap) * 3072 + X * 1024 + h * 128 + c];
    }
    bf16x8 nxt[3][5];
    float pfx_g = 0.f, pfx_b = 0.f;
#define G1_RAWLOAD(nn)                                                                                         \
  {                                                                                                            \
    const int rg_ = tid0 >> 4, cgi_ = tid0 & 15, r0_ = rg_ * 2;                                                \
    _Pragma("unroll") for (int X = 0; X < 3; ++X) {                                                            \
      _Pragma("unroll") for (int i = 0; i < 5; ++i) {                                                          \
        const int rr = r0_ - 3 + i;                                                                            \
        if (rr >= 0) nxt[X][i] = *(const bf16x8*)&proj[(size_t)X * PLANE + (size_t)(bh * 4096 + (nn) * 64 + rr) * 128 + cgi_ * 8];   \
        else if ((nn) > 0) nxt[X][i] = *(const bf16x8*)&HALO[((size_t)(b * 64 + (nn) - 1) * 3 + 3 + rr) * 3072 + X * 1024 + h * 128 + cgi_ * 8];   \
        else nxt[X][i] = (bf16x8){0, 0, 0, 0, 0, 0, 0, 0};                                                     \
      }                                                                                                        \
    }                                                                                                          \
  }
    G1_RAWLOAD((grp * 8) & 63);
#pragma unroll 1
    for (int half = 0; half < 2; ++half) {
      {
        int tid = tid0; asm volatile("" : "+v"(tid));
        const int lane = tid & 63, wv = tid >> 6;
        if (half == 0) {
          const int un = grp * 8 + wv, n = un & 63, t0 = b * 4096 + n * 64;
          float a_in = AB[(size_t)(t0 + lane) * 16 + h], b_in = AB[(size_t)(t0 + lane) * 16 + 8 + h];
          float g = -__expf(p.gdn_a_log[j * 8 + h]) * softplusf_(a_in + p.gdn_dt_bias[j * 8 + h]);
#pragma unroll
          for (int off = 1; off < 64; off <<= 1) {
            float v = __shfl_up(g, off);
            if (lane >= off) g += v;
          }
          pfx_g = g; pfx_b = sigmoidf_(b_in);
          if (lane == 63) EL[un] = __expf(g);
          if (wv < 4) { gc[wv * 64 + lane] = pfx_g; be[wv * 64 + lane] = pfx_b; }
        } else if (wv >= 4) {
          gc[(wv - 4) * 64 + lane] = pfx_g; be[(wv - 4) * 64 + lane] = pfx_b;
        }
      }
#pragma unroll 1
      for (int u = 0; u < 4; ++u) {
        const int un = grp * 8 + half * 4 + u, n = un & 63, t0 = b * 4096 + n * 64;
        int tid = tid0; asm volatile("" : "+v"(tid));
        const int lane = tid & 63, wv = tid >> 6, l15 = lane & 15, q = lane >> 4;
        const int rg = tid >> 4, cgi = tid & 15, r0 = rg * 2;
        __syncthreads();
        bf16x8 cur[3][5];
#pragma unroll
        for (int X = 0; X < 3; ++X)
#pragma unroll
          for (int i = 0; i < 5; ++i) cur[X][i] = nxt[X][i];
        if (half * 4 + u < 7) G1_RAWLOAD(n + 1);
#pragma unroll
        for (int X = 0; X < 3; ++X) {
          float val[2][8];
#pragma unroll
          for (int rr = 0; rr < 2; ++rr)
#pragma unroll
            for (int e = 0; e < 8; ++e) {
              float sacc = 0.f;
#pragma unroll
              for (int tp = 0; tp < 4; ++tp) sacc += cw[(X * 4 + tp) * 128 + cgi * 8 + e] * bfe(cur[X][rr + tp], e);
              val[rr][e] = siluf_(sacc);
            }
          if (X < 2) {
#pragma unroll
            for (int rr = 0; rr < 2; ++rr) {
              float ss = 0.f;
#pragma unroll
              for (int e = 0; e < 8; ++e) ss += val[rr][e] * val[rr][e];
              ss = sum16(ss);
              float rn = rsqrtf(ss + EPS);
              if (X == 0) rn *= 0.08838834764831845f;
#pragma unroll
              for (int e = 0; e < 8; ++e) val[rr][e] *= rn;
            }
          }
          bfr* Tile = (X == 0) ? Qt : (X == 1 ? Kt : Vt);
#pragma unroll
          for (int rr = 0; rr < 2; ++rr) {
            const int r = r0 + rr;
            u32x4 pk;
            pk[0] = pack2(val[rr][0], val[rr][1]); pk[1] = pack2(val[rr][2], val[rr][3]);
            pk[2] = pack2(val[rr][4], val[rr][5]); pk[3] = pack2(val[rr][6], val[rr][7]);
            *(u32x4*)&Tile[r * 136 + cgi * 8] = pk;
            if (X == 0) {
              const float eg = __expf(gc[u * 64 + r]);
              pk[0] = pack2(val[rr][0] * eg, val[rr][1] * eg); pk[1] = pack2(val[rr][2] * eg, val[rr][3] * eg);
              pk[2] = pack2(val[rr][4] * eg, val[rr][5] * eg); pk[3] = pack2(val[rr][6] * eg, val[rr][7] * eg);
              *(u32x4*)&proj[(size_t)(bh * 4096 + n * 64 + r) * 128 + cgi * 8] = pk;
            }
          }
        }
        lds_barrier();
        {
          const int mt = wv >> 1;
          f32x4 kk[2], qk[2];
          kk[0] = kk[1] = qk[0] = qk[1] = (f32x4){0.f, 0.f, 0.f, 0.f};
#pragma unroll
          for (int ks = 0; ks < 4; ++ks) {
            bf16x8 ak = *(const bf16x8*)&Kt[(mt * 16 + l15) * 136 + ks * 32 + q * 8];
            bf16x8 aq = *(const bf16x8*)&Qt[(mt * 16 + l15) * 136 + ks * 32 + q * 8];
#pragma unroll
            for (int t2 = 0; t2 < 2; ++t2) {
              int nt = (wv & 1) * 2 + t2;
              bf16x8 bk = *(const bf16x8*)&Kt[(nt * 16 + l15) * 136 + ks * 32 + q * 8];
              kk[t2] = MFMA16(bk, ak, kk[t2]);
              qk[t2] = MFMA16(bk, aq, qk[t2]);
            }
          }
          const int i = mt * 16 + l15;
          const float giv = gc[u * 64 + i], bei = be[u * 64 + i];
#pragma unroll
          for (int t2 = 0; t2 < 2; ++t2) {
            const int m0 = ((wv & 1) * 2 + t2) * 16 + q * 4;
            f32x4 av, tv;
#pragma unroll
            for (int jx = 0; jx < 4; ++jx) {
              const int m = m0 + jx;
              const float d = (i >= m) ? __expf(giv - gc[u * 64 + m]) : 0.f;
              av[jx] = (i > m) ? bei * kk[t2][jx] * d : 0.f;
              tv[jx] = qk[t2][jx] * d;
            }
            *(f32x4*)&Asl[u * 4096 + i * 64 + m0] = av;
            u32x2 pk; pk[0] = pack2(tv[0], tv[1]); pk[1] = pack2(tv[2], tv[3]);
            *(u32x2*)&ATT[(size_t)un * 4096 + i * 64 + m0] = pk;
          }
        }
        {
          const int dd = tid >> 2, tq = tid & 3;
          const float glast = gc[u * 64 + 63];
#pragma unroll
          for (int g8 = 0; g8 < 2; ++g8) {
            const int tok0 = tq * 16 + g8 * 8;
            float okd[8], okb[8], ovb[8];
#pragma unroll
            for (int e = 0; e < 8; ++e) {
              const int tok = tok0 + e;
              const float kv = bf2f(Kt[tok * 136 + dd]), vv = bf2f(Vt[tok * 136 + dd]);
              const float gg = gc[u * 64 + tok], bb = be[u * 64 + tok];
              okd[e] = kv * __expf(glast - gg);
              okb[e] = kv * bb * __expf(gg);
              ovb[e] = vv * bb;
            }
            u32x4 pk;
            pk[0] = pack2(okd[0], okd[1]); pk[1] = pack2(okd[2], okd[3]); pk[2] = pack2(okd[4], okd[5]); pk[3] = pack2(okd[6], okd[7]);
            *(u32x4*)&KDT[(size_t)un * 8192 + dd * 64 + tok0] = pk;
            pk[0] = pack2(okb[0], okb[1]); pk[1] = pack2(okb[2], okb[3]); pk[2] = pack2(okb[4], okb[5]); pk[3] = pack2(okb[6], okb[7]);
            *(u32x4*)&SCR[(u * 2 + 0) * 8192 + dd * 64 + tok0] = pk;
            pk[0] = pack2(ovb[0], ovb[1]); pk[1] = pack2(ovb[2], ovb[3]); pk[2] = pack2(ovb[4], ovb[5]); pk[3] = pack2(ovb[6], ovb[7]);
            *(u32x4*)&SCR[(u * 2 + 1) * 8192 + dd * 64 + tok0] = pk;
          }
        }
      }
      __syncthreads();
      {
      int tid = tid0; asm volatile("" : "+v"(tid));
      const int lane = tid & 63, wv = tid >> 6;
      tri_invert32(Asl + (wv >> 1) * 4096, Tt + (wv >> 1) * 4608, Kt + (wv >> 1) * 1280, wv & 1, lane);
      __syncthreads();
      tri_merge(Asl + (wv >> 1) * 4096, Tt + (wv >> 1) * 4608, Kt + (wv >> 1) * 1280, wv & 1, lane);
      __syncthreads();
      }
      {
        int tid = tid0; asm volatile("" : "+v"(tid));
        const int lane = tid & 63, wv = tid >> 6, l15 = lane & 15, q = lane >> 4;
        bf16x8 bkf[4][2], bvf[4][2];
#pragma unroll
        for (int u = 0; u < 4; ++u)
#pragma unroll
          for (int ks = 0; ks < 2; ++ks) {
            bkf[u][ks] = *(const bf16x8*)&SCR[(u * 2) * 8192 + (wv * 16 + l15) * 64 + ks * 32 + q * 8];
            bvf[u][ks] = *(const bf16x8*)&SCR[(u * 2 + 1) * 8192 + (wv * 16 + l15) * 64 + ks * 32 + q * 8];
          }
#pragma unroll
        for (int u = 0; u < 4; ++u) {
          const int n = (grp * 8 + half * 4 + u) & 63;
          f32x4 aw[4], au[4];
#pragma unroll
          for (int i = 0; i < 4; ++i) aw[i] = au[i] = (f32x4){0.f, 0.f, 0.f, 0.f};
#pragma unroll
          for (int ks = 0; ks < 2; ++ks) {
#pragma unroll
            for (int mt = 0; mt < 4; ++mt) {
              bf16x8 a = *(const bf16x8*)&Tt[u * 4608 + (mt * 16 + l15) * 72 + ks * 32 + q * 8];
              aw[mt] = MFMA16(bkf[u][ks], a, aw[mt]);
              au[mt] = MFMA16(bvf[u][ks], a, au[mt]);
            }
          }
          bfr* Wst = (u & 1) ? Kt : (bfr*)Asl;
          bfr* Ust = Wst + 64 * 136;
#pragma unroll
          for (int mt = 0; mt < 4; ++mt) {
            const int i = mt * 16 + l15, dc = wv * 16 + q * 4;
            u32x2 pk; pk[0] = pack2(aw[mt][0], aw[mt][1]); pk[1] = pack2(aw[mt][2], aw[mt][3]);
            *(u32x2*)&Wst[i * 136 + dc] = pk;
            pk[0] = pack2(au[mt][0], au[mt][1]); pk[1] = pack2(au[mt][2], au[mt][3]);
            *(u32x2*)&Ust[i * 136 + dc] = pk;
          }
          lds_barrier();
#pragma unroll
          for (int k = 0; k < 2; ++k) {
            const int id = tid + 512 * k, row = id >> 4, c16 = id & 15;
            const size_t go = (size_t)(bh * 4096 + n * 64 + row) * 128 + c16 * 8;
            *(u32x4*)&proj[(size_t)PLANE + go] = *(const u32x4*)&Wst[row * 136 + c16 * 8];
            *(u32x4*)&proj[(size_t)2 * PLANE + go] = *(const u32x4*)&Ust[row * 136 + c16 * 8];
          }
        }
      }
      __syncthreads();
    }
  }
#undef G1_RAWLOAD
}

DI void gdn_g2(const Params& p, int j, char* lds) {
  bfr* SbT = (bfr*)lds;
  bfr* VbT = (bfr*)(lds + 4352);
  const int tid = otid(), lane = tid & 63, wv = tid >> 6, l15 = lane & 15, q = lane >> 4;
  const bfr* proj = (const bfr*)(ows(p) + O_PROJ);
  const bfr* KDT = (const bfr*)(ows(p) + O_H);
  const bfr* ATT = (const bfr*)(ows(p) + O_ATTN);
  const float* EL = (const float*)(ows(p) + O_ELAST);
  bfr* OB = (bfr*)(ows(p) + O_SCR);
  for (int unit = obid(); unit < 256; unit += gridDim.x) {
    const int xcd = unit & 7, li = unit >> 3, bh = xcd * 4 + (li >> 3), slice = li & 7;
    const int b = bh >> 3, h = bh & 7;
    const int mt = wv & 3;
    const bool lo = wv < 4;
    const float elv = EL[bh * 64 + lane];
    f32x4 S = (f32x4){0.f, 0.f, 0.f, 0.f};
    for (int e = tid; e < 16 * 136; e += 512) SbT[e] = 0;
    bf16x8 A1s[4][4], K2s[4][2], A2s[4][2];
    unsigned urs[4][4];
    const bfr* pa_u = proj + (lo ? (size_t)PLANE : (size_t)0) + (size_t)bh * 4096 * 128;
    const int pa_o = (mt * 16 + l15) * 128 + q * 8;
    const bfr* pu_u = proj + (size_t)2 * PLANE + (size_t)bh * 4096 * 128 + slice * 16;
    const int pu_o = (mt * 16 + q * 4) * 128 + (l15 & ~1);
    const int ush = (l15 & 1) * 16;
    const bfr* kd_u = KDT + (size_t)bh * 64 * 8192;
    const int kd_o = (wv * 16 + l15) * 64 + q * 8;
    const bfr* at_u = ATT + (size_t)bh * 64 * 4096;
    const int at_o = (mt * 16 + l15) * 64 + q * 8;
#define G2_GLOAD(set, n)                                                                                     \
  {                                                                                                          \
    const bfr* pa_n = pa_u + (size_t)(n) * 64 * 128;                                                         \
    _Pragma("unroll") for (int ks = 0; ks < 4; ++ks) A1s[set][ks] = *(const bf16x8*)&pa_n[pa_o + ks * 32];   \
    const bfr* kd_n = kd_u + (n) * 8192;                                                                     \
    K2s[set][0] = *(const bf16x8*)&kd_n[kd_o];                                                               \
    K2s[set][1] = *(const bf16x8*)&kd_n[kd_o + 32];                                                          \
    if (lo) {                                                                                                \
      const bfr* pu_n = pu_u + (size_t)(n) * 64 * 128;                                                       \
      _Pragma("unroll") for (int jx = 0; jx < 4; ++jx) urs[set][jx] = *(const unsigned*)&pu_n[pu_o + jx * 128];               \
    } else {                                                                                                 \
      const bfr* at_n = at_u + (n) * 4096;                                                                   \
      A2s[set][0] = *(const bf16x8*)&at_n[at_o];                                                             \
      A2s[set][1] = *(const bf16x8*)&at_n[at_o + 32];                                                        \
    }                                                                                                        \
  }
#define G2_STEP(n, rs)                                                                                       \
  {                                                                                                          \
    f32x4 acc = (f32x4){0.f, 0.f, 0.f, 0.f};                                                                 \
    _Pragma("unroll") for (int ks = 0; ks < 4; ++ks) {                                                       \
      bf16x8 sb = *(const bf16x8*)&SbT[l15 * 136 + ks * 32 + q * 8];                                         \
      acc = lo ? MFMA16(A1s[rs][ks], sb, acc) : MFMA16(sb, A1s[rs][ks], acc);     \
    }                                                                                                        \
    if (lo) {                                                                                                \
      u32x2 pk;                                                                                              \
      pk[0] = pack2(bf2f((bfr)(urs[rs][0] >> ush)) - acc[0], bf2f((bfr)(urs[rs][1] >> ush)) - acc[1]);       \
      pk[1] = pack2(bf2f((bfr)(urs[rs][2] >> ush)) - acc[2], bf2f((bfr)(urs[rs][3] >> ush)) - acc[3]);       \
      *(u32x2*)&VbT[l15 * 72 + mt * 16 + q * 4] = pk;                                                        \
    }                                                                                                        \
    lds_barrier();                                                                                           \
    bf16x8 vb0 = *(const bf16x8*)&VbT[l15 * 72 + q * 8];                                                     \
    bf16x8 vb1 = *(const bf16x8*)&VbT[l15 * 72 + 32 + q * 8];                                                \
    if (!lo) {                                                                                               \
      acc = MFMA16(vb0, A2s[rs][0], acc);                                                                    \
      acc = MFMA16(vb1, A2s[rs][1], acc);                                                                    \
      u32x2 ok; ok[0] = pack2(acc[0], acc[1]); ok[1] = pack2(acc[2], acc[3]);                                \
      *(u32x2*)&OB[((size_t)(b * 4096 + (n) * 64) + mt * 16 + l15) * 1024 + h * 128 + slice * 16 + q * 4] = ok;  \
    }                                                                                                        \
    const float el = __shfl(elv, (n));                                                                       \
    S = S * el;                                                                                              \
    S = MFMA16(K2s[rs][0], vb0, S);                                                                          \
    S = MFMA16(K2s[rs][1], vb1, S);                                                                          \
    {                                                                                                        \
      u32x2 pk;                                                                                              \
      pk[0] = pack2(S[0], S[1]);                                                                             \
      pk[1] = pack2(S[2], S[3]);                                                                             \
      *(u32x2*)&SbT[l15 * 136 + wv * 16 + q * 4] = pk;                                                       \
    }                                                                                                        \
    if ((n) + 4 < 64) G2_GLOAD(rs, (n) + 4);                                                                 \
    lds_barrier();                                                                                           \
  }
    G2_GLOAD(0, 0);
    G2_GLOAD(1, 1);
    G2_GLOAD(2, 2);
    G2_GLOAD(3, 3);
    __syncthreads();
#pragma unroll 1
    for (int n = 0; n < 64; n += 4) {
      G2_STEP(n, 0);
      G2_STEP(n + 1, 1);
      G2_STEP(n + 2, 2);
      G2_STEP(n + 3, 3);
    }
#undef G2_GLOAD
#undef G2_STEP
  }
}

DI void gdn_g2l(const Params& p, int j, char* lds) {
  constexpr int STG = 51200;
  bfr* SbT = (bfr*)(lds + 3 * STG);
  bfr* VbT = (bfr*)(lds + 3 * STG + 4352);
  const int tid = otid(), lane = tid & 63, wv = tid >> 6, l15 = lane & 15, q = lane >> 4;
  const bfr* proj = (const bfr*)(ows(p) + O_PROJ);
  const bfr* KDT = (const bfr*)(ows(p) + O_H);
  const bfr* ATT = (const bfr*)(ows(p) + O_ATTN);
  const float* EL = (const float*)(ows(p) + O_ELAST);
  bfr* OB = (bfr*)(ows(p) + O_SCR);
  for (int unit = obid(); unit < 256; unit += gridDim.x) {
    const int xcd = unit & 7, li = unit >> 3, bh = xcd * 4 + (li >> 3), slice = li & 7;
    const int b = bh >> 3, h = bh & 7;
    const bool loader = wv >= 4;
    for (int e = tid; e < 16 * 136; e += 512) SbT[e] = 0;
    if (loader) {
      const int lw = __builtin_amdgcn_readfirstlane(wv - 4);
      const bfr* wq_u = proj + (size_t)bh * 4096 * 128;
      const bfr* kd_u = KDT + (size_t)bh * 64 * 8192;
      const int lo_wq = (lane >> 2) * 128 + (lane & 3) * 8, lo_kd = (lane >> 2) * 64 + (lane & 3) * 8;
      const bfr* u_u = proj + (size_t)2 * PLANE + (size_t)bh * 4096 * 128 + slice * 16 + (lw * 32 + (lane >> 1)) * 128 + (lane & 1) * 8;
#define G2L_DMA(c, stg)                                                                                      \
  {                                                                                                          \
    const int cc = (c) < 64 ? (c) : 63;                                                                      \
    const bfr* wq_c = wq_u + (size_t)cc * 64 * 128;                                                          \
    const bfr* kd_c = kd_u + (size_t)cc * 8192;                                                              \
    _Pragma("unroll") for (int i = 0; i < 12; ++i) {                                                         \
      const int blk = lw * 12 + i, X = blk >> 4, idx = blk & 15;                                             \
      const bfr* g = (X == 2) ? (kd_c + ((idx >> 1) * 16 * 64 + (idx & 1) * 32) + lo_kd)                     \
                              : (wq_c + (X == 0 ? (size_t)PLANE : (size_t)0) + ((idx >> 2) * 16 * 128 + (idx & 3) * 32) + lo_wq);  \
      __builtin_amdgcn_global_load_lds((const unsigned*)g, (PG8_LAS unsigned*)(lds + (stg) * STG + blk * 1024), 16, 0, 0);  \
    }                                                                                                        \
    if (lw < 2) __builtin_amdgcn_global_load_lds((const unsigned*)(u_u + (size_t)cc * 64 * 128), (PG8_LAS unsigned*)(lds + (stg) * STG + (48 + lw) * 1024), 16, 0, 0);  \
  }
#define G2L_WAITPREV() { if (lw < 2) asm volatile("s_waitcnt vmcnt(13)" ::: "memory"); else asm volatile("s_waitcnt vmcnt(12)" ::: "memory"); }
      G2L_DMA(0, 0);
      G2L_DMA(1, 1);
      G2L_WAITPREV();
      lds_barrier();
#pragma unroll 1
      for (int n = 0; n < 64; n += 3) {
#pragma unroll
        for (int s3 = 0; s3 < 3; ++s3) {
          if (n + s3 < 64) {
            G2L_DMA(n + s3 + 2, (s3 + 2) % 3);
            lds_barrier();
            G2L_WAITPREV();
            lds_barrier();
          }
        }
      }
      asm volatile("s_waitcnt vmcnt(0)" ::: "memory");
#undef G2L_DMA
#undef G2L_WAITPREV
    } else {
      const int mt = wv;
      const float elv = EL[bh * 64 + lane];
      f32x4 S0 = (f32x4){0.f, 0.f, 0.f, 0.f}, S1 = S0;
      bf16x8 At[4][2];
      const bfr* at_u = ATT + (size_t)bh * 64 * 4096 + (mt * 16 + l15) * 64 + q * 8;
#define G2L_GLOAD(set, c)                                                                                    \
  {                                                                                                          \
    const int cc = (c) < 64 ? (c) : 63;                                                                      \
    At[set][0] = *(const bf16x8*)&at_u[cc * 4096];                                                           \
    At[set][1] = *(const bf16x8*)&at_u[cc * 4096 + 32];                                                      \
  }
#define G2L_STEP(n, stg, rs)                                                                                 \
  {                                                                                                          \
    const char* sb_ = lds + (stg) * STG + l15 * 64 + q * 16;                                                 \
    f32x4 accp = (f32x4){0.f, 0.f, 0.f, 0.f}, acco = accp;                                                   \
    if ((n) > 0) {     \
      accd = MFMA16(vbd0, Atd0, accd);                                                                       \
      accd = MFMA16(vbd1, Atd1, accd);                                                                       \
      u32x2 ok; ok[0] = pack2(accd[0], accd[1]); ok[1] = pack2(accd[2], accd[3]);                            \
      *(u32x2*)&OB[((size_t)(b * 4096 + ((n) - 1) * 64) + mt * 16 + l15) * 1024 + h * 128 + slice * 16 + q * 4] = ok;  \
    }                                                                                                        \
    _Pragma("unroll") for (int ks = 0; ks < 4; ++ks) {                                                       \
      const bf16x8 sb = *(const bf16x8*)&SbT[l15 * 136 + ks * 32 + q * 8];                                   \
      accp = MFMA16(*(const bf16x8*)(sb_ + (mt * 4 + ks) * 1024), sb, accp);                                 \
      acco = MFMA16(sb, *(const bf16x8*)(sb_ + (16 + mt * 4 + ks) * 1024), acco);     \
    }                                                                                                        \
    {                                                                                                        \
      u32x2 pk;                                                                                              \
      const bfr* up_ = (const bfr*)(lds + (stg) * STG + 48 * 1024) + (mt * 16 + q * 4) * 16 + l15;           \
      pk[0] = pack2(bf2f(up_[0]) - accp[0], bf2f(up_[16]) - accp[1]);                                        \
      pk[1] = pack2(bf2f(up_[32]) - accp[2], bf2f(up_[48]) - accp[3]);                                       \
      *(u32x2*)&VbT[l15 * 72 + mt * 16 + q * 4] = pk;                                                        \
    }                                                                                                        \
    lds_barrier();                                                                                           \
    const bf16x8 vb0 = *(const bf16x8*)&VbT[l15 * 72 + q * 8];                                               \
    const bf16x8 vb1 = *(const bf16x8*)&VbT[l15 * 72 + 32 + q * 8];                                          \
    accd = acco; vbd0 = vb0; vbd1 = vb1; Atd0 = At[rs][0]; Atd1 = At[rs][1];                                 \
    const float el = __uint_as_float(__builtin_amdgcn_readlane(__float_as_uint(elv), (n)));       \
    S0 = S0 * el; S1 = S1 * el;                                                                              \
    S0 = MFMA16(*(const bf16x8*)(sb_ + (32 + (2 * mt) * 2 + 0) * 1024), vb0, S0);                            \
    S0 = MFMA16(*(const bf16x8*)(sb_ + (32 + (2 * mt) * 2 + 1) * 1024), vb1, S0);                            \
    S1 = MFMA16(*(const bf16x8*)(sb_ + (32 + (2 * mt + 1) * 2 + 0) * 1024), vb0, S1);                        \
    S1 = MFMA16(*(const bf16x8*)(sb_ + (32 + (2 * mt + 1) * 2 + 1) * 1024), vb1, S1);                        \
    {                                                                                                        \
      u32x2 pk;                                                                                              \
      pk[0] = pack2(S0[0], S0[1]); pk[1] = pack2(S0[2], S0[3]);                                              \
      *(u32x2*)&SbT[l15 * 136 + (2 * mt) * 16 + q * 4] = pk;                                                 \
      pk[0] = pack2(S1[0], S1[1]); pk[1] = pack2(S1[2], S1[3]);                                              \
      *(u32x2*)&SbT[l15 * 136 + (2 * mt + 1) * 16 + q * 4] = pk;                                             \
    }                                                                                                        \
    G2L_GLOAD(rs, (n) + 4);                                                                                  \
    lds_barrier();                                                                                           \
  }
      G2L_GLOAD(0, 0);
      G2L_GLOAD(1, 1);
      G2L_GLOAD(2, 2);
      G2L_GLOAD(3, 3);
      f32x4 accd = (f32x4){0.f, 0.f, 0.f, 0.f};
      bf16x8 vbd0 = (bf16x8){0, 0, 0, 0, 0, 0, 0, 0}, vbd1 = vbd0, Atd0 = vbd0, Atd1 = vbd0;
      lds_barrier();
#pragma unroll 1
      for (int n = 0; n < 60; n += 12) {
        G2L_STEP(n, 0, 0); G2L_STEP(n + 1, 1, 1); G2L_STEP(n + 2, 2, 2); G2L_STEP(n + 3, 0, 3);
        G2L_STEP(n + 4, 1, 0); G2L_STEP(n + 5, 2, 1); G2L_STEP(n + 6, 0, 2); G2L_STEP(n + 7, 1, 3);
        G2L_STEP(n + 8, 2, 0); G2L_STEP(n + 9, 0, 1); G2L_STEP(n + 10, 1, 2); G2L_STEP(n + 11, 2, 3);
      }
      G2L_STEP(60, 0, 0); G2L_STEP(61, 1, 1); G2L_STEP(62, 2, 2); G2L_STEP(63, 0, 3);
      {
        accd = MFMA16(vbd0, Atd0, accd);
        accd = MFMA16(vbd1, Atd1, accd);
        u32x2 ok; ok[0] = pack2(accd[0], accd[1]); ok[1] = pack2(accd[2], accd[3]);
        *(u32x2*)&OB[((size_t)(b * 4096 + 63 * 64) + mt * 16 + l15) * 1024 + h * 128 + slice * 16 + q * 4] = ok;
      }
#undef G2L_GLOAD
#undef G2L_STEP
    }
    __syncthreads();
  }
}

DI void gdn_g3(const Params& p, int j, char* lds) {
  const int tid = otid(), lane = tid & 63, wv = tid >> 6, l15 = lane & 15, q = lane >> 4;
  const bfr* proj = (const bfr*)(ows(p) + O_PROJ);
  bfr* OB = (bfr*)(ows(p) + O_SCR);
  f32x4 g0 = *(const f32x4*)&p.gdn_onorm_g[j * 128 + l15 * 8], g1 = *(const f32x4*)&p.gdn_onorm_g[j * 128 + l15 * 8 + 4];
  const int stride = gridDim.x * 32;
  int pi = (obid() * 8 + wv) * 4 + q;
  bf16x8 ov, zv;
#define G3_LOAD(pp)                                                                                                  \
  {                                                                                                                  \
    const int t_ = (pp) >> 3, h_ = (pp) & 7;                                                                         \
    ov = __builtin_nontemporal_load((const bf16x8*)&OB[(size_t)t_ * 1024 + h_ * 128 + l15 * 8]);                     \
    zv = __builtin_nontemporal_load((const bf16x8*)&proj[(size_t)3 * PLANE + (size_t)(((t_ >> 12) * 8 + h_) * 4096 + (t_ & 4095)) * 128 + l15 * 8]);  \
  }
  bf16x8 ov2 = (bf16x8){0, 0, 0, 0, 0, 0, 0, 0}, zv2 = ov2;
  if (pi < 131072) G3_LOAD(pi);
  if (pi + stride < 131072) { const bf16x8 o1 = ov, z1 = zv; G3_LOAD(pi + stride); ov2 = ov; zv2 = zv; ov = o1; zv = z1; }
  for (; pi < 131072; pi += stride) {
    const int t = pi >> 3, h = pi & 7;
    const bf16x8 oc = ov, zc = zv;
    ov = ov2; zv = zv2;
    if (pi + 2 * stride < 131072) { const bf16x8 o1 = ov, z1 = zv; G3_LOAD(pi + 2 * stride); ov2 = ov; zv2 = zv; ov = o1; zv = z1; }
    float o[8], ss = 0.f;
#pragma unroll
    for (int e = 0; e < 8; ++e) { o[e] = bfe(oc, e); ss += o[e] * o[e]; }
    ss = sum16(ss);
    const float rstd = rsqrtf(ss * (1.f / 128.f) + EPS);
    float y[8];
#pragma unroll
    for (int e = 0; e < 8; ++e) y[e] = o[e] * rstd * (e < 4 ? g0[e] : g1[e - 4]) * siluf_(bfe(zc, e));
    u32x4 pk;
    pk[0] = pack2(y[0], y[1]); pk[1] = pack2(y[2], y[3]); pk[2] = pack2(y[4], y[5]); pk[3] = pack2(y[6], y[7]);
    *(u32x4*)&OB[(size_t)t * 1024 + h * 128 + l15 * 8] = pk;
  }
#undef G3_LOAD
}


#define XB_TMO      128
#define XB_XCNT(j)  (256  + 64 * (j))
#define XB_XSUB(j)  (1280 + 64 * (j))
#define XB_XGEN(j)  (2304 + 64 * (j))
#define XB_TOP      3328
#define XB_TOPGEN   3392
#define XCD_BAR_WORDS 3456
#define XB_SPIN_CAP (1u << 18)
#define LAS __attribute__((address_space(3)))

__device__ __forceinline__ unsigned xb_ld(unsigned* p)              { return __hip_atomic_load(p, __ATOMIC_RELAXED, __HIP_MEMORY_SCOPE_AGENT); }
__device__ __forceinline__ unsigned xb_add(unsigned* p, unsigned v) { return __hip_atomic_fetch_add(p, v, __ATOMIC_RELAXED, __HIP_MEMORY_SCOPE_AGENT); }
__device__ __forceinline__ unsigned xb_xcc_id() { return (unsigned)__builtin_amdgcn_s_getreg((3 << 11) | 20) & 0xFu; }
#define XB_SPIN(cond, bar) do { unsigned _sp = 0; while (cond) { __builtin_amdgcn_s_sleep(1); \
    if ((++_sp & 255u) == 0u) { if (xb_ld(&(bar)[XB_TMO])) break; if (_sp > XB_SPIN_CAP) { atomicAdd(&(bar)[XB_TMO], 1u); break; } } } } while (0)

struct XcdBarrier {
    unsigned* bar; unsigned x;
    volatile LAS unsigned* st;
};

__device__ __forceinline__ XcdBarrier xcd_barrier_post(unsigned* bar, volatile LAS unsigned* st) {
    XcdBarrier b; b.bar = bar; b.x = xb_xcc_id(); b.st = st;
    if (threadIdx.x == 0) (void)xb_add(&bar[XB_XCNT(b.x)], 1u);
    return b;
}
__device__ __forceinline__ void xcd_barrier_complete(unsigned* bar, unsigned x, unsigned& nloc, unsigned& nx) {
    const unsigned G = gridDim.x * gridDim.y * gridDim.z;
    unsigned sum, cnt, mine, sp = 0u;
    for (;;) {
        sum = 0u; cnt = 0u; mine = 0u;
#pragma unroll
        for (unsigned j = 0; j < 16; ++j) { const unsigned c = xb_ld(&bar[XB_XCNT(j)]); sum += c; cnt += (c > 0u) ? 1u : 0u; mine = (j == x) ? c : mine; }
        if (sum == G) break;
        __builtin_amdgcn_s_sleep(1);
        if ((++sp & 255u) == 0u) { if (xb_ld(&bar[XB_TMO])) break; if (sp > XB_SPIN_CAP) { atomicAdd(&bar[XB_TMO], 1u); break; } }
    }
    nloc = mine > 0u ? mine : 1u; nx = cnt > 0u ? cnt : 1u;
}

__device__ __forceinline__ void xcd_barrier(const XcdBarrier& b) {
    asm volatile("s_waitcnt vmcnt(0)" ::: "memory");
    __syncthreads();
    if (threadIdx.x == 0) {
        unsigned* bar = b.bar;
        __builtin_amdgcn_s_waitcnt(0);
        unsigned nloc = b.st[0], nx = b.st[1];
        if (nloc == 0u) { xcd_barrier_complete(bar, b.x, nloc, nx); b.st[0] = nloc; b.st[1] = nx; }
        const unsigned old = xb_add(&bar[XB_XSUB(b.x)], 1u);
        const unsigned gen = old / nloc;
        if (old + 1u == (gen + 1u) * nloc) {
            __builtin_amdgcn_fence(__ATOMIC_RELEASE, "agent");
            asm volatile("s_waitcnt vmcnt(0)" ::: "memory");
            const unsigned og = xb_add(&bar[XB_TOP], 1u);
            const unsigned tg = og / nx;
            if (og + 1u == (tg + 1u) * nx) xb_add(&bar[XB_TOPGEN], 1u);
            else XB_SPIN(xb_ld(&bar[XB_TOPGEN]) == tg, bar);
            __builtin_amdgcn_fence(__ATOMIC_ACQUIRE, "agent");
            xb_add(&bar[XB_XGEN(b.x)], 1u);
            asm volatile("s_waitcnt vmcnt(0)" ::: "memory");
        } else {
            XB_SPIN(xb_ld(&bar[XB_XGEN(b.x)]) == gen, bar);
            __builtin_amdgcn_fence(__ATOMIC_ACQUIRE, "agent");
            asm volatile("s_waitcnt vmcnt(0)" ::: "memory");
        }
    }
    __syncthreads();
}


DI void run_phase(const Params& p, int ph, char* lds) {
  if (ph == 0) { phase0(p, lds); return; }
  if (ph == NPHASE - 1) { norm_phase(p, 4, ows(p) + O_H, lds); return; }
  int layer, sub;
  if (ph < 5) { layer = 0; sub = ph - 1; }
  else if (ph < 11) { layer = 1; sub = ph - 5; }
  else if (ph < 15) { layer = 2; sub = ph - 11; }
  else { layer = 3; sub = ph - 15; }
  const int j = layer >> 1;
  const bool is_lru = (layer & 1) == 0;
  const bfr* H = (const bfr*)(ows(p) + O_H);
  const void* xcur = (layer == 0) ? (const void*)p.x : (const void*)p.out;
  bfr* xnext = (layer == 3) ? (bfr*)(ows(p) + O_H) : (bfr*)p.out;
  if (is_lru) {
    switch (sub) {
      case 0: norm_phase(p, layer, xcur, lds); break;
      case 1: gemm_phase<0>(p, H, 1024, (const bfr*)(ows(p) + O_WLI) + (size_t)j * 2048 * 1024, 8, layer, nullptr, nullptr, lds); break;
      case 2: lru_phase(p, j, lds); break;
      case 3: gemm_phase<2>(p, H, 1024, (const bfr*)(ows(p) + O_WLO) + (size_t)j * 1024 * 1024, 4, layer, xcur, xnext, lds); break;
    }
  } else {
    switch (sub) {
      case 0: norm_phase(p, layer, xcur, lds); break;
      case 1: gemm_phase<1>(p, H, 1024, (const bfr*)(ows(p) + O_WGI) + (size_t)j * 4224 * 1024, 16, layer, nullptr, nullptr, lds); break;
      case 2: gdn_g1(p, j, lds); break;
#if G2_LOADER
      case 3: gdn_g2l(p, j, lds); break;
#else
      case 3: gdn_g2(p, j, lds); break;
#endif
      case 4: gdn_g3(p, j, lds); break;
      case 5: gemm_phase<2>(p, (const bfr*)(ows(p) + O_SCR), 1024, (const bfr*)(ows(p) + O_WGO) + (size_t)j * 1024 * 1024, 4, layer, xcur, xnext, lds); break;
    }
  }
}

__global__ void __launch_bounds__(512) mega_fwd(Params p) {
  extern __shared__ __attribute__((aligned(16))) char lds[];
#if MK_MODE == 1
  cg::grid_group grid = cg::this_grid();
  if (p.ph_lo < 0) grid.sync();
  volatile LAS unsigned* bst = (volatile LAS unsigned*)(lds + LDS_BYTES - 16);
  if (threadIdx.x == 0) { bst[0] = 0u; bst[1] = 0u; }
  __syncthreads();
  const XcdBarrier xb = xcd_barrier_post((unsigned*)(p.ws + O_BAR), bst);
  for (int ph = p.ph_lo; ph < p.ph_hi; ++ph) {
    if (ph > p.ph_lo) xcd_barrier(xb);
#ifdef PROBE_MASK
    const bool probe = (PROBE_MASK >> ph) & 1;
    long long ts = 0;
    if (probe) ts = wall_clock64();
#endif
    run_phase(p, ph, lds);
#ifdef PROBE_MASK
    if (probe) {
      xcd_barrier(xb);
      if (blockIdx.x == 0 && threadIdx.x == 0) {
        long long dt = wall_clock64() - ts, t1 = wall_clock64();
        while (wall_clock64() - t1 < dt) __builtin_amdgcn_s_sleep(8);
      }
    }
#endif
  }
#else
  for (int ph = p.ph_lo; ph < p.ph_hi; ++ph) run_phase(p, ph, lds);
#endif
}

extern "C" void kernel_launch(void* const* d_in, const int* in_sizes, int n_in, void* d_out, int out_size, void* d_ws, size_t ws_size, hipStream_t stream) {
  static int grid = 0;
  if (grid == 0) {
    if (n_in != 19 || ws_size < WS_END) { fprintf(stderr, "kernel_launch: unexpected inputs (n_in %d, ws %zu)\n", n_in, ws_size); grid = -1; return; }
    int dev = 0, cus = 0, per_cu = 0;
    hipGetDevice(&dev);
    hipDeviceGetAttribute(&cus, hipDeviceAttributeMultiprocessorCount, dev);
    if (hipFuncSetAttribute((const void*)mega_fwd, hipFuncAttributeMaxDynamicSharedMemorySize, LDS_BYTES) != hipSuccess) { fprintf(stderr, "kernel_launch: hipFuncSetAttribute failed\n"); grid = -1; return; }
    hipOccupancyMaxActiveBlocksPerMultiprocessor(&per_cu, (const void*)mega_fwd, 512, LDS_BYTES);
    if (per_cu < 1) { fprintf(stderr, "kernel_launch: occupancy query returned %d\n", per_cu); per_cu = 1; }
    (void)hipGetLastError();
    grid = cus * per_cu;
    if (grid > 256) grid = 256;
  }
  if (grid < 0) return;
  Params p{};
  const float** pp = (const float**)&p;
  for (int i = 0; i < 19; ++i) pp[i] = (const float*)d_in[i];
  p.out = (float*)d_out;
  p.ws = (char*)d_ws;
#if MK_MODE == 1
  p.ph_lo = 0; p.ph_hi = NPHASE;
  if (hipMemsetAsync((char*)d_ws + O_BAR, 0, 16384, stream) != hipSuccess) { fprintf(stderr, "kernel_launch: memset of barrier words failed\n"); return; }
  void* args[] = {&p};
  hipError_t e = hipLaunchCooperativeKernel((const void*)mega_fwd, dim3(grid), dim3(512), args, LDS_BYTES, stream);
  if (e != hipSuccess) fprintf(stderr, "cooperative launch failed: %s (grid %d)\n", hipGetErrorString(e), grid);
#else
  for (int ph = 0; ph < NPHASE; ++ph) {
    p.ph_lo = ph; p.ph_hi = ph + 1;
    hipLaunchKernelGGL(mega_fwd, dim3(grid), dim3(512), LDS_BYTES, stream, p);
  }
#endif
}
```

```cpp
#include <hip/hip_runtime.h>
#include <hip/hip_cooperative_groups.h>
#include <cstdio>
namespace cg = cooperative_groups;

#ifndef G2_LOADER
#define G2_LOADER 1
#endif
#ifndef MK_MODE
#define MK_MODE 1
#endif

typedef unsigned short bfr;
typedef __attribute__((ext_vector_type(8))) short bf16x8;
typedef __attribute__((ext_vector_type(4))) short bf16x4;
typedef __attribute__((ext_vector_type(4))) float f32x4;
typedef __attribute__((ext_vector_type(4))) unsigned u32x4;
typedef __attribute__((ext_vector_type(2))) unsigned u32x2;

#define DI __device__ __forceinline__
#define MFMA16(a, b, c) __builtin_amdgcn_mfma_f32_16x16x32_bf16((a), (b), (c), 0, 0, 0)

constexpr int PLANE = 16384 * 1024;
constexpr float EPS = 1e-6f;
constexpr int NPHASE = 22;
constexpr int LDS_BYTES = 163840;

constexpr size_t O_WLI = 0;
constexpr size_t O_WLO = 8388608;
constexpr size_t O_WGI = 12582912;
constexpr size_t O_WGO = 29884416;
constexpr size_t O_WG = 34078720;
constexpr size_t O_CONDP = 35127296;
constexpr size_t O_H = 36700160;
constexpr size_t O_PROJ = 70254592;
constexpr size_t O_ATTN = 204996608;
constexpr size_t O_HALO = 221773824;
constexpr size_t O_SCR = 226492416;
constexpr size_t O_AB = 260046848;
constexpr size_t O_ELAST = 261095424;
constexpr size_t O_AGG = 261103616;
constexpr size_t O_COND = 263200768;
constexpr size_t O_BAR = 263397376;
constexpr size_t WS_END = 263397376 + 16384;

struct Params {
  const float *x, *c, *ada_w, *ada_b, *norm_g, *final_g;
  const float *lru_in_w, *lru_conv_w, *lru_conv_b, *lru_gate_w, *lru_gate_b, *lru_lambda, *lru_out_w;
  const float *gdn_in_w, *gdn_conv_w, *gdn_a_log, *gdn_dt_bias, *gdn_onorm_g, *gdn_out_w;
  float* out;
  char* ws;
  int ph_lo, ph_hi;
};

DI int otid() { int t = threadIdx.x; asm volatile("" : "+v"(t)); return t; }
DI int obid() { int b = blockIdx.x; asm volatile("" : "+s"(b)); return b; }
DI void lds_barrier() { asm volatile("s_waitcnt lgkmcnt(0)" ::: "memory"); __builtin_amdgcn_s_barrier(); asm volatile("" ::: "memory"); }
typedef float f32x2_t __attribute__((ext_vector_type(2)));
typedef __bf16 bf16x2_t __attribute__((ext_vector_type(2)));
DI unsigned pack2(float a, float b) { f32x2_t v = {a, b}; bf16x2_t r = __builtin_convertvector(v, bf16x2_t); return __builtin_bit_cast(unsigned, r); }
DI bfr f2bf(float x) { return (bfr)(pack2(x, x) & 0xffffu); }
DI float bf2f(bfr b) { return __uint_as_float(((unsigned)b) << 16); }
DI float sum16(float x) {
  x += __uint_as_float(__builtin_amdgcn_update_dpp(0, __float_as_uint(x), 0xB1, 0xF, 0xF, true));
  x += __uint_as_float(__builtin_amdgcn_update_dpp(0, __float_as_uint(x), 0x4E, 0xF, 0xF, true));
  x += __uint_as_float(__builtin_amdgcn_update_dpp(0, __float_as_uint(x), 0x141, 0xF, 0xF, true));
  x += __uint_as_float(__builtin_amdgcn_update_dpp(0, __float_as_uint(x), 0x140, 0xF, 0xF, true));
  return x;
}
DI float sigmoidf_(float x) { return __builtin_amdgcn_rcpf(1.f + __expf(-x)); }
DI float siluf_(float x) { return x * __builtin_amdgcn_rcpf(1.f + __expf(-x)); }
DI float softplusf_(float x) { return x > 20.f ? x : log1pf(expf(x)); }
DI float bfe(const bf16x8& v, int e) { return bf2f((bfr)v[e]); }

DI char* ows(const Params& p) { size_t z = 0; asm volatile("" : "+s"(z)); return p.ws + z; }
DI float cond_get(const Params& p, int layer, int b, int n) {
  const float* cp = (const float*)(ows(p) + O_CONDP);
  float s = p.ada_b[layer * 3072 + n];
#pragma unroll
  for (int sg = 0; sg < 8; ++sg) s += cp[((sg * 4 + layer) * 4 + b) * 3072 + n];
  return s;
}

DI void transpose_tile(const float* __restrict__ src, int ldsrc, int nvalid, bfr* __restrict__ dst, int ldd, int k0, int n0, float* sm) {
  const int tid = otid();
  for (int e = tid; e < 4096; e += 512) {
    int kk = e >> 6, nn = e & 63;
    float v = 0.f;
    if (n0 + nn < nvalid) v = src[(size_t)(k0 + kk) * ldsrc + n0 + nn];
    sm[kk * 65 + nn] = v;
  }
  __syncthreads();
  for (int e = tid; e < 4096; e += 512) {
    int nn = e >> 6, kk = e & 63;
    dst[(size_t)(n0 + nn) * ldd + k0 + kk] = f2bf(sm[kk * 65 + nn]);
  }
  __syncthreads();
}

struct P0Item { const float* src; bfr* dst; int ldsrc, nvalid, ldd, k0, n0; };
DI P0Item p0_decode(const Params& p, int it) {
  P0Item r;
  if (it < 1024) {
    int l = it >> 9, q = it & 511, kt = q >> 5, nt = q & 31;
    r.src = p.lru_in_w + (size_t)l * 1024 * 2048; r.ldsrc = 2048; r.nvalid = 2048; r.dst = (bfr*)(ows(p) + O_WLI) + (size_t)l * 2048 * 1024; r.ldd = 1024; r.k0 = kt * 64; r.n0 = nt * 64;
  } else if (it < 1536) {
    int r0 = it - 1024, l = r0 >> 8, q = r0 & 255, kt = q >> 4, nt = q & 15;
    r.src = p.lru_out_w + (size_t)l * 1024 * 1024; r.ldsrc = 1024; r.nvalid = 1024; r.dst = (bfr*)(ows(p) + O_WLO) + (size_t)l * 1024 * 1024; r.ldd = 1024; r.k0 = kt * 64; r.n0 = nt * 64;
  } else if (it < 3648) {
    int r0 = it - 1536, l = r0 / 1056, q = r0 % 1056, kt = q / 66, nt = q % 66;
    r.src = p.gdn_in_w + (size_t)l * 1024 * 4112; r.ldsrc = 4112; r.nvalid = 4112; r.dst = (bfr*)(ows(p) + O_WGI) + (size_t)l * 4224 * 1024; r.ldd = 1024; r.k0 = kt * 64; r.n0 = nt * 64;
  } else if (it < 4160) {
    int r0 = it - 3648, l = r0 >> 8, q = r0 & 255, kt = q >> 4, nt = q & 15;
    r.src = p.gdn_out_w + (size_t)l * 1024 * 1024; r.ldsrc = 1024; r.nvalid = 1024; r.dst = (bfr*)(ows(p) + O_WGO) + (size_t)l * 1024 * 1024; r.ldd = 1024; r.k0 = kt * 64; r.n0 = nt * 64;
  } else {
    int r0 = it - 4160, mat = r0 >> 2, q = r0 & 3, kt = q >> 1, nt = q & 1;
    r.src = p.lru_gate_w + (size_t)mat * 16384; r.ldsrc = 128; r.nvalid = 128; r.dst = (bfr*)(ows(p) + O_WG) + (size_t)mat * 16384; r.ldd = 128; r.k0 = kt * 64; r.n0 = nt * 64;
  }
  return r;
}

DI void phase0(const Params& p, char* lds) {
  float* sm = (float*)lds;
  const int tid = otid();
  float v[8];
#define P0_LOAD(it_)                                                                                 \
  {                                                                                                  \
    const P0Item t_ = p0_decode(p, (it_));                                                           \
    _Pragma("unroll") for (int i = 0; i < 8; ++i) {                                                  \
      const int e = tid + 512 * i, kk = e >> 6, nn = e & 63;                                         \
      v[i] = (t_.n0 + nn < t_.nvalid) ? __builtin_nontemporal_load(&t_.src[(size_t)(t_.k0 + kk) * t_.ldsrc + t_.n0 + nn]) : 0.f; \
    }                                                                                                \
  }
  if (obid() < 4288) P0_LOAD(obid());
#pragma unroll 1
  for (int it = obid(); it < 4288; it += gridDim.x) {
    const P0Item t = p0_decode(p, it);
#pragma unroll
    for (int i = 0; i < 8; ++i) { const int e = tid + 512 * i; sm[(e >> 6) * 65 + (e & 63)] = v[i]; }
    lds_barrier();
    if (it + (int)gridDim.x < 4288) P0_LOAD(it + gridDim.x);
#pragma unroll
    for (int i = 0; i < 4; ++i) {
      const int e = tid + 512 * i, nn = e >> 5, kp = e & 31;
      *(unsigned*)&t.dst[(size_t)(t.n0 + nn) * t.ldd + t.k0 + 2 * kp] = pack2(sm[(2 * kp) * 65 + nn], sm[(2 * kp + 1) * 65 + nn]);
    }
    lds_barrier();
  }
#undef P0_LOAD
  __syncthreads();
  for (int r0 = obid(); r0 < 192; r0 += gridDim.x) {
    int i = r0 / 48, r = r0 % 48, sg = r / 6, cb = r % 6;
    sm[tid] = siluf_(p.c[(tid >> 7) * 1024 + sg * 128 + (tid & 127)]);
    __syncthreads();
    int n = cb * 512 + tid;
    float a0 = 0.f, a1 = 0.f, a2 = 0.f, a3 = 0.f;
    const float* w = p.ada_w + ((size_t)i * 1024 + sg * 128) * 3072 + n;
#pragma unroll 32
    for (int k = 0; k < 128; ++k) {
      float wv = __builtin_nontemporal_load(&w[(size_t)k * 3072]);
      a0 += sm[k] * wv; a1 += sm[128 + k] * wv; a2 += sm[256 + k] * wv; a3 += sm[384 + k] * wv;
    }
    float* cp = (float*)(ows(p) + O_CONDP);
    cp[((sg * 4 + i) * 4 + 0) * 3072 + n] = a0;
    cp[((sg * 4 + i) * 4 + 1) * 3072 + n] = a1;
    cp[((sg * 4 + i) * 4 + 2) * 3072 + n] = a2;
    cp[((sg * 4 + i) * 4 + 3) * 3072 + n] = a3;
    __syncthreads();
  }
}

DI void norm_phase(const Params& p, int layer, const void* __restrict__ xsrc, char* lds) {
  const float* xs = (const float*)xsrc; const bfr* xsb = (const bfr*)xsrc;
  float* gm = (float*)lds;
  float* sh = gm + 1024;
  const int tid = otid(), lane = tid & 63, wv = tid >> 6;
  bfr* H = (bfr*)(ows(p) + O_H);
  if (layer == 0) {
    float* cd = (float*)(ows(p) + O_COND);
    for (int e = obid() * 512 + tid; e < 4 * 4 * 3072; e += gridDim.x * 512) {
      int n = e % 3072, ib = e / 3072;
      cd[e] = cond_get(p, ib >> 2, ib & 3, n);
    }
  }
  const float* cd = (const float*)(ows(p) + O_COND);
  for (int rt = obid(); rt < 256; rt += gridDim.x) {
    int b = rt >> 6;
    for (int c = tid; c < 1024; c += 512) {
      if (layer == 0) {
        float scale = cond_get(p, layer, b, 1024 + c), shift = cond_get(p, layer, b, c);
        gm[c] = p.norm_g[layer * 1024 + c] * (1.f + scale);
        sh[c] = shift;
      } else if (layer < 4) {
        gm[c] = p.norm_g[layer * 1024 + c] * (1.f + cd[(size_t)(layer * 4 + b) * 3072 + 1024 + c]);
        sh[c] = cd[(size_t)(layer * 4 + b) * 3072 + c];
      } else {
        gm[c] = p.final_g[c];
        sh[c] = 0.f;
      }
    }
    __syncthreads();
    u32x2 rb[2][4][4];
    if (layer != 0) {
#pragma unroll
      for (int g = 0; g < 2; ++g)
#pragma unroll
        for (int r = 0; r < 4; ++r)
#pragma unroll
          for (int jx = 0; jx < 4; ++jx) {
            const u32x2* xp = (const u32x2*)&xsb[((size_t)rt * 64 + wv * 8 + g * 4 + r) * 1024 + jx * 256 + lane * 4];
            rb[g][r][jx] = (layer == 4) ? __builtin_nontemporal_load(xp) : *xp;
          }
    }
#pragma unroll
    for (int r4 = 0; r4 < 8; r4 += 4) {
      f32x4 v[4][4];
#pragma unroll
      for (int r = 0; r < 4; ++r)
#pragma unroll
        for (int jx = 0; jx < 4; ++jx) {
          const size_t xi = ((size_t)rt * 64 + wv * 8 + r4 + r) * 1024 + jx * 256 + lane * 4;
          if (layer == 0) v[r][jx] = __builtin_nontemporal_load((const f32x4*)&xs[xi]);
          else {
            const u32x2 xb = rb[r4 >> 2][r][jx];
            v[r][jx] = (f32x4){__uint_as_float(xb[0] << 16), __uint_as_float(xb[0] & 0xffff0000u), __uint_as_float(xb[1] << 16), __uint_as_float(xb[1] & 0xffff0000u)};
          }
        }
#pragma unroll
      for (int r = 0; r < 4; ++r) {
        const size_t row = (size_t)rt * 64 + wv * 8 + r4 + r;
        float ss = 0.f;
#pragma unroll
        for (int jx = 0; jx < 4; ++jx) ss += v[r][jx][0] * v[r][jx][0] + v[r][jx][1] * v[r][jx][1] + v[r][jx][2] * v[r][jx][2] + v[r][jx][3] * v[r][jx][3];
        ss = sum16(ss);
        ss += __shfl_xor(ss, 16);
        ss += __shfl_xor(ss, 32);
        const float rstd = rsqrtf(ss * (1.f / 1024.f) + EPS);
#pragma unroll
        for (int jx = 0; jx < 4; ++jx) {
          const int c = jx * 256 + lane * 4;
          f32x4 g4 = *(const f32x4*)&gm[c], s4 = *(const f32x4*)&sh[c];
          f32x4 y;
#pragma unroll
          for (int e = 0; e < 4; ++e) y[e] = v[r][jx][e] * rstd * g4[e] + s4[e];
          if (layer < 4) {
            u32x2 o2; o2[0] = pack2(y[0], y[1]); o2[1] = pack2(y[2], y[3]);
            *(u32x2*)&H[row * 1024 + c] = o2;
          } else {
            __builtin_nontemporal_store(y, (f32x4*)&p.out[row * 1024 + c]);
          }
        }
      }
    }
    __syncthreads();
  }
}

namespace pg8 {
#define PG8_LAS __attribute__((address_space(3)))
typedef unsigned short bf16_t;
typedef short bf16x8 __attribute__((ext_vector_type(8)));
typedef float f32x4 __attribute__((ext_vector_type(4)));
typedef unsigned u32x4 __attribute__((ext_vector_type(4)));
constexpr int BM = 256, BK = 64, HALF = 128, HTB = HALF * BK * 2  , STAGE_BYTES = 8 * HTB, NXCD = 8, WGM = 8;

__host__ __device__ __forceinline__ int lds_byte(int r, int c) { const int st = (r >> 4) * 2 + (c >> 5), rr = r & 15, cc = c & 31, ob = rr * 64 + cc * 2; return st * 1024 + (ob ^ (((ob >> 9) & 1) << 5)); }
__host__ __device__ __forceinline__ void stage_rc(int b, int& R, int& C) { const int st = b / 1024, sb = b % 1024, swz = sb ^ (((sb >> 9) & 1) << 5); R = (st >> 1) * 16 + swz / 64; C = (st & 1) * 32 + (swz % 64) / 2; }
__host__ __device__ __forceinline__ int perm32(int rho) { const int n = rho >> 4, i = rho & 15; return 8 * (i >> 2) + 4 * n + (i & 3); }

struct Unit { int pm, pn; };
struct Gemm { const bf16_t* A; const bf16_t* Bt; int M, N, K; };

struct StaticOrder {
    int nM, nN, nwg, G, c;
    __host__ __device__ void init(int M, int N, int G_, int c_) { nM = M / BM; nN = N / BM; nwg = nM * nN; G = G_; c = c_; }
    __host__ __device__ bool next(int i, Unit& u) const {
        const long L = (long)i * G + c; if (L >= nwg) return false;
        int wgid = (int)L; { const int q = nwg / NXCD, r = nwg % NXCD, xcd = wgid % NXCD, off = wgid / NXCD; wgid = (xcd < r ? xcd * (q + 1) : r * (q + 1) + (xcd - r) * q) + off; }
        const int nig = WGM * nN, gid = wgid / nig, fm = gid * WGM, gsz = (nM - fm) < WGM ? (nM - fm) : WGM;
        u.pm = fm + ((wgid % nig) % gsz); u.pn = (wgid % nig) / gsz; return true;
    }
    __device__ __forceinline__ void a_ready(const Unit&) const {}
    __device__ __forceinline__ void done(const Unit&) const {}
};
__device__ __forceinline__ unsigned cvt_pk_bf16(float lo, float hi) { unsigned r; asm volatile("v_cvt_pk_bf16_f32 %0, %1, %2" : "=v"(r) : "v"(lo), "v"(hi)); return r; }

template <class Epi, class Sched, bool STAMP = false>
__device__ __forceinline__ void gemm_phase(PG8_LAS unsigned char* lds, const Gemm g, const Sched& S, const Epi& E, unsigned long long* stamps) {
    const int tid = otid(), wid = __builtin_amdgcn_readfirstlane(tid >> 6), lane = tid & 63, wr = wid >> 2, wc = wid & 3, fr = lane & 15, fq = lane >> 4;
    const int K = g.K, nt = K / BK;
    int ts_lo = 0, ts_hi = 0, nts = 0; const unsigned long long rt_entry = STAMP ? (unsigned long long)wall_clock64() : 0ull;
#define PG8_STAMP() do { if (STAMP && wid == 0 && nts < 64) { const unsigned long long _c = (unsigned long long)clock64(); \
        ts_lo = (lane == nts) ? (int)(unsigned)_c : ts_lo; ts_hi = (lane == nts) ? (int)(unsigned)(_c >> 32) : ts_hi; ++nts; } } while (0)
    PG8_STAMP();
    unsigned voffA[2], voffB[2];
#pragma unroll
    for (int i = 0; i < 2; ++i) { int R, C; stage_rc(tid * 16 + i * 8192, R, C); const int Rb = Epi::PERM ? ((R & ~31) + perm32(R & 31)) : R;
        voffA[i] = (unsigned)(R * K + C) * 2u; voffB[i] = (unsigned)(Rb * K + C) * 2u; }
    const size_t kstep = (size_t)(BK * 2);
    const size_t hstep = (size_t)HALF * K * 2;
    const size_t tstep = 2 * hstep;
    const unsigned ldsw = (unsigned)wid * 1024u;
    const int aoff = lds_byte(wr * 64 + fr, fq * 8), boff = lds_byte(wc * 32 + fr, fq * 8);
#define PG8_SA(b, h) (((b) * 2 + (h)) * HTB)
#define PG8_SB(b, h) ((4 + (b) * 2 + (h)) * HTB)
#define PG8_STAGE(bufoff, gbase, voff) do { _Pragma("unroll") for (int _i = 0; _i < 2; ++_i) \
        __builtin_amdgcn_global_load_lds((const unsigned*)((const char*)(gbase) + (voff)[_i]), (PG8_LAS unsigned*)(lds + (bufoff) + ldsw + _i * 8192), 16, 0, 0); } while (0)
#define PG8_LDA(dst, b, h) do { _Pragma("unroll") for (int m = 0; m < 4; ++m) _Pragma("unroll") for (int k = 0; k < 2; ++k) dst[m][k] = *(const PG8_LAS bf16x8*)(lds + PG8_SA(b, h) + aoff + m * 2048 + k * 1024); } while (0)
#define PG8_LDB(dst, b, h) do { _Pragma("unroll") for (int n = 0; n < 2; ++n) _Pragma("unroll") for (int k = 0; k < 2; ++k) dst[n][k] = *(const PG8_LAS bf16x8*)(lds + PG8_SB(b, h) + boff + n * 2048 + k * 1024); } while (0)
#define PG8_MMA(ai, bj, At, Bt) do { __builtin_amdgcn_s_setprio(1); _Pragma("unroll") for (int m = 0; m < 4; ++m) _Pragma("unroll") for (int n = 0; n < 2; ++n) _Pragma("unroll") for (int k = 0; k < 2; ++k) \
        acc[ai][bj][m][n] = __builtin_amdgcn_mfma_f32_16x16x32_bf16(Bt[n][k], At[m][k], acc[ai][bj][m][n], 0, 0, 0); __builtin_amdgcn_s_setprio(0); } while (0)
#define PG8_WAIT_V(n) asm volatile("s_waitcnt vmcnt(" #n ")" ::: "memory")
#define PG8_WAIT_L(n) asm volatile("s_waitcnt lgkmcnt(" #n ")" ::: "memory")
#define PG8_BAR __builtin_amdgcn_s_barrier()
#define PG8_SCHED __builtin_amdgcn_sched_barrier(0)
    Unit cur, nxt; int ui = 0;
    if (!S.next(0, cur)) return;
    f32x4 acc[2][2][4][2];
#pragma unroll
    for (int a = 0; a < 2; ++a)
#pragma unroll
        for (int b = 0; b < 2; ++b)
#pragma unroll
            for (int m = 0; m < 4; ++m)
#pragma unroll
                for (int n = 0; n < 2; ++n) acc[a][b][m][n] = (f32x4){0.f, 0.f, 0.f, 0.f};
    bf16x8 At[4][2], B0[2][2], B1[2][2];
    const char* cA = (const char*)g.A + (size_t)cur.pm * tstep; const char* cB = (const char*)g.Bt + (size_t)cur.pn * tstep;
    S.a_ready(cur);
    PG8_STAGE(PG8_SB(0, 0), cB, voffB); PG8_STAGE(PG8_SA(0, 0), cA, voffA); PG8_STAGE(PG8_SB(0, 1), cB + hstep, voffB); PG8_STAGE(PG8_SA(0, 1), cA + hstep, voffA);
    if (wr == 1) PG8_BAR;
    PG8_WAIT_V(4); PG8_BAR;
    PG8_STAGE(PG8_SB(1, 0), cB + kstep, voffB); PG8_STAGE(PG8_SA(1, 0), cA + kstep, voffA); PG8_STAGE(PG8_SB(1, 1), cB + hstep + kstep, voffB);
    PG8_WAIT_V(6); PG8_BAR;
    PG8_STAMP();
    for (;;) {
        const bool has_next = S.next(ui + 1, nxt);
        const char* nA = has_next ? (const char*)g.A + (size_t)nxt.pm * tstep : cA; const char* nB = has_next ? (const char*)g.Bt + (size_t)nxt.pn * tstep : cB;
        for (int t = 0; t < nt; t += 2) {
            const bool last = (t == nt - 2);
            const char* a1 = cA + (size_t)(t + 1) * kstep;
            const char* a2 = last ? nA : cA + (size_t)(t + 2) * kstep; const char* b2 = last ? nB : cB + (size_t)(t + 2) * kstep;
            const char* a3 = a2 + kstep; const char* b3 = b2 + kstep;
            if (last && has_next) S.a_ready(nxt);
            PG8_LDB(B0, 0, 0); PG8_SCHED; PG8_LDA(At, 0, 0); PG8_STAGE(PG8_SA(1, 1), a1 + hstep, voffA);
            PG8_WAIT_L(8); PG8_BAR; PG8_WAIT_L(0); PG8_MMA(0, 0, At, B0); PG8_BAR; PG8_SCHED;
            PG8_LDB(B1, 0, 1); PG8_STAGE(PG8_SB(0, 0), b2, voffB);
            PG8_BAR; PG8_WAIT_L(0); PG8_MMA(0, 1, At, B1); PG8_BAR;
            PG8_LDA(At, 0, 1); PG8_STAGE(PG8_SA(0, 0), a2, voffA);
            PG8_BAR; PG8_WAIT_L(0); PG8_MMA(1, 0, At, B0); PG8_BAR; PG8_SCHED;
            PG8_STAGE(PG8_SB(0, 1), b2 + hstep, voffB);
            PG8_WAIT_V(6); PG8_BAR; PG8_MMA(1, 1, At, B1); PG8_BAR;
            PG8_LDB(B0, 1, 0); PG8_SCHED; PG8_LDA(At, 1, 0); PG8_STAGE(PG8_SA(0, 1), a2 + hstep, voffA);
            PG8_WAIT_L(8); PG8_BAR; PG8_WAIT_L(0); PG8_MMA(0, 0, At, B0); PG8_BAR; PG8_SCHED;
            PG8_LDB(B1, 1, 1); PG8_STAGE(PG8_SB(1, 0), b3, voffB);
            PG8_BAR; PG8_WAIT_L(0); PG8_MMA(0, 1, At, B1); PG8_BAR;
            PG8_LDA(At, 1, 1); PG8_STAGE(PG8_SA(1, 0), a3, voffA);
            PG8_BAR; PG8_WAIT_L(0); PG8_MMA(1, 0, At, B0); PG8_BAR; PG8_SCHED;
            PG8_STAGE(PG8_SB(1, 1), b3 + hstep, voffB);
            PG8_WAIT_V(6); PG8_BAR; PG8_MMA(1, 1, At, B1); PG8_BAR;
        }
        PG8_STAMP();
        if constexpr (!Epi::AFTER_DRAIN) { E(acc, cur, wr, wc, fr, fq); S.done(cur); }
        PG8_STAMP();
        if (!has_next) break;
#pragma unroll
        for (int a = 0; a < 2; ++a)
#pragma unroll
            for (int b = 0; b < 2; ++b)
#pragma unroll
                for (int m = 0; m < 4; ++m)
#pragma unroll
                    for (int n = 0; n < 2; ++n) acc[a][b][m][n] = (f32x4){0.f, 0.f, 0.f, 0.f};
        cur = nxt; cA = nA; cB = nB; ++ui;
    }
    PG8_WAIT_V(0);
    if (wr == 0) PG8_BAR;
    PG8_BAR;
    if constexpr (Epi::AFTER_DRAIN) { E.fused(acc, cur, wr, wc, fr, fq, lds, wid, lane); S.done(cur); }
    PG8_STAMP();
    if (STAMP && wid == 0) { stamps[lane] = lane < nts ? (((unsigned long long)(unsigned)ts_hi << 32) | (unsigned)ts_lo) : 0ull;
        if (lane == 62) stamps[62] = rt_entry; if (lane == 63) stamps[63] = (unsigned long long)wall_clock64(); }
#undef PG8_STAMP
#undef PG8_SA
#undef PG8_SB
#undef PG8_STAGE
#undef PG8_LDA
#undef PG8_LDB
#undef PG8_MMA
#undef PG8_WAIT_V
#undef PG8_WAIT_L
#undef PG8_BAR
#undef PG8_SCHED
}
}

struct EpiProjBf16 {
  static constexpr bool PERM = true, AFTER_DRAIN = false;
  bfr* O; bfr* halo;
  __device__ __forceinline__ void operator()(const f32x4 (&acc)[2][2][4][2], const pg8::Unit& u, int wr, int wc, int fr, int fq) const {
    const int row0 = u.pm * 256 + wr * 64 + fr, col0 = u.pn * 256 + wc * 32 + 8 * fq;
#pragma unroll
    for (int ai = 0; ai < 2; ++ai)
#pragma unroll
      for (int m = 0; m < 4; ++m) {
        const int row = row0 + ai * 128 + m * 16;
        const int bb = row >> 12, ts = row & 4095;
#pragma unroll
        for (int bj = 0; bj < 2; ++bj) {
          const int col = col0 + bj * 128;
          const f32x4 v0 = acc[ai][bj][m][0], v1 = acc[ai][bj][m][1];
          u32x4 w; w.x = pack2(v0[0], v0[1]); w.y = pack2(v0[2], v0[3]); w.z = pack2(v1[0], v1[1]); w.w = pack2(v1[2], v1[3]);
          *(u32x4*)(O + (size_t)(col >> 10) * PLANE + ((size_t)((bb * 8 + ((col >> 7) & 7)) * 4096 + ts)) * 128 + (col & 127)) = w;
          if (halo && (row & 63) >= 61 && col < 3072)
            *(u32x4*)(halo + ((size_t)(row >> 6) * 3 + ((row & 63) - 61)) * 3072 + col) = w;
        }
      }
  }
};
struct EpiResid {
  static constexpr bool PERM = true, AFTER_DRAIN = false;
  bfr* out; const void* xin; int xin_f32; const float* gate;
  __device__ __forceinline__ void operator()(const f32x4 (&acc)[2][2][4][2], const pg8::Unit& u, int wr, int wc, int fr, int fq) const {
    const int row0 = u.pm * 256 + wr * 64 + fr, col0 = u.pn * 256 + wc * 32 + 8 * fq;
    const float* gp = gate + (size_t)((u.pm * 256) >> 12) * 3072 + col0;
    f32x4 gv[2][2];
#pragma unroll
    for (int bj = 0; bj < 2; ++bj)
#pragma unroll
      for (int n = 0; n < 2; ++n) gv[bj][n] = *(const f32x4*)(gp + bj * 128 + n * 4);
#pragma unroll
    for (int ai = 0; ai < 2; ++ai)
#pragma unroll
      for (int m = 0; m < 4; ++m) {
        const size_t ro = (size_t)(row0 + ai * 128 + m * 16) * 1024 + col0;
#pragma unroll
        for (int bj = 0; bj < 2; ++bj) {
          f32x4 x0, x1;
          if (xin_f32) {
            x0 = __builtin_nontemporal_load((const f32x4*)((const float*)xin + ro + bj * 128));
            x1 = __builtin_nontemporal_load((const f32x4*)((const float*)xin + ro + bj * 128 + 4));
          } else {
            const u32x4 xb = *(const u32x4*)((const bfr*)xin + ro + bj * 128);
            x0 = (f32x4){__uint_as_float(xb[0] << 16), __uint_as_float(xb[0] & 0xffff0000u), __uint_as_float(xb[1] << 16), __uint_as_float(xb[1] & 0xffff0000u)};
            x1 = (f32x4){__uint_as_float(xb[2] << 16), __uint_as_float(xb[2] & 0xffff0000u), __uint_as_float(xb[3] << 16), __uint_as_float(xb[3] & 0xffff0000u)};
          }
          const f32x4 v0 = x0 + gv[bj][0] * acc[ai][bj][m][0], v1 = x1 + gv[bj][1] * acc[ai][bj][m][1];
          u32x4 w; w.x = pack2(v0[0], v0[1]); w.y = pack2(v0[2], v0[3]); w.z = pack2(v1[0], v1[1]); w.w = pack2(v1[2], v1[3]);
          *(u32x4*)(out + ro + bj * 128) = w;
        }
      }
  }
};

template <int EPI>
DI void gemm_phase(const Params& p, const bfr* __restrict__ A, int lda, const bfr* __restrict__ Bt, int nN, int layer, const void* __restrict__ xin, bfr* __restrict__ xout, char* lds) {
  pg8::Gemm g; g.A = A; g.Bt = Bt; g.M = 16384; g.N = nN * 256; g.K = 1024;
  pg8::StaticOrder S; S.init(g.M, g.N, gridDim.x, obid());
  if (EPI == 2) {
    EpiResid E; E.out = xout; E.xin = xin; E.xin_f32 = (layer == 0) ? 1 : 0; E.gate = (const float*)(ows(p) + O_COND) + (size_t)layer * 4 * 3072 + 2048;
    pg8::gemm_phase<EpiResid, pg8::StaticOrder, false>((PG8_LAS unsigned char*)lds, g, S, E, nullptr);
  } else {
    EpiProjBf16 E; E.O = (bfr*)(ows(p) + O_PROJ); E.halo = (EPI == 1) ? (bfr*)(ows(p) + O_HALO) : nullptr;
    pg8::gemm_phase<EpiProjBf16, pg8::StaticOrder, false>((PG8_LAS unsigned char*)lds, g, S, E, nullptr);
  }
  if (EPI == 1) {
    __syncthreads();
    float* red = (float*)lds;
    const int tid = otid(), lane = tid & 63, wv = tid >> 6, l15 = lane & 15, q = lane >> 4;
    const int mt4 = wv & 3, kh = wv >> 2;
    for (int rt = obid(); rt < 256; rt += gridDim.x) {
      const bfr* Ar = A + (size_t)(rt * 64 + mt4 * 16 + l15) * lda + kh * 512 + q * 8;
      const bfr* Br = Bt + (size_t)(4096 + l15) * 1024 + kh * 512 + q * 8;
      f32x4 acc = (f32x4){0.f, 0.f, 0.f, 0.f};
#pragma unroll 4
      for (int ks = 0; ks < 16; ++ks) acc = MFMA16(*(const bf16x8*)(Ar + ks * 32), *(const bf16x8*)(Br + ks * 32), acc);
      if (kh == 1) *(f32x4*)&red[(mt4 * 64 + lane) * 4] = acc;
      __syncthreads();
      if (kh == 0) {
        f32x4 o = *(const f32x4*)&red[(mt4 * 64 + lane) * 4];
#pragma unroll
        for (int jx = 0; jx < 4; ++jx) ((float*)(ows(p) + O_AB))[(size_t)(rt * 64 + mt4 * 16 + q * 4 + jx) * 16 + l15] = acc[jx] + o[jx];
      }
      __syncthreads();
    }
  }
}

DI void lru_phase(const Params& p, int j, char* lds) {
  const int tid = otid(), lane = tid & 63, wv = tid >> 6, l15 = lane & 15, q = lane >> 4;
  bfr* Xw = (bfr*)lds + wv * (32 * 136);
  float* WAgg = (float*)(lds + 8 * 32 * 136 * 2);
  const bfr* proj = (const bfr*)(ows(p) + O_PROJ);
  bfr* Yb = (bfr*)(ows(p) + O_H);
  const bfr* WG = (const bfr*)(ows(p) + O_WG);
  for (int unit = obid(); unit < 256; unit += gridDim.x) {
    const int xcd = unit & 7, li = unit >> 3, idx = xcd * 4 + (li >> 3), sl = li & 7, b = idx >> 3, gb = idx & 7;
    const int ch = gb * 128 + sl * 16 + l15;
    bf16x8 Bf[2][4];
#pragma unroll
    for (int kq = 0; kq < 2; ++kq)
#pragma unroll
      for (int ks = 0; ks < 4; ++ks) Bf[kq][ks] = *(const bf16x8*)&WG[(size_t)((j * 2 + kq) * 8 + gb) * 16384 + (sl * 16 + l15) * 128 + ks * 32 + q * 8];
    const float gbr = p.lru_gate_b[(j * 2) * 1024 + ch], gbi = p.lru_gate_b[(j * 2 + 1) * 1024 + ch];
    const float sp = softplusf_(-p.lru_lambda[j * 1024 + ch]);
    const int cg = lane & 15, rs = lane >> 4, ccol = gb * 128 + cg * 8;
    float cwv[4][8], cb[8];
#pragma unroll
    for (int tp = 0; tp < 4; ++tp)
#pragma unroll
      for (int e = 0; e < 8; ++e) cwv[tp][e] = p.lru_conv_w[(size_t)(j * 4 + tp) * 1024 + ccol + e];
#pragma unroll
    for (int e = 0; e < 8; ++e) cb[e] = p.lru_conv_b[j * 1024 + ccol + e];
    const bfr* xb_u = proj + (size_t)(b * 8 + gb) * 4096 * 128;
    bfr* yb_u = Yb + (size_t)b * 4096 * 1024;
    const int xo = (wv * 32 + rs * 8 - 3) * 128 + cg * 8;
    const int zo = PLANE + (wv * 32 + q * 4) * 128 + sl * 16 + (l15 & ~1);
    const int zsh = (l15 & 1) * 16;
    const int yo = (wv * 32 + q * 4) * 1024 + ch;
    float carry = 0.f;
    bf16x8 raw[11];
    unsigned zr[8];
#define LRU_LOAD(it)                                                                                   \
  {                                                                                                    \
    const bfr* xit = xb_u + (it) * (256 * 128);                                                        \
    _Pragma("unroll") for (int i = 0; i < 11; ++i) {                                                   \
      const int t = (it) * 256 + wv * 32 + rs * 8 - 3 + i;                                             \
      if (t >= 0) raw[i] = *(const bf16x8*)&xit[xo + i * 128];                                         \
      else raw[i] = (bf16x8){0, 0, 0, 0, 0, 0, 0, 0};                                                  \
    }                                                                                                  \
    _Pragma("unroll") for (int mt = 0; mt < 2; ++mt) _Pragma("unroll") for (int jx = 0; jx < 4; ++jx)  \
      zr[mt * 4 + jx] = *(const unsigned*)&xit[zo + (mt * 16 + jx) * 128];                                               \
  }
    LRU_LOAD(0);
#pragma unroll 1
    for (int it = 0; it < 16; ++it) {
#pragma unroll
      for (int r = 0; r < 8; ++r) {
        float o[8];
#pragma unroll
        for (int e = 0; e < 8; ++e) {
          float s = cb[e];
#pragma unroll
          for (int tp = 0; tp < 4; ++tp) s += cwv[tp][e] * bfe(raw[r + tp], e);
          o[e] = s;
        }
        u32x4 pk; pk[0] = pack2(o[0], o[1]); pk[1] = pack2(o[2], o[3]); pk[2] = pack2(o[4], o[5]); pk[3] = pack2(o[6], o[7]);
        *(u32x4*)&Xw[(rs * 8 + r) * 136 + cg * 8] = pk;
      }
      float zc[8];
#pragma unroll
      for (int i = 0; i < 8; ++i) zc[i] = bf2f((bfr)(zr[i] >> zsh));
      if (it < 15) LRU_LOAD(it + 1);
      f32x4 accr[2], acci[2];
#pragma unroll
      for (int mt = 0; mt < 2; ++mt) {
        accr[mt] = acci[mt] = (f32x4){0.f, 0.f, 0.f, 0.f};
#pragma unroll
        for (int ks = 0; ks < 4; ++ks) {
          bf16x8 af = *(const bf16x8*)&Xw[(mt * 16 + l15) * 136 + ks * 32 + q * 8];
          accr[mt] = MFMA16(af, Bf[0][ks], accr[mt]);
          acci[mt] = MFMA16(af, Bf[1][ks], acci[mt]);
        }
      }
      float av[2][4], bv[2][4];
      float Aex[2], Bex[2], At[2], Bt_[2];
#pragma unroll
      for (int mt = 0; mt < 2; ++mt) {
        float Al = 1.f, Bl = 0.f;
#pragma unroll
        for (int jx = 0; jx < 4; ++jx) {
          const float r = sigmoidf_(accr[mt][jx] + gbr), ig = sigmoidf_(acci[mt][jx] + gbi);
          const float a = __expf(-8.f * r * sp);
          const float mult = __builtin_amdgcn_sqrtf(fmaxf(1.f - a * a, 0.f));
          const float xf = bf2f(Xw[(mt * 16 + q * 4 + jx) * 136 + sl * 16 + l15]);
          const float bt = mult * ig * xf;
          av[mt][jx] = a; bv[mt][jx] = bt;
          Bl = a * Bl + bt; Al *= a;
        }
        float Ai = Al, Bi = Bl;
#pragma unroll
        for (int off = 16; off < 64; off <<= 1) {
          const float Ap = __shfl_up(Ai, off), Bp = __shfl_up(Bi, off);
          if (lane >= off) { Bi = Ai * Bp + Bi; Ai = Ai * Ap; }
        }
        float Ae = __shfl_up(Ai, 16), Be = __shfl_up(Bi, 16);
        if (q == 0) { Ae = 1.f; Be = 0.f; }
        Aex[mt] = Ae; Bex[mt] = Be;
        At[mt] = __shfl(Ai, 48 + l15); Bt_[mt] = __shfl(Bi, 48 + l15);
      }
      float* wa = WAgg + (it & 1) * 256;
      if (q == 0) { wa[(wv * 16 + l15) * 2] = At[0] * At[1]; wa[(wv * 16 + l15) * 2 + 1] = At[1] * Bt_[0] + Bt_[1]; }
      lds_barrier();
      float cin = carry, cnew = carry;
#pragma unroll
      for (int w = 0; w < 8; ++w) {
        const float Aw = wa[(w * 16 + l15) * 2], Bw = wa[(w * 16 + l15) * 2 + 1];
        cnew = Aw * cnew + Bw;
        if (w < wv) cin = Aw * cin + Bw;
      }
      carry = cnew;
      bfr* yit = yb_u + it * (256 * 1024);
#pragma unroll
      for (int mt = 0; mt < 2; ++mt) {
        float h = Aex[mt] * cin + Bex[mt];
#pragma unroll
        for (int jx = 0; jx < 4; ++jx) {
          h = av[mt][jx] * h + bv[mt][jx];
          yit[yo + (mt * 16 + jx) * 1024] = f2bf(h * siluf_(zc[mt * 4 + jx]));
        }
        cin = At[mt] * cin + Bt_[mt];
      }
    }
#undef LRU_LOAD
  }
}

DI bf16x8 ld_perm(const bfr* base) {
  u32x2 lo = *(const u32x2*)base, hi = *(const u32x2*)(base + 16);
  u32x4 r; r[0] = lo[0]; r[1] = lo[1]; r[2] = hi[0]; r[3] = hi[1];
  return __builtin_bit_cast(bf16x8, r);
}
DI bf16x8 pack_cc(const f32x4& a, const f32x4& b) {
  u32x4 r; r[0] = pack2(a[0], a[1]); r[1] = pack2(a[2], a[3]); r[2] = pack2(b[0], b[1]); r[3] = pack2(b[2], b[3]);
  return __builtin_bit_cast(bf16x8, r);
}


template <int NL> DI void row_load(f32x4 (&a)[8], unsigned addr, float& dep) {
  if constexpr (NL == 1) asm volatile("ds_read_b128 %0, %2\n\ts_waitcnt lgkmcnt(0)" : "=&v"(a[0]), "+v"(dep) : "v"(addr) : "memory");
  if constexpr (NL == 2) asm volatile("ds_read_b128 %0, %3\n\tds_read_b128 %1, %3 offset:16\n\ts_waitcnt lgkmcnt(0)" : "=&v"(a[0]), "=&v"(a[1]), "+v"(dep) : "v"(addr) : "memory");
  if constexpr (NL == 3) asm volatile("ds_read_b128 %0, %4\n\tds_read_b128 %1, %4 offset:16\n\tds_read_b128 %2, %4 offset:32\n\ts_waitcnt lgkmcnt(0)" : "=&v"(a[0]), "=&v"(a[1]), "=&v"(a[2]), "+v"(dep) : "v"(addr) : "memory");
  if constexpr (NL == 4) asm volatile("ds_read_b128 %0, %5\n\tds_read_b128 %1, %5 offset:16\n\tds_read_b128 %2, %5 offset:32\n\tds_read_b128 %3, %5 offset:48\n\ts_waitcnt lgkmcnt(0)" : "=&v"(a[0]), "=&v"(a[1]), "=&v"(a[2]), "=&v"(a[3]), "+v"(dep) : "v"(addr) : "memory");
  if constexpr (NL == 5) asm volatile("ds_read_b128 %0, %6\n\tds_read_b128 %1, %6 offset:16\n\tds_read_b128 %2, %6 offset:32\n\tds_read_b128 %3, %6 offset:48\n\tds_read_b128 %4, %6 offset:64\n\ts_waitcnt lgkmcnt(0)" : "=&v"(a[0]), "=&v"(a[1]), "=&v"(a[2]), "=&v"(a[3]), "=&v"(a[4]), "+v"(dep) : "v"(addr) : "memory");
  if constexpr (NL == 6) asm volatile("ds_read_b128 %0, %7\n\tds_read_b128 %1, %7 offset:16\n\tds_read_b128 %2, %7 offset:32\n\tds_read_b128 %3, %7 offset:48\n\tds_read_b128 %4, %7 offset:64\n\tds_read_b128 %5, %7 offset:80\n\ts_waitcnt lgkmcnt(0)" : "=&v"(a[0]), "=&v"(a[1]), "=&v"(a[2]), "=&v"(a[3]), "=&v"(a[4]), "=&v"(a[5]), "+v"(dep) : "v"(addr) : "memory");
  if constexpr (NL == 7) asm volatile("ds_read_b128 %0, %8\n\tds_read_b128 %1, %8 offset:16\n\tds_read_b128 %2, %8 offset:32\n\tds_read_b128 %3, %8 offset:48\n\tds_read_b128 %4, %8 offset:64\n\tds_read_b128 %5, %8 offset:80\n\tds_read_b128 %6, %8 offset:96\n\ts_waitcnt lgkmcnt(0)" : "=&v"(a[0]), "=&v"(a[1]), "=&v"(a[2]), "=&v"(a[3]), "=&v"(a[4]), "=&v"(a[5]), "=&v"(a[6]), "+v"(dep) : "v"(addr) : "memory");
  if constexpr (NL == 8) asm volatile("ds_read_b128 %0, %9\n\tds_read_b128 %1, %9 offset:16\n\tds_read_b128 %2, %9 offset:32\n\tds_read_b128 %3, %9 offset:48\n\tds_read_b128 %4, %9 offset:64\n\tds_read_b128 %5, %9 offset:80\n\tds_read_b128 %6, %9 offset:96\n\tds_read_b128 %7, %9 offset:112\n\ts_waitcnt lgkmcnt(0)" : "=&v"(a[0]), "=&v"(a[1]), "=&v"(a[2]), "=&v"(a[3]), "=&v"(a[4]), "=&v"(a[5]), "=&v"(a[6]), "=&v"(a[7]), "+v"(dep) : "v"(addr) : "memory");
}
template <int I> DI void inv_rows(float (&t)[32], unsigned abase, int j) {
  if constexpr (I < 32) {
    float s = (I == j) ? 1.f : 0.f;
    if constexpr (I > 0) {
      f32x4 a[8];
      row_load<(I + 3) / 4>(a, abase + I * 256, t[I - 1]);
#pragma unroll
      for (int m4 = 0; m4 < I; m4 += 4) {
        s -= a[m4 >> 2][0] * t[m4];
        if (m4 + 1 < I) s -= a[m4 >> 2][1] * t[m4 + 1];
        if (m4 + 2 < I) s -= a[m4 >> 2][2] * t[m4 + 2];
        if (m4 + 3 < I) s -= a[m4 >> 2][3] * t[m4 + 3];
      }
    }
    t[I] = s;
    inv_rows<I + 1>(t, abase, j);
  }
}
DI void tri_invert32(const float* __restrict__ Au, bfr* __restrict__ Ttu, bfr* __restrict__ Tcu, int hf, int lane) {
  const int j = lane & 31;
  const float* Ab = Au + (32 * hf) * 64 + 32 * hf;
  float t[32];
  const unsigned abase = (unsigned)(size_t)Ab;
  inv_rows<0>(t, abase, j);
  if (lane < 32) {
#pragma unroll
    for (int i = 0; i < 32; ++i) Ttu[(32 * hf + i) * 72 + 32 * hf + j] = f2bf(t[i]);
    if (hf == 0) {
#pragma unroll
      for (int i = 0; i < 32; ++i) Ttu[i * 72 + 32 + j] = 0;
#pragma unroll
      for (int i4 = 0; i4 < 4; ++i4) {
        u32x4 pk;
        pk[0] = pack2(t[8 * i4], t[8 * i4 + 1]); pk[1] = pack2(t[8 * i4 + 2], t[8 * i4 + 3]);
        pk[2] = pack2(t[8 * i4 + 4], t[8 * i4 + 5]); pk[3] = pack2(t[8 * i4 + 6], t[8 * i4 + 7]);
        *(u32x4*)&Tcu[j * 40 + 8 * i4] = pk;
      }
    }
  }
}
DI void tri_merge(const float* __restrict__ Au, bfr* __restrict__ Ttu, const bfr* __restrict__ Tcu, int nt2, int lane) {
  const int l15 = lane & 15, q = lane >> 4;
  const f32x4 zero = (f32x4){0.f, 0.f, 0.f, 0.f};
  bf16x8 bfrag = *(const bf16x8*)&Tcu[(nt2 * 16 + l15) * 40 + q * 8];
  f32x4 X[2];
#pragma unroll
  for (int mt = 0; mt < 2; ++mt) {
    const float* ar = Au + (32 + mt * 16 + l15) * 64 + q * 8;
    f32x4 a0 = *(const f32x4*)ar, a1 = *(const f32x4*)(ar + 4);
    X[mt] = MFMA16(pack_cc(a0, a1), bfrag, zero);
  }
  bf16x8 xb = pack_cc(X[0], X[1]);
#pragma unroll
  for (int mt2 = 0; mt2 < 2; ++mt2) {
    bf16x8 a = ld_perm(Ttu + (32 + mt2 * 16 + l15) * 72 + 32 + q * 4);
    f32x4 r = MFMA16(a, xb, zero);
#pragma unroll
    for (int jx = 0; jx < 4; ++jx) Ttu[(32 + mt2 * 16 + q * 4 + jx) * 72 + nt2 * 16 + l15] = f2bf(-r[jx]);
  }
}

DI void gdn_g1(const Params& p, int j, char* lds) {
  float* Asl = (float*)lds;
  bfr* Tt = (bfr*)(lds + 65536);
  bfr* Kt = (bfr*)(lds + 102400);
  bfr* Qt = (bfr*)(lds + 119808);
  bfr* Vt = (bfr*)(lds + 137216);
  float* gc = (float*)(lds + 154624);
  float* be = (float*)(lds + 155648);
  float* cw = (float*)(lds + 156672);
  const int tid0 = otid();
  bfr* proj = (bfr*)(ows(p) + O_PROJ);
  bfr* KDT = (bfr*)(ows(p) + O_H);
  bfr* ATT = (bfr*)(ows(p) + O_ATTN);
  const bfr* HALO = (const bfr*)(ows(p) + O_HALO);
  bfr* SCR = (bfr*)(ows(p) + O_SCR) + (size_t)obid() * (4 * 2 * 8192);
  const float* AB = (const float*)(ows(p) + O_AB);
  float* EL = (float*)(ows(p) + O_ELAST);
  for (int grp = obid(); grp < 256; grp += gridDim.x) {
    const int bh = grp >> 3, b = bh >> 3, h = bh & 7;
    for (int e = tid0; e < 1536; e += 512) {
      int X = e >> 9, rem = e & 511, tap = rem >> 7, c = rem & 127;
      cw[(X * 4 + tap) * 128 + c] = p.gdn_conv_w[(size_t)(j * 4 + tap) * 3072 + X * 1024 + h * 128 + c];
    }
    bf16x8 nxt[3][5];
    float pfx_g = 0.f, pfx_b = 0.f;
#define G1_RAWLOAD(nn)                                                                                         \
  {                                                                                                            \
    const int rg_ = tid0 >> 4, cgi_ = tid0 & 15, r0_ = rg_ * 2;                                                \
    _Pragma("unroll") for (int X = 0; X < 3; ++X) {                                                            \
      _Pragma("unroll") for (int i = 0; i < 5; ++i) {                                                          \
        const int rr = r0_ - 3 + i;                                                                            \
        if (rr >= 0) nxt[X][i] = *(const bf16x8*)&proj[(size_t)X * PLANE + (size_t)(bh * 4096 + (nn) * 64 + rr) * 128 + cgi_ * 8];   \
        else if ((nn) > 0) nxt[X][i] = *(const bf16x8*)&HALO[((size_t)(b * 64 + (nn) - 1) * 3 + 3 + rr) * 3072 + X * 1024 + h * 128 + cgi_ * 8];   \
        else nxt[X][i] = (bf16x8){0, 0, 0, 0, 0, 0, 0, 0};                                                     \
      }                                                                                                        \
    }                                                                                                          \
  }
    G1_RAWLOAD((grp * 8) & 63);
#pragma unroll 1
    for (int half = 0; half < 2; ++half) {
      {
        int tid = tid0; asm volatile("" : "+v"(tid));
        const int lane = tid & 63, wv = tid >> 6;
        if (half == 0) {
          const int un = grp * 8 + wv, n = un & 63, t0 = b * 4096 + n * 64;
          float a_in = AB[(size_t)(t0 + lane) * 16 + h], b_in = AB[(size_t)(t0 + lane) * 16 + 8 + h];
          float g = -__expf(p.gdn_a_log[j * 8 + h]) * softplusf_(a_in + p.gdn_dt_bias[j * 8 + h]);
#pragma unroll
          for (int off = 1; off < 64; off <<= 1) {
            float v = __shfl_up(g, off);
            if (lane >= off) g += v;
          }
          pfx_g = g; pfx_b = sigmoidf_(b_in);
          if (lane == 63) EL[un] = __expf(g);
          if (wv < 4) { gc[wv * 64 + lane] = pfx_g; be[wv * 64 + lane] = pfx_b; }
        } else if (wv >= 4) {
          gc[(wv - 4) * 64 + lane] = pfx_g; be[(wv - 4) * 64 + lane] = pfx_b;
        }
      }
#pragma unroll 1
      for (int u = 0; u < 4; ++u) {
        const int un = grp * 8 + half * 4 + u, n = un & 63, t0 = b * 4096 + n * 64;
        int tid = tid0; asm volatile("" : "+v"(tid));
        const int lane = tid & 63, wv = tid >> 6, l15 = lane & 15, q = lane >> 4;
        const int rg = tid >> 4, cgi = tid & 15, r0 = rg * 2;
        __syncthreads();
        bf16x8 cur[3][5];
#pragma unroll
        for (int X = 0; X < 3; ++X)
#pragma unroll
          for (int i = 0; i < 5; ++i) cur[X][i] = nxt[X][i];
        if (half * 4 + u < 7) G1_RAWLOAD(n + 1);
#pragma unroll
        for (int X = 0; X < 3; ++X) {
          float val[2][8];
#pragma unroll
          for (int rr = 0; rr < 2; ++rr)
#pragma unroll
            for (int e = 0; e < 8; ++e) {
              float sacc = 0.f;
#pragma unroll
              for (int tp = 0; tp < 4; ++tp) sacc += cw[(X * 4 + tp) * 128 + cgi * 8 + e] * bfe(cur[X][rr + tp], e);
              val[rr][e] = siluf_(sacc);
            }
          if (X < 2) {
#pragma unroll
            for (int rr = 0; rr < 2; ++rr) {
              float ss = 0.f;
#pragma unroll
              for (int e = 0; e < 8; ++e) ss += val[rr][e] * val[rr][e];
              ss = sum16(ss);
              float rn = rsqrtf(ss + EPS);
              if (X == 0) rn *= 0.08838834764831845f;
#pragma unroll
              for (int e = 0; e < 8; ++e) val[rr][e] *= rn;
            }
          }
          bfr* Tile = (X == 0) ? Qt : (X == 1 ? Kt : Vt);
#pragma unroll
          for (int rr = 0; rr < 2; ++rr) {
            const int r = r0 + rr;
            u32x4 pk;
            pk[0] = pack2(val[rr][0], val[rr][1]); pk[1] = pack2(val[rr][2], val[rr][3]);
            pk[2] = pack2(val[rr][4], val[rr][5]); pk[3] = pack2(val[rr][6], val[rr][7]);
            *(u32x4*)&Tile[r * 136 + cgi * 8] = pk;
            if (X == 0) {
              const float eg = __expf(gc[u * 64 + r]);
              pk[0] = pack2(val[rr][0] * eg, val[rr][1] * eg); pk[1] = pack2(val[rr][2] * eg, val[rr][3] * eg);
              pk[2] = pack2(val[rr][4] * eg, val[rr][5] * eg); pk[3] = pack2(val[rr][6] * eg, val[rr][7] * eg);
              *(u32x4*)&proj[(size_t)(bh * 4096 + n * 64 + r) * 128 + cgi * 8] = pk;
            }
          }
        }
        lds_barrier();
        {
          const int mt = wv >> 1;
          f32x4 kk[2], qk[2];
          kk[0] = kk[1] = qk[0] = qk[1] = (f32x4){0.f, 0.f, 0.f, 0.f};
#pragma unroll
          for (int ks = 0; ks < 4; ++ks) {
            bf16x8 ak = *(const bf16x8*)&Kt[(mt * 16 + l15) * 136 + ks * 32 + q * 8];
            bf16x8 aq = *(const bf16x8*)&Qt[(mt * 16 + l15) * 136 + ks * 32 + q * 8];
#pragma unroll
            for (int t2 = 0; t2 < 2; ++t2) {
              int nt = (wv & 1) * 2 + t2;
              bf16x8 bk = *(const bf16x8*)&Kt[(nt * 16 + l15) * 136 + ks * 32 + q * 8];
              kk[t2] = MFMA16(bk, ak, kk[t2]);
              qk[t2] = MFMA16(bk, aq, qk[t2]);
            }
          }
          const int i = mt * 16 + l15;
          const float giv = gc[u * 64 + i], bei = be[u * 64 + i];
#pragma unroll
          for (int t2 = 0; t2 < 2; ++t2) {
            const int m0 = ((wv & 1) * 2 + t2) * 16 + q * 4;
            f32x4 av, tv;
#pragma unroll
            for (int jx = 0; jx < 4; ++jx) {
              const int m = m0 + jx;
              const float d = (i >= m) ? __expf(giv - gc[u * 64 + m]) : 0.f;
              av[jx] = (i > m) ? bei * kk[t2][jx] * d : 0.f;
              tv[jx] = qk[t2][jx] * d;
            }
            *(f32x4*)&Asl[u * 4096 + i * 64 + m0] = av;
            u32x2 pk; pk[0] = pack2(tv[0], tv[1]); pk[1] = pack2(tv[2], tv[3]);
            *(u32x2*)&ATT[(size_t)un * 4096 + i * 64 + m0] = pk;
          }
        }
        {
          const int dd = tid >> 2, tq = tid & 3;
          const float glast = gc[u * 64 + 63];
#pragma unroll
          for (int g8 = 0; g8 < 2; ++g8) {
            const int tok0 = tq * 16 + g8 * 8;
            float okd[8], okb[8], ovb[8];
#pragma unroll
            for (int e = 0; e < 8; ++e) {
              const int tok = tok0 + e;
              const float kv = bf2f(Kt[tok * 136 + dd]), vv = bf2f(Vt[tok * 136 + dd]);
              const float gg = gc[u * 64 + tok], bb = be[u * 64 + tok];
              okd[e] = kv * __expf(glast - gg);
              okb[e] = kv * bb * __expf(gg);
              ovb[e] = vv * bb;
            }
            u32x4 pk;
            pk[0] = pack2(okd[0], okd[1]); pk[1] = pack2(okd[2], okd[3]); pk[2] = pack2(okd[4], okd[5]); pk[3] = pack2(okd[6], okd[7]);
            *(u32x4*)&KDT[(size_t)un * 8192 + dd * 64 + tok0] = pk;
            pk[0] = pack2(okb[0], okb[1]); pk[1] = pack2(okb[2], okb[3]); pk[2] = pack2(okb[4], okb[5]); pk[3] = pack2(okb[6], okb[7]);
            *(u32x4*)&SCR[(u * 2 + 0) * 8192 + dd * 64 + tok0] = pk;
            pk[0] = pack2(ovb[0], ovb[1]); pk[1] = pack2(ovb[2], ovb[3]); pk[2] = pack2(ovb[4], ovb[5]); pk[3] = pack2(ovb[6], ovb[7]);
            *(u32x4*)&SCR[(u * 2 + 1) * 8192 + dd * 64 + tok0] = pk;
          }
        }
      }
      __syncthreads();
      {
      int tid = tid0; asm volatile("" : "+v"(tid));
      const int lane = tid & 63, wv = tid >> 6;
      tri_invert32(Asl + (wv >> 1) * 4096, Tt + (wv >> 1) * 4608, Kt + (wv >> 1) * 1280, wv & 1, lane);
      __syncthreads();
      tri_merge(Asl + (wv >> 1) * 4096, Tt + (wv >> 1) * 4608, Kt + (wv >> 1) * 1280, wv & 1, lane);
      __syncthreads();
      }
      {
        int tid = tid0; asm volatile("" : "+v"(tid));
        const int lane = tid & 63, wv = tid >> 6, l15 = lane & 15, q = lane >> 4;
        bf16x8 bkf[4][2], bvf[4][2];
#pragma unroll
        for (int u = 0; u < 4; ++u)
#pragma unroll
          for (int ks = 0; ks < 2; ++ks) {
            bkf[u][ks] = *(const bf16x8*)&SCR[(u * 2) * 8192 + (wv * 16 + l15) * 64 + ks * 32 + q * 8];
            bvf[u][ks] = *(const bf16x8*)&SCR[(u * 2 + 1) * 8192 + (wv * 16 + l15) * 64 + ks * 32 + q * 8];
          }
#pragma unroll
        for (int u = 0; u < 4; ++u) {
          const int n = (grp * 8 + half * 4 + u) & 63;
          f32x4 aw[4], au[4];
#pragma unroll
          for (int i = 0; i < 4; ++i) aw[i] = au[i] = (f32x4){0.f, 0.f, 0.f, 0.f};
#pragma unroll
          for (int ks = 0; ks < 2; ++ks) {
#pragma unroll
            for (int mt = 0; mt < 4; ++mt) {
              bf16x8 a = *(const bf16x8*)&Tt[u * 4608 + (mt * 16 + l15) * 72 + ks * 32 + q * 8];
              aw[mt] = MFMA16(bkf[u][ks], a, aw[mt]);
              au[mt] = MFMA16(bvf[u][ks], a, au[mt]);
            }
          }
          bfr* Wst = (u & 1) ? Kt : (bfr*)Asl;
          bfr* Ust = Wst + 64 * 136;
#pragma unroll
          for (int mt = 0; mt < 4; ++mt) {
            const int i = mt * 16 + l15, dc = wv * 16 + q * 4;
            u32x2 pk; pk[0] = pack2(aw[mt][0], aw[mt][1]); pk[1] = pack2(aw[mt][2], aw[mt][3]);
            *(u32x2*)&Wst[i * 136 + dc] = pk;
            pk[0] = pack2(au[mt][0], au[mt][1]); pk[1] = pack2(au[mt][2], au[mt][3]);
            *(u32x2*)&Ust[i * 136 + dc] = pk;
          }
          lds_barrier();
#pragma unroll
          for (int k = 0; k < 2; ++k) {
            const int id = tid + 512 * k, row = id >> 4, c16 = id & 15;
            const size_t go = (size_t)(bh * 4096 + n * 64 + row) * 128 + c16 * 8;
            *(u32x4*)&proj[(size_t)PLANE + go] = *(const u32x4*)&Wst[row * 136 + c16 * 8];
            *(u32x4*)&proj[(size_t)2 * PLANE + go] = *(const u32x4*)&Ust[row * 136 + c16 * 8];
          }
        }
      }
      __syncthreads();
    }
  }
#undef G1_RAWLOAD
}

DI void gdn_g2(const Params& p, int j, char* lds) {
  bfr* SbT = (bfr*)lds;
  bfr* VbT = (bfr*)(lds + 4352);
  const int tid = otid(), lane = tid & 63, wv = tid >> 6, l15 = lane & 15, q = lane >> 4;
  const bfr* proj = (const bfr*)(ows(p) + O_PROJ);
  const bfr* KDT = (const bfr*)(ows(p) + O_H);
  const bfr* ATT = (const bfr*)(ows(p) + O_ATTN);
  const float* EL = (const float*)(ows(p) + O_ELAST);
  bfr* OB = (bfr*)(ows(p) + O_SCR);
  for (int unit = obid(); unit < 256; unit += gridDim.x) {
    const int xcd = unit & 7, li = unit >> 3, bh = xcd * 4 + (li >> 3), slice = li & 7;
    const int b = bh >> 3, h = bh & 7;
    const int mt = wv & 3;
    const bool lo = wv < 4;
    const float elv = EL[bh * 64 + lane];
    f32x4 S = (f32x4){0.f, 0.f, 0.f, 0.f};
    for (int e = tid; e < 16 * 136; e += 512) SbT[e] = 0;
    bf16x8 A1s[4][4], K2s[4][2], A2s[4][2];
    unsigned urs[4][4];
    const bfr* pa_u = proj + (lo ? (size_t)PLANE : (size_t)0) + (size_t)bh * 4096 * 128;
    const int pa_o = (mt * 16 + l15) * 128 + q * 8;
    const bfr* pu_u = proj + (size_t)2 * PLANE + (size_t)bh * 4096 * 128 + slice * 16;
    const int pu_o = (mt * 16 + q * 4) * 128 + (l15 & ~1);
    const int ush = (l15 & 1) * 16;
    const bfr* kd_u = KDT + (size_t)bh * 64 * 8192;
    const int kd_o = (wv * 16 + l15) * 64 + q * 8;
    const bfr* at_u = ATT + (size_t)bh * 64 * 4096;
    const int at_o = (mt * 16 + l15) * 64 + q * 8;
#define G2_GLOAD(set, n)                                                                                     \
  {                                                                                                          \
    const bfr* pa_n = pa_u + (size_t)(n) * 64 * 128;                                                         \
    _Pragma("unroll") for (int ks = 0; ks < 4; ++ks) A1s[set][ks] = *(const bf16x8*)&pa_n[pa_o + ks * 32];   \
    const bfr* kd_n = kd_u + (n) * 8192;                                                                     \
    K2s[set][0] = *(const bf16x8*)&kd_n[kd_o];                                                               \
    K2s[set][1] = *(const bf16x8*)&kd_n[kd_o + 32];                                                          \
    if (lo) {                                                                                                \
      const bfr* pu_n = pu_u + (size_t)(n) * 64 * 128;                                                       \
      _Pragma("unroll") for (int jx = 0; jx < 4; ++jx) urs[set][jx] = *(const unsigned*)&pu_n[pu_o + jx * 128];               \
    } else {                                                                                                 \
      const bfr* at_n = at_u + (n) * 4096;                                                                   \
      A2s[set][0] = *(const bf16x8*)&at_n[at_o];                                                             \
      A2s[set][1] = *(const bf16x8*)&at_n[at_o + 32];                                                        \
    }                                                                                                        \
  }
#define G2_STEP(n, rs)                                                                                       \
  {                                                                                                          \
    f32x4 acc = (f32x4){0.f, 0.f, 0.f, 0.f};                                                                 \
    _Pragma("unroll") for (int ks = 0; ks < 4; ++ks) {                                                       \
      bf16x8 sb = *(const bf16x8*)&SbT[l15 * 136 + ks * 32 + q * 8];                                         \
      acc = lo ? MFMA16(A1s[rs][ks], sb, acc) : MFMA16(sb, A1s[rs][ks], acc);     \
    }                                                                                                        \
    if (lo) {                                                                                                \
      u32x2 pk;                                                                                              \
      pk[0] = pack2(bf2f((bfr)(urs[rs][0] >> ush)) - acc[0], bf2f((bfr)(urs[rs][1] >> ush)) - acc[1]);       \
      pk[1] = pack2(bf2f((bfr)(urs[rs][2] >> ush)) - acc[2], bf2f((bfr)(urs[rs][3] >> ush)) - acc[3]);       \
      *(u32x2*)&VbT[l15 * 72 + mt * 16 + q * 4] = pk;                                                        \
    }                                                                                                        \
    lds_barrier();                                                                                           \
    bf16x8 vb0 = *(const bf16x8*)&VbT[l15 * 72 + q * 8];                                                     \
    bf16x8 vb1 = *(const bf16x8*)&VbT[l15 * 72 + 32 + q * 8];                                                \
    if (!lo) {                                                                                               \
      acc = MFMA16(vb0, A2s[rs][0], acc);                                                                    \
      acc = MFMA16(vb1, A2s[rs][1], acc);                                                                    \
      u32x2 ok; ok[0] = pack2(acc[0], acc[1]); ok[1] = pack2(acc[2], acc[3]);                                \
      *(u32x2*)&OB[((size_t)(b * 4096 + (n) * 64) + mt * 16 + l15) * 1024 + h * 128 + slice * 16 + q * 4] = ok;  \
    }                                                                                                        \
    const float el = __shfl(elv, (n));                                                                       \
    S = S * el;                                                                                              \
    S = MFMA16(K2s[rs][0], vb0, S);                                                                          \
    S = MFMA16(K2s[rs][1], vb1, S);                                                                          \
    {                                                                                                        \
      u32x2 pk;                                                                                              \
      pk[0] = pack2(S[0], S[1]);                                                                             \
      pk[1] = pack2(S[2], S[3]);                                                                             \
      *(u32x2*)&SbT[l15 * 136 + wv * 16 + q * 4] = pk;                                                       \
    }                                                                                                        \
    if ((n) + 4 < 64) G2_GLOAD(rs, (n) + 4);                                                                 \
    lds_barrier();                                                                                           \
  }
    G2_GLOAD(0, 0);
    G2_GLOAD(1, 1);
    G2_GLOAD(2, 2);
    G2_GLOAD(3, 3);
    __syncthreads();
#pragma unroll 1
    for (int n = 0; n < 64; n += 4) {
      G2_STEP(n, 0);
      G2_STEP(n + 1, 1);
      G2_STEP(n + 2, 2);
      G2_STEP(n + 3, 3);
    }
#undef G2_GLOAD
#undef G2_STEP
  }
}

DI void gdn_g2l(const Params& p, int j, char* lds) {
  constexpr int STG = 51200;
  bfr* SbT = (bfr*)(lds + 3 * STG);
  bfr* VbT = (bfr*)(lds + 3 * STG + 4352);
  const int tid = otid(), lane = tid & 63, wv = tid >> 6, l15 = lane & 15, q = lane >> 4;
  const bfr* proj = (const bfr*)(ows(p) + O_PROJ);
  const bfr* KDT = (const bfr*)(ows(p) + O_H);
  const bfr* ATT = (const bfr*)(ows(p) + O_ATTN);
  const float* EL = (const float*)(ows(p) + O_ELAST);
  bfr* OB = (bfr*)(ows(p) + O_SCR);
  for (int unit = obid(); unit < 256; unit += gridDim.x) {
    const int xcd = unit & 7, li = unit >> 3, bh = xcd * 4 + (li >> 3), slice = li & 7;
    const int b = bh >> 3, h = bh & 7;
    const bool loader = wv >= 4;
    for (int e = tid; e < 16 * 136; e += 512) SbT[e] = 0;
    if (loader) {
      const int lw = __builtin_amdgcn_readfirstlane(wv - 4);
      const bfr* wq_u = proj + (size_t)bh * 4096 * 128;
      const bfr* kd_u = KDT + (size_t)bh * 64 * 8192;
      const int lo_wq = (lane >> 2) * 128 + (lane & 3) * 8, lo_kd = (lane >> 2) * 64 + (lane & 3) * 8;
      const bfr* u_u = proj + (size_t)2 * PLANE + (size_t)bh * 4096 * 128 + slice * 16 + (lw * 32 + (lane >> 1)) * 128 + (lane & 1) * 8;
#define G2L_DMA(c, stg)                                                                                      \
  {                                                                                                          \
    const int cc = (c) < 64 ? (c) : 63;                                                                      \
    const bfr* wq_c = wq_u + (size_t)cc * 64 * 128;                                                          \
    const bfr* kd_c = kd_u + (size_t)cc * 8192;                                                              \
    _Pragma("unroll") for (int i = 0; i < 12; ++i) {                                                         \
      const int blk = lw * 12 + i, X = blk >> 4, idx = blk & 15;                                             \
      const bfr* g = (X == 2) ? (kd_c + ((idx >> 1) * 16 * 64 + (idx & 1) * 32) + lo_kd)                     \
                              : (wq_c + (X == 0 ? (size_t)PLANE : (size_t)0) + ((idx >> 2) * 16 * 128 + (idx & 3) * 32) + lo_wq);  \
      __builtin_amdgcn_global_load_lds((const unsigned*)g, (PG8_LAS unsigned*)(lds + (stg) * STG + blk * 1024), 16, 0, 0);  \
    }                                                                                                        \
    if (lw < 2) __builtin_amdgcn_global_load_lds((const unsigned*)(u_u + (size_t)cc * 64 * 128), (PG8_LAS unsigned*)(lds + (stg) * STG + (48 + lw) * 1024), 16, 0, 0);  \
  }
#define G2L_WAITPREV() { if (lw < 2) asm volatile("s_waitcnt vmcnt(13)" ::: "memory"); else asm volatile("s_waitcnt vmcnt(12)" ::: "memory"); }
      G2L_DMA(0, 0);
      G2L_DMA(1, 1);
      G2L_WAITPREV();
      lds_barrier();
#pragma unroll 1
      for (int n = 0; n < 64; n += 3) {
#pragma unroll
        for (int s3 = 0; s3 < 3; ++s3) {
          if (n + s3 < 64) {
            G2L_DMA(n + s3 + 2, (s3 + 2) % 3);
            lds_barrier();
            G2L_WAITPREV();
            lds_barrier();
          }
        }
      }
      asm volatile("s_waitcnt vmcnt(0)" ::: "memory");
#undef G2L_DMA
#undef G2L_WAITPREV
    } else {
      const int mt = wv;
      const float elv = EL[bh * 64 + lane];
      f32x4 S0 = (f32x4){0.f, 0.f, 0.f, 0.f}, S1 = S0;
      bf16x8 At[4][2];
      const bfr* at_u = ATT + (size_t)bh * 64 * 4096 + (mt * 16 + l15) * 64 + q * 8;
#define G2L_GLOAD(set, c)                                                                                    \
  {                                                                                                          \
    const int cc = (c) < 64 ? (c) : 63;                                                                      \
    At[set][0] = *(const bf16x8*)&at_u[cc * 4096];                                                           \
    At[set][1] = *(const bf16x8*)&at_u[cc * 4096 + 32];                                                      \
  }
#define G2L_STEP(n, stg, rs)                                                                                 \
  {                                                                                                          \
    const char* sb_ = lds + (stg) * STG + l15 * 64 + q * 16;                                                 \
    f32x4 accp = (f32x4){0.f, 0.f, 0.f, 0.f}, acco = accp;                                                   \
    if ((n) > 0) {     \
      accd = MFMA16(vbd0, Atd0, accd);                                                                       \
      accd = MFMA16(vbd1, Atd1, accd);                                                                       \
      u32x2 ok; ok[0] = pack2(accd[0], accd[1]); ok[1] = pack2(accd[2], accd[3]);                            \
      *(u32x2*)&OB[((size_t)(b * 4096 + ((n) - 1) * 64) + mt * 16 + l15) * 1024 + h * 128 + slice * 16 + q * 4] = ok;  \
    }                                                                                                        \
    _Pragma("unroll") for (int ks = 0; ks < 4; ++ks) {                                                       \
      const bf16x8 sb = *(const bf16x8*)&SbT[l15 * 136 + ks * 32 + q * 8];                                   \
      accp = MFMA16(*(const bf16x8*)(sb_ + (mt * 4 + ks) * 1024), sb, accp);                                 \
      acco = MFMA16(sb, *(const bf16x8*)(sb_ + (16 + mt * 4 + ks) * 1024), acco);     \
    }                                                                                                        \
    {                                                                                                        \
      u32x2 pk;                                                                                              \
      const bfr* up_ = (const bfr*)(lds + (stg) * STG + 48 * 1024) + (mt * 16 + q * 4) * 16 + l15;           \
      pk[0] = pack2(bf2f(up_[0]) - accp[0], bf2f(up_[16]) - accp[1]);                                        \
      pk[1] = pack2(bf2f(up_[32]) - accp[2], bf2f(up_[48]) - accp[3]);                                       \
      *(u32x2*)&VbT[l15 * 72 + mt * 16 + q * 4] = pk;                                                        \
    }                                                                                                        \
    lds_barrier();                                                                                           \
    const bf16x8 vb0 = *(const bf16x8*)&VbT[l15 * 72 + q * 8];                                               \
    const bf16x8 vb1 = *(const bf16x8*)&VbT[l15 * 72 + 32 + q * 8];                                          \
    accd = acco; vbd0 = vb0; vbd1 = vb1; Atd0 = At[rs][0]; Atd1 = At[rs][1];                                 \
    const float el = __uint_as_float(__builtin_amdgcn_readlane(__float_as_uint(elv), (n)));       \
    S0 = S0 * el; S1 = S1 * el;                                                                              \
    S0 = MFMA16(*(const bf16x8*)(sb_ + (32 + (2 * mt) * 2 + 0) * 1024), vb0, S0);                            \
    S0 = MFMA16(*(const bf16x8*)(sb_ + (32 + (2 * mt) * 2 + 1) * 1024), vb1, S0);                            \
    S1 = MFMA16(*(const bf16x8*)(sb_ + (32 + (2 * mt + 1) * 2 + 0) * 1024), vb0, S1);                        \
    S1 = MFMA16(*(const bf16x8*)(sb_ + (32 + (2 * mt + 1) * 2 + 1) * 1024), vb1, S1);                        \
    {                                                                                                        \
      u32x2 pk;                                                                                              \
      pk[0] = pack2(S0[0], S0[1]); pk[1] = pack2(S0[2], S0[3]);                                              \
      *(u32x2*)&SbT[l15 * 136 + (2 * mt) * 16 + q * 4] = pk;                                                 \
      pk[0] = pack2(S1[0], S1[1]); pk[1] = pack2(S1[2], S1[3]);                                              \
      *(u32x2*)&SbT[l15 * 136 + (2 * mt + 1) * 16 + q * 4] = pk;                                             \
    }                                                                                                        \
    G2L_GLOAD(rs, (n) + 4);                                                                                  \
    lds_barrier();                                                                                           \
  }
      G2L_GLOAD(0, 0);
      G2L_GLOAD(1, 1);
      G2L_GLOAD(2, 2);
      G2L_GLOAD(3, 3);
      f32x4 accd = (f32x4){0.f, 0.f, 0.f, 0.f};
      bf16x8 vbd0 = (bf16x8){0, 0, 0, 0, 0, 0, 0, 0}, vbd1 = vbd0, Atd0 = vbd0, Atd1 = vbd0;
      lds_barrier();
#pragma unroll 1
      for (int n = 0; n < 60; n += 12) {
        G2L_STEP(n, 0, 0); G2L_STEP(n + 1, 1, 1); G2L_STEP(n + 2, 2, 2); G2L_STEP(n + 3, 0, 3);
        G2L_STEP(n + 4, 1, 0); G2L_STEP(n + 5, 2, 1); G2L_STEP(n + 6, 0, 2); G2L_STEP(n + 7, 1, 3);
        G2L_STEP(n + 8, 2, 0); G2L_STEP(n + 9, 0, 1); G2L_STEP(n + 10, 1, 2); G2L_STEP(n + 11, 2, 3);
      }
      G2L_STEP(60, 0, 0); G2L_STEP(61, 1, 1); G2L_STEP(62, 2, 2); G2L_STEP(63, 0, 3);
      {
        accd = MFMA16(vbd0, Atd0, accd);
        accd = MFMA16(vbd1, Atd1, accd);
        u32x2 ok; ok[0] = pack2(accd[0], accd[1]); ok[1] = pack2(accd[2], accd[3]);
        *(u32x2*)&OB[((size_t)(b * 4096 + 63 * 64) + mt * 16 + l15) * 1024 + h * 128 + slice * 16 + q * 4] = ok;
      }
#undef G2L_GLOAD
#undef G2L_STEP
    }
    __syncthreads();
  }
}

DI void gdn_g3(const Params& p, int j, char* lds) {
  const int tid = otid(), lane = tid & 63, wv = tid >> 6, l15 = lane & 15, q = lane >> 4;
  const bfr* proj = (const bfr*)(ows(p) + O_PROJ);
  bfr* OB = (bfr*)(ows(p) + O_SCR);
  f32x4 g0 = *(const f32x4*)&p.gdn_onorm_g[j * 128 + l15 * 8], g1 = *(const f32x4*)&p.gdn_onorm_g[j * 128 + l15 * 8 + 4];
  const int stride = gridDim.x * 32;
  int pi = (obid() * 8 + wv) * 4 + q;
  bf16x8 ov, zv;
#define G3_LOAD(pp)                                                                                                  \
  {                                                                                                                  \
    const int t_ = (pp) >> 3, h_ = (pp) & 7;                                                                         \
    ov = __builtin_nontemporal_load((const bf16x8*)&OB[(size_t)t_ * 1024 + h_ * 128 + l15 * 8]);                     \
    zv = __builtin_nontemporal_load((const bf16x8*)&proj[(size_t)3 * PLANE + (size_t)(((t_ >> 12) * 8 + h_) * 4096 + (t_ & 4095)) * 128 + l15 * 8]);  \
  }
  bf16x8 ov2 = (bf16x8){0, 0, 0, 0, 0, 0, 0, 0}, zv2 = ov2;
  if (pi < 131072) G3_LOAD(pi);
  if (pi + stride < 131072) { const bf16x8 o1 = ov, z1 = zv; G3_LOAD(pi + stride); ov2 = ov; zv2 = zv; ov = o1; zv = z1; }
  for (; pi < 131072; pi += stride) {
    const int t = pi >> 3, h = pi & 7;
    const bf16x8 oc = ov, zc = zv;
    ov = ov2; zv = zv2;
    if (pi + 2 * stride < 131072) { const bf16x8 o1 = ov, z1 = zv; G3_LOAD(pi + 2 * stride); ov2 = ov; zv2 = zv; ov = o1; zv = z1; }
    float o[8], ss = 0.f;
#pragma unroll
    for (int e = 0; e < 8; ++e) { o[e] = bfe(oc, e); ss += o[e] * o[e]; }
    ss = sum16(ss);
    const float rstd = rsqrtf(ss * (1.f / 128.f) + EPS);
    float y[8];
#pragma unroll
    for (int e = 0; e < 8; ++e) y[e] = o[e] * rstd * (e < 4 ? g0[e] : g1[e - 4]) * siluf_(bfe(zc, e));
    u32x4 pk;
    pk[0] = pack2(y[0], y[1]); pk[1] = pack2(y[2], y[3]); pk[2] = pack2(y[4], y[5]); pk[3] = pack2(y[6], y[7]);
    *(u32x4*)&OB[(size_t)t * 1024 + h * 128 + l15 * 8] = pk;
  }
#undef G3_LOAD
}


#define XB_TMO      128
#define XB_XCNT(j)  (256  + 64 * (j))
#define XB_XSUB(j)  (1280 + 64 * (j))
#define XB_XGEN(j)  (2304 + 64 * (j))
#define XB_TOP      3328
#define XB_TOPGEN   3392
#define XCD_BAR_WORDS 3456
#define XB_SPIN_CAP (1u << 18)
#define LAS __attribute__((address_space(3)))

__device__ __forceinline__ unsigned xb_ld(unsigned* p)              { return __hip_atomic_load(p, __ATOMIC_RELAXED, __HIP_MEMORY_SCOPE_AGENT); }
__device__ __forceinline__ unsigned xb_add(unsigned* p, unsigned v) { return __hip_atomic_fetch_add(p, v, __ATOMIC_RELAXED, __HIP_MEMORY_SCOPE_AGENT); }
__device__ __forceinline__ unsigned xb_xcc_id() { return (unsigned)__builtin_amdgcn_s_getreg((3 << 11) | 20) & 0xFu; }
#define XB_SPIN(cond, bar) do { unsigned _sp = 0; while (cond) { __builtin_amdgcn_s_sleep(1); \
    if ((++_sp & 255u) == 0u) { if (xb_ld(&(bar)[XB_TMO])) break; if (_sp > XB_SPIN_CAP) { atomicAdd(&(bar)[XB_TMO], 1u); break; } } } } while (0)

struct XcdBarrier {
    unsigned* bar; unsigned x;
    volatile LAS unsigned* st;
};

__device__ __forceinline__ XcdBarrier xcd_barrier_post(unsigned* bar, volatile LAS unsigned* st) {
    XcdBarrier b; b.bar = bar; b.x = xb_xcc_id(); b.st = st;
    if (threadIdx.x == 0) (void)xb_add(&bar[XB_XCNT(b.x)], 1u);
    return b;
}
__device__ __forceinline__ void xcd_barrier_complete(unsigned* bar, unsigned x, unsigned& nloc, unsigned& nx) {
    const unsigned G = gridDim.x * gridDim.y * gridDim.z;
    unsigned sum, cnt, mine, sp = 0u;
    for (;;) {
        sum = 0u; cnt = 0u; mine = 0u;
#pragma unroll
        for (unsigned j = 0; j < 16; ++j) { const unsigned c = xb_ld(&bar[XB_XCNT(j)]); sum += c; cnt += (c > 0u) ? 1u : 0u; mine = (j == x) ? c : mine; }
        if (sum == G) break;
        __builtin_amdgcn_s_sleep(1);
        if ((++sp & 255u) == 0u) { if (xb_ld(&bar[XB_TMO])) break; if (sp > XB_SPIN_CAP) { atomicAdd(&bar[XB_TMO], 1u); break; } }
    }
    nloc = mine > 0u ? mine : 1u; nx = cnt > 0u ? cnt : 1u;
}

__device__ __forceinline__ void xcd_barrier(const XcdBarrier& b) {
    asm volatile("s_waitcnt vmcnt(0)" ::: "memory");
    __syncthreads();
    if (threadIdx.x == 0) {
        unsigned* bar = b.bar;
        __builtin_amdgcn_s_waitcnt(0);
        unsigned nloc = b.st[0], nx = b.st[1];
        if (nloc == 0u) { xcd_barrier_complete(bar, b.x, nloc, nx); b.st[0] = nloc; b.st[1] = nx; }
        const unsigned old = xb_add(&bar[XB_XSUB(b.x)], 1u);
        const unsigned gen = old / nloc;
        if (old + 1u == (gen + 1u) * nloc) {
            __builtin_amdgcn_fence(__ATOMIC_RELEASE, "agent");
            asm volatile("s_waitcnt vmcnt(0)" ::: "memory");
            const unsigned og = xb_add(&bar[XB_TOP], 1u);
            const unsigned tg = og / nx;
            if (og + 1u == (tg + 1u) * nx) xb_add(&bar[XB_TOPGEN], 1u);
            else XB_SPIN(xb_ld(&bar[XB_TOPGEN]) == tg, bar);
            __builtin_amdgcn_fence(__ATOMIC_ACQUIRE, "agent");
            xb_add(&bar[XB_XGEN(b.x)], 1u);
            asm volatile("s_waitcnt vmcnt(0)" ::: "memory");
        } else {
            XB_SPIN(xb_ld(&bar[XB_XGEN(b.x)]) == gen, bar);
            __builtin_amdgcn_fence(__ATOMIC_ACQUIRE, "agent");
            asm volatile("s_waitcnt vmcnt(0)" ::: "memory");
        }
    }
    __syncthreads();
}


DI void run_phase(const Params& p, int ph, char* lds) {
  if (ph == 0) { phase0(p, lds); return; }
  if (ph == NPHASE - 1) { norm_phase(p, 4, ows(p) + O_H, lds); return; }
  int layer, sub;
  if (ph < 5) { layer = 0; sub = ph - 1; }
  else if (ph < 11) { layer = 1; sub = ph - 5; }
  else if (ph < 15) { layer = 2; sub = ph - 11; }
  else { layer = 3; sub = ph - 15; }
  const int j = layer >> 1;
  const bool is_lru = (layer & 1) == 0;
  const bfr* H = (const bfr*)(ows(p) + O_H);
  const void* xcur = (layer == 0) ? (const void*)p.x : (const void*)p.out;
  bfr* xnext = (layer == 3) ? (bfr*)(ows(p) + O_H) : (bfr*)p.out;
  if (is_lru) {
    switch (sub) {
      case 0: norm_phase(p, layer, xcur, lds); break;
      case 1: gemm_phase<0>(p, H, 1024, (const bfr*)(ows(p) + O_WLI) + (size_t)j * 2048 * 1024, 8, layer, nullptr, nullptr, lds); break;
      case 2: lru_phase(p, j, lds); break;
      case 3: gemm_phase<2>(p, H, 1024, (const bfr*)(ows(p) + O_WLO) + (size_t)j * 1024 * 1024, 4, layer, xcur, xnext, lds); break;
    }
  } else {
    switch (sub) {
      case 0: norm_phase(p, layer, xcur, lds); break;
      case 1: gemm_phase<1>(p, H, 1024, (const bfr*)(ows(p) + O_WGI) + (size_t)j * 4224 * 1024, 16, layer, nullptr, nullptr, lds); break;
      case 2: gdn_g1(p, j, lds); break;
#if G2_LOADER
      case 3: gdn_g2l(p, j, lds); break;
#else
      case 3: gdn_g2(p, j, lds); break;
#endif
      case 4: gdn_g3(p, j, lds); break;
      case 5: gemm_phase<2>(p, (const bfr*)(ows(p) + O_SCR), 1024, (const bfr*)(ows(p) + O_WGO) + (size_t)j * 1024 * 1024, 4, layer, xcur, xnext, lds); break;
    }
  }
}

__global__ void __launch_bounds__(512) mega_fwd(Params p) {
  extern __shared__ __attribute__((aligned(16))) char lds[];
#if MK_MODE == 1
  cg::grid_group grid = cg::this_grid();
  if (p.ph_lo < 0) grid.sync();
  volatile LAS unsigned* bst = (volatile LAS unsigned*)(lds + LDS_BYTES - 16);
  if (threadIdx.x == 0) { bst[0] = 0u; bst[1] = 0u; }
  __syncthreads();
  const XcdBarrier xb = xcd_barrier_post((unsigned*)(p.ws + O_BAR), bst);
  for (int ph = p.ph_lo; ph < p.ph_hi; ++ph) {
    if (ph > p.ph_lo) xcd_barrier(xb);
#ifdef PROBE_MASK
    const bool probe = (PROBE_MASK >> ph) & 1;
    long long ts = 0;
    if (probe) ts = wall_clock64();
#endif
    run_phase(p, ph, lds);
#ifdef PROBE_MASK
    if (probe) {
      xcd_barrier(xb);
      if (blockIdx.x == 0 && threadIdx.x == 0) {
        long long dt = wall_clock64() - ts, t1 = wall_clock64();
        while (wall_clock64() - t1 < dt) __builtin_amdgcn_s_sleep(8);
      }
    }
#endif
  }
#else
  for (int ph = p.ph_lo; ph < p.ph_hi; ++ph) run_phase(p, ph, lds);
#endif
}

extern "C" void kernel_launch(void* const* d_in, const int* in_sizes, int n_in, void* d_out, int out_size, void* d_ws, size_t ws_size, hipStream_t stream) {
  static int grid = 0;
  if (grid == 0) {
    if (n_in != 19 || ws_size < WS_END) { fprintf(stderr, "kernel_launch: unexpected inputs (n_in %d, ws %zu)\n", n_in, ws_size); grid = -1; return; }
    int dev = 0, cus = 0, per_cu = 0;
    hipGetDevice(&dev);
    hipDeviceGetAttribute(&cus, hipDeviceAttributeMultiprocessorCount, dev);
    if (hipFuncSetAttribute((const void*)mega_fwd, hipFuncAttributeMaxDynamicSharedMemorySize, LDS_BYTES) != hipSuccess) { fprintf(stderr, "kernel_launch: hipFuncSetAttribute failed\n"); grid = -1; return; }
    hipOccupancyMaxActiveBlocksPerMultiprocessor(&per_cu, (const void*)mega_fwd, 512, LDS_BYTES);
    if (per_cu < 1) { fprintf(stderr, "kernel_launch: occupancy query returned %d\n", per_cu); per_cu = 1; }
    (void)hipGetLastError();
    grid = cus * per_cu;
    if (grid > 256) grid = 256;
  }
  if (grid < 0) return;
  Params p{};
  const float** pp = (const float**)&p;
  for (int i = 0; i < 19; ++i) pp[i] = (const float*)d_in[i];
  p.out = (float*)d_out;
  p.ws = (char*)d_ws;
#if MK_MODE == 1
  p.ph_lo = 0; p.ph_hi = NPHASE;
  if (hipMemsetAsync((char*)d_ws + O_BAR, 0, 16384, stream) != hipSuccess) { fprintf(stderr, "kernel_launch: memset of barrier words failed\n"); return; }
  void* args[] = {&p};
  hipError_t e = hipLaunchCooperativeKernel((const void*)mega_fwd, dim3(grid), dim3(512), args, LDS_BYTES, stream);
  if (e != hipSuccess) fprintf(stderr, "cooperative launch failed: %s (grid %d)\n", hipGetErrorString(e), grid);
#else
  for (int ph = 0; ph < NPHASE; ++ph) {
    p.ph_lo = ph; p.ph_hi = ph + 1;
    hipLaunchKernelGGL(mega_fwd, dim3(grid), dim3(512), LDS_BYTES, stream, p);
  }
#endif
}
```

```cpp
#include <hip/hip_runtime.h>
#include <hip/hip_cooperative_groups.h>
#include <cstdio>
namespace cg = cooperative_groups;

#ifndef G2_LOADER
#define G2_LOADER 1
#endif
#ifndef MK_MODE
#define MK_MODE 1
#endif

typedef unsigned short bfr;
typedef __attribute__((ext_vector_type(8))) short bf16x8;
typedef __attribute__((ext_vector_type(4))) short bf16x4;
typedef __attribute__((ext_vector_type(4))) float f32x4;
typedef __attribute__((ext_vector_type(4))) unsigned u32x4;
typedef __attribute__((ext_vector_type(2))) unsigned u32x2;

#define DI __device__ __forceinline__
#define MFMA16(a, b, c) __builtin_amdgcn_mfma_f32_16x16x32_bf16((a), (b), (c), 0, 0, 0)

constexpr int PLANE = 16384 * 1024;
constexpr float EPS = 1e-6f;
constexpr int NPHASE = 22;
constexpr int LDS_BYTES = 163840;

constexpr size_t O_WLI = 0;
constexpr size_t O_WLO = 8388608;
constexpr size_t O_WGI = 12582912;
constexpr size_t O_WGO = 29884416;
constexpr size_t O_WG = 34078720;
constexpr size_t O_CONDP = 35127296;
constexpr size_t O_H = 36700160;
constexpr size_t O_PROJ = 70254592;
constexpr size_t O_ATTN = 204996608;
constexpr size_t O_HALO = 221773824;
constexpr size_t O_SCR = 226492416;
constexpr size_t O_AB = 260046848;
constexpr size_t O_ELAST = 261095424;
constexpr size_t O_AGG = 261103616;
constexpr size_t O_COND = 263200768;
constexpr size_t O_BAR = 263397376;
constexpr size_t WS_END = 263397376 + 16384;

struct Params {
  const float *x, *c, *ada_w, *ada_b, *norm_g, *final_g;
  const float *lru_in_w, *lru_conv_w, *lru_conv_b, *lru_gate_w, *lru_gate_b, *lru_lambda, *lru_out_w;
  const float *gdn_in_w, *gdn_conv_w, *gdn_a_log, *gdn_dt_bias, *gdn_onorm_g, *gdn_out_w;
  float* out;
  char* ws;
  int ph_lo, ph_hi;
};

DI int otid() { int t = threadIdx.x; asm volatile("" : "+v"(t)); return t; }
DI int obid() { int b = blockIdx.x; asm volatile("" : "+s"(b)); return b; }
DI void lds_barrier() { asm volatile("s_waitcnt lgkmcnt(0)" ::: "memory"); __builtin_amdgcn_s_barrier(); asm volatile("" ::: "memory"); }
typedef float f32x2_t __attribute__((ext_vector_type(2)));
typedef __bf16 bf16x2_t __attribute__((ext_vector_type(2)));
DI unsigned pack2(float a, float b) { f32x2_t v = {a, b}; bf16x2_t r = __builtin_convertvector(v, bf16x2_t); return __builtin_bit_cast(unsigned, r); }
DI bfr f2bf(float x) { return (bfr)(pack2(x, x) & 0xffffu); }
DI float bf2f(bfr b) { return __uint_as_float(((unsigned)b) << 16); }
DI float sum16(float x) {
  x += __uint_as_float(__builtin_amdgcn_update_dpp(0, __float_as_uint(x), 0xB1, 0xF, 0xF, true));
  x += __uint_as_float(__builtin_amdgcn_update_dpp(0, __float_as_uint(x), 0x4E, 0xF, 0xF, true));
  x += __uint_as_float(__builtin_amdgcn_update_dpp(0, __float_as_uint(x), 0x141, 0xF, 0xF, true));
  x += __uint_as_float(__builtin_amdgcn_update_dpp(0, __float_as_uint(x), 0x140, 0xF, 0xF, true));
  return x;
}
DI float sigmoidf_(float x) { return __builtin_amdgcn_rcpf(1.f + __expf(-x)); }
DI float siluf_(float x) { return x * __builtin_amdgcn_rcpf(1.f + __expf(-x)); }
DI float softplusf_(float x) { return x > 20.f ? x : log1pf(expf(x)); }
DI float bfe(const bf16x8& v, int e) { return bf2f((bfr)v[e]); }

DI char* ows(const Params& p) { size_t z = 0; asm volatile("" : "+s"(z)); return p.ws + z; }
DI float cond_get(const Params& p, int layer, int b, int n) {
  const float* cp = (const float*)(ows(p) + O_CONDP);
  float s = p.ada_b[layer * 3072 + n];
#pragma unroll
  for (int sg = 0; sg < 8; ++sg) s += cp[((sg * 4 + layer) * 4 + b) * 3072 + n];
  return s;
}

DI void transpose_tile(const float* __restrict__ src, int ldsrc, int nvalid, bfr* __restrict__ dst, int ldd, int k0, int n0, float* sm) {
  const int tid = otid();
  for (int e = tid; e < 4096; e += 512) {
    int kk = e >> 6, nn = e & 63;
    float v = 0.f;
    if (n0 + nn < nvalid) v = src[(size_t)(k0 + kk) * ldsrc + n0 + nn];
    sm[kk * 65 + nn] = v;
  }
  __syncthreads();
  for (int e = tid; e < 4096; e += 512) {
    int nn = e >> 6, kk = e & 63;
    dst[(size_t)(n0 + nn) * ldd + k0 + kk] = f2bf(sm[kk * 65 + nn]);
  }
  __syncthreads();
}

struct P0Item { const float* src; bfr* dst; int ldsrc, nvalid, ldd, k0, n0; };
DI P0Item p0_decode(const Params& p, int it) {
  P0Item r;
  if (it < 1024) {
    int l = it >> 9, q = it & 511, kt = q >> 5, nt = q & 31;
    r.src = p.lru_in_w + (size_t)l * 1024 * 2048; r.ldsrc = 2048; r.nvalid = 2048; r.dst = (bfr*)(ows(p) + O_WLI) + (size_t)l * 2048 * 1024; r.ldd = 1024; r.k0 = kt * 64; r.n0 = nt * 64;
  } else if (it < 1536) {
    int r0 = it - 1024, l = r0 >> 8, q = r0 & 255, kt = q >> 4, nt = q & 15;
    r.src = p.lru_out_w + (size_t)l * 1024 * 1024; r.ldsrc = 1024; r.nvalid = 1024; r.dst = (bfr*)(ows(p) + O_WLO) + (size_t)l * 1024 * 1024; r.ldd = 1024; r.k0 = kt * 64; r.n0 = nt * 64;
  } else if (it < 3648) {
    int r0 = it - 1536, l = r0 / 1056, q = r0 % 1056, kt = q / 66, nt = q % 66;
    r.src = p.gdn_in_w + (size_t)l * 1024 * 4112; r.ldsrc = 4112; r.nvalid = 4112; r.dst = (bfr*)(ows(p) + O_WGI) + (size_t)l * 4224 * 1024; r.ldd = 1024; r.k0 = kt * 64; r.n0 = nt * 64;
  } else if (it < 4160) {
    int r0 = it - 3648, l = r0 >> 8, q = r0 & 255, kt = q >> 4, nt = q & 15;
    r.src = p.gdn_out_w + (size_t)l * 1024 * 1024; r.ldsrc = 1024; r.nvalid = 1024; r.dst = (bfr*)(ows(p) + O_WGO) + (size_t)l * 1024 * 1024; r.ldd = 1024; r.k0 = kt * 64; r.n0 = nt * 64;
  } else {
    int r0 = it - 4160, mat = r0 >> 2, q = r0 & 3, kt = q >> 1, nt = q & 1;
    r.src = p.lru_gate_w + (size_t)mat * 16384; r.ldsrc = 128; r.nvalid = 128; r.dst = (bfr*)(ows(p) + O_WG) + (size_t)mat * 16384; r.ldd = 128; r.k0 = kt * 64; r.n0 = nt * 64;
  }
  return r;
}

DI void phase0(const Params& p, char* lds) {
  float* sm = (float*)lds;
  const int tid = otid();
  float v[8];
#define P0_LOAD(it_)                                                                                 \
  {                                                                                                  \
    const P0Item t_ = p0_decode(p, (it_));                                                           \
    _Pragma("unroll") for (int i = 0; i < 8; ++i) {                                                  \
      const int e = tid + 512 * i, kk = e >> 6, nn = e & 63;                                         \
      v[i] = (t_.n0 + nn < t_.nvalid) ? __builtin_nontemporal_load(&t_.src[(size_t)(t_.k0 + kk) * t_.ldsrc + t_.n0 + nn]) : 0.f; \
    }                                                                                                \
  }
  if (obid() < 4288) P0_LOAD(obid());
#pragma unroll 1
  for (int it = obid(); it < 4288; it += gridDim.x) {
    const P0Item t = p0_decode(p, it);
#pragma unroll
    for (int i = 0; i < 8; ++i) { const int e = tid + 512 * i; sm[(e >> 6) * 65 + (e & 63)] = v[i]; }
    lds_barrier();
    if (it + (int)gridDim.x < 4288) P0_LOAD(it + gridDim.x);
#pragma unroll
    for (int i = 0; i < 4; ++i) {
      const int e = tid + 512 * i, nn = e >> 5, kp = e & 31;
      *(unsigned*)&t.dst[(size_t)(t.n0 + nn) * t.ldd + t.k0 + 2 * kp] = pack2(sm[(2 * kp) * 65 + nn], sm[(2 * kp + 1) * 65 + nn]);
    }
    lds_barrier();
  }
#undef P0_LOAD
  __syncthreads();
  for (int r0 = obid(); r0 < 192; r0 += gridDim.x) {
    int i = r0 / 48, r = r0 % 48, sg = r / 6, cb = r % 6;
    sm[tid] = siluf_(p.c[(tid >> 7) * 1024 + sg * 128 + (tid & 127)]);
    __syncthreads();
    int n = cb * 512 + tid;
    float a0 = 0.f, a1 = 0.f, a2 = 0.f, a3 = 0.f;
    const float* w = p.ada_w + ((size_t)i * 1024 + sg * 128) * 3072 + n;
#pragma unroll 32
    for (int k = 0; k < 128; ++k) {
      float wv = __builtin_nontemporal_load(&w[(size_t)k * 3072]);
      a0 += sm[k] * wv; a1 += sm[128 + k] * wv; a2 += sm[256 + k] * wv; a3 += sm[384 + k] * wv;
    }
    float* cp = (float*)(ows(p) + O_CONDP);
    cp[((sg * 4 + i) * 4 + 0) * 3072 + n] = a0;
    cp[((sg * 4 + i) * 4 + 1) * 3072 + n] = a1;
    cp[((sg * 4 + i) * 4 + 2) * 3072 + n] = a2;
    cp[((sg * 4 + i) * 4 + 3) * 3072 + n] = a3;
    __syncthreads();
  }
}

DI void norm_phase(const Params& p, int layer, const void* __restrict__ xsrc, char* lds) {
  const float* xs = (const float*)xsrc; const bfr* xsb = (const bfr*)xsrc;
  float* gm = (float*)lds;
  float* sh = gm + 1024;
  const int tid = otid(), lane = tid & 63, wv = tid >> 6;
  bfr* H = (bfr*)(ows(p) + O_H);
  if (layer == 0) {
    float* cd = (float*)(ows(p) + O_COND);
    for (int e = obid() * 512 + tid; e < 4 * 4 * 3072; e += gridDim.x * 512) {
      int n = e % 3072, ib = e / 3072;
      cd[e] = cond_get(p, ib >> 2, ib & 3, n);
    }
  }
  const float* cd = (const float*)(ows(p) + O_COND);
  for (int rt = obid(); rt < 256; rt += gridDim.x) {
    int b = rt >> 6;
    for (int c = tid; c < 1024; c += 512) {
      if (layer == 0) {
        float scale = cond_get(p, layer, b, 1024 + c), shift = cond_get(p, layer, b, c);
        gm[c] = p.norm_g[layer * 1024 + c] * (1.f + scale);
        sh[c] = shift;
      } else if (layer < 4) {
        gm[c] = p.norm_g[layer * 1024 + c] * (1.f + cd[(size_t)(layer * 4 + b) * 3072 + 1024 + c]);
        sh[c] = cd[(size_t)(layer * 4 + b) * 3072 + c];
      } else {
        gm[c] = p.final_g[c];
        sh[c] = 0.f;
      }
    }
    __syncthreads();
    u32x2 rb[2][4][4];
    if (layer != 0) {
#pragma unroll
      for (int g = 0; g < 2; ++g)
#pragma unroll
        for (int r = 0; r < 4; ++r)
#pragma unroll
          for (int jx = 0; jx < 4; ++jx) {
            const u32x2* xp = (const u32x2*)&xsb[((size_t)rt * 64 + wv * 8 + g * 4 + r) * 1024 + jx * 256 + lane * 4];
            rb[g][r][jx] = __builtin_nontemporal_load(xp);
          }
    }
#pragma unroll
    for (int r4 = 0; r4 < 8; r4 += 4) {
      f32x4 v[4][4];
#pragma unroll
      for (int r = 0; r < 4; ++r)
#pragma unroll
        for (int jx = 0; jx < 4; ++jx) {
          const size_t xi = ((size_t)rt * 64 + wv * 8 + r4 + r) * 1024 + jx * 256 + lane * 4;
          if (layer == 0) v[r][jx] = __builtin_nontemporal_load((const f32x4*)&xs[xi]);
          else {
            const u32x2 xb = rb[r4 >> 2][r][jx];
            v[r][jx] = (f32x4){__uint_as_float(xb[0] << 16), __uint_as_float(xb[0] & 0xffff0000u), __uint_as_float(xb[1] << 16), __uint_as_float(xb[1] & 0xffff0000u)};
          }
        }
#pragma unroll
      for (int r = 0; r < 4; ++r) {
        const size_t row = (size_t)rt * 64 + wv * 8 + r4 + r;
        float ss = 0.f;
#pragma unroll
        for (int jx = 0; jx < 4; ++jx) ss += v[r][jx][0] * v[r][jx][0] + v[r][jx][1] * v[r][jx][1] + v[r][jx][2] * v[r][jx][2] + v[r][jx][3] * v[r][jx][3];
        ss = sum16(ss);
        ss += __shfl_xor(ss, 16);
        ss += __shfl_xor(ss, 32);
        const float rstd = rsqrtf(ss * (1.f / 1024.f) + EPS);
#pragma unroll
        for (int jx = 0; jx < 4; ++jx) {
          const int c = jx * 256 + lane * 4;
          f32x4 g4 = *(const f32x4*)&gm[c], s4 = *(const f32x4*)&sh[c];
          f32x4 y;
#pragma unroll
          for (int e = 0; e < 4; ++e) y[e] = v[r][jx][e] * rstd * g4[e] + s4[e];
          if (layer < 4) {
            u32x2 o2; o2[0] = pack2(y[0], y[1]); o2[1] = pack2(y[2], y[3]);
            *(u32x2*)&H[row * 1024 + c] = o2;
          } else {
            __builtin_nontemporal_store(y, (f32x4*)&p.out[row * 1024 + c]);
          }
        }
      }
    }
    __syncthreads();
  }
}

namespace pg8 {
#define PG8_LAS __attribute__((address_space(3)))
typedef unsigned short bf16_t;
typedef short bf16x8 __attribute__((ext_vector_type(8)));
typedef float f32x4 __attribute__((ext_vector_type(4)));
typedef unsigned u32x4 __attribute__((ext_vector_type(4)));
constexpr int BM = 256, BK = 64, HALF = 128, HTB = HALF * BK * 2  , STAGE_BYTES = 8 * HTB, NXCD = 8, WGM = 8;

__host__ __device__ __forceinline__ int lds_byte(int r, int c) { const int st = (r >> 4) * 2 + (c >> 5), rr = r & 15, cc = c & 31, ob = rr * 64 + cc * 2; return st * 1024 + (ob ^ (((ob >> 9) & 1) << 5)); }
__host__ __device__ __forceinline__ void stage_rc(int b, int& R, int& C) { const int st = b / 1024, sb = b % 1024, swz = sb ^ (((sb >> 9) & 1) << 5); R = (st >> 1) * 16 + swz / 64; C = (st & 1) * 32 + (swz % 64) / 2; }
__host__ __device__ __forceinline__ int perm32(int rho) { const int n = rho >> 4, i = rho & 15; return 8 * (i >> 2) + 4 * n + (i & 3); }

struct Unit { int pm, pn; };
struct Gemm { const bf16_t* A; const bf16_t* Bt; int M, N, K; };

struct StaticOrder {
    int nM, nN, nwg, G, c;
    __host__ __device__ void init(int M, int N, int G_, int c_) { nM = M / BM; nN = N / BM; nwg = nM * nN; G = G_; c = c_; }
    __host__ __device__ bool next(int i, Unit& u) const {
        const long L = (long)i * G + c; if (L >= nwg) return false;
        int wgid = (int)L; { const int q = nwg / NXCD, r = nwg % NXCD, xcd = wgid % NXCD, off = wgid / NXCD; wgid = (xcd < r ? xcd * (q + 1) : r * (q + 1) + (xcd - r) * q) + off; }
        const int nig = WGM * nN, gid = wgid / nig, fm = gid * WGM, gsz = (nM - fm) < WGM ? (nM - fm) : WGM;
        u.pm = fm + ((wgid % nig) % gsz); u.pn = (wgid % nig) / gsz; return true;
    }
    __device__ __forceinline__ void a_ready(const Unit&) const {}
    __device__ __forceinline__ void done(const Unit&) const {}
};
__device__ __forceinline__ unsigned cvt_pk_bf16(float lo, float hi) { unsigned r; asm volatile("v_cvt_pk_bf16_f32 %0, %1, %2" : "=v"(r) : "v"(lo), "v"(hi)); return r; }

template <class Epi, class Sched, bool STAMP = false>
__device__ __forceinline__ void gemm_phase(PG8_LAS unsigned char* lds, const Gemm g, const Sched& S, const Epi& E, unsigned long long* stamps) {
    const int tid = otid(), wid = __builtin_amdgcn_readfirstlane(tid >> 6), lane = tid & 63, wr = wid >> 2, wc = wid & 3, fr = lane & 15, fq = lane >> 4;
    const int K = g.K, nt = K / BK;
    int ts_lo = 0, ts_hi = 0, nts = 0; const unsigned long long rt_entry = STAMP ? (unsigned long long)wall_clock64() : 0ull;
#define PG8_STAMP() do { if (STAMP && wid == 0 && nts < 64) { const unsigned long long _c = (unsigned long long)clock64(); \
        ts_lo = (lane == nts) ? (int)(unsigned)_c : ts_lo; ts_hi = (lane == nts) ? (int)(unsigned)(_c >> 32) : ts_hi; ++nts; } } while (0)
    PG8_STAMP();
    unsigned voffA[2], voffB[2];
#pragma unroll
    for (int i = 0; i < 2; ++i) { int R, C; stage_rc(tid * 16 + i * 8192, R, C); const int Rb = Epi::PERM ? ((R & ~31) + perm32(R & 31)) : R;
        voffA[i] = (unsigned)(R * K + C) * 2u; voffB[i] = (unsigned)(Rb * K + C) * 2u; }
    const size_t kstep = (size_t)(BK * 2);
    const size_t hstep = (size_t)HALF * K * 2;
    const size_t tstep = 2 * hstep;
    const unsigned ldsw = (unsigned)wid * 1024u;
    const int aoff = lds_byte(wr * 64 + fr, fq * 8), boff = lds_byte(wc * 32 + fr, fq * 8);
#define PG8_SA(b, h) (((b) * 2 + (h)) * HTB)
#define PG8_SB(b, h) ((4 + (b) * 2 + (h)) * HTB)
#define PG8_STAGE(bufoff, gbase, voff) do { _Pragma("unroll") for (int _i = 0; _i < 2; ++_i) \
        __builtin_amdgcn_global_load_lds((const unsigned*)((const char*)(gbase) + (voff)[_i]), (PG8_LAS unsigned*)(lds + (bufoff) + ldsw + _i * 8192), 16, 0, 0); } while (0)
#define PG8_LDA(dst, b, h) do { _Pragma("unroll") for (int m = 0; m < 4; ++m) _Pragma("unroll") for (int k = 0; k < 2; ++k) dst[m][k] = *(const PG8_LAS bf16x8*)(lds + PG8_SA(b, h) + aoff + m * 2048 + k * 1024); } while (0)
#define PG8_LDB(dst, b, h) do { _Pragma("unroll") for (int n = 0; n < 2; ++n) _Pragma("unroll") for (int k = 0; k < 2; ++k) dst[n][k] = *(const PG8_LAS bf16x8*)(lds + PG8_SB(b, h) + boff + n * 2048 + k * 1024); } while (0)
#define PG8_MMA(ai, bj, At, Bt) do { __builtin_amdgcn_s_setprio(1); _Pragma("unroll") for (int m = 0; m < 4; ++m) _Pragma("unroll") for (int n = 0; n < 2; ++n) _Pragma("unroll") for (int k = 0; k < 2; ++k) \
        acc[ai][bj][m][n] = __builtin_amdgcn_mfma_f32_16x16x32_bf16(Bt[n][k], At[m][k], acc[ai][bj][m][n], 0, 0, 0); __builtin_amdgcn_s_setprio(0); } while (0)
#define PG8_WAIT_V(n) asm volatile("s_waitcnt vmcnt(" #n ")" ::: "memory")
#define PG8_WAIT_L(n) asm volatile("s_waitcnt lgkmcnt(" #n ")" ::: "memory")
#define PG8_BAR __builtin_amdgcn_s_barrier()
#define PG8_SCHED __builtin_amdgcn_sched_barrier(0)
    Unit cur, nxt; int ui = 0;
    if (!S.next(0, cur)) return;
    f32x4 acc[2][2][4][2];
#pragma unroll
    for (int a = 0; a < 2; ++a)
#pragma unroll
        for (int b = 0; b < 2; ++b)
#pragma unroll
            for (int m = 0; m < 4; ++m)
#pragma unroll
                for (int n = 0; n < 2; ++n) acc[a][b][m][n] = (f32x4){0.f, 0.f, 0.f, 0.f};
    bf16x8 At[4][2], B0[2][2], B1[2][2];
    const char* cA = (const char*)g.A + (size_t)cur.pm * tstep; const char* cB = (const char*)g.Bt + (size_t)cur.pn * tstep;
    S.a_ready(cur);
    PG8_STAGE(PG8_SB(0, 0), cB, voffB); PG8_STAGE(PG8_SA(0, 0), cA, voffA); PG8_STAGE(PG8_SB(0, 1), cB + hstep, voffB); PG8_STAGE(PG8_SA(0, 1), cA + hstep, voffA);
    if (wr == 1) PG8_BAR;
    PG8_WAIT_V(4); PG8_BAR;
    PG8_STAGE(PG8_SB(1, 0), cB + kstep, voffB); PG8_STAGE(PG8_SA(1, 0), cA + kstep, voffA); PG8_STAGE(PG8_SB(1, 1), cB + hstep + kstep, voffB);
    PG8_WAIT_V(6); PG8_BAR;
    PG8_STAMP();
    for (;;) {
        const bool has_next = S.next(ui + 1, nxt);
        const char* nA = has_next ? (const char*)g.A + (size_t)nxt.pm * tstep : cA; const char* nB = has_next ? (const char*)g.Bt + (size_t)nxt.pn * tstep : cB;
        for (int t = 0; t < nt; t += 2) {
            const bool last = (t == nt - 2);
            const char* a1 = cA + (size_t)(t + 1) * kstep;
            const char* a2 = last ? nA : cA + (size_t)(t + 2) * kstep; const char* b2 = last ? nB : cB + (size_t)(t + 2) * kstep;
            const char* a3 = a2 + kstep; const char* b3 = b2 + kstep;
            if (last && has_next) S.a_ready(nxt);
            PG8_LDB(B0, 0, 0); PG8_SCHED; PG8_LDA(At, 0, 0); PG8_STAGE(PG8_SA(1, 1), a1 + hstep, voffA);
            PG8_WAIT_L(8); PG8_BAR; PG8_WAIT_L(0); PG8_MMA(0, 0, At, B0); PG8_BAR; PG8_SCHED;
            PG8_LDB(B1, 0, 1); PG8_STAGE(PG8_SB(0, 0), b2, voffB);
            PG8_BAR; PG8_WAIT_L(0); PG8_MMA(0, 1, At, B1); PG8_BAR;
            PG8_LDA(At, 0, 1); PG8_STAGE(PG8_SA(0, 0), a2, voffA);
            PG8_BAR; PG8_WAIT_L(0); PG8_MMA(1, 0, At, B0); PG8_BAR; PG8_SCHED;
            PG8_STAGE(PG8_SB(0, 1), b2 + hstep, voffB);
            PG8_WAIT_V(6); PG8_BAR; PG8_MMA(1, 1, At, B1); PG8_BAR;
            PG8_LDB(B0, 1, 0); PG8_SCHED; PG8_LDA(At, 1, 0); PG8_STAGE(PG8_SA(0, 1), a2 + hstep, voffA);
            PG8_WAIT_L(8); PG8_BAR; PG8_WAIT_L(0); PG8_MMA(0, 0, At, B0); PG8_BAR; PG8_SCHED;
            PG8_LDB(B1, 1, 1); PG8_STAGE(PG8_SB(1, 0), b3, voffB);
            PG8_BAR; PG8_WAIT_L(0); PG8_MMA(0, 1, At, B1); PG8_BAR;
            PG8_LDA(At, 1, 1); PG8_STAGE(PG8_SA(1, 0), a3, voffA);
            PG8_BAR; PG8_WAIT_L(0); PG8_MMA(1, 0, At, B0); PG8_BAR; PG8_SCHED;
            PG8_STAGE(PG8_SB(1, 1), b3 + hstep, voffB);
            PG8_WAIT_V(6); PG8_BAR; PG8_MMA(1, 1, At, B1); PG8_BAR;
        }
        PG8_STAMP();
        if constexpr (!Epi::AFTER_DRAIN) { E(acc, cur, wr, wc, fr, fq); S.done(cur); }
        PG8_STAMP();
        if (!has_next) break;
#pragma unroll
        for (int a = 0; a < 2; ++a)
#pragma unroll
            for (int b = 0; b < 2; ++b)
#pragma unroll
                for (int m = 0; m < 4; ++m)
#pragma unroll
                    for (int n = 0; n < 2; ++n) acc[a][b][m][n] = (f32x4){0.f, 0.f, 0.f, 0.f};
        cur = nxt; cA = nA; cB = nB; ++ui;
    }
    PG8_WAIT_V(0);
    if (wr == 0) PG8_BAR;
    PG8_BAR;
    if constexpr (Epi::AFTER_DRAIN) { E.fused(acc, cur, wr, wc, fr, fq, lds, wid, lane); S.done(cur); }
    PG8_STAMP();
    if (STAMP && wid == 0) { stamps[lane] = lane < nts ? (((unsigned long long)(unsigned)ts_hi << 32) | (unsigned)ts_lo) : 0ull;
        if (lane == 62) stamps[62] = rt_entry; if (lane == 63) stamps[63] = (unsigned long long)wall_clock64(); }
#undef PG8_STAMP
#undef PG8_SA
#undef PG8_SB
#undef PG8_STAGE
#undef PG8_LDA
#undef PG8_LDB
#undef PG8_MMA
#undef PG8_WAIT_V
#undef PG8_WAIT_L
#undef PG8_BAR
#undef PG8_SCHED
}
}

struct EpiProjBf16 {
  static constexpr bool PERM = true, AFTER_DRAIN = false;
  bfr* O; bfr* halo;
  __device__ __forceinline__ void operator()(const f32x4 (&acc)[2][2][4][2], const pg8::Unit& u, int wr, int wc, int fr, int fq) const {
    const int row0 = u.pm * 256 + wr * 64 + fr, col0 = u.pn * 256 + wc * 32 + 8 * fq;
#pragma unroll
    for (int ai = 0; ai < 2; ++ai)
#pragma unroll
      for (int m = 0; m < 4; ++m) {
        const int row = row0 + ai * 128 + m * 16;
        const int bb = row >> 12, ts = row & 4095;
#pragma unroll
        for (int bj = 0; bj < 2; ++bj) {
          const int col = col0 + bj * 128;
          const f32x4 v0 = acc[ai][bj][m][0], v1 = acc[ai][bj][m][1];
          u32x4 w; w.x = pack2(v0[0], v0[1]); w.y = pack2(v0[2], v0[3]); w.z = pack2(v1[0], v1[1]); w.w = pack2(v1[2], v1[3]);
          *(u32x4*)(O + (size_t)(col >> 10) * PLANE + ((size_t)((bb * 8 + ((col >> 7) & 7)) * 4096 + ts)) * 128 + (col & 127)) = w;
          if (halo && (row & 63) >= 61 && col < 3072)
            *(u32x4*)(halo + ((size_t)(row >> 6) * 3 + ((row & 63) - 61)) * 3072 + col) = w;
        }
      }
  }
};
struct EpiResid {
  static constexpr bool PERM = true, AFTER_DRAIN = false;
  bfr* out; const void* xin; int xin_f32; const float* gate;
  __device__ __forceinline__ void operator()(const f32x4 (&acc)[2][2][4][2], const pg8::Unit& u, int wr, int wc, int fr, int fq) const {
    const int row0 = u.pm * 256 + wr * 64 + fr, col0 = u.pn * 256 + wc * 32 + 8 * fq;
    const float* gp = gate + (size_t)((u.pm * 256) >> 12) * 3072 + col0;
    f32x4 gv[2][2];
#pragma unroll
    for (int bj = 0; bj < 2; ++bj)
#pragma unroll
      for (int n = 0; n < 2; ++n) gv[bj][n] = *(const f32x4*)(gp + bj * 128 + n * 4);
#pragma unroll
    for (int ai = 0; ai < 2; ++ai)
#pragma unroll
      for (int m = 0; m < 4; ++m) {
        const size_t ro = (size_t)(row0 + ai * 128 + m * 16) * 1024 + col0;
#pragma unroll
        for (int bj = 0; bj < 2; ++bj) {
          f32x4 x0, x1;
          if (xin_f32) {
            x0 = __builtin_nontemporal_load((const f32x4*)((const float*)xin + ro + bj * 128));
            x1 = __builtin_nontemporal_load((const f32x4*)((const float*)xin + ro + bj * 128 + 4));
          } else {
            const u32x4 xb = *(const u32x4*)((const bfr*)xin + ro + bj * 128);
            x0 = (f32x4){__uint_as_float(xb[0] << 16), __uint_as_float(xb[0] & 0xffff0000u), __uint_as_float(xb[1] << 16), __uint_as_float(xb[1] & 0xffff0000u)};
            x1 = (f32x4){__uint_as_float(xb[2] << 16), __uint_as_float(xb[2] & 0xffff0000u), __uint_as_float(xb[3] << 16), __uint_as_float(xb[3] & 0xffff0000u)};
          }
          const f32x4 v0 = x0 + gv[bj][0] * acc[ai][bj][m][0], v1 = x1 + gv[bj][1] * acc[ai][bj][m][1];
          u32x4 w; w.x = pack2(v0[0], v0[1]); w.y = pack2(v0[2], v0[3]); w.z = pack2(v1[0], v1[1]); w.w = pack2(v1[2], v1[3]);
          *(u32x4*)(out + ro + bj * 128) = w;
        }
      }
  }
};

template <int EPI>
DI void gemm_phase(const Params& p, const bfr* __restrict__ A, int lda, const bfr* __restrict__ Bt, int nN, int layer, const void* __restrict__ xin, bfr* __restrict__ xout, char* lds) {
  pg8::Gemm g; g.A = A; g.Bt = Bt; g.M = 16384; g.N = nN * 256; g.K = 1024;
  pg8::StaticOrder S; S.init(g.M, g.N, gridDim.x, obid());
  if (EPI == 2) {
    EpiResid E; E.out = xout; E.xin = xin; E.xin_f32 = (layer == 0) ? 1 : 0; E.gate = (const float*)(ows(p) + O_COND) + (size_t)layer * 4 * 3072 + 2048;
    pg8::gemm_phase<EpiResid, pg8::StaticOrder, false>((PG8_LAS unsigned char*)lds, g, S, E, nullptr);
  } else {
    EpiProjBf16 E; E.O = (bfr*)(ows(p) + O_PROJ); E.halo = (EPI == 1) ? (bfr*)(ows(p) + O_HALO) : nullptr;
    pg8::gemm_phase<EpiProjBf16, pg8::StaticOrder, false>((PG8_LAS unsigned char*)lds, g, S, E, nullptr);
  }
  if (EPI == 1) {
    __syncthreads();
    float* red = (float*)lds;
    const int tid = otid(), lane = tid & 63, wv = tid >> 6, l15 = lane & 15, q = lane >> 4;
    const int mt4 = wv & 3, kh = wv >> 2;
    for (int rt = obid(); rt < 256; rt += gridDim.x) {
      const bfr* Ar = A + (size_t)(rt * 64 + mt4 * 16 + l15) * lda + kh * 512 + q * 8;
      const bfr* Br = Bt + (size_t)(4096 + l15) * 1024 + kh * 512 + q * 8;
      f32x4 acc = (f32x4){0.f, 0.f, 0.f, 0.f};
#pragma unroll 4
      for (int ks = 0; ks < 16; ++ks) acc = MFMA16(*(const bf16x8*)(Ar + ks * 32), *(const bf16x8*)(Br + ks * 32), acc);
      if (kh == 1) *(f32x4*)&red[(mt4 * 64 + lane) * 4] = acc;
      __syncthreads();
      if (kh == 0) {
        f32x4 o = *(const f32x4*)&red[(mt4 * 64 + lane) * 4];
#pragma unroll
        for (int jx = 0; jx < 4; ++jx) ((float*)(ows(p) + O_AB))[(size_t)(rt * 64 + mt4 * 16 + q * 4 + jx) * 16 + l15] = acc[jx] + o[jx];
      }
      __syncthreads();
    }
  }
}

DI void lru_phase(const Params& p, int j, char* lds) {
  const int tid = otid(), lane = tid & 63, wv = tid >> 6, l15 = lane & 15, q = lane >> 4;
  bfr* Xw = (bfr*)lds + wv * (32 * 136);
  float* WAgg = (float*)(lds + 8 * 32 * 136 * 2);
  const bfr* proj = (const bfr*)(ows(p) + O_PROJ);
  bfr* Yb = (bfr*)(ows(p) + O_H);
  const bfr* WG = (const bfr*)(ows(p) + O_WG);
  for (int unit = obid(); unit < 256; unit += gridDim.x) {
    const int xcd = unit & 7, li = unit >> 3, idx = xcd * 4 + (li >> 3), sl = li & 7, b = idx >> 3, gb = idx & 7;
    const int ch = gb * 128 + sl * 16 + l15;
    bf16x8 Bf[2][4];
#pragma unroll
    for (int kq = 0; kq < 2; ++kq)
#pragma unroll
      for (int ks = 0; ks < 4; ++ks) Bf[kq][ks] = *(const bf16x8*)&WG[(size_t)((j * 2 + kq) * 8 + gb) * 16384 + (sl * 16 + l15) * 128 + ks * 32 + q * 8];
    const float gbr = p.lru_gate_b[(j * 2) * 1024 + ch], gbi = p.lru_gate_b[(j * 2 + 1) * 1024 + ch];
    const float sp = softplusf_(-p.lru_lambda[j * 1024 + ch]);
    const int cg = lane & 15, rs = lane >> 4, ccol = gb * 128 + cg * 8;
    float cwv[4][8], cb[8];
#pragma unroll
    for (int tp = 0; tp < 4; ++tp)
#pragma unroll
      for (int e = 0; e < 8; ++e) cwv[tp][e] = p.lru_conv_w[(size_t)(j * 4 + tp) * 1024 + ccol + e];
#pragma unroll
    for (int e = 0; e < 8; ++e) cb[e] = p.lru_conv_b[j * 1024 + ccol + e];
    const bfr* xb_u = proj + (size_t)(b * 8 + gb) * 4096 * 128;
    bfr* yb_u = Yb + (size_t)b * 4096 * 1024;
    const int xo = (wv * 32 + rs * 8 - 3) * 128 + cg * 8;
    const int zo = PLANE + (wv * 32 + q * 4) * 128 + sl * 16 + (l15 & ~1);
    const int zsh = (l15 & 1) * 16;
    const int yo = (wv * 32 + q * 4) * 1024 + ch;
    float carry = 0.f;
    bf16x8 raw[11];
    unsigned zr[8];
#define LRU_LOAD(it)                                                                                   \
  {                                                                                                    \
    const bfr* xit = xb_u + (it) * (256 * 128);                                                        \
    _Pragma("unroll") for (int i = 0; i < 11; ++i) {                                                   \
      const int t = (it) * 256 + wv * 32 + rs * 8 - 3 + i;                                             \
      if (t >= 0) raw[i] = *(const bf16x8*)&xit[xo + i * 128];                                         \
      else raw[i] = (bf16x8){0, 0, 0, 0, 0, 0, 0, 0};                                                  \
    }                                                                                                  \
    _Pragma("unroll") for (int mt = 0; mt < 2; ++mt) _Pragma("unroll") for (int jx = 0; jx < 4; ++jx)  \
      zr[mt * 4 + jx] = *(const unsigned*)&xit[zo + (mt * 16 + jx) * 128];                                               \
  }
    LRU_LOAD(0);
#pragma unroll 1
    for (int it = 0; it < 16; ++it) {
#pragma unroll
      for (int r = 0; r < 8; ++r) {
        float o[8];
#pragma unroll
        for (int e = 0; e < 8; ++e) {
          float s = cb[e];
#pragma unroll
          for (int tp = 0; tp < 4; ++tp) s += cwv[tp][e] * bfe(raw[r + tp], e);
          o[e] = s;
        }
        u32x4 pk; pk[0] = pack2(o[0], o[1]); pk[1] = pack2(o[2], o[3]); pk[2] = pack2(o[4], o[5]); pk[3] = pack2(o[6], o[7]);
        *(u32x4*)&Xw[(rs * 8 + r) * 136 + cg * 8] = pk;
      }
      float zc[8];
#pragma unroll
      for (int i = 0; i < 8; ++i) zc[i] = bf2f((bfr)(zr[i] >> zsh));
      if (it < 15) LRU_LOAD(it + 1);
      f32x4 accr[2], acci[2];
#pragma unroll
      for (int mt = 0; mt < 2; ++mt) {
        accr[mt] = acci[mt] = (f32x4){0.f, 0.f, 0.f, 0.f};
#pragma unroll
        for (int ks = 0; ks < 4; ++ks) {
          bf16x8 af = *(const bf16x8*)&Xw[(mt * 16 + l15) * 136 + ks * 32 + q * 8];
          accr[mt] = MFMA16(af, Bf[0][ks], accr[mt]);
          acci[mt] = MFMA16(af, Bf[1][ks], acci[mt]);
        }
      }
      float av[2][4], bv[2][4];
      float Aex[2], Bex[2], At[2], Bt_[2];
#pragma unroll
      for (int mt = 0; mt < 2; ++mt) {
        float Al = 1.f, Bl = 0.f;
#pragma unroll
        for (int jx = 0; jx < 4; ++jx) {
          const float r = sigmoidf_(accr[mt][jx] + gbr), ig = sigmoidf_(acci[mt][jx] + gbi);
          const float a = __expf(-8.f * r * sp);
          const float mult = __builtin_amdgcn_sqrtf(fmaxf(1.f - a * a, 0.f));
          const float xf = bf2f(Xw[(mt * 16 + q * 4 + jx) * 136 + sl * 16 + l15]);
          const float bt = mult * ig * xf;
          av[mt][jx] = a; bv[mt][jx] = bt;
          Bl = a * Bl + bt; Al *= a;
        }
        float Ai = Al, Bi = Bl;
#pragma unroll
        for (int off = 16; off < 64; off <<= 1) {
          const float Ap = __shfl_up(Ai, off), Bp = __shfl_up(Bi, off);
          if (lane >= off) { Bi = Ai * Bp + Bi; Ai = Ai * Ap; }
        }
        float Ae = __shfl_up(Ai, 16), Be = __shfl_up(Bi, 16);
        if (q == 0) { Ae = 1.f; Be = 0.f; }
        Aex[mt] = Ae; Bex[mt] = Be;
        At[mt] = __shfl(Ai, 48 + l15); Bt_[mt] = __shfl(Bi, 48 + l15);
      }
      float* wa = WAgg + (it & 1) * 256;
      if (q == 0) { wa[(wv * 16 + l15) * 2] = At[0] * At[1]; wa[(wv * 16 + l15) * 2 + 1] = At[1] * Bt_[0] + Bt_[1]; }
      lds_barrier();
      float cin = carry, cnew = carry;
#pragma unroll
      for (int w = 0; w < 8; ++w) {
        const float Aw = wa[(w * 16 + l15) * 2], Bw = wa[(w * 16 + l15) * 2 + 1];
        cnew = Aw * cnew + Bw;
        if (w < wv) cin = Aw * cin + Bw;
      }
      carry = cnew;
      bfr* yit = yb_u + it * (256 * 1024);
#pragma unroll
      for (int mt = 0; mt < 2; ++mt) {
        float h = Aex[mt] * cin + Bex[mt];
#pragma unroll
        for (int jx = 0; jx < 4; ++jx) {
          h = av[mt][jx] * h + bv[mt][jx];
          yit[yo + (mt * 16 + jx) * 1024] = f2bf(h * siluf_(zc[mt * 4 + jx]));
        }
        cin = At[mt] * cin + Bt_[mt];
      }
    }
#undef LRU_LOAD
  }
}

DI bf16x8 ld_perm(const bfr* base) {
  u32x2 lo = *(const u32x2*)base, hi = *(const u32x2*)(base + 16);
  u32x4 r; r[0] = lo[0]; r[1] = lo[1]; r[2] = hi[0]; r[3] = hi[1];
  return __builtin_bit_cast(bf16x8, r);
}
DI bf16x8 pack_cc(const f32x4& a, const f32x4& b) {
  u32x4 r; r[0] = pack2(a[0], a[1]); r[1] = pack2(a[2], a[3]); r[2] = pack2(b[0], b[1]); r[3] = pack2(b[2], b[3]);
  return __builtin_bit_cast(bf16x8, r);
}


template <int NL> DI void row_load(f32x4 (&a)[8], unsigned addr, float& dep) {
  if constexpr (NL == 1) asm volatile("ds_read_b128 %0, %2\n\ts_waitcnt lgkmcnt(0)" : "=&v"(a[0]), "+v"(dep) : "v"(addr) : "memory");
  if constexpr (NL == 2) asm volatile("ds_read_b128 %0, %3\n\tds_read_b128 %1, %3 offset:16\n\ts_waitcnt lgkmcnt(0)" : "=&v"(a[0]), "=&v"(a[1]), "+v"(dep) : "v"(addr) : "memory");
  if constexpr (NL == 3) asm volatile("ds_read_b128 %0, %4\n\tds_read_b128 %1, %4 offset:16\n\tds_read_b128 %2, %4 offset:32\n\ts_waitcnt lgkmcnt(0)" : "=&v"(a[0]), "=&v"(a[1]), "=&v"(a[2]), "+v"(dep) : "v"(addr) : "memory");
  if constexpr (NL == 4) asm volatile("ds_read_b128 %0, %5\n\tds_read_b128 %1, %5 offset:16\n\tds_read_b128 %2, %5 offset:32\n\tds_read_b128 %3, %5 offset:48\n\ts_waitcnt lgkmcnt(0)" : "=&v"(a[0]), "=&v"(a[1]), "=&v"(a[2]), "=&v"(a[3]), "+v"(dep) : "v"(addr) : "memory");
  if constexpr (NL == 5) asm volatile("ds_read_b128 %0, %6\n\tds_read_b128 %1, %6 offset:16\n\tds_read_b128 %2, %6 offset:32\n\tds_read_b128 %3, %6 offset:48\n\tds_read_b128 %4, %6 offset:64\n\ts_waitcnt lgkmcnt(0)" : "=&v"(a[0]), "=&v"(a[1]), "=&v"(a[2]), "=&v"(a[3]), "=&v"(a[4]), "+v"(dep) : "v"(addr) : "memory");
  if constexpr (NL == 6) asm volatile("ds_read_b128 %0, %7\n\tds_read_b128 %1, %7 offset:16\n\tds_read_b128 %2, %7 offset:32\n\tds_read_b128 %3, %7 offset:48\n\tds_read_b128 %4, %7 offset:64\n\tds_read_b128 %5, %7 offset:80\n\ts_waitcnt lgkmcnt(0)" : "=&v"(a[0]), "=&v"(a[1]), "=&v"(a[2]), "=&v"(a[3]), "=&v"(a[4]), "=&v"(a[5]), "+v"(dep) : "v"(addr) : "memory");
  if constexpr (NL == 7) asm volatile("ds_read_b128 %0, %8\n\tds_read_b128 %1, %8 offset:16\n\tds_read_b128 %2, %8 offset:32\n\tds_read_b128 %3, %8 offset:48\n\tds_read_b128 %4, %8 offset:64\n\tds_read_b128 %5, %8 offset:80\n\tds_read_b128 %6, %8 offset:96\n\ts_waitcnt lgkmcnt(0)" : "=&v"(a[0]), "=&v"(a[1]), "=&v"(a[2]), "=&v"(a[3]), "=&v"(a[4]), "=&v"(a[5]), "=&v"(a[6]), "+v"(dep) : "v"(addr) : "memory");
  if constexpr (NL == 8) asm volatile("ds_read_b128 %0, %9\n\tds_read_b128 %1, %9 offset:16\n\tds_read_b128 %2, %9 offset:32\n\tds_read_b128 %3, %9 offset:48\n\tds_read_b128 %4, %9 offset:64\n\tds_read_b128 %5, %9 offset:80\n\tds_read_b128 %6, %9 offset:96\n\tds_read_b128 %7, %9 offset:112\n\ts_waitcnt lgkmcnt(0)" : "=&v"(a[0]), "=&v"(a[1]), "=&v"(a[2]), "=&v"(a[3]), "=&v"(a[4]), "=&v"(a[5]), "=&v"(a[6]), "=&v"(a[7]), "+v"(dep) : "v"(addr) : "memory");
}
template <int I> DI void inv_rows(float (&t)[32], unsigned abase, int j) {
  if constexpr (I < 32) {
    float s = (I == j) ? 1.f : 0.f;
    if constexpr (I > 0) {
      f32x4 a[8];
      row_load<(I + 3) / 4>(a, abase + I * 256, t[I - 1]);
#pragma unroll
      for (int m4 = 0; m4 < I; m4 += 4) {
        s -= a[m4 >> 2][0] * t[m4];
        if (m4 + 1 < I) s -= a[m4 >> 2][1] * t[m4 + 1];
        if (m4 + 2 < I) s -= a[m4 >> 2][2] * t[m4 + 2];
        if (m4 + 3 < I) s -= a[m4 >> 2][3] * t[m4 + 3];
      }
    }
    t[I] = s;
    inv_rows<I + 1>(t, abase, j);
  }
}
DI void tri_invert32(const float* __restrict__ Au, bfr* __restrict__ Ttu, bfr* __restrict__ Tcu, int hf, int lane) {
  const int j = lane & 31;
  const float* Ab = Au + (32 * hf) * 64 + 32 * hf;
  float t[32];
  const unsigned abase = (unsigned)(size_t)Ab;
  inv_rows<0>(t, abase, j);
  if (lane < 32) {
#pragma unroll
    for (int i = 0; i < 32; ++i) Ttu[(32 * hf + i) * 72 + 32 * hf + j] = f2bf(t[i]);
    if (hf == 0) {
#pragma unroll
      for (int i = 0; i < 32; ++i) Ttu[i * 72 + 32 + j] = 0;
#pragma unroll
      for (int i4 = 0; i4 < 4; ++i4) {
        u32x4 pk;
        pk[0] = pack2(t[8 * i4], t[8 * i4 + 1]); pk[1] = pack2(t[8 * i4 + 2], t[8 * i4 + 3]);
        pk[2] = pack2(t[8 * i4 + 4], t[8 * i4 + 5]); pk[3] = pack2(t[8 * i4 + 6], t[8 * i4 + 7]);
        *(u32x4*)&Tcu[j * 40 + 8 * i4] = pk;
      }
    }
  }
}
DI void tri_merge(const float* __restrict__ Au, bfr* __restrict__ Ttu, const bfr* __restrict__ Tcu, int nt2, int lane) {
  const int l15 = lane & 15, q = lane >> 4;
  const f32x4 zero = (f32x4){0.f, 0.f, 0.f, 0.f};
  bf16x8 bfrag = *(const bf16x8*)&Tcu[(nt2 * 16 + l15) * 40 + q * 8];
  f32x4 X[2];
#pragma unroll
  for (int mt = 0; mt < 2; ++mt) {
    const float* ar = Au + (32 + mt * 16 + l15) * 64 + q * 8;
    f32x4 a0 = *(const f32x4*)ar, a1 = *(const f32x4*)(ar + 4);
    X[mt] = MFMA16(pack_cc(a0, a1), bfrag, zero);
  }
  bf16x8 xb = pack_cc(X[0], X[1]);
#pragma unroll
  for (int mt2 = 0; mt2 < 2; ++mt2) {
    bf16x8 a = ld_perm(Ttu + (32 + mt2 * 16 + l15) * 72 + 32 + q * 4);
    f32x4 r = MFMA16(a, xb, zero);
#pragma unroll
    for (int jx = 0; jx < 4; ++jx) Ttu[(32 + mt2 * 16 + q * 4 + jx) * 72 + nt2 * 16 + l15] = f2bf(-r[jx]);
  }
}

DI void gdn_g1(const Params& p, int j, char* lds) {
  float* Asl = (float*)lds;
  bfr* Tt = (bfr*)(lds + 65536);
  bfr* Kt = (bfr*)(lds + 102400);
  bfr* Qt = (bfr*)(lds + 119808);
  bfr* Vt = (bfr*)(lds + 137216);
  float* gc = (float*)(lds + 154624);
  float* be = (float*)(lds + 155648);
  float* cw = (float*)(lds + 156672);
  const int tid0 = otid();
  bfr* proj = (bfr*)(ows(p) + O_PROJ);
  bfr* KDT = (bfr*)(ows(p) + O_H);
  bfr* ATT = (bfr*)(ows(p) + O_ATTN);
  const bfr* HALO = (const bfr*)(ows(p) + O_HALO);
  bfr* SCR = (bfr*)(ows(p) + O_SCR) + (size_t)obid() * (4 * 2 * 8192);
  const float* AB = (const float*)(ows(p) + O_AB);
  float* EL = (float*)(ows(p) + O_ELAST);
  for (int grp = obid(); grp < 256; grp += gridDim.x) {
    const int bh = grp >> 3, b = bh >> 3, h = bh & 7;
    for (int e = tid0; e < 1536; e += 512) {
      int X = e >> 9, rem = e & 511, tap = rem >> 7, c = rem & 127;
      cw[(X * 4 + tap) * 128 + c] = p.gdn_conv_w[(size_t)(j * 4 + tap) * 3072 + X * 1024 + h * 128 + c];
    }
    bf16x8 nxt[3][5];
    float pfx_g = 0.f, pfx_b = 0.f;
#define G1_RAWLOAD(nn)                                                                                         \
  {                                                                                                            \
    const int rg_ = tid0 >> 4, cgi_ = tid0 & 15, r0_ = rg_ * 2;                                                \
    _Pragma("unroll") for (int X = 0; X < 3; ++X) {                                                            \
      _Pragma("unroll") for (int i = 0; i < 5; ++i) {                                                          \
        const int rr = r0_ - 3 + i;                                                                            \
        if (rr >= 0) nxt[X][i] = *(const bf16x8*)&proj[(size_t)X * PLANE + (size_t)(bh * 4096 + (nn) * 64 + rr) * 128 + cgi_ * 8];   \
        else if ((nn) > 0) nxt[X][i] = *(const bf16x8*)&HALO[((size_t)(b * 64 + (nn) - 1) * 3 + 3 + rr) * 3072 + X * 1024 + h * 128 + cgi_ * 8];   \
        else nxt[X][i] = (bf16x8){0, 0, 0, 0, 0, 0, 0, 0};                                                     \
      }                                                                                                        \
    }                                                                                                          \
  }
    G1_RAWLOAD((grp * 8) & 63);
#pragma unroll 1
    for (int half = 0; half < 2; ++half) {
      {
        int tid = tid0; asm volatile("" : "+v"(tid));
        const int lane = tid & 63, wv = tid >> 6;
        if (half == 0) {
          const int un = grp * 8 + wv, n = un & 63, t0 = b * 4096 + n * 64;
          float a_in = AB[(size_t)(t0 + lane) * 16 + h], b_in = AB[(size_t)(t0 + lane) * 16 + 8 + h];
          float g = -__expf(p.gdn_a_log[j * 8 + h]) * softplusf_(a_in + p.gdn_dt_bias[j * 8 + h]);
#pragma unroll
          for (int off = 1; off < 64; off <<= 1) {
            float v = __shfl_up(g, off);
            if (lane >= off) g += v;
          }
          pfx_g = g; pfx_b = sigmoidf_(b_in);
          if (lane == 63) EL[un] = __expf(g);
          if (wv < 4) { gc[wv * 64 + lane] = pfx_g; be[wv * 64 + lane] = pfx_b; }
        } else if (wv >= 4) {
          gc[(wv - 4) * 64 + lane] = pfx_g; be[(wv - 4) * 64 + lane] = pfx_b;
        }
      }
#pragma unroll 1
      for (int u = 0; u < 4; ++u) {
        const int un = grp * 8 + half * 4 + u, n = un & 63, t0 = b * 4096 + n * 64;
        int tid = tid0; asm volatile("" : "+v"(tid));
        const int lane = tid & 63, wv = tid >> 6, l15 = lane & 15, q = lane >> 4;
        const int rg = tid >> 4, cgi = tid & 15, r0 = rg * 2;
        __syncthreads();
        bf16x8 cur[3][5];
#pragma unroll
        for (int X = 0; X < 3; ++X)
#pragma unroll
          for (int i = 0; i < 5; ++i) cur[X][i] = nxt[X][i];
        if (half * 4 + u < 7) G1_RAWLOAD(n + 1);
#pragma unroll
        for (int X = 0; X < 3; ++X) {
          float val[2][8];
#pragma unroll
          for (int rr = 0; rr < 2; ++rr)
#pragma unroll
            for (int e = 0; e < 8; ++e) {
              float sacc = 0.f;
#pragma unroll
              for (int tp = 0; tp < 4; ++tp) sacc += cw[(X * 4 + tp) * 128 + cgi * 8 + e] * bfe(cur[X][rr + tp], e);
              val[rr][e] = siluf_(sacc);
            }
          if (X < 2) {
#pragma unroll
            for (int rr = 0; rr < 2; ++rr) {
              float ss = 0.f;
#pragma unroll
              for (int e = 0; e < 8; ++e) ss += val[rr][e] * val[rr][e];
              ss = sum16(ss);
              float rn = rsqrtf(ss + EPS);
              if (X == 0) rn *= 0.08838834764831845f;
#pragma unroll
              for (int e = 0; e < 8; ++e) val[rr][e] *= rn;
            }
          }
          bfr* Tile = (X == 0) ? Qt : (X == 1 ? Kt : Vt);
#pragma unroll
          for (int rr = 0; rr < 2; ++rr) {
            const int r = r0 + rr;
            u32x4 pk;
            pk[0] = pack2(val[rr][0], val[rr][1]); pk[1] = pack2(val[rr][2], val[rr][3]);
            pk[2] = pack2(val[rr][4], val[rr][5]); pk[3] = pack2(val[rr][6], val[rr][7]);
            *(u32x4*)&Tile[r * 136 + cgi * 8] = pk;
            if (X == 0) {
              const float eg = __expf(gc[u * 64 + r]);
              pk[0] = pack2(val[rr][0] * eg, val[rr][1] * eg); pk[1] = pack2(val[rr][2] * eg, val[rr][3] * eg);
              pk[2] = pack2(val[rr][4] * eg, val[rr][5] * eg); pk[3] = pack2(val[rr][6] * eg, val[rr][7] * eg);
              *(u32x4*)&proj[(size_t)(bh * 4096 + n * 64 + r) * 128 + cgi * 8] = pk;
            }
          }
        }
        lds_barrier();
        {
          const int mt = wv >> 1;
          f32x4 kk[2], qk[2];
          kk[0] = kk[1] = qk[0] = qk[1] = (f32x4){0.f, 0.f, 0.f, 0.f};
#pragma unroll
          for (int ks = 0; ks < 4; ++ks) {
            bf16x8 ak = *(const bf16x8*)&Kt[(mt * 16 + l15) * 136 + ks * 32 + q * 8];
            bf16x8 aq = *(const bf16x8*)&Qt[(mt * 16 + l15) * 136 + ks * 32 + q * 8];
#pragma unroll
            for (int t2 = 0; t2 < 2; ++t2) {
              int nt = (wv & 1) * 2 + t2;
              bf16x8 bk = *(const bf16x8*)&Kt[(nt * 16 + l15) * 136 + ks * 32 + q * 8];
              kk[t2] = MFMA16(bk, ak, kk[t2]);
              qk[t2] = MFMA16(bk, aq, qk[t2]);
            }
          }
          const int i = mt * 16 + l15;
          const float giv = gc[u * 64 + i], bei = be[u * 64 + i];
#pragma unroll
          for (int t2 = 0; t2 < 2; ++t2) {
            const int m0 = ((wv & 1) * 2 + t2) * 16 + q * 4;
            f32x4 av, tv;
#pragma unroll
            for (int jx = 0; jx < 4; ++jx) {
              const int m = m0 + jx;
              const float d = (i >= m) ? __expf(giv - gc[u * 64 + m]) : 0.f;
              av[jx] = (i > m) ? bei * kk[t2][jx] * d : 0.f;
              tv[jx] = qk[t2][jx] * d;
            }
            *(f32x4*)&Asl[u * 4096 + i * 64 + m0] = av;
            u32x2 pk; pk[0] = pack2(tv[0], tv[1]); pk[1] = pack2(tv[2], tv[3]);
            *(u32x2*)&ATT[(size_t)un * 4096 + i * 64 + m0] = pk;
          }
        }
        {
          const int dd = tid >> 2, tq = tid & 3;
          const float glast = gc[u * 64 + 63];
#pragma unroll
          for (int g8 = 0; g8 < 2; ++g8) {
            const int tok0 = tq * 16 + g8 * 8;
            float okd[8], okb[8], ovb[8];
#pragma unroll
            for (int e = 0; e < 8; ++e) {
              const int tok = tok0 + e;
              const float kv = bf2f(Kt[tok * 136 + dd]), vv = bf2f(Vt[tok * 136 + dd]);
              const float gg = gc[u * 64 + tok], bb = be[u * 64 + tok];
              okd[e] = kv * __expf(glast - gg);
              okb[e] = kv * bb * __expf(gg);
              ovb[e] = vv * bb;
            }
            u32x4 pk;
            pk[0] = pack2(okd[0], okd[1]); pk[1] = pack2(okd[2], okd[3]); pk[2] = pack2(okd[4], okd[5]); pk[3] = pack2(okd[6], okd[7]);
            *(u32x4*)&KDT[(size_t)un * 8192 + dd * 64 + tok0] = pk;
            pk[0] = pack2(okb[0], okb[1]); pk[1] = pack2(okb[2], okb[3]); pk[2] = pack2(okb[4], okb[5]); pk[3] = pack2(okb[6], okb[7]);
            *(u32x4*)&SCR[(u * 2 + 0) * 8192 + dd * 64 + tok0] = pk;
            pk[0] = pack2(ovb[0], ovb[1]); pk[1] = pack2(ovb[2], ovb[3]); pk[2] = pack2(ovb[4], ovb[5]); pk[3] = pack2(ovb[6], ovb[7]);
            *(u32x4*)&SCR[(u * 2 + 1) * 8192 + dd * 64 + tok0] = pk;
          }
        }
      }
      __syncthreads();
      {
      int tid = tid0; asm volatile("" : "+v"(tid));
      const int lane = tid & 63, wv = tid >> 6;
      tri_invert32(Asl + (wv >> 1) * 4096, Tt + (wv >> 1) * 4608, Kt + (wv >> 1) * 1280, wv & 1, lane);
      __syncthreads();
      tri_merge(Asl + (wv >> 1) * 4096, Tt + (wv >> 1) * 4608, Kt + (wv >> 1) * 1280, wv & 1, lane);
      __syncthreads();
      }
      {
        int tid = tid0; asm volatile("" : "+v"(tid));
        const int lane = tid & 63, wv = tid >> 6, l15 = lane & 15, q = lane >> 4;
        bf16x8 bkf[4][2], bvf[4][2];
#pragma unroll
        for (int u = 0; u < 4; ++u)
#pragma unroll
          for (int ks = 0; ks < 2; ++ks) {
            bkf[u][ks] = *(const bf16x8*)&SCR[(u * 2) * 8192 + (wv * 16 + l15) * 64 + ks * 32 + q * 8];
            bvf[u][ks] = *(const bf16x8*)&SCR[(u * 2 + 1) * 8192 + (wv * 16 + l15) * 64 + ks * 32 + q * 8];
          }
#pragma unroll
        for (int u = 0; u < 4; ++u) {
          const int n = (grp * 8 + half * 4 + u) & 63;
          f32x4 aw[4], au[4];
#pragma unroll
          for (int i = 0; i < 4; ++i) aw[i] = au[i] = (f32x4){0.f, 0.f, 0.f, 0.f};
#pragma unroll
          for (int ks = 0; ks < 2; ++ks) {
#pragma unroll
            for (int mt = 0; mt < 4; ++mt) {
              bf16x8 a = *(const bf16x8*)&Tt[u * 4608 + (mt * 16 + l15) * 72 + ks * 32 + q * 8];
              aw[mt] = MFMA16(bkf[u][ks], a, aw[mt]);
              au[mt] = MFMA16(bvf[u][ks], a, au[mt]);
            }
          }
          bfr* Wst = (u & 1) ? Kt : (bfr*)Asl;
          bfr* Ust = Wst + 64 * 136;
#pragma unroll
          for (int mt = 0; mt < 4; ++mt) {
            const int i = mt * 16 + l15, dc = wv * 16 + q * 4;
            u32x2 pk; pk[0] = pack2(aw[mt][0], aw[mt][1]); pk[1] = pack2(aw[mt][2], aw[mt][3]);
            *(u32x2*)&Wst[i * 136 + dc] = pk;
            pk[0] = pack2(au[mt][0], au[mt][1]); pk[1] = pack2(au[mt][2], au[mt][3]);
            *(u32x2*)&Ust[i * 136 + dc] = pk;
          }
          lds_barrier();
#pragma unroll
          for (int k = 0; k < 2; ++k) {
            const int id = tid + 512 * k, row = id >> 4, c16 = id & 15;
            const size_t go = (size_t)(bh * 4096 + n * 64 + row) * 128 + c16 * 8;
            *(u32x4*)&proj[(size_t)PLANE + go] = *(const u32x4*)&Wst[row * 136 + c16 * 8];
            *(u32x4*)&proj[(size_t)2 * PLANE + go] = *(const u32x4*)&Ust[row * 136 + c16 * 8];
          }
        }
      }
      __syncthreads();
    }
  }
#undef G1_RAWLOAD
}

DI void gdn_g2(const Params& p, int j, char* lds) {
  bfr* SbT = (bfr*)lds;
  bfr* VbT = (bfr*)(lds + 4352);
  const int tid = otid(), lane = tid & 63, wv = tid >> 6, l15 = lane & 15, q = lane >> 4;
  const bfr* proj = (const bfr*)(ows(p) + O_PROJ);
  const bfr* KDT = (const bfr*)(ows(p) + O_H);
  const bfr* ATT = (const bfr*)(ows(p) + O_ATTN);
  const float* EL = (const float*)(ows(p) + O_ELAST);
  bfr* OB = (bfr*)(ows(p) + O_SCR);
  for (int unit = obid(); unit < 256; unit += gridDim.x) {
    const int xcd = unit & 7, li = unit >> 3, bh = xcd * 4 + (li >> 3), slice = li & 7;
    const int b = bh >> 3, h = bh & 7;
    const int mt = wv & 3;
    const bool lo = wv < 4;
    const float elv = EL[bh * 64 + lane];
    f32x4 S = (f32x4){0.f, 0.f, 0.f, 0.f};
    for (int e = tid; e < 16 * 136; e += 512) SbT[e] = 0;
    bf16x8 A1s[4][4], K2s[4][2], A2s[4][2];
    unsigned urs[4][4];
    const bfr* pa_u = proj + (lo ? (size_t)PLANE : (size_t)0) + (size_t)bh * 4096 * 128;
    const int pa_o = (mt * 16 + l15) * 128 + q * 8;
    const bfr* pu_u = proj + (size_t)2 * PLANE + (size_t)bh * 4096 * 128 + slice * 16;
    const int pu_o = (mt * 16 + q * 4) * 128 + (l15 & ~1);
    const int ush = (l15 & 1) * 16;
    const bfr* kd_u = KDT + (size_t)bh * 64 * 8192;
    const int kd_o = (wv * 16 + l15) * 64 + q * 8;
    const bfr* at_u = ATT + (size_t)bh * 64 * 4096;
    const int at_o = (mt * 16 + l15) * 64 + q * 8;
#define G2_GLOAD(set, n)                                                                                     \
  {                                                                                                          \
    const bfr* pa_n = pa_u + (size_t)(n) * 64 * 128;                                                         \
    _Pragma("unroll") for (int ks = 0; ks < 4; ++ks) A1s[set][ks] = *(const bf16x8*)&pa_n[pa_o + ks * 32];   \
    const bfr* kd_n = kd_u + (n) * 8192;                                                                     \
    K2s[set][0] = *(const bf16x8*)&kd_n[kd_o];                                                               \
    K2s[set][1] = *(const bf16x8*)&kd_n[kd_o + 32];                                                          \
    if (lo) {                                                                                                \
      const bfr* pu_n = pu_u + (size_t)(n) * 64 * 128;                                                       \
      _Pragma("unroll") for (int jx = 0; jx < 4; ++jx) urs[set][jx] = *(const unsigned*)&pu_n[pu_o + jx * 128];               \
    } else {                                                                                                 \
      const bfr* at_n = at_u + (n) * 4096;                                                                   \
      A2s[set][0] = *(const bf16x8*)&at_n[at_o];                                                             \
      A2s[set][1] = *(const bf16x8*)&at_n[at_o + 32];                                                        \
    }                                                                                                        \
  }
#define G2_STEP(n, rs)                                                                                       \
  {                                                                                                          \
    f32x4 acc = (f32x4){0.f, 0.f, 0.f, 0.f};                                                                 \
    _Pragma("unroll") for (int ks = 0; ks < 4; ++ks) {                                                       \
      bf16x8 sb = *(const bf16x8*)&SbT[l15 * 136 + ks * 32 + q * 8];                                         \
      acc = lo ? MFMA16(A1s[rs][ks], sb, acc) : MFMA16(sb, A1s[rs][ks], acc);     \
    }                                                                                                        \
    if (lo) {                                                                                                \
      u32x2 pk;                                                                                              \
      pk[0] = pack2(bf2f((bfr)(urs[rs][0] >> ush)) - acc[0], bf2f((bfr)(urs[rs][1] >> ush)) - acc[1]);       \
      pk[1] = pack2(bf2f((bfr)(urs[rs][2] >> ush)) - acc[2], bf2f((bfr)(urs[rs][3] >> ush)) - acc[3]);       \
      *(u32x2*)&VbT[l15 * 72 + mt * 16 + q * 4] = pk;                                                        \
    }                                                                                                        \
    lds_barrier();                                                                                           \
    bf16x8 vb0 = *(const bf16x8*)&VbT[l15 * 72 + q * 8];                                                     \
    bf16x8 vb1 = *(const bf16x8*)&VbT[l15 * 72 + 32 + q * 8];                                                \
    if (!lo) {                                                                                               \
      acc = MFMA16(vb0, A2s[rs][0], acc);                                                                    \
      acc = MFMA16(vb1, A2s[rs][1], acc);                                                                    \
      u32x2 ok; ok[0] = pack2(acc[0], acc[1]); ok[1] = pack2(acc[2], acc[3]);                                \
      *(u32x2*)&OB[((size_t)(b * 4096 + (n) * 64) + mt * 16 + l15) * 1024 + h * 128 + slice * 16 + q * 4] = ok;  \
    }                                                                                                        \
    const float el = __shfl(elv, (n));                                                                       \
    S = S * el;                                                                                              \
    S = MFMA16(K2s[rs][0], vb0, S);                                                                          \
    S = MFMA16(K2s[rs][1], vb1, S);                                                                          \
    {                                                                                                        \
      u32x2 pk;                                                                                              \
      pk[0] = pack2(S[0], S[1]);                                                                             \
      pk[1] = pack2(S[2], S[3]);                                                                             \
      *(u32x2*)&SbT[l15 * 136 + wv * 16 + q * 4] = pk;                                                       \
    }                                                                                                        \
    if ((n) + 4 < 64) G2_GLOAD(rs, (n) + 4);                                                                 \
    lds_barrier();                                                                                           \
  }
    G2_GLOAD(0, 0);
    G2_GLOAD(1, 1);
    G2_GLOAD(2, 2);
    G2_GLOAD(3, 3);
    __syncthreads();
#pragma unroll 1
    for (int n = 0; n < 64; n += 4) {
      G2_STEP(n, 0);
      G2_STEP(n + 1, 1);
      G2_STEP(n + 2, 2);
      G2_STEP(n + 3, 3);
    }
#undef G2_GLOAD
#undef G2_STEP
  }
}

DI void gdn_g2l(const Params& p, int j, char* lds) {
  constexpr int STG = 51200;
  bfr* SbT = (bfr*)(lds + 3 * STG);
  bfr* VbT = (bfr*)(lds + 3 * STG + 4352);
  const int tid = otid(), lane = tid & 63, wv = tid >> 6, l15 = lane & 15, q = lane >> 4;
  const bfr* proj = (const bfr*)(ows(p) + O_PROJ);
  const bfr* KDT = (const bfr*)(ows(p) + O_H);
  const bfr* ATT = (const bfr*)(ows(p) + O_ATTN);
  const float* EL = (const float*)(ows(p) + O_ELAST);
  bfr* OB = (bfr*)(ows(p) + O_SCR);
  for (int unit = obid(); unit < 256; unit += gridDim.x) {
    const int xcd = unit & 7, li = unit >> 3, bh = xcd * 4 + (li >> 3), slice = li & 7;
    const int b = bh >> 3, h = bh & 7;
    const bool loader = wv >= 4;
    for (int e = tid; e < 16 * 136; e += 512) SbT[e] = 0;
    if (loader) {
      const int lw = __builtin_amdgcn_readfirstlane(wv - 4);
      const bfr* wq_u = proj + (size_t)bh * 4096 * 128;
      const bfr* kd_u = KDT + (size_t)bh * 64 * 8192;
      const int lo_wq = (lane >> 2) * 128 + (lane & 3) * 8, lo_kd = (lane >> 2) * 64 + (lane & 3) * 8;
      const bfr* u_u = proj + (size_t)2 * PLANE + (size_t)bh * 4096 * 128 + slice * 16 + (lw * 32 + (lane >> 1)) * 128 + (lane & 1) * 8;
#define G2L_DMA(c, stg)                                                                                      \
  {                                                                                                          \
    const int cc = (c) < 64 ? (c) : 63;                                                                      \
    const bfr* wq_c = wq_u + (size_t)cc * 64 * 128;                                                          \
    const bfr* kd_c = kd_u + (size_t)cc * 8192;                                                              \
    _Pragma("unroll") for (int i = 0; i < 12; ++i) {                                                         \
      const int blk = lw * 12 + i, X = blk >> 4, idx = blk & 15;                                             \
      const bfr* g = (X == 2) ? (kd_c + ((idx >> 1) * 16 * 64 + (idx & 1) * 32) + lo_kd)                     \
                              : (wq_c + (X == 0 ? (size_t)PLANE : (size_t)0) + ((idx >> 2) * 16 * 128 + (idx & 3) * 32) + lo_wq);  \
      __builtin_amdgcn_global_load_lds((const unsigned*)g, (PG8_LAS unsigned*)(lds + (stg) * STG + blk * 1024), 16, 0, 0);  \
    }                                                                                                        \
    if (lw < 2) __builtin_amdgcn_global_load_lds((const unsigned*)(u_u + (size_t)cc * 64 * 128), (PG8_LAS unsigned*)(lds + (stg) * STG + (48 + lw) * 1024), 16, 0, 0);  \
  }
#define G2L_WAITPREV() { if (lw < 2) asm volatile("s_waitcnt vmcnt(13)" ::: "memory"); else asm volatile("s_waitcnt vmcnt(12)" ::: "memory"); }
      G2L_DMA(0, 0);
      G2L_DMA(1, 1);
      G2L_WAITPREV();
      lds_barrier();
#pragma unroll 1
      for (int n = 0; n < 64; n += 3) {
#pragma unroll
        for (int s3 = 0; s3 < 3; ++s3) {
          if (n + s3 < 64) {
            G2L_DMA(n + s3 + 2, (s3 + 2) % 3);
            lds_barrier();
            G2L_WAITPREV();
            lds_barrier();
          }
        }
      }
      asm volatile("s_waitcnt vmcnt(0)" ::: "memory");
#undef G2L_DMA
#undef G2L_WAITPREV
    } else {
      const int mt = wv;
      const float elv = EL[bh * 64 + lane];
      f32x4 S0 = (f32x4){0.f, 0.f, 0.f, 0.f}, S1 = S0;
      bf16x8 At[4][2];
      const bfr* at_u = ATT + (size_t)bh * 64 * 4096 + (mt * 16 + l15) * 64 + q * 8;
#define G2L_GLOAD(set, c)                                                                                    \
  {                                                                                                          \
    const int cc = (c) < 64 ? (c) : 63;                                                                      \
    At[set][0] = *(const bf16x8*)&at_u[cc * 4096];                                                           \
    At[set][1] = *(const bf16x8*)&at_u[cc * 4096 + 32];                                                      \
  }
#define G2L_STEP(n, stg, rs)                                                                                 \
  {                                                                                                          \
    const char* sb_ = lds + (stg) * STG + l15 * 64 + q * 16;                                                 \
    f32x4 accp = (f32x4){0.f, 0.f, 0.f, 0.f}, acco = accp;                                                   \
    if ((n) > 0) {     \
      accd = MFMA16(vbd0, Atd0, accd);                                                                       \
      accd = MFMA16(vbd1, Atd1, accd);                                                                       \
      u32x2 ok; ok[0] = pack2(accd[0], accd[1]); ok[1] = pack2(accd[2], accd[3]);                            \
      *(u32x2*)&OB[((size_t)(b * 4096 + ((n) - 1) * 64) + mt * 16 + l15) * 1024 + h * 128 + slice * 16 + q * 4] = ok;  \
    }                                                                                                        \
    _Pragma("unroll") for (int ks = 0; ks < 4; ++ks) {                                                       \
      const bf16x8 sb = *(const bf16x8*)&SbT[l15 * 136 + ks * 32 + q * 8];                                   \
      accp = MFMA16(*(const bf16x8*)(sb_ + (mt * 4 + ks) * 1024), sb, accp);                                 \
      acco = MFMA16(sb, *(const bf16x8*)(sb_ + (16 + mt * 4 + ks) * 1024), acco);     \
    }                                                                                                        \
    {                                                                                                        \
      u32x2 pk;                                                                                              \
      const bfr* up_ = (const bfr*)(lds + (stg) * STG + 48 * 1024) + (mt * 16 + q * 4) * 16 + l15;           \
      pk[0] = pack2(bf2f(up_[0]) - accp[0], bf2f(up_[16]) - accp[1]);                                        \
      pk[1] = pack2(bf2f(up_[32]) - accp[2], bf2f(up_[48]) - accp[3]);                                       \
      *(u32x2*)&VbT[l15 * 72 + mt * 16 + q * 4] = pk;                                                        \
    }                                                                                                        \
    lds_barrier();                                                                                           \
    const bf16x8 vb0 = *(const bf16x8*)&VbT[l15 * 72 + q * 8];                                               \
    const bf16x8 vb1 = *(const bf16x8*)&VbT[l15 * 72 + 32 + q * 8];                                          \
    accd = acco; vbd0 = vb0; vbd1 = vb1; Atd0 = At[rs][0]; Atd1 = At[rs][1];                                 \
    const float el = __uint_as_float(__builtin_amdgcn_readlane(__float_as_uint(elv), (n)));       \
    S0 = S0 * el; S1 = S1 * el;                                                                              \
    S0 = MFMA16(*(const bf16x8*)(sb_ + (32 + (2 * mt) * 2 + 0) * 1024), vb0, S0);                            \
    S0 = MFMA16(*(const bf16x8*)(sb_ + (32 + (2 * mt) * 2 + 1) * 1024), vb1, S0);                            \
    S1 = MFMA16(*(const bf16x8*)(sb_ + (32 + (2 * mt + 1) * 2 + 0) * 1024), vb0, S1);                        \
    S1 = MFMA16(*(const bf16x8*)(sb_ + (32 + (2 * mt + 1) * 2 + 1) * 1024), vb1, S1);                        \
    {                                                                                                        \
      u32x2 pk;                                                                                              \
      pk[0] = pack2(S0[0], S0[1]); pk[1] = pack2(S0[2], S0[3]);                                              \
      *(u32x2*)&SbT[l15 * 136 + (2 * mt) * 16 + q * 4] = pk;                                                 \
      pk[0] = pack2(S1[0], S1[1]); pk[1] = pack2(S1[2], S1[3]);                                              \
      *(u32x2*)&SbT[l15 * 136 + (2 * mt + 1) * 16 + q * 4] = pk;                                             \
    }                                                                                                        \
    G2L_GLOAD(rs, (n) + 4);                                                                                  \
    lds_barrier();                                                                                           \
  }
      G2L_GLOAD(0, 0);
      G2L_GLOAD(1, 1);
      G2L_GLOAD(2, 2);
      G2L_GLOAD(3, 3);
      f32x4 accd = (f32x4){0.f, 0.f, 0.f, 0.f};
      bf16x8 vbd0 = (bf16x8){0, 0, 0, 0, 0, 0, 0, 0}, vbd1 = vbd0, Atd0 = vbd0, Atd1 = vbd0;
      lds_barrier();
#pragma unroll 1
      for (int n = 0; n < 60; n += 12) {
        G2L_STEP(n, 0, 0); G2L_STEP(n + 1, 1, 1); G2L_STEP(n + 2, 2, 2); G2L_STEP(n + 3, 0, 3);
        G2L_STEP(n + 4, 1, 0); G2L_STEP(n + 5, 2, 1); G2L_STEP(n + 6, 0, 2); G2L_STEP(n + 7, 1, 3);
        G2L_STEP(n + 8, 2, 0); G2L_STEP(n + 9, 0, 1); G2L_STEP(n + 10, 1, 2); G2L_STEP(n + 11, 2, 3);
      }
      G2L_STEP(60, 0, 0); G2L_STEP(61, 1, 1); G2L_STEP(62, 2, 2); G2L_STEP(63, 0, 3);
      {
        accd = MFMA16(vbd0, Atd0, accd);
        accd = MFMA16(vbd1, Atd1, accd);
        u32x2 ok; ok[0] = pack2(accd[0], accd[1]); ok[1] = pack2(accd[2], accd[3]);
        *(u32x2*)&OB[((size_t)(b * 4096 + 63 * 64) + mt * 16 + l15) * 1024 + h * 128 + slice * 16 + q * 4] = ok;
      }
#undef G2L_GLOAD
#undef G2L_STEP
    }
    __syncthreads();
  }
}

DI void gdn_g3(const Params& p, int j, char* lds) {
  const int tid = otid(), lane = tid & 63, wv = tid >> 6, l15 = lane & 15, q = lane >> 4;
  const bfr* proj = (const bfr*)(ows(p) + O_PROJ);
  bfr* OB = (bfr*)(ows(p) + O_SCR);
  f32x4 g0 = *(const f32x4*)&p.gdn_onorm_g[j * 128 + l15 * 8], g1 = *(const f32x4*)&p.gdn_onorm_g[j * 128 + l15 * 8 + 4];
  const int stride = gridDim.x * 32;
  int pi = (obid() * 8 + wv) * 4 + q;
  bf16x8 ov, zv;
#define G3_LOAD(pp)                                                                                                  \
  {                                                                                                                  \
    const int t_ = (pp) >> 3, h_ = (pp) & 7;                                                                         \
    ov = __builtin_nontemporal_load((const bf16x8*)&OB[(size_t)t_ * 1024 + h_ * 128 + l15 * 8]);                     \
    zv = __builtin_nontemporal_load((const bf16x8*)&proj[(size_t)3 * PLANE + (size_t)(((t_ >> 12) * 8 + h_) * 4096 + (t_ & 4095)) * 128 + l15 * 8]);  \
  }
  bf16x8 ov2 = (bf16x8){0, 0, 0, 0, 0, 0, 0, 0}, zv2 = ov2;
  if (pi < 131072) G3_LOAD(pi);
  if (pi + stride < 131072) { const bf16x8 o1 = ov, z1 = zv; G3_LOAD(pi + stride); ov2 = ov; zv2 = zv; ov = o1; zv = z1; }
  for (; pi < 131072; pi += stride) {
    const int t = pi >> 3, h = pi & 7;
    const bf16x8 oc = ov, zc = zv;
    ov = ov2; zv = zv2;
    if (pi + 2 * stride < 131072) { const bf16x8 o1 = ov, z1 = zv; G3_LOAD(pi + 2 * stride); ov2 = ov; zv2 = zv; ov = o1; zv = z1; }
    float o[8], ss = 0.f;
#pragma unroll
    for (int e = 0; e < 8; ++e) { o[e] = bfe(oc, e); ss += o[e] * o[e]; }
    ss = sum16(ss);
    const float rstd = rsqrtf(ss * (1.f / 128.f) + EPS);
    float y[8];
#pragma unroll
    for (int e = 0; e < 8; ++e) y[e] = o[e] * rstd * (e < 4 ? g0[e] : g1[e - 4]) * siluf_(bfe(zc, e));
    u32x4 pk;
    pk[0] = pack2(y[0], y[1]); pk[1] = pack2(y[2], y[3]); pk[2] = pack2(y[4], y[5]); pk[3] = pack2(y[6], y[7]);
    *(u32x4*)&OB[(size_t)t * 1024 + h * 128 + l15 * 8] = pk;
  }
#undef G3_LOAD
}


#define XB_TMO      128
#define XB_XCNT(j)  (256  + 64 * (j))
#define XB_XSUB(j)  (1280 + 64 * (j))
#define XB_XGEN(j)  (2304 + 64 * (j))
#define XB_TOP      3328
#define XB_TOPGEN   3392
#define XCD_BAR_WORDS 3456
#define XB_SPIN_CAP (1u << 18)
#define LAS __attribute__((address_space(3)))

__device__ __forceinline__ unsigned xb_ld(unsigned* p)              { return __hip_atomic_load(p, __ATOMIC_RELAXED, __HIP_MEMORY_SCOPE_AGENT); }
__device__ __forceinline__ unsigned xb_add(unsigned* p, unsigned v) { return __hip_atomic_fetch_add(p, v, __ATOMIC_RELAXED, __HIP_MEMORY_SCOPE_AGENT); }
__device__ __forceinline__ unsigned xb_xcc_id() { return (unsigned)__builtin_amdgcn_s_getreg((3 << 11) | 20) & 0xFu; }
#define XB_SPIN(cond, bar) do { unsigned _sp = 0; while (cond) { __builtin_amdgcn_s_sleep(1); \
    if ((++_sp & 255u) == 0u) { if (xb_ld(&(bar)[XB_TMO])) break; if (_sp > XB_SPIN_CAP) { atomicAdd(&(bar)[XB_TMO], 1u); break; } } } } while (0)

struct XcdBarrier {
    unsigned* bar; unsigned x;
    volatile LAS unsigned* st;
};

__device__ __forceinline__ XcdBarrier xcd_barrier_post(unsigned* bar, volatile LAS unsigned* st) {
    XcdBarrier b; b.bar = bar; b.x = xb_xcc_id(); b.st = st;
    if (threadIdx.x == 0) (void)xb_add(&bar[XB_XCNT(b.x)], 1u);
    return b;
}
__device__ __forceinline__ void xcd_barrier_complete(unsigned* bar, unsigned x, unsigned& nloc, unsigned& nx) {
    const unsigned G = gridDim.x * gridDim.y * gridDim.z;
    unsigned sum, cnt, mine, sp = 0u;
    for (;;) {
        sum = 0u; cnt = 0u; mine = 0u;
#pragma unroll
        for (unsigned j = 0; j < 16; ++j) { const unsigned c = xb_ld(&bar[XB_XCNT(j)]); sum += c; cnt += (c > 0u) ? 1u : 0u; mine = (j == x) ? c : mine; }
        if (sum == G) break;
        __builtin_amdgcn_s_sleep(1);
        if ((++sp & 255u) == 0u) { if (xb_ld(&bar[XB_TMO])) break; if (sp > XB_SPIN_CAP) { atomicAdd(&bar[XB_TMO], 1u); break; } }
    }
    nloc = mine > 0u ? mine : 1u; nx = cnt > 0u ? cnt : 1u;
}

__device__ __forceinline__ void xcd_barrier(const XcdBarrier& b) {
    asm volatile("s_waitcnt vmcnt(0)" ::: "memory");
    __syncthreads();
    if (threadIdx.x == 0) {
        unsigned* bar = b.bar;
        __builtin_amdgcn_s_waitcnt(0);
        unsigned nloc = b.st[0], nx = b.st[1];
        if (nloc == 0u) { xcd_barrier_complete(bar, b.x, nloc, nx); b.st[0] = nloc; b.st[1] = nx; }
        const unsigned old = xb_add(&bar[XB_XSUB(b.x)], 1u);
        const unsigned gen = old / nloc;
        if (old + 1u == (gen + 1u) * nloc) {
            __builtin_amdgcn_fence(__ATOMIC_RELEASE, "agent");
            asm volatile("s_waitcnt vmcnt(0)" ::: "memory");
            const unsigned og = xb_add(&bar[XB_TOP], 1u);
            const unsigned tg = og / nx;
            if (og + 1u == (tg + 1u) * nx) xb_add(&bar[XB_TOPGEN], 1u);
            else XB_SPIN(xb_ld(&bar[XB_TOPGEN]) == tg, bar);
            __builtin_amdgcn_fence(__ATOMIC_ACQUIRE, "agent");
            xb_add(&bar[XB_XGEN(b.x)], 1u);
            asm volatile("s_waitcnt vmcnt(0)" ::: "memory");
        } else {
            XB_SPIN(xb_ld(&bar[XB_XGEN(b.x)]) == gen, bar);
            __builtin_amdgcn_fence(__ATOMIC_ACQUIRE, "agent");
            asm volatile("s_waitcnt vmcnt(0)" ::: "memory");
        }
    }
    __syncthreads();
}


DI void run_phase(const Params& p, int ph, char* lds) {
  if (ph == 0) { phase0(p, lds); return; }
  if (ph == NPHASE - 1) { norm_phase(p, 4, ows(p) + O_H, lds); return; }
  int layer, sub;
  if (ph < 5) { layer = 0; sub = ph - 1; }
  else if (ph < 11) { layer = 1; sub = ph - 5; }
  else if (ph < 15) { layer = 2; sub = ph - 11; }
  else { layer = 3; sub = ph - 15; }
  const int j = layer >> 1;
  const bool is_lru = (layer & 1) == 0;
  const bfr* H = (const bfr*)(ows(p) + O_H);
  const void* xcur = (layer == 0) ? (const void*)p.x : (const void*)p.out;
  bfr* xnext = (layer == 3) ? (bfr*)(ows(p) + O_H) : (bfr*)p.out;
  if (is_lru) {
    switch (sub) {
      case 0: norm_phase(p, layer, xcur, lds); break;
      case 1: gemm_phase<0>(p, H, 1024, (const bfr*)(ows(p) + O_WLI) + (size_t)j * 2048 * 1024, 8, layer, nullptr, nullptr, lds); break;
      case 2: lru_phase(p, j, lds); break;
      case 3: gemm_phase<2>(p, H, 1024, (const bfr*)(ows(p) + O_WLO) + (size_t)j * 1024 * 1024, 4, layer, xcur, xnext, lds); break;
    }
  } else {
    switch (sub) {
      case 0: norm_phase(p, layer, xcur, lds); break;
      case 1: gemm_phase<1>(p, H, 1024, (const bfr*)(ows(p) + O_WGI) + (size_t)j * 4224 * 1024, 16, layer, nullptr, nullptr, lds); break;
      case 2: gdn_g1(p, j, lds); break;
#if G2_LOADER
      case 3: gdn_g2l(p, j, lds); break;
#else
      case 3: gdn_g2(p, j, lds); break;
#endif
      case 4: gdn_g3(p, j, lds); break;
      case 5: gemm_phase<2>(p, (const bfr*)(ows(p) + O_SCR), 1024, (const bfr*)(ows(p) + O_WGO) + (size_t)j * 1024 * 1024, 4, layer, xcur, xnext, lds); break;
    }
  }
}

__global__ void __launch_bounds__(512) mega_fwd(Params p) {
  extern __shared__ __attribute__((aligned(16))) char lds[];
#if MK_MODE == 1
  cg::grid_group grid = cg::this_grid();
  if (p.ph_lo < 0) grid.sync();
  volatile LAS unsigned* bst = (volatile LAS unsigned*)(lds + LDS_BYTES - 16);
  if (threadIdx.x == 0) { bst[0] = 0u; bst[1] = 0u; }
  __syncthreads();
  const XcdBarrier xb = xcd_barrier_post((unsigned*)(p.ws + O_BAR), bst);
  for (int ph = p.ph_lo; ph < p.ph_hi; ++ph) {
    if (ph > p.ph_lo) xcd_barrier(xb);
#ifdef PROBE_MASK
    const bool probe = (PROBE_MASK >> ph) & 1;
    long long ts = 0;
    if (probe) ts = wall_clock64();
#endif
    run_phase(p, ph, lds);
#ifdef PROBE_MASK
    if (probe) {
      xcd_barrier(xb);
      if (blockIdx.x == 0 && threadIdx.x == 0) {
        long long dt = wall_clock64() - ts, t1 = wall_clock64();
        while (wall_clock64() - t1 < dt) __builtin_amdgcn_s_sleep(8);
      }
    }
#endif
  }
#else
  for (int ph = p.ph_lo; ph < p.ph_hi; ++ph) run_phase(p, ph, lds);
#endif
}

extern "C" void kernel_launch(void* const* d_in, const int* in_sizes, int n_in, void* d_out, int out_size, void* d_ws, size_t ws_size, hipStream_t stream) {
  static int grid = 0;
  if (grid == 0) {
    if (n_in != 19 || ws_size < WS_END) { fprintf(stderr, "kernel_launch: unexpected inputs (n_in %d, ws %zu)\n", n_in, ws_size); grid = -1; return; }
    int dev = 0, cus = 0, per_cu = 0;
    hipGetDevice(&dev);
    hipDeviceGetAttribute(&cus, hipDeviceAttributeMultiprocessorCount, dev);
    if (hipFuncSetAttribute((const void*)mega_fwd, hipFuncAttributeMaxDynamicSharedMemorySize, LDS_BYTES) != hipSuccess) { fprintf(stderr, "kernel_launch: hipFuncSetAttribute failed\n"); grid = -1; return; }
    hipOccupancyMaxActiveBlocksPerMultiprocessor(&per_cu, (const void*)mega_fwd, 512, LDS_BYTES);
    if (per_cu < 1) { fprintf(stderr, "kernel_launch: occupancy query returned %d\n", per_cu); per_cu = 1; }
    (void)hipGetLastError();
    grid = cus * per_cu;
    if (grid > 256) grid = 256;
  }
  if (grid < 0) return;
  Params p{};
  const float** pp = (const float**)&p;
  for (int i = 0; i < 19; ++i) pp[i] = (const float*)d_in[i];
  p.out = (float*)d_out;
  p.ws = (char*)d_ws;
#if MK_MODE == 1
  p.ph_lo = 0; p.ph_hi = NPHASE;
  if (hipMemsetAsync((char*)d_ws + O_BAR, 0, 16384, stream) != hipSuccess) { fprintf(stderr, "kernel_launch: memset of barrier words failed\n"); return; }
  void* args[] = {&p};
  hipError_t e = hipLaunchCooperativeKernel((const void*)mega_fwd, dim3(grid), dim3(512), args, LDS_BYTES, stream);
  if (e != hipSuccess) fprintf(stderr, "cooperative launch failed: %s (grid %d)\n", hipGetErrorString(e), grid);
#else
  for (int ph = 0; ph < NPHASE; ++ph) {
    p.ph_lo = ph; p.ph_hi = ph + 1;
    hipLaunchKernelGGL(mega_fwd, dim3(grid), dim3(512), LDS_BYTES, stream, p);
  }
#endif
}
```
